# Optimizing an MI355X kernel written in HIP

```python
import math
import jax, jax.numpy as jnp
from jax import lax
import numpy as np

D_MODEL = 2048
BATCH = 4
SEQ = 4096
DEPTH = 1

CHUNK = 64
Q_BLOCK = 128
HEAD_DIM = 128
MIX_WIDTH = D_MODEL
DIFF_WIDTH = MIX_WIDTH // 2
FOX_WIDTH = MIX_WIDTH - DIFF_WIDTH
DIFF_HEADS = DIFF_WIDTH // (2 * HEAD_DIM)
FOX_HEADS = FOX_WIDTH // HEAD_DIM
IN_COLS = 3 * DIFF_WIDTH + 3 * FOX_WIDTH + FOX_HEADS
ROPE_THETA = 10000.0
NORM_EPS = 1e-5
NEG_INF = -1e30
N_EXPERTS = 32
TOP_K = 4
D_EXPERT = D_MODEL
SWIGLU_LIMIT = 7.0
SWIGLU_ALPHA = 1.702
EXPERT_BLOCK = 256

kernel_name = "hybrid_diff_fox_moe_block"


def _lambda_init(layer_idx):
    return 0.8 - 0.6 * math.exp(-0.3 * layer_idx)


def _rms_norm(x, gain):
    xf = x.astype(jnp.float32)
    y = xf * lax.rsqrt(jnp.mean(xf * xf, axis=-1, keepdims=True) + NORM_EPS)
    return (y * gain.astype(jnp.float32)).astype(x.dtype)


def _rope_tables(positions):
    inv_freq = ROPE_THETA ** (-jnp.arange(0, HEAD_DIM, 2, dtype=jnp.float32) / HEAD_DIM)
    ang = positions.astype(jnp.float32)[..., None] * inv_freq
    ang = jnp.concatenate([ang, ang], axis=-1)[:, :, None, :]
    return jnp.cos(ang), jnp.sin(ang)


def _apply_rope(x, cos, sin):
    xf = x.astype(jnp.float32)
    x1, x2 = jnp.split(xf, 2, axis=-1)
    rot = jnp.concatenate([-x2, x1], axis=-1)
    return (xf * cos + rot * sin).astype(x.dtype)


def _sweep_queries(block_fn, *per_query):
    n_qb = per_query[0].shape[1] // Q_BLOCK

    def split(a):
        a = a.reshape(a.shape[0], n_qb, Q_BLOCK, *a.shape[2:])
        return jnp.moveaxis(a, 1, 0)

    out = lax.map(block_fn, (jnp.arange(n_qb), *[split(a) for a in per_query]))
    out = jnp.moveaxis(out, 0, 1)
    return out.reshape(out.shape[0], n_qb * Q_BLOCK, *out.shape[3:])


def _diff_attention(q1, q2, k1, k2, v, lam):
    seq = k1.shape[1]
    scale = HEAD_DIM ** -0.5
    key_chunk = jnp.arange(seq) // CHUNK

    def block(args):
        i, q1b, q2b = args
        q_chunk = (i * Q_BLOCK + jnp.arange(Q_BLOCK)) // CHUNK
        mask = key_chunk[None, :] <= q_chunk[:, None]

        def probs(qb, k):
            s = jnp.einsum('bqhd,bkhd->bhqk', qb, k, preferred_element_type=jnp.float32) * scale
            return jax.nn.softmax(jnp.where(mask, s, NEG_INF), axis=-1)

        w = probs(q1b, k1) - lam * probs(q2b, k2)
        return jnp.einsum('bhqk,bkhv->bqhv', w.astype(v.dtype), v,
                          preferred_element_type=jnp.float32).astype(v.dtype)

    return _sweep_queries(block, q1, q2)


def _forgetting_attention(q, k, v, cum_log_f):
    seq = k.shape[1]
    scale = HEAD_DIM ** -0.5
    key_pos = jnp.arange(seq)
    cum_keys = jnp.transpose(cum_log_f, (0, 2, 1))

    def block(args):
        i, qb, cb = args
        q_pos = i * Q_BLOCK + jnp.arange(Q_BLOCK)
        mask = key_pos[None, :] <= q_pos[:, None]
        s = jnp.einsum('bqhd,bkhd->bhqk', qb, k, preferred_element_type=jnp.float32) * scale
        s = s + jnp.transpose(cb, (0, 2, 1))[..., :, None] - cum_keys[..., None, :]
        p = jax.nn.softmax(jnp.where(mask, s, NEG_INF), axis=-1)
        return jnp.einsum('bhqk,bkhv->bqhv', p.astype(v.dtype), v,
                          preferred_element_type=jnp.float32).astype(v.dtype)

    return _sweep_queries(block, q, cum_log_f)


def _moe(xt, w_router, b_router, w_gate, b_gate, w_up, b_up, w_down, b_down):
    n_tok, d = xt.shape
    logits = jnp.dot(xt, w_router, preferred_element_type=jnp.float32) + b_router.astype(jnp.float32)
    top_vals, top_idx = lax.top_k(logits, TOP_K)
    gates = jax.nn.softmax(top_vals, axis=-1)

    n_assign = n_tok * TOP_K
    e_flat = top_idx.reshape(-1)
    tok_flat = jnp.repeat(jnp.arange(n_tok, dtype=jnp.int32), TOP_K)
    g_flat = gates.reshape(-1)
    order = jnp.argsort(e_flat)
    e_sorted = e_flat[order]
    tok_sorted = tok_flat[order]
    g_sorted = g_flat[order]

    counts = jnp.bincount(e_flat, length=N_EXPERTS)
    starts = jnp.cumsum(counts) - counts
    padded = (counts + EXPERT_BLOCK - 1) // EXPERT_BLOCK * EXPERT_BLOCK
    pad_ends = jnp.cumsum(padded)
    pad_starts = pad_ends - padded
    dest = pad_starts[e_sorted] + (jnp.arange(n_assign) - starts[e_sorted])

    n_blocks = -(-n_assign // EXPERT_BLOCK) + N_EXPERTS
    rows = n_blocks * EXPERT_BLOCK
    xs = jnp.zeros((rows, d), xt.dtype).at[dest].set(xt[tok_sorted])
    block_expert = jnp.minimum(
        jnp.searchsorted(pad_ends, jnp.arange(n_blocks) * EXPERT_BLOCK, side='right'), N_EXPERTS - 1)

    def expert_block(args):
        xb, e = args
        g = xb @ w_gate[e] + b_gate[e]
        u = xb @ w_up[e] + b_up[e]
        g = jnp.minimum(g, SWIGLU_LIMIT)
        u = jnp.clip(u, -SWIGLU_LIMIT, SWIGLU_LIMIT)
        hdn = g * jax.nn.sigmoid(SWIGLU_ALPHA * g) * (u + 1.0)
        return hdn @ w_down[e] + b_down[e]

    ys = lax.map(expert_block, (xs.reshape(n_blocks, EXPERT_BLOCK, d), block_expert)).reshape(rows, d)
    y_assign = ys[dest] * g_sorted[:, None].astype(ys.dtype)
    return jax.ops.segment_sum(y_assign, tok_sorted, num_segments=n_tok)


def setup_inputs(seed: int = 0) -> dict:
    key = jax.random.key(seed)
    ks = jax.random.split(key, 24)
    f32 = jnp.float32

    def nrm(k, shape, scale):
        return jax.random.normal(k, shape, f32) * scale

    def gain(k, shape):
        return 1.0 + 0.02 * jax.random.normal(k, shape, f32)

    x = jax.random.normal(ks[0], (BATCH, SEQ, D_MODEL), f32)
    offset = jax.random.randint(ks[1], (BATCH, 1), 0, 1024, dtype=jnp.int32)
    positions = (offset + jnp.arange(SEQ, dtype=jnp.int32)[None, :]).astype(jnp.int32)
    return {
        'x': x,
        'positions': positions,
        'g_attn_norm': gain(ks[2], (DEPTH, D_MODEL)),
        'w_in': nrm(ks[3], (DEPTH, D_MODEL, IN_COLS), D_MODEL ** -0.5),
        'b_forget': 1.0 + 0.1 * jax.random.normal(ks[4], (DEPTH, FOX_HEADS), f32),
        'lambda_q1': nrm(ks[5], (DEPTH, HEAD_DIM), 0.1),
        'lambda_k1': nrm(ks[6], (DEPTH, HEAD_DIM), 0.1),
        'lambda_q2': nrm(ks[7], (DEPTH, HEAD_DIM), 0.1),
        'lambda_k2': nrm(ks[8], (DEPTH, HEAD_DIM), 0.1),
        'g_diff_sub': gain(ks[9], (DEPTH, 2 * HEAD_DIM)),
        'g_fox_out': gain(ks[10], (DEPTH, HEAD_DIM)),
        'w_out': nrm(ks[11], (DEPTH, MIX_WIDTH, D_MODEL), MIX_WIDTH ** -0.5),
        'g_ffn_norm': gain(ks[12], (DEPTH, D_MODEL)),
        'w_router': nrm(ks[13], (DEPTH, D_MODEL, N_EXPERTS), D_MODEL ** -0.5),
        'b_router': nrm(ks[14], (DEPTH, N_EXPERTS), 0.01),
        'w_gate': nrm(ks[15], (DEPTH, N_EXPERTS, D_MODEL, D_EXPERT), D_MODEL ** -0.5),
        'b_gate': nrm(ks[16], (DEPTH, N_EXPERTS, D_EXPERT), 0.01),
        'w_up': nrm(ks[17], (DEPTH, N_EXPERTS, D_MODEL, D_EXPERT), D_MODEL ** -0.5),
        'b_up': nrm(ks[18], (DEPTH, N_EXPERTS, D_EXPERT), 0.01),
        'w_down': nrm(ks[19], (DEPTH, N_EXPERTS, D_EXPERT, D_MODEL), D_EXPERT ** -0.5),
        'b_down': nrm(ks[20], (DEPTH, N_EXPERTS, D_MODEL), 0.01),
        'g_final': gain(ks[21], (D_MODEL,)),
    }


def reference(x, positions, g_attn_norm, w_in, b_forget, lambda_q1, lambda_k1, lambda_q2, lambda_k2,
              g_diff_sub, g_fox_out, w_out, g_ffn_norm, w_router, b_router, w_gate, b_gate,
              w_up, b_up, w_down, b_down, g_final):
    bsz, seq, _ = x.shape
    cos, sin = _rope_tables(positions)
    split_at = [DIFF_WIDTH * i for i in range(1, 4)] + [3 * DIFF_WIDTH + FOX_WIDTH * i for i in range(1, 4)]

    for l in range(DEPTH):
        lam_init = _lambda_init(l)
        xn = _rms_norm(x, g_attn_norm[l])
        proj = xn @ w_in[l]
        dq, dk, dv, fq, fk, fv, f_logit = jnp.split(proj, split_at, axis=-1)

        dq = dq.reshape(bsz, seq, DIFF_HEADS, 2, HEAD_DIM)
        dk = dk.reshape(bsz, seq, DIFF_HEADS, 2, HEAD_DIM)
        q1 = _apply_rope(dq[..., 0, :], cos, sin)
        q2 = _apply_rope(dq[..., 1, :], cos, sin)
        k1 = _apply_rope(dk[..., 0, :], cos, sin)
        k2 = _apply_rope(dk[..., 1, :], cos, sin)
        dv = dv.reshape(bsz, seq, DIFF_HEADS, 2 * HEAD_DIM)
        lam = (jnp.exp(jnp.sum(lambda_q1[l].astype(jnp.float32) * lambda_k1[l].astype(jnp.float32)))
               - jnp.exp(jnp.sum(lambda_q2[l].astype(jnp.float32) * lambda_k2[l].astype(jnp.float32)))
               + lam_init)
        od = _diff_attention(q1, q2, k1, k2, dv, lam)
        od = _rms_norm(od, g_diff_sub[l]) * (1.0 - lam_init)

        fq = fq.reshape(bsz, seq, FOX_HEADS, HEAD_DIM)
        fk = fk.reshape(bsz, seq, FOX_HEADS, HEAD_DIM)
        fv = fv.reshape(bsz, seq, FOX_HEADS, HEAD_DIM)
        log_f = jax.nn.log_sigmoid(f_logit.astype(jnp.float32) + b_forget[l].astype(jnp.float32))
        cum_log_f = jnp.cumsum(log_f, axis=1)
        of = _forgetting_attention(fq, fk, fv, cum_log_f)
        of = _rms_norm(of, g_fox_out[l])

        mix = jnp.concatenate([od.reshape(bsz, seq, DIFF_WIDTH), of.reshape(bsz, seq, FOX_WIDTH)], axis=-1)
        h = x + mix @ w_out[l]

        hn = _rms_norm(h, g_ffn_norm[l]).reshape(bsz * seq, D_MODEL)
        moe_out = _moe(hn, w_router[l], b_router[l], w_gate[l], b_gate[l], w_up[l], b_up[l],
                       w_down[l], b_down[l])
        x = h + moe_out.reshape(bsz, seq, D_MODEL).astype(h.dtype)

    return _rms_norm(x, g_final)
```

```cpp
#include <hip/hip_runtime.h>
#include <cstdio>
#include <cstdint>

#define LAS __attribute__((address_space(3)))
#define GAS __attribute__((address_space(1)))
typedef unsigned short bf16_t;
typedef short bf16x8 __attribute__((ext_vector_type(8)));
typedef short s16x4 __attribute__((ext_vector_type(4)));
typedef float f32x4 __attribute__((ext_vector_type(4)));
typedef float f32x2 __attribute__((ext_vector_type(2)));
typedef float f32x16 __attribute__((ext_vector_type(16)));
typedef unsigned u32x4 __attribute__((ext_vector_type(4)));
typedef unsigned u32x2 __attribute__((ext_vector_type(2)));
typedef int v4i_t __attribute__((ext_vector_type(4)));
typedef int v8i_t __attribute__((ext_vector_type(8)));

constexpr int DM = 2048, BATCH = 4, SEQ = 4096, MTOK = BATCH * SEQ, INC = 6152, NQKV = 6144, NE = 32, TOPK = 4, ECAP = 16384;
constexpr float EPS = 1e-5f, L2E = 1.4426950408889634f, QSCALE = 0.08838834764831845f * 1.4426950408889634f;
constexpr int NWAVES = 8, NTHREADS = 512;
constexpr size_t MiB = 1u << 20;
constexpr size_t WS_CTL = 0, CTL_ZERO_BYTES = 1 * MiB;
constexpr size_t WS_GWF = 2 * MiB;
constexpr size_t WS_CLOG = 3 * MiB;
constexpr size_t WS_FLOG = 4 * MiB;
constexpr size_t WS_TKE = 5 * MiB;
constexpr size_t WS_TOK = 6 * MiB;
constexpr size_t WS_RSTD = 8 * MiB;
constexpr size_t WS_GATE = 10 * MiB;
constexpr size_t WS_ROPE = 12 * MiB;
constexpr size_t WS_WIN = 20 * MiB;
constexpr size_t WS_WOUT = 44 * MiB;
constexpr size_t WS_TSTART = 52 * MiB;
constexpr size_t WS_WGU = 64 * MiB;
constexpr size_t WS_WD = 576 * MiB;
constexpr size_t WS_XN = 832 * MiB;
constexpr size_t WS_QKV = 896 * MiB;
constexpr size_t WS_O = 1088 * MiB;
constexpr size_t WS_MIX = 1184 * MiB;
constexpr size_t WS_HG = 1248 * MiB;
constexpr size_t WS_HDN = 1312 * MiB;
constexpr size_t WS_YS = 1600 * MiB;
constexpr size_t WS_END = 1888 * MiB;
constexpr int CW_TMO = 0, CW_BAR = 4096, CW_CNT = 8192;
constexpr int CW_QMAX = 12288, CW_KMAX = 12800;
constexpr float FOX_SKIP_T = 30.0f;
constexpr int RING_BYTES = 131072;
constexpr int LDS_IDX = RING_BYTES;
constexpr int LDS_TAB = RING_BYTES + 1024;
constexpr int LDS_MISC = RING_BYTES + 1024 + 512;
constexpr int LDS_BYTES = 147456;

__device__ __forceinline__ unsigned f2bf(float f) { unsigned u = __builtin_bit_cast(unsigned, f); return (u + 0x7fffu + ((u >> 16) & 1u)) >> 16; }
__device__ __forceinline__ unsigned pk2(float lo, float hi) { return f2bf(lo) | (f2bf(hi) << 16); }
__device__ __forceinline__ float bf2f(unsigned short b) { return __builtin_bit_cast(float, (unsigned)b << 16); }
__device__ __forceinline__ unsigned cvt_pk_bf16(float lo, float hi) { unsigned r; asm volatile("v_cvt_pk_bf16_f32 %0, %1, %2" : "=v"(r) : "v"(lo), "v"(hi)); return r; }
__device__ __forceinline__ float wave_sum(float v) {
#pragma unroll
    for (int o = 1; o < 64; o <<= 1) v += __shfl_xor(v, o);
    return v;
}

__device__ __forceinline__ void glds16s(const char* sbase, unsigned voff, unsigned lds_dst) { unsigned keep;
    asm volatile("s_mov_b32 %0, m0\n\ts_mov_b32 m0, %3\n\ts_nop 0\n\tglobal_load_lds_dwordx4 %1, %2\n\ts_mov_b32 m0, %0" : "=&s"(keep) : "v"(voff), "s"(sbase), "s"(lds_dst) : "memory"); }
__device__ __forceinline__ void glds4s(const char* sbase, unsigned voff, unsigned lds_dst) { unsigned keep;
    asm volatile("s_mov_b32 %0, m0\n\ts_mov_b32 m0, %3\n\ts_nop 0\n\tglobal_load_lds_dword %1, %2\n\ts_mov_b32 m0, %0" : "=&s"(keep) : "v"(voff), "s"(sbase), "s"(lds_dst) : "memory"); }
__device__ __forceinline__ const char* uni_ptr(const char* p) { const unsigned long long v = (unsigned long long)p;
    const unsigned lo = (unsigned)__builtin_amdgcn_readfirstlane((int)(unsigned)v), hi = (unsigned)__builtin_amdgcn_readfirstlane((int)(unsigned)(v >> 32)); return (const char*)(((unsigned long long)hi << 32) | lo); }

#ifndef MK_DMA_FIRST
#define MK_DMA_FIRST 1
#endif
#ifndef MK_EPI_LDS
#define MK_EPI_LDS 1
#endif
namespace pg8 {
constexpr int BM = 256, BK = 64, HALF = 128, HTB = HALF * BK * 2, STAGE_BYTES = 8 * HTB, NXCD = 8, WGM = 8;
__host__ __device__ __forceinline__ int lds_byte(int r, int c) { const int st = (r >> 4) * 2 + (c >> 5), rr = r & 15, cc = c & 31, ob = rr * 64 + cc * 2; return st * 1024 + (ob ^ (((ob >> 9) & 1) << 5)); }
__host__ __device__ __forceinline__ void stage_rc(int b, int& R, int& C) { const int st = b / 1024, sb = b % 1024, swz = sb ^ (((sb >> 9) & 1) << 5); R = (st >> 1) * 16 + swz / 64; C = (st & 1) * 32 + (swz % 64) / 2; }
__host__ __device__ __forceinline__ int perm32(int rho) { const int n = rho >> 4, i = rho & 15; return 8 * (i >> 2) + 4 * n + (i & 3); }

struct Unit { int pm, pn, e, rows0; };

struct DenseOrder {
    const bf16_t* A; const bf16_t* Bt; int RB; int nM, nN, nwg, G, c; int rot = 0;
    __device__ void init(const bf16_t* A_, const bf16_t* Bt_, int M, int N, int RB_, int G_, int c_) { A = A_; Bt = Bt_; RB = RB_; nM = M / BM; nN = N / BM; nwg = nM * nN; G = G_; c = c_; }
    __device__ __forceinline__ bool next(int i, Unit& u) const {
        const long L = (long)i * G + c; if (L >= nwg) return false;
        int wgid = (int)L; { const int q = nwg / NXCD, r = nwg % NXCD, xcd = wgid % NXCD, off = wgid / NXCD; wgid = (xcd < r ? xcd * (q + 1) : r * (q + 1) + (xcd - r) * q) + off; }
        const int nig = WGM * nN, gid = wgid / nig, fm = gid * WGM, gsz = (nM - fm) < WGM ? (nM - fm) : WGM;
        u.pm = fm + ((wgid % nig) % gsz); u.pn = (wgid % nig) / gsz; u.e = 0; u.rows0 = 0; return true;
    }
    __device__ __forceinline__ const char* a_base(const Unit& u) const { return (const char*)A + (size_t)u.pm * BM * RB; }
    __device__ __forceinline__ const char* b_base(const Unit& u) const { return (const char*)Bt + (size_t)u.pn * BM * RB; }
};
struct MoeOrder {
    const float* rowsc = nullptr;
    const void* A; const void* Bt; int RB; int nN; int NperE; int G, c; int rot; const LAS int* tab; const int* tok;
    __device__ __forceinline__ bool next(int i, Unit& u) const {
        const int T = __builtin_amdgcn_readfirstlane(tab[NE]);
        int t;
        if (G == 256) {
            const int x = c & 7, j = c >> 3, XP = nN >> 3, tpr = 256 / nN;
            t = i * tpr + (x / XP) * 4 + (j & 3); u.pn = (x % XP) * 8 + (j >> 2);
            if (t >= T) return false;
        } else {
            const int L = i * G + c; if (L >= T * nN) return false;
            t = L / nN; u.pn = L - t * nN;
        }
        u.pm = t;
        int e; { const int ln = (int)(threadIdx.x & 63); const int tv = tab[ln & 31];
                 e = (int)__popcll(__ballot(ln < NE && tv <= t)) - 1; }
        u.e = e; u.rows0 = __builtin_amdgcn_readfirstlane((t - tab[e]) * BM); return true;
    }
    __device__ __forceinline__ int cnt_of(const Unit& u) const { return __builtin_amdgcn_readfirstlane(tab[NE + 1 + u.e]); }
    __device__ __forceinline__ const char* a_base(const Unit& u) const { return (const char*)A; }
    __device__ __forceinline__ const char* a_base_dense(const Unit& u) const { return (const char*)A + (size_t)u.pm * BM * RB; }
    __device__ __forceinline__ const char* b_base(const Unit& u) const { return (const char*)Bt + ((size_t)u.e * NperE + (size_t)u.pn * BM) * RB; }
};
struct MoeOrderDense : MoeOrder {
    __device__ __forceinline__ const char* a_base(const Unit& u) const { return a_base_dense(u); }
};

template <class Epi, class Sched, bool GATHER, bool FP8 = false, int SCW = 127, int SCA = 127, int KREP = 1, bool FP6 = false, bool BAL = false>
__device__ __forceinline__ void gemm_phase(LAS unsigned char* lds, LAS unsigned char* lds_idx, const int RB, const Sched& S, const Epi& E) {
    const int tid = threadIdx.x, wid = __builtin_amdgcn_readfirstlane(tid >> 6), lane = tid & 63, wr = wid >> 2, wc = wid & 3, fr = lane & 15, fq = lane >> 4;
    const int nt = (RB / 128) * KREP;
    unsigned voffA[2], voffB[2]; int RA[2], CA2[2];
#pragma unroll
    for (int i = 0; i < 2; ++i) { int R, C; stage_rc(tid * 16 + i * 8192, R, C); const int Rb = (R & ~31) + perm32(R & 31);
        voffA[i] = (unsigned)(R * RB + C * 2); voffB[i] = (unsigned)(Rb * RB + C * 2); RA[i] = R; CA2[i] = C * 2; }
    const int rot = S.rot, ntm = RB / 128 - 1;
#define PG8_KOFF(t) ((size_t)((((t) + rot) & ntm) * 128))
    const size_t hstep = (size_t)HALF * RB;
    const unsigned ldsw = (unsigned)wid * 1024u;
    const unsigned ldsb = (unsigned)__builtin_amdgcn_readfirstlane((int)(unsigned)(uintptr_t)lds);
    const int aoff = lds_byte(wr * 64 + fr, fq * 8), boff = lds_byte(wc * 32 + fr, fq * 8);
#define PG8_SA(b, h) (((b) * 2 + (h)) * HTB)
#define PG8_SB(b, h) ((4 + (b) * 2 + (h)) * HTB)
#define PG8_GL(bufoff, gptr, v0, v1) do { const char* gp_ = uni_ptr((const char*)(gptr)); \
        glds16s(gp_, (v0), ldsb + (unsigned)(bufoff) + ldsw); glds16s(gp_, (v1), ldsb + (unsigned)(bufoff) + ldsw + 8192u); } while (0)
#define PG8_STAGE_B(bufoff, gbase) PG8_GL(bufoff, gbase, voffB[0], voffB[1])
#define PG8_STAGE_A(bufoff, gbase, h, V) do { if constexpr (GATHER) { PG8_GL(bufoff, gbase, V[h][0], V[h][1]); } else { PG8_GL(bufoff, (gbase) + (h) * hstep, voffA[0], voffA[1]); } } while (0)
#define PG8_LDA(dst, b, h) do { _Pragma("unroll") for (int m = 0; m < 4; ++m) _Pragma("unroll") for (int k = 0; k < 2; ++k) dst[m][k] = *(const LAS bf16x8*)(lds + PG8_SA(b, h) + aoff + m * 2048 + k * 1024); } while (0)
#define PG8_LDB(dst, b, h) do { _Pragma("unroll") for (int n = 0; n < 2; ++n) _Pragma("unroll") for (int k = 0; k < 2; ++k) dst[n][k] = *(const LAS bf16x8*)(lds + PG8_SB(b, h) + boff + n * 2048 + k * 1024); } while (0)
#define PG8_CAT(x, y) __builtin_shufflevector(__builtin_bit_cast(v4i_t, x), __builtin_bit_cast(v4i_t, y), 0, 1, 2, 3, 4, 5, 6, 7)
#define PG8_MMA(ai, bj, At, Bt) do { __builtin_amdgcn_s_setprio(1); _Pragma("unroll") for (int m = 0; m < 4; ++m) _Pragma("unroll") for (int n = 0; n < 2; ++n) { \
        if constexpr (FP6) { acc[ai][bj][m][n] = __builtin_amdgcn_mfma_scale_f32_16x16x128_f8f6f4(PG8_CAT(Bt[n][0], Bt[n][1]), PG8_CAT(At[m][0], At[m][1]), acc[ai][bj][m][n], 2, 2, 0, __builtin_bit_cast(v4i_t, Bt[n][1])[2], 0, __builtin_bit_cast(v4i_t, At[m][1])[2]); } \
        else if constexpr (FP8) { acc[ai][bj][m][n] = __builtin_amdgcn_mfma_scale_f32_16x16x128_f8f6f4(PG8_CAT(Bt[n][0], Bt[n][1]), PG8_CAT(At[m][0], At[m][1]), acc[ai][bj][m][n], 0, 0, 0, (SCW | (SCA << 8)), 1, (SCW | (SCA << 8))); }     \
        else { _Pragma("unroll") for (int k = 0; k < 2; ++k) acc[ai][bj][m][n] = __builtin_amdgcn_mfma_f32_16x16x32_bf16(Bt[n][k], At[m][k], acc[ai][bj][m][n], 0, 0, 0); } } \
        __builtin_amdgcn_s_setprio(0); } while (0)
#define PG8_WAIT_V(n) asm volatile("s_waitcnt vmcnt(" #n ")" ::: "memory")
#define PG8_WAIT_L(n) asm volatile("s_waitcnt lgkmcnt(" #n ")" ::: "memory")
#define PG8_BAR __builtin_amdgcn_s_barrier()
#define PG8_SCHED __builtin_amdgcn_sched_barrier(0)
    Unit cur, nxt; int ui = 0;
    if (!S.next(0, cur)) return;
    f32x4 acc[2][2][4][2];
#pragma unroll
    for (int a = 0; a < 2; ++a)
#pragma unroll
        for (int b = 0; b < 2; ++b)
#pragma unroll
            for (int m = 0; m < 4; ++m)
#pragma unroll
                for (int n = 0; n < 2; ++n) acc[a][b][m][n] = (f32x4){0.f, 0.f, 0.f, 0.f};
    bf16x8 At[4][2], B0[2][2], B1[2][2];
    unsigned VC[2][2];
    if constexpr (GATHER) {
        const int cnt = S.cnt_of(cur);
#pragma unroll
        for (int h = 0; h < 2; ++h)
#pragma unroll
            for (int i = 0; i < 2; ++i) { const int pos = cur.rows0 + h * HALF + RA[i]; int tk = S.tok[(size_t)cur.e * ECAP + pos]; tk = pos < cnt ? tk : 0; VC[h][i] = (unsigned)tk * (unsigned)RB + (unsigned)CA2[i]; }
    } else {
#pragma unroll
        for (int h = 0; h < 2; ++h)
#pragma unroll
            for (int i = 0; i < 2; ++i) VC[h][i] = 0u;
    }
    const char* cA = S.a_base(cur); const char* cB = S.b_base(cur);
    PG8_STAGE_B(PG8_SB(0, 0), cB + PG8_KOFF(0)); PG8_STAGE_B(PG8_SB(0, 1), cB + hstep + PG8_KOFF(0)); PG8_STAGE_A(PG8_SA(0, 0), cA + PG8_KOFF(0), 0, VC); PG8_STAGE_A(PG8_SA(0, 1), cA + PG8_KOFF(0), 1, VC);
    if (wr == 1) PG8_BAR;
    PG8_WAIT_V(2); PG8_BAR;
    if constexpr (BAL) { PG8_STAGE_B(PG8_SB(1, 0), cB + PG8_KOFF(1)); PG8_STAGE_B(PG8_SB(1, 1), cB + hstep + PG8_KOFF(1)); PG8_WAIT_V(4); PG8_BAR; }
    else { PG8_STAGE_B(PG8_SB(1, 0), cB + PG8_KOFF(1)); PG8_STAGE_A(PG8_SA(1, 0), cA + PG8_KOFF(1), 0, VC); PG8_STAGE_B(PG8_SB(1, 1), cB + hstep + PG8_KOFF(1));
    PG8_WAIT_V(6); PG8_BAR; }
    for (;;) {
        const bool has_next = S.next(ui + 1, nxt);
        const char* nA = has_next ? S.a_base(nxt) : cA; const char* nB = has_next ? S.b_base(nxt) : cB;
        for (int t = 0; t < nt; t += 2) {
            const bool last = (t == nt - 2);
            if constexpr (FP8 && MK_EPI_LDS) {
                if (t == nt - 4 && wid >= 4)
                    glds4s(uni_ptr((const char*)(S.rowsc + (size_t)cur.e * ECAP + cur.rows0 + (wid - 4) * 64)), (unsigned)lane * 4u, (unsigned)__builtin_amdgcn_readfirstlane((int)(unsigned)(uintptr_t)lds_idx) + 2048u + (unsigned)(wid - 4) * 256u);
            }
            if constexpr (GATHER) {
                if (has_next && t == nt - 4 && wid < 4)
                    glds4s(uni_ptr((const char*)(S.tok + (size_t)nxt.e * ECAP + nxt.rows0 + wid * 64)), (unsigned)lane * 4u, (unsigned)__builtin_amdgcn_readfirstlane((int)(unsigned)(uintptr_t)lds_idx) + (unsigned)wid * 256u);
            }
            const char* a1 = cA + PG8_KOFF(t + 1);
            const char* a2 = (last ? nA : cA) + PG8_KOFF(t + 2); const char* b2 = (last ? nB : cB) + PG8_KOFF(t + 2);
            const char* a3 = (last ? nA : cA) + PG8_KOFF(t + 3); const char* b3 = (last ? nB : cB) + PG8_KOFF(t + 3);
            if constexpr (BAL && MK_DMA_FIRST) { PG8_STAGE_A(PG8_SA(1, 0), a1, 0, VC); PG8_STAGE_A(PG8_SA(1, 1), a1, 1, VC); PG8_SCHED; }
            PG8_LDB(B0, 0, 0); PG8_LDB(B1, 0, 1); PG8_SCHED; PG8_LDA(At, 0, 0); if constexpr (!(BAL && MK_DMA_FIRST)) { if constexpr (BAL) PG8_STAGE_A(PG8_SA(1, 0), a1, 0, VC); PG8_STAGE_A(PG8_SA(1, 1), a1, 1, VC); }
            if constexpr (GATHER) {
                if (last && has_next) { const int cntn = S.cnt_of(nxt);
#pragma unroll
                    for (int h = 0; h < 2; ++h)
#pragma unroll
                        for (int i = 0; i < 2; ++i) { const int r = h * HALF + RA[i]; int tk = *(const LAS int*)(lds_idx + r * 4); tk = (nxt.rows0 + r) < cntn ? tk : 0; VC[h][i] = (unsigned)tk * (unsigned)RB + (unsigned)CA2[i]; } }
            }
            PG8_WAIT_V(8); PG8_WAIT_L(0); PG8_BAR; PG8_MMA(0, 0, At, B0); PG8_MMA(0, 1, At, B1); PG8_BAR; PG8_SCHED;
            if constexpr (BAL && MK_DMA_FIRST) { PG8_STAGE_B(PG8_SB(0, 0), b2); PG8_STAGE_B(PG8_SB(0, 1), b2 + hstep); PG8_SCHED; PG8_LDA(At, 0, 1); }
            else { PG8_LDA(At, 0, 1); PG8_STAGE_B(PG8_SB(0, 0), b2); PG8_STAGE_B(PG8_SB(0, 1), b2 + hstep); if constexpr (!BAL) PG8_STAGE_A(PG8_SA(0, 0), a2, 0, VC); }
            if constexpr (BAL) PG8_WAIT_V(6); else PG8_WAIT_V(8); PG8_WAIT_L(0); PG8_BAR; PG8_MMA(1, 0, At, B0); PG8_MMA(1, 1, At, B1); PG8_BAR; PG8_SCHED;
            if constexpr (BAL && MK_DMA_FIRST) { PG8_STAGE_A(PG8_SA(0, 0), a2, 0, VC); PG8_STAGE_A(PG8_SA(0, 1), a2, 1, VC); PG8_SCHED; }
            PG8_LDB(B0, 1, 0); PG8_LDB(B1, 1, 1); PG8_SCHED; PG8_LDA(At, 1, 0); if constexpr (!(BAL && MK_DMA_FIRST)) { if constexpr (BAL) PG8_STAGE_A(PG8_SA(0, 0), a2, 0, VC); PG8_STAGE_A(PG8_SA(0, 1), a2, 1, VC); }
            PG8_WAIT_V(8); PG8_WAIT_L(0); PG8_BAR; PG8_MMA(0, 0, At, B0); PG8_MMA(0, 1, At, B1); PG8_BAR; PG8_SCHED;
            if constexpr (BAL && MK_DMA_FIRST) { PG8_STAGE_B(PG8_SB(1, 0), b3); PG8_STAGE_B(PG8_SB(1, 1), b3 + hstep); PG8_SCHED; PG8_LDA(At, 1, 1); }
            else { PG8_LDA(At, 1, 1); PG8_STAGE_B(PG8_SB(1, 0), b3); PG8_STAGE_B(PG8_SB(1, 1), b3 + hstep); if constexpr (!BAL) PG8_STAGE_A(PG8_SA(1, 0), a3, 0, VC); }
            if constexpr (BAL) PG8_WAIT_V(6); else PG8_WAIT_V(8); PG8_WAIT_L(0); PG8_BAR; PG8_MMA(1, 0, At, B0); PG8_MMA(1, 1, At, B1); PG8_BAR; PG8_SCHED;
        }
        if (wr == 0) PG8_BAR;
        if constexpr (FP6 && KREP > 1) {
#pragma unroll
            for (int a = 0; a < 2; ++a)
#pragma unroll
                for (int b = 0; b < 2; ++b)
#pragma unroll
                    for (int m = 0; m < 4; ++m)
#pragma unroll
                        for (int n = 0; n < 2; ++n) acc[a][b][m][n] = acc[a][b][m][n] * (1.0f / KREP);
        }
        { int ln_; asm volatile("v_mbcnt_lo_u32_b32 %0, -1, 0\n\tv_mbcnt_hi_u32_b32 %0, -1, %0" : "=v"(ln_));
          E(acc, cur, wr, wc, ln_ & 15, ln_ >> 4);
#ifdef MK_PROBE_EPI2
          if constexpr (FP8) { asm volatile("" ::: "memory"); E(acc, cur, wr, wc, ln_ & 15, ln_ >> 4); }
#endif
        }
        if (!has_next) break;
#pragma unroll
        for (int a = 0; a < 2; ++a)
#pragma unroll
            for (int b = 0; b < 2; ++b)
#pragma unroll
                for (int m = 0; m < 4; ++m)
#pragma unroll
                    for (int n = 0; n < 2; ++n) acc[a][b][m][n] = (f32x4){0.f, 0.f, 0.f, 0.f};
        cur = nxt; cA = nA; cB = nB; ++ui;
        if (wr == 1) PG8_BAR;
    }
    PG8_WAIT_V(0);
    PG8_BAR;
#undef PG8_SA
#undef PG8_SB
#undef PG8_GL
#undef PG8_STAGE_A
#undef PG8_STAGE_B
#undef PG8_LDA
#undef PG8_LDB
#undef PG8_MMA
#undef PG8_CAT
#undef PG8_KOFF
#undef PG8_WAIT_V
#undef PG8_WAIT_L
#undef PG8_BAR
#undef PG8_SCHED
}

}
namespace att {
constexpr int D = 128, NW = 8, QBLK = 32, KVBLK = 64, QB = NW * QBLK;
constexpr int SHM_V = KVBLK * D * 2, SHM_K = KVBLK * D * 2;
constexpr int OFF_WS = 2 * SHM_V + 2 * SHM_K, OFF_CLOG = OFF_WS + NW * 64 * 4, LDS_BYTES = OFF_CLOG + SEQ * 4;
constexpr float THR2 = 8.f * 1.4426950408889634f;
#define KSWZ(row, colB) ((row) * 256 + ((colB) ^ (((row) & 7) << 4)))
#define SBAR() __builtin_amdgcn_sched_barrier(0)
__device__ __forceinline__ int v_st(int k, int c) { const int kk = (k & ~0xC) | ((k & 4) << 1) | ((k & 8) >> 1); return ((kk >> 3) * 4 + (c >> 5)) * 512 + ((kk & 7) * 32 + (c & 31)) * 2; }
__device__ __forceinline__ int v_rd_base(int lane) { return ((lane & 3) << 3) | (((lane >> 2) & 3) << 6) | (((lane >> 4) & 1) << 5) | (((lane >> 5) & 1) << 8); }
constexpr int v_rd_off(int d0, int ks, int half) { return d0 * 512 + ks * 4096 + half * 2048; }
__device__ __forceinline__ int crow(int r, int hi) { return (r & 3) + 8 * (r >> 2) + 4 * hi; }
__device__ __forceinline__ unsigned cvtpk(float lo, float hi) { unsigned r; asm volatile("v_cvt_pk_bf16_f32 %0, %1, %2" : "=v"(r) : "v"(lo), "v"(hi)); return r; }
__device__ __forceinline__ void mask_tile(f32x16& p0, f32x16& p1, int dq) {
    const float NEG = -__builtin_inff();
#pragma unroll
    for (int r = 0; r < 16; ++r) {
        const int c = (r & 3) + 8 * (r >> 2);
        if (dq - c < 0) p0[r] = NEG;
        if (dq - c - 32 < 0) p1[r] = NEG;
    }
}
__device__ __forceinline__ void partialSM(f32x16& p0, f32x16& p1, float& m_reg, float& mn, float& alpha) {
    float pmax = p0[0];
#pragma unroll
    for (int r = 1; r < 16; ++r) pmax = fmaxf(pmax, p0[r]);
#pragma unroll
    for (int r = 0; r < 16; ++r) pmax = fmaxf(pmax, p1[r]);
    { auto rr = __builtin_amdgcn_permlane32_swap(__float_as_uint(pmax), __float_as_uint(pmax), false, false);
      pmax = fmaxf(__uint_as_float(rr[0]), __uint_as_float(rr[1])); }
    if (__builtin_expect(__all((pmax - m_reg) <= THR2), 1)) { mn = m_reg; alpha = 1.f; }
    else { mn = fmaxf(m_reg, pmax); alpha = __builtin_amdgcn_exp2f(m_reg - mn); m_reg = mn; }
#pragma unroll
    for (int r = 0; r < 16; ++r) p0[r] = p0[r] - mn;
#pragma unroll
    for (int r = 0; r < 16; ++r) p1[r] = p1[r] - mn;
#pragma unroll
    for (int r = 0; r < 16; ++r) p0[r] = __builtin_amdgcn_exp2f(p0[r]);
}
__device__ __forceinline__ void finishSM(f32x16& p0, f32x16& p1, float alpha, float& l_reg, bf16x8& pa0, bf16x8& pa1, bf16x8& pa2, bf16x8& pa3) {
#pragma unroll
    for (int r = 0; r < 16; ++r) p1[r] = __builtin_amdgcn_exp2f(p1[r]);
    float ps = 0;
#pragma unroll
    for (int r = 0; r < 16; ++r) ps += p0[r];
#pragma unroll
    for (int r = 0; r < 16; ++r) ps += p1[r];
    { auto rr = __builtin_amdgcn_permlane32_swap(__float_as_uint(ps), __float_as_uint(ps), false, false);
      ps = __uint_as_float(rr[0]) + __uint_as_float(rr[1]); }
    l_reg = l_reg * alpha + ps;
#define PK4(P, B_, OUT) do { unsigned a0 = cvtpk(P[B_+0], P[B_+1]), a1 = cvtpk(P[B_+2], P[B_+3]);                          \
        unsigned b0 = cvtpk(P[B_+4], P[B_+5]), b1 = cvtpk(P[B_+6], P[B_+7]);                                             \
        auto r0 = __builtin_amdgcn_permlane32_swap(a0, b0, false, false); auto r1 = __builtin_amdgcn_permlane32_swap(a1, b1, false, false); \
        u32x4 w = {r0[0], r1[0], r0[1], r1[1]}; OUT = *reinterpret_cast<bf16x8*>(&w); } while (0)
    PK4(p0, 0, pa0); PK4(p0, 8, pa1); PK4(p1, 0, pa2); PK4(p1, 8, pa3);
#undef PK4
}
template <int KB, bool FOX>
__device__ __forceinline__ void qkt(f32x16& p0, f32x16& p1, const char* K_lds, int r32, int hi, const bf16x8* qr, const float* cl  , float cq) {
    if constexpr (FOX) {
#pragma unroll
        for (int g = 0; g < 4; ++g) { const f32x4 c0 = *(const f32x4*)(cl + 8 * g + 4 * hi); const f32x4 c1 = *(const f32x4*)(cl + 32 + 8 * g + 4 * hi);
#pragma unroll
            for (int j = 0; j < 4; ++j) { p0[4 * g + j] = cq - c0[j]; p1[4 * g + j] = cq - c1[j]; } }
    } else { p0 = f32x16{}; p1 = f32x16{}; }
    const char* kb[4];
#pragma unroll
    for (int dd = 0; dd < 4; ++dd) kb[dd] = K_lds + KB * SHM_K + KSWZ(r32, (dd * 16 + hi * 8) * 2);
#pragma unroll
    for (int d0 = 0; d0 < 8; ++d0) { const char* a = kb[d0 & 3] + (d0 >> 2) * 128;
        bf16x8 b0 = *reinterpret_cast<const bf16x8*>(a);
        bf16x8 b1 = *reinterpret_cast<const bf16x8*>(a + 32 * 256);
        p0 = __builtin_amdgcn_mfma_f32_32x32x16_bf16(b0, qr[d0], p0, 0, 0, 0);
        p1 = __builtin_amdgcn_mfma_f32_32x32x16_bf16(b1, qr[d0], p1, 0, 0, 0); }
}
template <int KB>
__device__ __forceinline__ void qkt_lean(f32x16& p0, f32x16& p1, const char* K_lds, int r32, int hi, const bf16x8* qr) {
    p0 = f32x16{}; p1 = f32x16{};
    int kb[4];
#pragma unroll
    for (int dd = 0; dd < 4; ++dd) kb[dd] = (int)(uintptr_t)K_lds + KB * SHM_K + KSWZ(r32, (dd * 16 + hi * 8) * 2);
#define KRD(dst, d0, half) asm volatile("ds_read_b128 %0, %1 offset:%2" : "=&v"(dst) : "v"(kb[(d0) & 3]), "i"(((d0) >> 2) * 128 + (half) * 32 * 256) : "memory")
#define KRD4(P, d0) do { KRD(P##00, d0, 0); KRD(P##01, d0, 1); KRD(P##10, (d0) + 1, 0); KRD(P##11, (d0) + 1, 1); } while (0)
#define KMM(P, d0) do { p0 = __builtin_amdgcn_mfma_f32_32x32x16_bf16(P##00, qr[d0], p0, 0, 0, 0); p1 = __builtin_amdgcn_mfma_f32_32x32x16_bf16(P##01, qr[d0], p1, 0, 0, 0); \
        p0 = __builtin_amdgcn_mfma_f32_32x32x16_bf16(P##10, qr[(d0) + 1], p0, 0, 0, 0); p1 = __builtin_amdgcn_mfma_f32_32x32x16_bf16(P##11, qr[(d0) + 1], p1, 0, 0, 0); } while (0)
#define KW4() do { asm volatile("s_waitcnt lgkmcnt(4)" ::: "memory"); SBAR(); } while (0)
    bf16x8 A00, A01, A10, A11, B00, B01, B10, B11;
    KRD4(A, 0);
    KRD4(B, 2); KW4(); KMM(A, 0); SBAR();
    KRD4(A, 4); KW4(); KMM(B, 2); SBAR();
    KRD4(B, 6); KW4(); KMM(A, 4); SBAR();
    asm volatile("s_waitcnt lgkmcnt(0)" ::: "memory"); SBAR(); KMM(B, 6); SBAR();
#undef KRD
#undef KRD4
#undef KMM
#undef KW4
}
template <int VB>
__device__ __forceinline__ void pv_tile(f32x16* o, int vb0, bf16x8 pa0, bf16x8 pa1, bf16x8 pa2, bf16x8 pa3) {
#define TRRD(dst, off) asm volatile("ds_read_b64_tr_b16 %0, %1 offset:%2" : "=&v"(dst) : "v"(vb0), "i"(off) : "memory")
#define PV_D0(d0) do { s16x4 l0, l1, l2, l3, h0, h1, h2, h3; constexpr int b_ = VB * SHM_V + v_rd_off(d0, 0, 0); \
        TRRD(l0, b_); TRRD(h0, b_ + 2048); TRRD(l1, b_ + 4096); TRRD(h1, b_ + 6144); TRRD(l2, b_ + 8192); TRRD(h2, b_ + 10240); TRRD(l3, b_ + 12288); TRRD(h3, b_ + 14336); \
        asm volatile("s_waitcnt lgkmcnt(0)" ::: "memory"); SBAR();   \
        o[d0] = __builtin_amdgcn_mfma_f32_32x32x16_bf16(pa0, (bf16x8){l0[0], l0[1], l0[2], l0[3], h0[0], h0[1], h0[2], h0[3]}, o[d0], 0, 0, 0);   \
        o[d0] = __builtin_amdgcn_mfma_f32_32x32x16_bf16(pa1, (bf16x8){l1[0], l1[1], l1[2], l1[3], h1[0], h1[1], h1[2], h1[3]}, o[d0], 0, 0, 0);   \
        o[d0] = __builtin_amdgcn_mfma_f32_32x32x16_bf16(pa2, (bf16x8){l2[0], l2[1], l2[2], l2[3], h2[0], h2[1], h2[2], h2[3]}, o[d0], 0, 0, 0);   \
        o[d0] = __builtin_amdgcn_mfma_f32_32x32x16_bf16(pa3, (bf16x8){l3[0], l3[1], l3[2], l3[3], h3[0], h3[1], h3[2], h3[3]}, o[d0], 0, 0, 0); } while (0)
    PV_D0(0); PV_D0(1); PV_D0(2); PV_D0(3);
#undef PV_D0
#undef TRRD
}
constexpr int PV8_V1 = 3 * SHM_V;
__device__ __forceinline__ void pv_pipe8(f32x16* o, int vbA, bf16x8 pa0, bf16x8 pa1, bf16x8 pa2, bf16x8 pa3) {
#define TRR(dst, vb, off) asm volatile("ds_read_b64_tr_b16 %0, %1 offset:%2" : "=&v"(dst) : "v"(vb), "i"(off) : "memory")
#define RD8(P, vb, d0) do { constexpr int b_ = v_rd_off((d0) & 3, 0, 0) + ((d0) >> 2) * PV8_V1; TRR(P##l0, vb, b_); TRR(P##h0, vb, b_ + 2048); TRR(P##l1, vb, b_ + 4096); TRR(P##h1, vb, b_ + 6144); \
        TRR(P##l2, vb, b_ + 8192); TRR(P##h2, vb, b_ + 10240); TRR(P##l3, vb, b_ + 12288); TRR(P##h3, vb, b_ + 14336); } while (0)
#define FR(P, k) (bf16x8){P##l##k[0], P##l##k[1], P##l##k[2], P##l##k[3], P##h##k[0], P##h##k[1], P##h##k[2], P##h##k[3]}
#define MM4(P, oi) do { o[oi] = __builtin_amdgcn_mfma_f32_32x32x16_bf16(pa0, FR(P, 0), o[oi], 0, 0, 0); o[oi] = __builtin_amdgcn_mfma_f32_32x32x16_bf16(pa1, FR(P, 1), o[oi], 0, 0, 0); \
        o[oi] = __builtin_amdgcn_mfma_f32_32x32x16_bf16(pa2, FR(P, 2), o[oi], 0, 0, 0); o[oi] = __builtin_amdgcn_mfma_f32_32x32x16_bf16(pa3, FR(P, 3), o[oi], 0, 0, 0); } while (0)
#define W8() do { asm volatile("s_waitcnt lgkmcnt(8)" ::: "memory"); SBAR(); } while (0)
    s16x4 Al0, Al1, Al2, Al3, Ah0, Ah1, Ah2, Ah3, Bl0, Bl1, Bl2, Bl3, Bh0, Bh1, Bh2, Bh3;
    RD8(A, vbA, 0);
    RD8(B, vbA, 1); W8(); MM4(A, 0); SBAR();
    RD8(A, vbA, 2); W8(); MM4(B, 1); SBAR();
    RD8(B, vbA, 3); W8(); MM4(A, 2); SBAR();
    RD8(A, vbA, 4); W8(); MM4(B, 3); SBAR();
    RD8(B, vbA, 5); W8(); MM4(A, 4); SBAR();
    RD8(A, vbA, 6); W8(); MM4(B, 5); SBAR();
    RD8(B, vbA, 7); W8(); MM4(A, 6); SBAR();
    asm volatile("s_waitcnt lgkmcnt(0)" ::: "memory"); SBAR(); MM4(B, 7);
#undef TRR
#undef RD8
#undef FR
#undef MM4
#undef W8
}
struct BlockRef { unsigned Q, K, V, O; int P0; unsigned clog; int jlo; };
struct Seam { bf16x8 qr[8]; bf16x8 st_v0, st_v1, st_k0, st_k1; };
#define ROWB(p, k0, rr) ((const char*)wsb + (size_t)((p) + (unsigned)((k0) + (rr)) * (unsigned)(D * 2)) + lnoff)
#define VMW() asm volatile("s_waitcnt vmcnt(0)" ::: "memory")
#define VMWN(n) asm volatile("s_waitcnt vmcnt(%0)" :: "i"(n) : "memory")
#define LD8(p) (*reinterpret_cast<const bf16x8*>(p))
#define SLOAD_H(Kp, Vp, k0) do { S.st_v0 = LD8(ROWB(Vp, k0, 0)); S.st_v1 = LD8(ROWB(Vp, k0, 32)); S.st_k0 = LD8(ROWB(Kp, k0, 0)); S.st_k1 = LD8(ROWB(Kp, k0, 32)); } while (0)
#define SWRITE_HK(bf) do { *(bf16x8*)(K_lds + (bf) * SHM_K + kws) = S.st_k0; *(bf16x8*)(K_lds + (bf) * SHM_K + kws + 32 * 256) = S.st_k1; } while (0)
#define SWRITE_HV(bf) do { *(bf16x8*)(V_lds + (bf) * SHM_V + vst0) = S.st_v0; *(bf16x8*)(V_lds + (bf) * SHM_V + vst1) = S.st_v1; } while (0)
#define SWRITE_H(bf) do { SWRITE_HV(bf); SWRITE_HK(bf); } while (0)
__device__ __forceinline__ void attn_prime(const unsigned char* wsb, const BlockRef& cur, char* lds, Seam& S) {
    const int tid = threadIdx.x, wid = __builtin_amdgcn_readfirstlane(tid >> 6), lane = tid & 63, r32 = lane & 31, hi = lane >> 5;
    const int sr = tid >> 4, sc = (tid & 15) * 8, kws = KSWZ(sr, sc * 2); char* K_lds = lds + 2 * SHM_V;
    const unsigned lnoff = (unsigned)(sr * D + sc) * 2u;
#pragma unroll
    for (int d0 = 0; d0 < 8; ++d0) S.qr[d0] = LD8(wsb + (size_t)cur.Q + (unsigned)((wid * QBLK + r32) * D + d0 * 16 + hi * 8) * 2u);
    SLOAD_H(cur.K, cur.V, cur.jlo * KVBLK); VMW(); SWRITE_HK(0);
    __syncthreads();
}
template <bool FOX, class NR>
__device__ __forceinline__ void attn_block(const unsigned char* wsb, const BlockRef& cur, const NR& nref, char* lds, Seam& S) {
    const int tid = threadIdx.x, wid = __builtin_amdgcn_readfirstlane(tid >> 6), lane = tid & 63, r32 = lane & 31, hi = lane >> 5;
    const int j_lo = cur.jlo;
    const int NT = (cur.P0 + QB) / KVBLK - j_lo;
    const int qlo = cur.P0 + wid * QBLK;
    const int qe = FOX ? qlo : (qlo | 63);
    const int qm = (FOX ? (qlo + r32) : (qlo | 63)) - 4 * hi;
    char* V_lds = lds; char* K_lds = lds + 2 * SHM_V;
    float* ws = (float*)(lds + OFF_WS) + wid * 64; float* li_l = ws, * al_l = ws + 32;
    float* cl_lds = (float*)(lds + OFF_CLOG);
    float cq = 0.f;
    if constexpr (FOX) {
        const int nkeys = NT * KVBLK;
        const float* clg = (const float*)(wsb + (size_t)cur.clog);
        for (int i = tid * 4; i < nkeys; i += NTHREADS * 4) *(f32x4*)(cl_lds + i) = *(const f32x4*)(clg + j_lo * KVBLK + i);
        cq = clg[qlo + r32];
        __syncthreads();
    }
    float m_reg = -1e30f, l_reg = 0; f32x16 o[4] = {};
    const int sr = tid >> 4, sc = (tid & 15) * 8, vst0 = v_st(sr, sc), vst1 = v_st(32 + sr, sc), kws = KSWZ(sr, sc * 2);
    const unsigned lnoff = (unsigned)(sr * D + sc) * 2u;
    const int vb0 = (int)(uintptr_t)V_lds + v_rd_base(lane);
    const unsigned Kh = cur.K, Vh = cur.V;
#define RESC(a) do { if (__any((a) < 1.f)) { if (hi == 0) al_l[r32] = (a); asm volatile("s_waitcnt lgkmcnt(0)" ::: "memory");              \
                     for (int d_ = 0; d_ < 4; ++d_) for (int r = 0; r < 16; ++r) o[d_][r] *= al_l[crow(r, hi)]; } } while (0)
#define KBASE(t) ((j_lo + (t)) * KVBLK)
#define CLT(t) (cl_lds + (t) * KVBLK)
#define MASKT(P0_, P1_, t) do { const int kb_ = KBASE(t); if (kb_ + KVBLK - 1 > qe) mask_tile(P0_, P1_, qm - kb_); } while (0)
    f32x16 pA0, pA1, pB0, pB1; float mnA, mnB, alA, alB; bf16x8 pa0, pa1, pa2, pa3;
    SWRITE_HV(0); SBAR();
    if (NT > 1) { SLOAD_H(Kh, Vh, KBASE(1)); }
    SBAR(); qkt<0, FOX>(pA0, pA1, K_lds, r32, hi, S.qr, CLT(0), cq);
    MASKT(pA0, pA1, 0); partialSM(pA0, pA1, m_reg, mnA, alA);
    if (NT > 1) { VMW(); SWRITE_H(1); }
    __syncthreads();
#define HALF_STEP(PX0, PX1, mnX, alX, PY0, PY1, alY, t, KB, VB, SB) do {                                                      \
        SBAR(); qkt<KB, FOX>(PX0, PX1, K_lds, r32, hi, S.qr, CLT(t), cq);                                          \
        finishSM(PY0, PY1, alY, l_reg, pa0, pa1, pa2, pa3); SBAR();                                                           \
        if ((t) + 1 < NT) { SLOAD_H(Kh, Vh, KBASE((t) + 1)); SBAR(); }                                                        \
        pv_tile<VB>(o, vb0, pa0, pa1, pa2, pa3); MASKT(PX0, PX1, (t)); partialSM(PX0, PX1, m_reg, mnX, alX);                  \
        __syncthreads();                                                                                                      \
        if ((t) + 1 < NT) { VMW(); SWRITE_H(SB); }                                                                            \
        RESC(alX); __syncthreads(); } while (0)
    for (int t = 1; t + 1 < NT; t += 2) {
        HALF_STEP(pB0, pB1, mnB, alB, pA0, pA1, alA, t, 1, 0, 0);
        HALF_STEP(pA0, pA1, mnA, alA, pB0, pB1, alB, t + 1, 0, 1, 1);
    }
    constexpr bool even = true;
    if (even) { SBAR(); qkt<1, FOX>(pB0, pB1, K_lds, r32, hi, S.qr, CLT(NT - 1), cq); SBAR(); }
    const BlockRef nxt = nref();
    SLOAD_H(nxt.K, nxt.V, nxt.jlo * KVBLK); SBAR();
#pragma unroll
    for (int d0 = 0; d0 < 8; ++d0) S.qr[d0] = LD8(wsb + (size_t)nxt.Q + (unsigned)((wid * QBLK + r32) * D + d0 * 16 + hi * 8) * 2u);
    SBAR();
    finishSM(pA0, pA1, alA, l_reg, pa0, pa1, pa2, pa3); SBAR();
    pv_tile<0>(o, vb0, pa0, pa1, pa2, pa3);
    if (even) { MASKT(pB0, pB1, NT - 1); partialSM(pB0, pB1, m_reg, mnB, alB); __syncthreads(); RESC(alB);
        finishSM(pB0, pB1, alB, l_reg, pa0, pa1, pa2, pa3); SBAR(); pv_tile<1>(o, vb0, pa0, pa1, pa2, pa3); }
    SBAR(); VMWN(8); SWRITE_HK(0); SBAR();
    if (hi == 0) li_l[r32] = l_reg; asm volatile("s_waitcnt lgkmcnt(0)" ::: "memory");
    float rli[16];
#pragma unroll
    for (int r = 0; r < 16; ++r) rli[r] = __builtin_amdgcn_rcpf(li_l[crow(r, hi)]);
    bf16_t* Ow = (bf16_t*)(const_cast<unsigned char*>(wsb) + (size_t)cur.O) + (size_t)(wid * QBLK) * D;
#pragma unroll
    for (int r = 0; r < 16; ++r) { const int orow = crow(r, hi);
#pragma unroll
        for (int d0 = 0; d0 < 4; ++d0) { const float v = o[d0][r] * rli[r];
            const float vn = __uint_as_float((unsigned)__builtin_amdgcn_update_dpp(0, (int)__float_as_uint(v), 0xB1, 0xF, 0xF, false));
            if ((r32 & 1) == 0) *(unsigned*)(Ow + (size_t)orow * D + d0 * 32 + r32) = cvtpk(v, vn); } }
    __syncthreads();
#undef RESC
#undef KBASE
#undef CLT
#undef MASKT
#undef HALF_STEP
}
constexpr int W_OFF_V1 = 3 * SHM_V, W_OFF_K = 6 * SHM_V, W_OFF_WS = 133120, W_LDS_BYTES = W_OFF_WS + NW * 64 * 4;
struct BlockRefW { unsigned Q, K, V0, V1, O0, O1; int P0; };
struct SeamW { bf16x8 qr[8]; int vs; };
#define DMA_W(R, k0, bf, vsl) do { const unsigned kb_ = (unsigned)(k0) * 256u; \
        const char* gk_ = (const char*)wsb + (size_t)((R).K + kb_); const char* g0_ = (const char*)wsb + (size_t)((R).V0 + kb_); const char* g1_ = (const char*)wsb + (size_t)((R).V1 + kb_); \
        const unsigned lk_ = ldsb + W_OFF_K + (bf) * SHM_K + wid * 2048, lv_ = ldsb + (unsigned)(vsl) * SHM_V + wid * 2048; \
        glds16s(uni_ptr(gk_), vofK0, lk_); glds16s(uni_ptr(gk_), (vofK0 + 1024u) ^ 64u, lk_ + 1024u); \
        glds16s(uni_ptr(g0_), vofV0, lv_); glds16s(uni_ptr(g0_), vofV1, lv_ + 1024u); \
        glds16s(uni_ptr(g1_), vofV0, lv_ + W_OFF_V1); glds16s(uni_ptr(g1_), vofV1, lv_ + W_OFF_V1 + 1024u); } while (0)
#define DMA_OFFS() \
    const unsigned ldsb = (unsigned)__builtin_amdgcn_readfirstlane((int)(unsigned)(uintptr_t)lds); \
    unsigned vofK0, vofV0, vofV1; \
    { int lane; asm volatile("v_mbcnt_lo_u32_b32 %0, -1, 0\n\tv_mbcnt_hi_u32_b32 %0, -1, %0" : "=v"(lane));     \
      const int rk0 = 4 * (2 * wid) + (lane >> 4), rk1 = rk0 + 4; vofK0 = (unsigned)(rk0 * 256 + (((lane & 15) ^ (rk0 & 7)) << 4)); (void)rk1;     \
      const int p0_ = (2 * wid) * 64 + lane, p1_ = p0_ + 64; \
      { const int sub = p0_ >> 5, kk = (sub >> 2) * 8 + ((p0_ >> 2) & 7), k = (kk & ~0xC) | ((kk & 4) << 1) | ((kk & 8) >> 1), c = (sub & 3) * 32 + (p0_ & 3) * 8; vofV0 = (unsigned)(k * 256 + c * 2); } \
      { const int sub = p1_ >> 5, kk = (sub >> 2) * 8 + ((p1_ >> 2) & 7), k = (kk & ~0xC) | ((kk & 4) << 1) | ((kk & 8) >> 1), c = (sub & 3) * 32 + (p1_ & 3) * 8; vofV1 = (unsigned)(k * 256 + c * 2); } }
__device__ __forceinline__ void attn_primeW(const unsigned char* wsb, const BlockRefW& cur, char* lds, SeamW& S) {
    const int tid = threadIdx.x, wid = __builtin_amdgcn_readfirstlane(tid >> 6), lane = tid & 63, r32 = lane & 31, hi = lane >> 5;
    DMA_OFFS();
    S.vs = 0;
    DMA_W(cur, 0, 0, 0);
#pragma unroll
    for (int d0 = 0; d0 < 8; ++d0) S.qr[d0] = LD8(wsb + (size_t)cur.Q + (unsigned)((wid * QBLK + r32) * D + d0 * 16 + hi * 8) * 2u);
    VMW();
    __syncthreads();
}
template <class NR>
__device__ __forceinline__ void attn_blockW(const unsigned char* wsb, const BlockRefW& cur, const NR& nref, char* lds, SeamW& S) {
    const int tid = threadIdx.x, wid = __builtin_amdgcn_readfirstlane(tid >> 6), lane = tid & 63, r32 = lane & 31, hi = lane >> 5;
    const int NT = (cur.P0 + QB) / KVBLK;
    const int qlo = cur.P0 + wid * QBLK, qe = qlo | 63, qm = (qlo | 63) - 4 * hi;
    char* V_lds = lds; char* K_lds = lds + W_OFF_K;
    float* ws = (float*)(lds + W_OFF_WS) + wid * 64; float* li_l = ws, * al_l = ws + 32;
    float m_reg = -1e30f, l_reg = 0; f32x16 o[8] = {};
    DMA_OFFS();
    const int vb0 = (int)(uintptr_t)V_lds + v_rd_base(lane);
    static_assert(PV8_V1 == W_OFF_V1 && v_rd_off(3, 3, 1) + PV8_V1 < 65536, "V1 ring reachable by the 16-bit ds offset");
#define RESCW(a) do { if (__any((a) < 1.f)) { if (hi == 0) al_l[r32] = (a); asm volatile("s_waitcnt lgkmcnt(0)" ::: "memory");              \
                      for (int d_ = 0; d_ < 8; ++d_) for (int r = 0; r < 16; ++r) o[d_][r] *= al_l[crow(r, hi)]; } } while (0)
#define MASKW(P0_, P1_, t) do { const int kb_ = (t) * KVBLK; if (kb_ + KVBLK - 1 > qe) mask_tile(P0_, P1_, qm - kb_); } while (0)
    f32x16 p0, p1; float mn, al; bf16x8 pa0, pa1, pa2, pa3;
    const bool lag = wid >= 4;
    int vs = S.vs;
#define PVW(slot) do { pv_pipe8(o, vb0 + (slot) * SHM_V, pa0, pa1, pa2, pa3); } while (0)
#define STEPW(t, BF) do { const int nvs_ = vs == 2 ? 0 : vs + 1;                                                                \
        DMA_W(cur, ((t) + 1) * KVBLK, 1 - (BF), nvs_);                                                                          \
        if (lag && (t) > 0) { SBAR(); PVW(vs == 0 ? 2 : vs - 1); }                                                               \
        SBAR(); qkt_lean<BF>(p0, p1, K_lds, r32, hi, S.qr); SBAR();                                                            \
        MASKW(p0, p1, (t)); partialSM(p0, p1, m_reg, mn, al); RESCW(al); finishSM(p0, p1, al, l_reg, pa0, pa1, pa2, pa3); SBAR(); \
        if (!lag) { PVW(vs); }                                                                                                   \
        VMW(); __syncthreads(); vs = nvs_; } while (0)
    for (int t = 0; t + 2 < NT; t += 2) { STEPW(t, 0); STEPW(t + 1, 1); }
    STEPW(NT - 2, 0);
    const BlockRefW nxt = nref();
    const int nvs = vs == 2 ? 0 : vs + 1;
    DMA_W(nxt, 0, 0, nvs);
    if (lag) { SBAR(); PVW(vs == 0 ? 2 : vs - 1); }
    SBAR(); qkt_lean<1>(p0, p1, K_lds, r32, hi, S.qr); SBAR();
#pragma unroll
    for (int d0 = 0; d0 < 8; ++d0) S.qr[d0] = LD8(wsb + (size_t)nxt.Q + (unsigned)((wid * QBLK + r32) * D + d0 * 16 + hi * 8) * 2u);
    SBAR();
    MASKW(p0, p1, NT - 1); partialSM(p0, p1, m_reg, mn, al); RESCW(al); finishSM(p0, p1, al, l_reg, pa0, pa1, pa2, pa3); SBAR();
    PVW(vs);
    S.vs = nvs;
    if (hi == 0) li_l[r32] = l_reg; asm volatile("s_waitcnt lgkmcnt(0)" ::: "memory");
    float rli[16];
#pragma unroll
    for (int r = 0; r < 16; ++r) rli[r] = __builtin_amdgcn_rcpf(li_l[crow(r, hi)]);
    { int ln_; asm volatile("v_mbcnt_lo_u32_b32 %0, -1, 0\n\tv_mbcnt_hi_u32_b32 %0, -1, %0" : "=v"(ln_));
      const int r32b = ln_ & 31, hib = ln_ >> 5; const unsigned lo_ = (unsigned)((wid * QBLK + 4 * hib) * D + r32b) * 2u;
#pragma unroll
      for (int hv = 0; hv < 2; ++hv) {
        unsigned char* Ob = const_cast<unsigned char*>(wsb) + (size_t)(hv ? cur.O1 : cur.O0);
#pragma unroll
        for (int r = 0; r < 16; ++r) { const unsigned ro_ = lo_ + (unsigned)(((r & 3) + 8 * (r >> 2)) * D) * 2u;
#pragma unroll
            for (int d0 = 0; d0 < 4; ++d0) { const float v = o[hv * 4 + d0][r] * rli[r];
                const float vn = __uint_as_float((unsigned)__builtin_amdgcn_update_dpp(0, (int)__float_as_uint(v), 0xB1, 0xF, 0xF, false));
                if ((r32b & 1) == 0) *(unsigned*)(Ob + (ro_ + (unsigned)(d0 * 64))) = cvtpk(v, vn); } }
      } }
    VMW(); __syncthreads();
#undef RESCW
#undef MASKW
#undef STEPW
#undef PVW
}
#undef DMA_W
#undef DMA_OFFS
#undef ROWB
#undef VMW
#undef VMWN
#undef LD8
#undef SLOAD_H
#undef SWRITE_HK
#undef SWRITE_HV
#undef SWRITE_H
#undef KSWZ
#undef SBAR
}
#ifndef MK_FP8
#define MK_FP8 1
#endif
constexpr int FP8_WSHIFT = 8, FP8_HGSHIFT = 3, FP8_HDSHIFT = 2, FP8_YSHIFT = 6;
#ifndef MK_YS8
#define MK_YS8 1
#endif
__device__ __forceinline__ float clamp448(float v) { return __builtin_amdgcn_fmed3f(v, -448.0f, 448.0f); }
__device__ __forceinline__ unsigned pk_fp8x4(float a, float b, float c, float d) {
    int w = 0; w = __builtin_amdgcn_cvt_pk_fp8_f32(clamp448(a), clamp448(b), w, false); w = __builtin_amdgcn_cvt_pk_fp8_f32(clamp448(c), clamp448(d), w, true); return (unsigned)w; }
#ifndef MK_FP6
#define MK_FP6 1
#endif
typedef float v16f_t __attribute__((ext_vector_type(16)));
typedef int v6i_t __attribute__((ext_vector_type(6)));
__device__ __forceinline__ void fp6_record(const v16f_t a, const v16f_t b, u32x4& lo, u32x4& hi) {
    float mx = 0.f;
#pragma unroll
    for (int i = 0; i < 16; ++i) asm("v_max3_f32 %0, |%1|, |%2|, %0" : "+v"(mx) : "v"(a[i]), "v"(b[i]));
    int sb = (int)((__float_as_uint(mx) >> 23) & 0xffu) - 2; sb = sb < 1 ? 1 : sb;
    const float scale = __uint_as_float((unsigned)sb << 23);
    const v6i_t r = __builtin_amdgcn_cvt_scalef32_2xpk16_fp6_f32(a, b, scale);
    lo = (u32x4){(unsigned)r[0], (unsigned)r[1], (unsigned)r[2], (unsigned)r[3]}; hi = (u32x4){(unsigned)r[4], (unsigned)r[5], (unsigned)sb, 0u};
}
__device__ __forceinline__ void xpose4(float (&X)[4][8]) {
#pragma unroll
    for (int m = 0; m < 2; ++m)
#pragma unroll
        for (int j = 0; j < 8; ++j) { auto r = __builtin_amdgcn_permlane32_swap(__float_as_uint(X[m][j]), __float_as_uint(X[m + 2][j]), false, false); X[m][j] = __uint_as_float(r[0]); X[m + 2][j] = __uint_as_float(r[1]); }
#pragma unroll
    for (int m = 0; m < 4; m += 2)
#pragma unroll
        for (int j = 0; j < 8; ++j) { auto r = __builtin_amdgcn_permlane16_swap(__float_as_uint(X[m][j]), __float_as_uint(X[m + 1][j]), false, false); X[m][j] = __uint_as_float(r[0]); X[m + 1][j] = __uint_as_float(r[1]); }
}
#define XROW16(X, q) X[q][0], X[q][1], X[q][2], X[q][3], X[q][4], X[q][5], X[q][6], X[q][7]
#ifndef MK_FUSE_NORMS
#define MK_FUSE_NORMS 1
#endif
namespace pg8 {
struct EpiQKV {
    bf16_t* QKV; const float* rope; unsigned* ctl; LAS float* nsc;
    __device__ __forceinline__ void operator()(const f32x4 (&acc)[2][2][4][2], const Unit& u, int wr, int wc, int fr, int fq) const {
        const int pn = u.pn; const bool isrope = pn < 8; const float sc = (pn < 4 || (pn >= 12 && pn < 16)) ? QSCALE : 1.0f;
        const bool isnorm = MK_FUSE_NORMS && pn >= 12 && pn < 20;
        const int cw = wc * 32 + 8 * fq;
#pragma unroll
        for (int ai = 0; ai < 2; ++ai)
#pragma unroll
            for (int m = 0; m < 4; ++m) {
                const int row = u.pm * BM + ai * HALF + wr * 64 + m * 16 + fr;
                f32x4 cs0 = {1.f, 0.f, 1.f, 0.f}, cs1 = {1.f, 0.f, 1.f, 0.f};
                if (isrope) { const float* rp = rope + (size_t)row * 128 + (16 * wc + 4 * fq) * 2; cs0 = *(const f32x4*)rp; cs1 = *(const f32x4*)(rp + 4); }
#pragma unroll
                for (int bj = 0; bj < 2; ++bj) {
                    f32x4 v0 = acc[ai][bj][m][0], v1 = acc[ai][bj][m][1];
                    if (isrope) {
                        const f32x4 a = v0, b = v1;
                        v0[0] = a[0] * cs0[0] - a[1] * cs0[1]; v0[1] = a[1] * cs0[0] + a[0] * cs0[1]; v0[2] = a[2] * cs0[2] - a[3] * cs0[3]; v0[3] = a[3] * cs0[2] + a[2] * cs0[3];
                        v1[0] = b[0] * cs1[0] - b[1] * cs1[1]; v1[1] = b[1] * cs1[0] + b[0] * cs1[1]; v1[2] = b[2] * cs1[2] - b[3] * cs1[3]; v1[3] = b[3] * cs1[2] + b[2] * cs1[3];
                    }
                    v0 = v0 * sc; v1 = v1 * sc;
                    if (isnorm) { float ss = (v0[0] * v0[0] + v0[1] * v0[1]) + (v0[2] * v0[2] + v0[3] * v0[3]) + (v1[0] * v1[0] + v1[1] * v1[1]) + (v1[2] * v1[2] + v1[3] * v1[3]);
                        ss += __shfl_xor(ss, 16); ss += __shfl_xor(ss, 32);
                        if (fq == 0) nsc[((ai * HALF + wr * 64 + m * 16 + fr) * 2 + bj) * 4 + wc] = ss; }
                    u32x4 w; w.x = cvt_pk_bf16(v0[0], v0[1]); w.y = cvt_pk_bf16(v0[2], v0[3]); w.z = cvt_pk_bf16(v1[0], v1[1]); w.w = cvt_pk_bf16(v1[2], v1[3]);
                    *(u32x4*)(QKV + ((size_t)(pn * 2 + bj) * MTOK + row) * 128 + cw) = w;
                }
            }
        if (isnorm) {
            __syncthreads();
            const int t = (int)threadIdx.x; const f32x4 pq = *(const LAS f32x4*)(nsc + t * 4);
            float s = (pq.x + pq.y) + (pq.z + pq.w);
            s = fmaxf(s, __shfl_xor(s, 2)); s = fmaxf(s, __shfl_xor(s, 4)); s = fmaxf(s, __shfl_xor(s, 8)); s = fmaxf(s, __shfl_xor(s, 16)); s = fmaxf(s, __shfl_xor(s, 32));
            if ((t & 63) < 2) { const int isk = pn >= 16, hd = ((pn - (isk ? 16 : 12)) * 2) + (t & 1), bh = (u.pm >> 4) * 8 + hd;
                atomicMax(ctl + (isk ? CW_KMAX + bh : CW_QMAX + bh * 16 + (u.pm & 15)), __float_as_uint(s)); }
        }
    }
};
struct EpiOut {
    const float* x; float* h; bf16_t* hg; const float* gffn;
    __device__ __forceinline__ void operator()(const f32x4 (&acc)[2][2][4][2], const Unit& u, int wr, int wc, int fr, int fq) const {
#pragma unroll
        for (int bj = 0; bj < 2; ++bj) {
            const int col0 = u.pn * BM + bj * HALF + wc * 32 + 8 * fq;
            const f32x4 g0 = *(const f32x4*)(gffn + col0), g1 = *(const f32x4*)(gffn + col0 + 4);
#pragma unroll
            for (int ai = 0; ai < 2; ++ai) {
#if MK_FP8 && MK_FP6
                float X[4][8];
#endif
#pragma unroll
                for (int m = 0; m < 4; ++m) {
                    const size_t off = (size_t)(u.pm * BM + ai * HALF + wr * 64 + m * 16 + fr) * DM + col0;
                    const f32x4 h0 = *(const f32x4*)(x + off) + acc[ai][bj][m][0], h1 = *(const f32x4*)(x + off + 4) + acc[ai][bj][m][1];
                    *(f32x4*)(h + off) = h0; *(f32x4*)(h + off + 4) = h1;
                    const f32x4 a = h0 * g0, b = h1 * g1;
#if MK_FP8 && MK_FP6
                    X[m][0] = a[0]; X[m][1] = a[1]; X[m][2] = a[2]; X[m][3] = a[3]; X[m][4] = b[0]; X[m][5] = b[1]; X[m][6] = b[2]; X[m][7] = b[3];
#elif MK_FP8
                    constexpr float sc8 = (float)(1 << FP8_HGSHIFT);
                    u32x2 w8; w8.x = pk_fp8x4(a[0] * sc8, a[1] * sc8, a[2] * sc8, a[3] * sc8); w8.y = pk_fp8x4(b[0] * sc8, b[1] * sc8, b[2] * sc8, b[3] * sc8);
                    *(u32x2*)((unsigned char*)hg + off) = w8;
#else
                    u32x4 w; w.x = cvt_pk_bf16(a[0], a[1]); w.y = cvt_pk_bf16(a[2], a[3]); w.z = cvt_pk_bf16(b[0], b[1]); w.w = cvt_pk_bf16(b[2], b[3]);
                    *(u32x4*)(hg + off) = w;
#endif
                }
#if MK_FP8 && MK_FP6
                xpose4(X);
                u32x4 lo, hi; fp6_record((v16f_t){XROW16(X, 0), XROW16(X, 1)}, (v16f_t){XROW16(X, 2), XROW16(X, 3)}, lo, hi);
                unsigned char* rp = (unsigned char*)hg + (size_t)(u.pm * BM + ai * HALF + wr * 64 + fq * 16 + fr) * DM + (2 * u.pn + bj) * 128 + 16 * wc;
                *(u32x4*)rp = lo; *(u32x4*)(rp + 64) = hi;
#endif
            }
        }
    }
};
template <int SC> __device__ __forceinline__ f32x2 swiglu_pk(f32x2 g, f32x2 u) {
    g.x = fminf(g.x, 7.0f); g.y = fminf(g.y, 7.0f);
    u.x = __builtin_amdgcn_fmed3f(u.x, -7.0f, 7.0f); u.y = __builtin_amdgcn_fmed3f(u.y, -7.0f, 7.0f);
    const f32x2 t = g * (-1.702f * 1.4426950408889634f);
    f32x2 e; e.x = __builtin_amdgcn_exp2f(t.x); e.y = __builtin_amdgcn_exp2f(t.y);
    const f32x2 d = e + 1.0f;
    f32x2 r; r.x = __builtin_amdgcn_rcpf(d.x); r.y = __builtin_amdgcn_rcpf(d.y);
    const f32x2 us = u * (float)SC + (float)SC;
    return (g * r) * us;
}
__device__ __forceinline__ unsigned pk_fp8x4_nc(f32x2 a, f32x2 b) {
    int w = 0; w = __builtin_amdgcn_cvt_pk_fp8_f32(a.x, a.y, w, false); w = __builtin_amdgcn_cvt_pk_fp8_f32(b.x, b.y, w, true); return (unsigned)w; }
__device__ __forceinline__ float swiglu1(float g, float uu) {
    g = fminf(g, 7.0f); uu = fminf(fmaxf(uu, -7.0f), 7.0f);
    const float e = __builtin_amdgcn_exp2f(g * (-1.702f * 1.4426950408889634f));
    return g * __builtin_amdgcn_rcpf(1.0f + e) * (uu + 1.0f);
}
struct EpiGU {
    bf16_t* hdn; const float* bgate; const float* bup; const float* rstd; const LAS int* tab; const LAS float* rl;
    __device__ __forceinline__ void operator()(const f32x4 (&acc)[2][2][4][2], const Unit& u, int wr, int wc, int fr, int fq) const {
        const int j0 = u.pn * HALF + wc * 32 + 8 * fq; const int cnt = tab[NE + 1 + u.e];
        const f32x4 bg0 = *(const f32x4*)(bgate + (size_t)u.e * DM + j0), bg1 = *(const f32x4*)(bgate + (size_t)u.e * DM + j0 + 4);
        const f32x4 bu0 = *(const f32x4*)(bup + (size_t)u.e * DM + j0), bu1 = *(const f32x4*)(bup + (size_t)u.e * DM + j0 + 4);
#pragma unroll
        for (int ai = 0; ai < 2; ++ai) {
#if MK_FP8 && MK_FP6
            float X[4][8];
#endif
#pragma unroll
            for (int m = 0; m < 4; ++m) {
                const int r = ai * HALF + wr * 64 + m * 16 + fr, pos = u.rows0 + r;
                float rs = MK_EPI_LDS ? rl[r] : rstd[(size_t)u.e * ECAP + pos]; rs = pos < cnt ? rs : 0.f;
                const f32x4 g0 = acc[ai][0][m][0] * rs + bg0, g1 = acc[ai][0][m][1] * rs + bg1, u0 = acc[ai][1][m][0] * rs + bu0, u1 = acc[ai][1][m][1] * rs + bu1;
#if MK_FP8 && MK_FP6
                { const f32x2 h00 = swiglu_pk<1>((f32x2){g0[0], g0[1]}, (f32x2){u0[0], u0[1]}), h01 = swiglu_pk<1>((f32x2){g0[2], g0[3]}, (f32x2){u0[2], u0[3]});
                  const f32x2 h10 = swiglu_pk<1>((f32x2){g1[0], g1[1]}, (f32x2){u1[0], u1[1]}), h11 = swiglu_pk<1>((f32x2){g1[2], g1[3]}, (f32x2){u1[2], u1[3]});
                  X[m][0] = h00.x; X[m][1] = h00.y; X[m][2] = h01.x; X[m][3] = h01.y; X[m][4] = h10.x; X[m][5] = h10.y; X[m][6] = h11.x; X[m][7] = h11.y; }
#elif MK_FP8
                constexpr int SC8 = 1 << FP8_HDSHIFT;
                const f32x2 h00 = swiglu_pk<SC8>((f32x2){g0[0], g0[1]}, (f32x2){u0[0], u0[1]}), h01 = swiglu_pk<SC8>((f32x2){g0[2], g0[3]}, (f32x2){u0[2], u0[3]});
                const f32x2 h10 = swiglu_pk<SC8>((f32x2){g1[0], g1[1]}, (f32x2){u1[0], u1[1]}), h11 = swiglu_pk<SC8>((f32x2){g1[2], g1[3]}, (f32x2){u1[2], u1[3]});
                u32x2 w8; w8.x = pk_fp8x4_nc(h00, h01); w8.y = pk_fp8x4_nc(h10, h11);
                *(u32x2*)((unsigned char*)hdn + (size_t)(u.pm * BM + r) * DM + j0) = w8;
#else
                u32x4 w; w.x = cvt_pk_bf16(swiglu1(g0[0], u0[0]), swiglu1(g0[1], u0[1])); w.y = cvt_pk_bf16(swiglu1(g0[2], u0[2]), swiglu1(g0[3], u0[3]));
                w.z = cvt_pk_bf16(swiglu1(g1[0], u1[0]), swiglu1(g1[1], u1[1])); w.w = cvt_pk_bf16(swiglu1(g1[2], u1[2]), swiglu1(g1[3], u1[3]));
                *(u32x4*)(hdn + (size_t)(u.pm * BM + r) * DM + j0) = w;
#endif
            }
#if MK_FP8 && MK_FP6
            xpose4(X);
            u32x4 lo, hi; fp6_record((v16f_t){XROW16(X, 0), XROW16(X, 1)}, (v16f_t){XROW16(X, 2), XROW16(X, 3)}, lo, hi);
            unsigned char* rp = (unsigned char*)hdn + (size_t)(u.pm * BM + ai * HALF + wr * 64 + fq * 16 + fr) * DM + u.pn * 128 + 16 * wc;
            *(u32x4*)rp = lo; *(u32x4*)(rp + 64) = hi;
#endif
        }
    }
};
struct EpiDown {
    bf16_t* ys; const float* bdown; const float* gate; const LAS int* tab; const LAS float* rl;
    __device__ __forceinline__ void operator()(const f32x4 (&acc)[2][2][4][2], const Unit& u, int wr, int wc, int fr, int fq) const {
        const int cnt = tab[NE + 1 + u.e]; const int c0 = u.pn * BM + wc * 32 + 8 * fq;
        const float* bp = bdown + (size_t)u.e * DM + c0;
        const f32x4 b00 = *(const f32x4*)(bp), b01 = *(const f32x4*)(bp + 4), b10 = *(const f32x4*)(bp + HALF), b11 = *(const f32x4*)(bp + HALF + 4);
#pragma unroll
        for (int ai = 0; ai < 2; ++ai)
#pragma unroll
            for (int m = 0; m < 4; ++m) {
                const int r = ai * HALF + wr * 64 + m * 16 + fr, pos = u.rows0 + r;
                float gt = MK_EPI_LDS ? rl[r] : gate[(size_t)u.e * ECAP + pos]; gt = pos < cnt ? gt : 0.f;
#if MK_YS8
                const float gs = gt * (float)(1 << FP8_YSHIFT);
                unsigned char* yp = (unsigned char*)ys + (size_t)(u.pm * BM + r) * DM + c0;
                { const f32x4 a = (acc[ai][0][m][0] + b00) * gs, b = (acc[ai][0][m][1] + b01) * gs; u32x2 w8; w8.x = pk_fp8x4(a[0], a[1], a[2], a[3]); w8.y = pk_fp8x4(b[0], b[1], b[2], b[3]); *(u32x2*)yp = w8; }
                { const f32x4 a = (acc[ai][1][m][0] + b10) * gs, b = (acc[ai][1][m][1] + b11) * gs; u32x2 w8; w8.x = pk_fp8x4(a[0], a[1], a[2], a[3]); w8.y = pk_fp8x4(b[0], b[1], b[2], b[3]); *(u32x2*)(yp + HALF) = w8; }
#else
                bf16_t* yp = ys + (size_t)(u.pm * BM + r) * DM + c0;
                { const f32x4 a = (acc[ai][0][m][0] + b00) * gt, b = (acc[ai][0][m][1] + b01) * gt; u32x4 w; w.x = cvt_pk_bf16(a[0], a[1]); w.y = cvt_pk_bf16(a[2], a[3]); w.z = cvt_pk_bf16(b[0], b[1]); w.w = cvt_pk_bf16(b[2], b[3]); *(u32x4*)yp = w; }
                { const f32x4 a = (acc[ai][1][m][0] + b10) * gt, b = (acc[ai][1][m][1] + b11) * gt; u32x4 w; w.x = cvt_pk_bf16(a[0], a[1]); w.y = cvt_pk_bf16(a[2], a[3]); w.z = cvt_pk_bf16(b[0], b[1]); w.w = cvt_pk_bf16(b[2], b[3]); *(u32x4*)(yp + HALF) = w; }
#endif
            }
    }
};
}

typedef GAS unsigned gu32;
#define RLX_AGENT __ATOMIC_RELAXED, __HIP_MEMORY_SCOPE_AGENT
#define LDS_WAIT() asm volatile("s_waitcnt lgkmcnt(0)" ::: "memory")
#define VM_WAIT() asm volatile("s_waitcnt vmcnt(0)" ::: "memory")
#define XB_TMO      128
#define XB_XCNT(j)  (256  + 64 * (j))
#define XB_XSUB(j)  (1280 + 64 * (j))
#define XB_XGEN(j)  (2304 + 64 * (j))
#define XB_TOP      3328
#define XB_TOPGEN   3392
#define XCD_BAR_WORDS 3456
#define XB_SPIN_CAP (1u << 18)
__device__ __forceinline__ unsigned xb_ld(unsigned* p)              { return __hip_atomic_load(p, __ATOMIC_RELAXED, __HIP_MEMORY_SCOPE_AGENT); }
__device__ __forceinline__ unsigned xb_add(unsigned* p, unsigned v) { return __hip_atomic_fetch_add(p, v, __ATOMIC_RELAXED, __HIP_MEMORY_SCOPE_AGENT); }
__device__ __forceinline__ unsigned xb_xcc_id() { return (unsigned)__builtin_amdgcn_s_getreg((3 << 11) | 20) & 0xFu; }
#define XB_SPIN(cond, bar) do { unsigned _sp = 0; while (cond) { __builtin_amdgcn_s_sleep(1); \
    if ((++_sp & 255u) == 0u) { if (xb_ld(&(bar)[XB_TMO])) break; if (_sp > XB_SPIN_CAP) { atomicAdd(&(bar)[XB_TMO], 1u); break; } } } } while (0)
struct XcdBarrier { unsigned* bar; unsigned x; volatile LAS unsigned* st; };
__device__ __forceinline__ XcdBarrier xcd_barrier_post(unsigned* bar, volatile LAS unsigned* st) {
    XcdBarrier b; b.bar = bar; b.x = xb_xcc_id(); b.st = st;
    if (threadIdx.x == 0) (void)xb_add(&bar[XB_XCNT(b.x)], 1u);
    return b;
}
__device__ __forceinline__ void xcd_barrier_complete(unsigned* bar, unsigned x, unsigned& nloc, unsigned& nx) {
    const unsigned G = gridDim.x * gridDim.y * gridDim.z;
    unsigned sum, cnt, mine, sp = 0u;
    for (;;) {
        sum = 0u; cnt = 0u; mine = 0u;
#pragma unroll
        for (unsigned j = 0; j < 16; ++j) { const unsigned c = xb_ld(&bar[XB_XCNT(j)]); sum += c; cnt += (c > 0u) ? 1u : 0u; mine = (j == x) ? c : mine; }
        if (sum == G) break;
        __builtin_amdgcn_s_sleep(1);
        if ((++sp & 255u) == 0u) { if (xb_ld(&bar[XB_TMO])) break; if (sp > XB_SPIN_CAP) { atomicAdd(&bar[XB_TMO], 1u); break; } }
    }
    nloc = mine > 0u ? mine : 1u; nx = cnt > 0u ? cnt : 1u;
}
__device__ __forceinline__ void xcd_barrier(const XcdBarrier& b) {
    asm volatile("s_waitcnt vmcnt(0)" ::: "memory");
    __syncthreads();
    if (threadIdx.x == 0) {
        unsigned* bar = b.bar;
        __builtin_amdgcn_s_waitcnt(0);
        unsigned nloc = b.st[0], nx = b.st[1];
        if (nloc == 0u) { xcd_barrier_complete(bar, b.x, nloc, nx); b.st[0] = nloc; b.st[1] = nx; }
        const unsigned old = xb_add(&bar[XB_XSUB(b.x)], 1u);
        const unsigned gen = old / nloc;
        if (old + 1u == (gen + 1u) * nloc) {
            __builtin_amdgcn_fence(__ATOMIC_RELEASE, "agent");
            asm volatile("s_waitcnt vmcnt(0)" ::: "memory");
            const unsigned og = xb_add(&bar[XB_TOP], 1u);
            const unsigned tg = og / nx;
            if (og + 1u == (tg + 1u) * nx) xb_add(&bar[XB_TOPGEN], 1u);
            else XB_SPIN(xb_ld(&bar[XB_TOPGEN]) == tg, bar);
            __builtin_amdgcn_fence(__ATOMIC_ACQUIRE, "agent");
            xb_add(&bar[XB_XGEN(b.x)], 1u);
            asm volatile("s_waitcnt vmcnt(0)" ::: "memory");
        } else {
            XB_SPIN(xb_ld(&bar[XB_XGEN(b.x)]) == gen, bar);
            __builtin_amdgcn_fence(__ATOMIC_ACQUIRE, "agent");
            asm volatile("s_waitcnt vmcnt(0)" ::: "memory");
        }
    }
    __syncthreads();
}

struct Args { const void* in[22]; float* out; unsigned char* ws; int ph_lo, ph_hi; };
typedef __attribute__((address_space(4))) const volatile Args* KArgs;
#define KIN(k) ((const void*)ka->in[k])
struct Frame {
    LAS unsigned char* lds; int wave, G, vcu;
    gu32* ctl; unsigned char* ws;
};

__device__ __forceinline__ void tr_item(const float* W, size_t ldw, int k0, int c0a, int c0b, bool perm, bf16_t* dst  , LAS float* scr, int lane) {
    const int kr = lane >> 4, q = lane & 15; const int col = (q < 8) ? c0a + 4 * q : c0b + 4 * (q - 8);
    f32x4 v[16];
#pragma unroll
    for (int it = 0; it < 16; ++it) v[it] = *(const f32x4*)(W + (size_t)(k0 + 4 * it + kr) * ldw + col);
#pragma unroll
    for (int it = 0; it < 16; ++it) { const int k = 4 * it + kr; *(LAS f32x4*)(scr + k * 64 + 4 * (q ^ ((k >> 3) & 7))) = v[it]; }
    LDS_WAIT(); asm volatile("" ::: "memory");
    const int n0l = lane >> 3, c = lane & 7;
#pragma unroll
    for (int j = 0; j < 8; ++j) { const int n = n0l + 8 * j; const int slot = perm ? ((n >> 1) + 32 * (n & 1)) : n;
        const LAS float* s = scr + (8 * c) * 64 + 4 * ((slot >> 2) ^ c) + (slot & 3);
        u32x4 o; o.x = pk2(s[0 * 64], s[1 * 64]); o.y = pk2(s[2 * 64], s[3 * 64]); o.z = pk2(s[4 * 64], s[5 * 64]); o.w = pk2(s[6 * 64], s[7 * 64]);
        *(u32x4*)(dst + (size_t)n * DM + k0 + 8 * c) = o; }
    LDS_WAIT(); asm volatile("" ::: "memory");
}
__device__ __forceinline__ void tr8_load(f32x4 (&v)[16], const float* W, size_t ldw, int k0, int c0, int lane) {
    const int kr = lane >> 3, q = lane & 7; const float* p = W + (size_t)(k0 + kr) * ldw + c0 + 4 * q;
#pragma unroll
    for (int it = 0; it < 16; ++it) v[it] = __builtin_nontemporal_load((const f32x4*)(p + (size_t)(8 * it) * ldw));
}
__device__ __forceinline__ void tr6_put(const f32x4 (&v)[16], LAS float* scr, int lane) {
    const int kr = lane >> 3, q = lane & 7;
#pragma unroll
    for (int it = 0; it < 16; ++it) { const int k = 8 * it + kr; *(LAS f32x4*)(scr + k * 32 + 4 * (q ^ ((k >> 4) & 7))) = v[it]; }
    LDS_WAIT(); asm volatile("" ::: "memory");
}
__device__ __forceinline__ void tr6_emit(int k0, unsigned char* dst, LAS float* scr, int lane) {
#pragma unroll
    for (int jj = 0; jj < 2; ++jj) { const int p = lane + 64 * jj, n = p >> 2, ch = p & 3;
        v16f_t a, b;
#pragma unroll
        for (int i = 0; i < 16; ++i) { const int ka = 32 * ch + i, kb = ka + 16;
            a[i] = scr[ka * 32 + 4 * ((n >> 2) ^ (2 * ch)) + (n & 3)]; b[i] = scr[kb * 32 + 4 * ((n >> 2) ^ (2 * ch + 1)) + (n & 3)]; }
        u32x4 lo, hi; fp6_record(a, b, lo, hi);
        unsigned char* rp = dst + (size_t)n * DM + k0 + 16 * ch;
        __builtin_nontemporal_store(lo, (u32x4*)rp); __builtin_nontemporal_store(hi, (u32x4*)(rp + 64)); }
    LDS_WAIT(); asm volatile("" ::: "memory");
}
__device__ __forceinline__ void tr6_store(const f32x4 (&v)[16], int k0, unsigned char* dst, LAS float* scr, int lane) { tr6_put(v, scr, lane); tr6_emit(k0, dst, scr, lane); }
__device__ __forceinline__ void tr8_store(const f32x4 (&v)[16], int k0, unsigned char* dst  , LAS float* scr, int lane) {
    const int kr = lane >> 3, q = lane & 7;
#pragma unroll
    for (int it = 0; it < 16; ++it) { const int k = 8 * it + kr; *(LAS f32x4*)(scr + k * 32 + 4 * (q ^ ((k >> 4) & 7))) = v[it]; }
    LDS_WAIT(); asm volatile("" ::: "memory");
    const int n0l = lane >> 3, c = lane & 7; constexpr float sc8 = (float)(1 << FP8_WSHIFT);
#pragma unroll
    for (int j = 0; j < 4; ++j) { const int n = n0l + 8 * j;
        const LAS float* s = scr + (16 * c) * 32 + 4 * ((n >> 2) ^ c) + (n & 3);
        u32x4 o; o.x = pk_fp8x4(s[0 * 32] * sc8, s[1 * 32] * sc8, s[2 * 32] * sc8, s[3 * 32] * sc8); o.y = pk_fp8x4(s[4 * 32] * sc8, s[5 * 32] * sc8, s[6 * 32] * sc8, s[7 * 32] * sc8);
        o.z = pk_fp8x4(s[8 * 32] * sc8, s[9 * 32] * sc8, s[10 * 32] * sc8, s[11 * 32] * sc8); o.w = pk_fp8x4(s[12 * 32] * sc8, s[13 * 32] * sc8, s[14 * 32] * sc8, s[15 * 32] * sc8);
        *(u32x4*)(dst + (size_t)n * DM + k0 + 16 * c) = o; }
    LDS_WAIT(); asm volatile("" ::: "memory");
}
__device__ __forceinline__ float log2_sigmoid(float z) {
    const float az = fabsf(z); const float e = __builtin_amdgcn_exp2f(-az * L2E);
    return fminf(z, 0.f) * L2E - __builtin_amdgcn_logf(1.0f + e) ;
}
__device__ __forceinline__ void p0_prologue(Frame& F, KArgs ka) {
    const float* x = (const float*)KIN(0); const int* pos = (const int*)KIN(1); const float* g_attn = (const float*)KIN(2); const float* w_in = (const float*)KIN(3);
    const float* b_forget = (const float*)KIN(4); const float* w_out = (const float*)KIN(11); const float* g_ffn = (const float*)KIN(12); const float* w_router = (const float*)KIN(13);
    const float* w_gate = (const float*)KIN(15); const float* w_up = (const float*)KIN(17); const float* w_down = (const float*)KIN(19);
    const int gw = F.vcu * NWAVES + F.wave, NGW = F.G * NWAVES; const int gt = F.vcu * NTHREADS + ((int)threadIdx.x), NGT = F.G * NTHREADS;
    { float* rope = (float*)(F.ws + WS_ROPE);
#pragma unroll 8
      for (int p = gt; p < MTOK * 64; p += NGT) { const int m = p >> 6, i = p & 63;
          const float invf = exp2f(-(float)i * 0.20762050593046014f); const float ang = (float)pos[m] * invf;
          const double rv = (double)ang * 0.15915494309189533576888; const float rev = (float)(rv - floor(rv));
          *(f32x2*)(rope + (size_t)p * 2) = (f32x2){__builtin_amdgcn_cosf(rev), __builtin_amdgcn_sinf(rev)}; } }
    { bf16_t* gwf = (bf16_t*)(F.ws + WS_GWF);
      for (int f = gt; f < 64 * 2 * 2 * 64; f += NGT) { const int ln = f & 63, p = (f >> 6) & 1, eh = (f >> 7) & 1, s = f >> 8;
          unsigned o[4];
#pragma unroll
          for (int j2 = 0; j2 < 4; ++j2) { unsigned hv[2];
#pragma unroll
              for (int q = 0; q < 2; ++q) { const int k = 32 * s + 8 * (ln >> 4) + 2 * j2 + q, e = 16 * eh + (ln & 15); const float val = g_ffn[k] * w_router[k * NE + e];
                  const unsigned hi = f2bf(val); const float lo = val - bf2f((unsigned short)hi); hv[q] = p ? f2bf(lo) : hi; }
              o[j2] = hv[0] | (hv[1] << 16); }
          *(u32x4*)(gwf + (size_t)f * 8) = (u32x4){o[0], o[1], o[2], o[3]}; } }
    { LAS float* gwfT = (LAS float*)F.lds;
#pragma unroll 4
      for (int k = ((int)threadIdx.x); k < DM; k += NTHREADS) { const f32x4 w0 = *(const f32x4*)(w_in + (size_t)k * INC + NQKV), w1 = *(const f32x4*)(w_in + (size_t)k * INC + NQKV + 4); const float g = g_attn[k];
          gwfT[0 * DM + k] = g * w0.x; gwfT[1 * DM + k] = g * w0.y; gwfT[2 * DM + k] = g * w0.z; gwfT[3 * DM + k] = g * w0.w; gwfT[4 * DM + k] = g * w1.x; gwfT[5 * DM + k] = g * w1.y; gwfT[6 * DM + k] = g * w1.z; gwfT[7 * DM + k] = g * w1.w; }
      __syncthreads();
      bf16_t* XN = (bf16_t*)(F.ws + WS_XN); float* flog = (float*)(F.ws + WS_FLOG);
      f32x4 gv[8];
#pragma unroll
      for (int j = 0; j < 8; ++j) gv[j] = *((const f32x4*)g_attn + ((int)(threadIdx.x & 63)) + 64 * j);
      f32x4 vn[8];
      if (gw < MTOK) { const f32x4* xr = (const f32x4*)(x + (size_t)gw * DM) + ((int)(threadIdx.x & 63));
#pragma unroll
          for (int j = 0; j < 8; ++j) vn[j] = __builtin_nontemporal_load(xr + 64 * j); }
      for (int m = gw; m < MTOK; m += NGW) {
          f32x4 v[8]; float s = 0.f;
#pragma unroll
          for (int j = 0; j < 8; ++j) { v[j] = vn[j]; s += (v[j].x * v[j].x + v[j].y * v[j].y) + (v[j].z * v[j].z + v[j].w * v[j].w); }
          if (m + NGW < MTOK) { const f32x4* xr = (const f32x4*)(x + (size_t)(m + NGW) * DM) + ((int)(threadIdx.x & 63));
#pragma unroll
              for (int j = 0; j < 8; ++j) vn[j] = __builtin_nontemporal_load(xr + 64 * j); }
          const float rstd = 1.0f / sqrtf(wave_sum(s) * (1.0f / DM) + EPS);
          unsigned long long* o8 = (unsigned long long*)(XN + (size_t)m * DM) + ((int)(threadIdx.x & 63));
#pragma unroll
          for (int j = 0; j < 8; ++j) { const f32x4 t = v[j] * gv[j] * rstd; o8[64 * j] = (unsigned long long)pk2(t.x, t.y) | ((unsigned long long)pk2(t.z, t.w) << 32); }
          float myz = 0.f;
#pragma unroll 1
          for (int jh = 0; jh < 8; ++jh) { float acc = 0.f;
#pragma unroll
              for (int j = 0; j < 8; ++j) { const f32x4 w = *(const LAS f32x4*)(gwfT + jh * DM + 256 * j + 4 * ((int)(threadIdx.x & 63))); acc += (v[j].x * w.x + v[j].y * w.y) + (v[j].z * w.z + v[j].w * w.w); }
              acc = wave_sum(acc); if (((int)(threadIdx.x & 63)) == jh) myz = acc; }
          if (((int)(threadIdx.x & 63)) < 8) flog[(size_t)m * 8 + ((int)(threadIdx.x & 63))] = log2_sigmoid(myz * rstd + b_forget[((int)(threadIdx.x & 63))]);
      }
      __syncthreads();
    }
    { LAS float* scr = (LAS float*)(F.lds + F.wave * 16384);
      bf16_t* Win = (bf16_t*)(F.ws + WS_WIN); bf16_t* Wout = (bf16_t*)(F.ws + WS_WOUT); bf16_t* Wgu = (bf16_t*)(F.ws + WS_WGU); bf16_t* Wd = (bf16_t*)(F.ws + WS_WD);
      constexpr int I_IN = 32 * 96, I_OUT = 32 * 32, I_GU = NE * 32 * 64, I_D = NE * 32 * 32, NITEMS = I_IN + I_OUT + I_GU + I_D;
      for (int it = gw; it < NITEMS; it += NGW) {
          int r = it;
          if (r < I_IN) { const int kb = r / 96, nb = r % 96, n0 = nb * 64;
              if (n0 < 2048) { const int base = n0 & ~127, i0 = ((n0 >> 6) & 1) * 32; tr_item(w_in, INC, kb * 64, base + i0, base + 64 + i0, true, Win + (size_t)n0 * DM, scr, ((int)(threadIdx.x & 63))); }
              else tr_item(w_in, INC, kb * 64, n0, n0 + 32, false, Win + (size_t)n0 * DM, scr, ((int)(threadIdx.x & 63)));
              continue; }
          r -= I_IN;
          if (r < I_OUT) { const int kb = r / 32, nb = r % 32; tr_item(w_out, DM, kb * 64, nb * 64, nb * 64 + 32, false, Wout + (size_t)nb * 64 * DM, scr, ((int)(threadIdx.x & 63))); continue; }
          r -= I_OUT;
#if MK_FP8
          break;
#else
          if (r < I_GU) { const int e = r / (32 * 64), rr = r % (32 * 64), kb = rr / 64, nb = rr % 64;
              const int pn = nb >> 2, w = nb & 3; const float* src = (w < 2 ? w_gate : w_up) + (size_t)e * DM * DM; const int c0 = pn * 128 + (w & 1) * 64;
              tr_item(src, DM, kb * 64, c0, c0 + 32, false, Wgu + ((size_t)e * 4096 + (size_t)nb * 64) * DM, scr, ((int)(threadIdx.x & 63))); continue; }
          r -= I_GU;
          { const int e = r / (32 * 32), rr = r % (32 * 32), kb = rr / 32, nb = rr % 32;
            tr_item(w_down + (size_t)e * DM * DM, DM, kb * 64, nb * 64, nb * 64 + 32, false, Wd + ((size_t)e * DM + (size_t)nb * 64) * DM, scr, ((int)(threadIdx.x & 63))); }
#endif
      }
    }
}

__device__ __forceinline__ void probe_stream(Frame& F, KArgs ka) {
    const float* src[3] = {(const float*)KIN(15), (const float*)KIN(17), (const float*)KIN(19)};
    const size_t n4 = (size_t)NE * DM * DM / 4; const size_t gt = (size_t)F.vcu * NTHREADS + threadIdx.x, NGT = (size_t)F.G * NTHREADS;
#pragma unroll
    for (int m = 0; m < 3; ++m) { unsigned* dst = (unsigned*)(F.ws + WS_HDN) + (size_t)m * n4;
#pragma unroll 8
        for (size_t i = gt; i < n4; i += NGT) { const f32x4 v = __builtin_nontemporal_load((const f32x4*)src[m] + i); dst[i] = pk_fp8x4(v.x * 256.f, v.y * 256.f, v.z * 256.f, v.w * 256.f); } }
}
#if MK_FP8
#if MK_FP6
#define P0B_STORE(v, k0, dst, scr, lane) tr6_store(v, k0, dst, scr, lane)
#else
#define P0B_STORE(v, k0, dst, scr, lane) tr8_store(v, k0, dst, scr, lane)
#endif
constexpr int P0B_ROWB = DM;
constexpr int P0B_IGU = NE * 32 * 64, P0B_ID = NE * 32 * 32, P0B_NI = P0B_IGU + P0B_ID;
__device__ __forceinline__ void p0b_experts(Frame& F, KArgs ka, const int it_lo, const int it_hi) {
    const float* w_gate = (const float*)KIN(15); const float* w_up = (const float*)KIN(17); const float* w_down = (const float*)KIN(19);
    const int gw = F.vcu * NWAVES + F.wave, NGW = F.G * NWAVES;
    constexpr int I_GU = P0B_IGU;
    LAS float* scr = (LAS float*)(F.lds + F.wave * 16384);
    bf16_t* Wgu = (bf16_t*)(F.ws + WS_WGU); bf16_t* Wd = (bf16_t*)(F.ws + WS_WD);
    __syncthreads();
      { const int lane = (int)(threadIdx.x & 63);
#define FP8_DESC(r_, SRC, K0, C0, DST) do { int r2 = (r_); \
          if (r2 < I_GU) { const int e = r2 / (16 * 128), rr = r2 % (16 * 128), kb = rr / 128, nb = rr % 128; const int pn = nb >> 3, w = nb & 7; \
              SRC = (w < 4 ? w_gate : w_up) + (size_t)e * DM * DM; C0 = pn * 128 + (w & 3) * 32; K0 = kb * 128; const size_t row = (size_t)e * 4096 + (size_t)nb * 32; \
              DST = (unsigned char*)Wgu + row * P0B_ROWB; } \
          else { r2 -= I_GU; const int e = r2 / (16 * 64), rr = r2 % (16 * 64), kb = rr / 64, nb = rr % 64; \
              SRC = w_down + (size_t)e * DM * DM; C0 = nb * 32; K0 = kb * 128; const size_t row = (size_t)e * DM + (size_t)nb * 32; \
              DST = (unsigned char*)Wd + row * P0B_ROWB; } } while (0)
        f32x4 va[16], vb[16]; const float* src; int k0 = 0, c0 = 0; unsigned char* dst = nullptr; const float* srcn; int k0n = 0, c0n = 0; unsigned char* dstn = nullptr;
        int it = it_lo + gw;
#if MK_FP6
        if (it < it_hi) { FP8_DESC(it, src, k0, c0, dst); tr8_load(va, src, DM, k0, c0, lane); }
        if (it + NGW < it_hi) { FP8_DESC(it + NGW, srcn, k0n, c0n, dstn); tr8_load(vb, srcn, DM, k0n, c0n, lane); }
        while (it < it_hi) {
            { tr6_put(va, scr, lane); const int ke = k0; unsigned char* de = dst;
              if (it + 2 * NGW < it_hi) { FP8_DESC(it + 2 * NGW, src, k0, c0, dst); tr8_load(va, src, DM, k0, c0, lane); }
              tr6_emit(ke, de, scr, lane); }
            it += NGW; if (it >= it_hi) break;
            { tr6_put(vb, scr, lane); const int ke = k0n; unsigned char* de = dstn;
              if (it + 2 * NGW < it_hi) { FP8_DESC(it + 2 * NGW, srcn, k0n, c0n, dstn); tr8_load(vb, srcn, DM, k0n, c0n, lane); }
              tr6_emit(ke, de, scr, lane); }
            it += NGW;
        }
#else
        if (it < it_hi) { FP8_DESC(it, src, k0, c0, dst); tr8_load(va, src, DM, k0, c0, lane); }
        while (it < it_hi) {
            int itn = it + NGW;
            if (itn < it_hi) { FP8_DESC(itn, srcn, k0n, c0n, dstn); tr8_load(vb, srcn, DM, k0n, c0n, lane); }
            P0B_STORE(va, k0, dst, scr, lane);
            it = itn; if (it >= it_hi) break;
            itn = it + NGW;
            if (itn < it_hi) { FP8_DESC(itn, src, k0, c0, dst); tr8_load(va, src, DM, k0, c0, lane); }
            P0B_STORE(vb, k0n, dstn, scr, lane);
            it = itn;
        }
#endif
#undef FP8_DESC
      }
    __syncthreads();
}
#endif
__device__ __forceinline__ void p1_scan(Frame& F) {
    if (blockIdx.x >= BATCH * 8) return;
    const int bh = blockIdx.x, b = bh >> 3, h = bh & 7, t = ((int)threadIdx.x);
    const float* flog = (const float*)(F.ws + WS_FLOG); float* clog = (float*)(F.ws + WS_CLOG) + (size_t)bh * SEQ;
    LAS double* sc = (LAS double*)F.lds;
    double loc[8]; double run = 0.0;
#pragma unroll
    for (int i = 0; i < 8; ++i) { run += (double)flog[(size_t)(b * SEQ + t * 8 + i) * 8 + h]; loc[i] = run; }
    double v = run; const int ln = t & 63, wv = t >> 6;
#pragma unroll
    for (int o = 1; o < 64; o <<= 1) { const double n = __shfl_up(v, o); v = ln >= o ? v + n : v; }
    if (ln == 63) sc[wv] = v;
    __syncthreads();
    double base = v - run;
#pragma unroll
    for (int w = 0; w < NWAVES - 1; ++w) { const double wt = sc[w]; base += w < wv ? wt : 0.0; }
#pragma unroll
    for (int i = 0; i < 8; ++i) clog[t * 8 + i] = (float)(base + loc[i]);
    __syncthreads();
}

__device__ __forceinline__ void p_norms(Frame& F) {
    const bf16_t* QKV = (const bf16_t*)(F.ws + WS_QKV);
    const int lane = (int)(threadIdx.x & 63), gw = F.vcu * NWAVES + F.wave, NGW = F.G * NWAVES;
    for (int task = gw; task < 2 * 32 * 16; task += NGW) {
        const int isk = task >> 9, bh = (task >> 4) & 31, ch = task & 15, b = bh >> 3, h = bh & 7;
        const bf16_t* base = QKV + ((size_t)((isk ? 32 : 24) + h) * MTOK + (size_t)b * SEQ + ch * 256) * 128 + (lane >> 4) * 128 + (lane & 15) * 8;
        float mx = 0.f;
#pragma unroll 4
        for (int it = 0; it < 64; ++it) {
            const u32x4 w = *(const u32x4*)(base + (size_t)it * 4 * 128);
            float ss = 0.f;
#pragma unroll
            for (int j = 0; j < 4; ++j) { const float a = bf2f((unsigned short)(w[j] & 0xffff)), c = bf2f((unsigned short)(w[j] >> 16)); ss += a * a + c * c; }
            ss += __shfl_xor(ss, 1); ss += __shfl_xor(ss, 2); ss += __shfl_xor(ss, 4); ss += __shfl_xor(ss, 8);
            mx = fmaxf(mx, ss);
        }
        mx = fmaxf(mx, __shfl_xor(mx, 16)); mx = fmaxf(mx, __shfl_xor(mx, 32));
        if (lane == 0) atomicMax((unsigned*)(F.ctl + (isk ? CW_KMAX + bh : CW_QMAX + bh * 16 + ch)), __float_as_uint(mx));
    }
}

__device__ __forceinline__ void p3_mix(Frame& F, KArgs ka) {
    const float* lq1 = (const float*)KIN(5); const float* lk1 = (const float*)KIN(6); const float* lq2 = (const float*)KIN(7); const float* lk2 = (const float*)KIN(8);
    const float* gd = (const float*)KIN(9); const float* gf = (const float*)KIN(10);
    const int l = ((int)(threadIdx.x & 63));
    const float s1 = wave_sum(lq1[l] * lk1[l] + lq1[l + 64] * lk1[l + 64]), s2 = wave_sum(lq2[l] * lk2[l] + lq2[l + 64] * lk2[l + 64]);
    const float lam = expf(s1) - expf(s2) + 0.2f;
    const bf16_t* O = (const bf16_t*)(F.ws + WS_O); bf16_t* mix = (bf16_t*)(F.ws + WS_MIX);
    const f32x2 gd0 = *(const f32x2*)(gd + 2 * l), gd1 = *(const f32x2*)(gd + 128 + 2 * l), gfv = *(const f32x2*)(gf + 2 * l);
    const int gw = F.vcu * NWAVES + F.wave, NGW = F.G * NWAVES;
    for (int m = gw; m < MTOK; m += NGW) {
        unsigned ov[24];
#pragma unroll
        for (int vh = 0; vh < 24; ++vh) ov[vh] = *(const unsigned*)(O + ((size_t)vh * MTOK + m) * 128 + 2 * l);
        unsigned* mrow = (unsigned*)(mix + (size_t)m * DM);
#pragma unroll
        for (int h = 0; h < 4; ++h) {
            const unsigned a0 = ov[8 + h * 4 + 0], a1 = ov[8 + h * 4 + 1], b0 = ov[8 + h * 4 + 2], b1 = ov[8 + h * 4 + 3];
            const float d00 = bf2f(a0 & 0xffff) - lam * bf2f(b0 & 0xffff), d01 = bf2f(a0 >> 16) - lam * bf2f(b0 >> 16);
            const float d10 = bf2f(a1 & 0xffff) - lam * bf2f(b1 & 0xffff), d11 = bf2f(a1 >> 16) - lam * bf2f(b1 >> 16);
            const float ss = wave_sum((d00 * d00 + d01 * d01) + (d10 * d10 + d11 * d11));
            const float rs = 0.8f / sqrtf(ss * (1.0f / 256.0f) + EPS);
            mrow[(h * 256) / 2 + l] = pk2(d00 * rs * gd0.x, d01 * rs * gd0.y);
            mrow[(h * 256 + 128) / 2 + l] = pk2(d10 * rs * gd1.x, d11 * rs * gd1.y);
        }
#pragma unroll
        for (int h = 0; h < 8; ++h) {
            const float f0 = bf2f(ov[h] & 0xffff), f1 = bf2f(ov[h] >> 16);
            const float ss = wave_sum(f0 * f0 + f1 * f1);
            const float rs = 1.0f / sqrtf(ss * (1.0f / 128.0f) + EPS);
            mrow[(1024 + h * 128) / 2 + l] = pk2(f0 * rs * gfv.x, f1 * rs * gfv.y);
        }
    }
}

__device__ __forceinline__ void p5_router(Frame& F, KArgs ka, const float* hbuf) {
    const float* b_router = (const float*)KIN(14);
    const bf16_t* gwf = (const bf16_t*)(F.ws + WS_GWF);
    int* tke = (int*)(F.ws + WS_TKE); int* tokl = (int*)(F.ws + WS_TOK); float* rstdl = (float*)(F.ws + WS_RSTD); float* gatel = (float*)(F.ws + WS_GATE);
    LAS float* sc = (LAS float*)(F.lds + F.wave * 4096);
    const int l = ((int)(threadIdx.x & 63)), r16 = l & 15, kq = l >> 4;
    const int gw = F.vcu * NWAVES + F.wave, NGW = F.G * NWAVES;
    for (int tile = gw; tile < MTOK / 16; tile += NGW) {
        const float* hr = hbuf + (size_t)(tile * 16 + r16) * DM + 8 * kq;
        f32x4 acc0 = {0.f, 0.f, 0.f, 0.f}, acc1 = {0.f, 0.f, 0.f, 0.f}; float ss = 0.f;
#pragma unroll 2
        for (int s = 0; s < 64; ++s) {
            const f32x4 v0 = *(const f32x4*)(hr + 32 * s), v1 = *(const f32x4*)(hr + 32 * s + 4);
            ss += (v0.x * v0.x + v0.y * v0.y) + (v0.z * v0.z + v0.w * v0.w) + (v1.x * v1.x + v1.y * v1.y) + (v1.z * v1.z + v1.w * v1.w);
            unsigned hi[4], lo[4];
#define SPL(i, A, B) do { const unsigned ha = f2bf(A), hb = f2bf(B); hi[i] = ha | (hb << 16); lo[i] = pk2(A - bf2f((unsigned short)ha), B - bf2f((unsigned short)hb)); } while (0)
            SPL(0, v0.x, v0.y); SPL(1, v0.z, v0.w); SPL(2, v1.x, v1.y); SPL(3, v1.z, v1.w);
#undef SPL
            const u32x4 hiv = {hi[0], hi[1], hi[2], hi[3]}, lov = {lo[0], lo[1], lo[2], lo[3]};
            const bf16x8 ah = __builtin_bit_cast(bf16x8, hiv), al = __builtin_bit_cast(bf16x8, lov);
            const bf16x8* bf = (const bf16x8*)(gwf + (size_t)s * 4 * 512) + l;
            const bf16x8 b0h = bf[0], b0l = bf[64], b1h = bf[128], b1l = bf[192];
            acc0 = __builtin_amdgcn_mfma_f32_16x16x32_bf16(ah, b0h, acc0, 0, 0, 0); acc0 = __builtin_amdgcn_mfma_f32_16x16x32_bf16(al, b0h, acc0, 0, 0, 0); acc0 = __builtin_amdgcn_mfma_f32_16x16x32_bf16(ah, b0l, acc0, 0, 0, 0);
            acc1 = __builtin_amdgcn_mfma_f32_16x16x32_bf16(ah, b1h, acc1, 0, 0, 0); acc1 = __builtin_amdgcn_mfma_f32_16x16x32_bf16(al, b1h, acc1, 0, 0, 0); acc1 = __builtin_amdgcn_mfma_f32_16x16x32_bf16(ah, b1l, acc1, 0, 0, 0);
        }
        ss += __shfl_xor(ss, 16); ss += __shfl_xor(ss, 32);
        const float rstd = 1.0f / sqrtf(ss * (1.0f / DM) + EPS);
        if (kq == 0) sc[16 * 33 + r16] = rstd;
        LDS_WAIT(); asm volatile("" ::: "memory");
#pragma unroll
        for (int rg = 0; rg < 4; ++rg) { const int tr = 4 * kq + rg; const float rt = sc[16 * 33 + tr];
            sc[tr * 33 + r16] = acc0[rg] * rt + b_router[r16]; sc[tr * 33 + 16 + r16] = acc1[rg] * rt + b_router[16 + r16]; }
        LDS_WAIT(); asm volatile("" ::: "memory");
        if (l < 16) {
            const int m = tile * 16 + l; float lg[NE];
#pragma unroll
            for (int e = 0; e < NE; ++e) lg[e] = sc[l * 33 + e];
            float tv[TOPK]; int ti[TOPK];
#pragma unroll
            for (int k = 0; k < TOPK; ++k) { float best = -3.4e38f; int bi = 0;
#pragma unroll
                for (int e = 0; e < NE; ++e) { const bool c = lg[e] > best; best = c ? lg[e] : best; bi = c ? e : bi; }
                tv[k] = best; ti[k] = bi;
#pragma unroll
                for (int e = 0; e < NE; ++e) lg[e] = (e == bi) ? -3.4e38f : lg[e]; }
            const float e1 = __expf(tv[1] - tv[0]), e2 = __expf(tv[2] - tv[0]), e3 = __expf(tv[3] - tv[0]); const float inv = 1.0f / (1.0f + e1 + e2 + e3);
            const float gk[TOPK] = {inv, e1 * inv, e2 * inv, e3 * inv}; const float rt = sc[16 * 33 + l];
#pragma unroll
            for (int k = 0; k < TOPK; ++k) { const int e = ti[k];
                const int pos = (int)__hip_atomic_fetch_add((unsigned*)(F.ctl + CW_CNT + 64 * e), 1u, RLX_AGENT);
                tokl[(size_t)e * ECAP + pos] = m; rstdl[(size_t)e * ECAP + pos] = rt; gatel[(size_t)e * ECAP + pos] = gk[k]; tke[m * TOPK + k] = pos * 32 + e; }
        }
        LDS_WAIT(); asm volatile("" ::: "memory");
    }
}

__device__ __forceinline__ void build_tab(Frame& F, LAS int* tab, bool publish) {
    if (((int)threadIdx.x) < NE) tab[NE + 1 + ((int)threadIdx.x)] = (int)__hip_atomic_load(F.ctl + CW_CNT + 64 * ((int)threadIdx.x), RLX_AGENT);
    __syncthreads();
    if (((int)threadIdx.x) == 0) { int s = 0; for (int e = 0; e < NE; ++e) { tab[e] = s; s += (tab[NE + 1 + e] + 255) >> 8; } tab[NE] = s; }
    __syncthreads();
    if (publish && blockIdx.x == 0 && ((int)threadIdx.x) <= NE) ((int*)(F.ws + WS_TSTART))[((int)threadIdx.x)] = tab[((int)threadIdx.x)];
}

__device__ __forceinline__ void p8_final(Frame& F, KArgs ka, float* hout) {
    const float* gfin = (const float*)KIN(21);
    const bf16_t* ys = (const bf16_t*)(F.ws + WS_YS); const int* tke = (const int*)(F.ws + WS_TKE); const int* tstart = (const int*)(F.ws + WS_TSTART);
    const int gw = F.vcu * NWAVES + F.wave, NGW = F.G * NWAVES;
    f32x4 gv[8];
#pragma unroll
    for (int j = 0; j < 8; ++j) gv[j] = *((const f32x4*)gfin + ((int)(threadIdx.x & 63)) + 64 * j);
    for (int m = gw; m < MTOK; m += NGW) {
        f32x4* hr = (f32x4*)(hout + (size_t)m * DM) + ((int)(threadIdx.x & 63));
        f32x4 v[8];
#pragma unroll
        for (int j = 0; j < 8; ++j) v[j] = hr[64 * j];
#pragma unroll
        for (int k = 0; k < TOPK; ++k) { const int code = tke[m * TOPK + k]; const int e = code & 31, pos = code >> 5; const size_t slot = (size_t)tstart[e] * 256 + pos;
#if MK_YS8
            const unsigned* yr = (const unsigned*)((const unsigned char*)ys + slot * DM) + ((int)(threadIdx.x & 63)); constexpr float ysc = 1.0f / (float)(1 << FP8_YSHIFT);
#pragma unroll
            for (int j = 0; j < 8; ++j) { const unsigned w = yr[64 * j]; const f32x2 lo = __builtin_amdgcn_cvt_pk_f32_fp8((int)w, false), hi = __builtin_amdgcn_cvt_pk_f32_fp8((int)w, true);
                v[j].x += lo.x * ysc; v[j].y += lo.y * ysc; v[j].z += hi.x * ysc; v[j].w += hi.y * ysc; } }
#else
            const u32x2* yr = (const u32x2*)(ys + slot * DM) + ((int)(threadIdx.x & 63));
#pragma unroll
            for (int j = 0; j < 8; ++j) { const u32x2 w = yr[64 * j]; v[j].x += bf2f(w.x & 0xffff); v[j].y += bf2f(w.x >> 16); v[j].z += bf2f(w.y & 0xffff); v[j].w += bf2f(w.y >> 16); } }
#endif
        float s = 0.f;
#pragma unroll
        for (int j = 0; j < 8; ++j) s += (v[j].x * v[j].x + v[j].y * v[j].y) + (v[j].z * v[j].z + v[j].w * v[j].w);
        const float rstd = 1.0f / sqrtf(wave_sum(s) * (1.0f / DM) + EPS);
#pragma unroll
        for (int j = 0; j < 8; ++j) hr[64 * j] = v[j] * gv[j] * rstd;
    }
}
template <bool FOX>
__device__ __forceinline__ att::BlockRef attn_ref(const Frame& F, int L, int pass) {
    const int xcd = L & 7, k = L >> 3, x = k & 7, qb = pass ? 15 - x : x;
    att::BlockRef r;
    if constexpr (FOX) {
        const int bh = xcd * 4 + (k >> 3), b = bh >> 3, h = bh & 7;
        r.Q = (unsigned)WS_QKV + (unsigned)(((24 + h) * MTOK + b * SEQ + qb * 256) * 256); r.K = (unsigned)WS_QKV + (unsigned)(((32 + h) * MTOK + b * SEQ) * 256);
        r.V = (unsigned)WS_QKV + (unsigned)(((40 + h) * MTOK + b * SEQ) * 256); r.O = (unsigned)WS_O + (unsigned)((h * MTOK + b * SEQ + qb * 256) * 256);
        r.clog = (unsigned)WS_CLOG + (unsigned)((b * 8 + h) * SEQ * 4);
        { const float qm2 = __uint_as_float(__hip_atomic_load((unsigned*)(F.ctl + CW_QMAX + bh * 16 + qb), RLX_AGENT)), km2 = __uint_as_float(__hip_atomic_load((unsigned*)(F.ctl + CW_KMAX + bh), RLX_AGENT));
          const float bound = (MK_FUSE_NORMS ? 2.02f : 2.002f) * sqrtf(qm2 * km2) + FOX_SKIP_T;       const float* clg = (const float*)(F.ws + WS_CLOG) + (size_t)(b * 8 + h) * SEQ;
          int lane; asm volatile("v_mbcnt_lo_u32_b32 %0, -1, 0\n\tv_mbcnt_hi_u32_b32 %0, -1, %0" : "=v"(lane));
          const int ntb = qb * 4;
          bool skip = false; if (lane < ntb) skip = (bound + clg[qb * 256] - clg[64 * lane + 63]) <= 0.f;
          r.jlo = (int)__popcll(__ballot(skip)) & ~1; }
    } else {
        const int vhb = xcd * 8 + (k >> 3), b = vhb >> 4, vv = vhb & 15, h = vv >> 2, mp = (vv >> 1) & 1, vhalf = vv & 1;
        r.Q = (unsigned)WS_QKV + (unsigned)(((h * 2 + mp) * MTOK + b * SEQ + qb * 256) * 256); r.K = (unsigned)WS_QKV + (unsigned)(((8 + h * 2 + mp) * MTOK + b * SEQ) * 256);
        r.V = (unsigned)WS_QKV + (unsigned)(((16 + h * 2 + vhalf) * MTOK + b * SEQ) * 256); r.O = (unsigned)WS_O + (unsigned)(((8 + vv) * MTOK + b * SEQ + qb * 256) * 256);
        r.clog = 0u; r.jlo = 0;
    }
    r.P0 = qb * 256;
    return r;
}
template <bool FOX>
__device__ __forceinline__ void attn_run(const Frame& F, char* lds) {
    constexpr int total = FOX ? 256 : 512;
    int L = blockIdx.x; if (L >= total) return;
    int pass = 0; const int stride = F.G;
    att::BlockRef cur = attn_ref<FOX>(F, L, 0);
    att::Seam S;
    att::attn_prime(F.ws, cur, lds, S);
    for (;;) {
        const bool more_pass = pass == 0, more_item = L + stride < total, last = !more_pass && !more_item;
        int passn = pass + 1, Ln = L;
        if (!more_pass) { passn = 0; Ln = more_item ? L + stride : L; }
        const int Lr = last ? L : Ln, pr = last ? pass : passn;
        auto nref = [&F, Lr, pr]() { return attn_ref<FOX>(F, Lr, pr); };
        att::attn_block<FOX>(F.ws, cur, nref, lds, S);
        if (last) break;
        pass = passn; L = Ln; cur = attn_ref<FOX>(F, L, pass);
    }
}

__device__ __forceinline__ att::BlockRefW attn_refW(int L, int pass) {
    const int xcd = L & 7, k = L >> 3, x = k & 7, qb = pass ? 15 - x : x;
    const int bhm = xcd * 4 + (k >> 3), b = bhm >> 3, hm = bhm & 7, h = hm >> 1, mp = hm & 1;
    att::BlockRefW r;
    r.Q = (unsigned)WS_QKV + (unsigned)(((h * 2 + mp) * MTOK + b * SEQ + qb * 256) * 256); r.K = (unsigned)WS_QKV + (unsigned)(((8 + h * 2 + mp) * MTOK + b * SEQ) * 256);
    r.V0 = (unsigned)WS_QKV + (unsigned)(((16 + h * 2) * MTOK + b * SEQ) * 256); r.V1 = (unsigned)WS_QKV + (unsigned)(((17 + h * 2) * MTOK + b * SEQ) * 256);
    r.O0 = (unsigned)WS_O + (unsigned)(((8 + h * 4 + mp * 2) * MTOK + b * SEQ + qb * 256) * 256); r.O1 = (unsigned)WS_O + (unsigned)(((9 + h * 4 + mp * 2) * MTOK + b * SEQ + qb * 256) * 256);
    r.P0 = qb * 256;
    return r;
}
__device__ __forceinline__ void attn_runW(const Frame& F, char* lds) {
    constexpr int total = 256;
    int L = blockIdx.x; if (L >= total) return;
    int pass = 0; const int stride = F.G;
    att::BlockRefW cur = attn_refW(L, 0);
    att::SeamW S;
    att::attn_primeW(F.ws, cur, lds, S);
    for (;;) {
        const bool more_pass = pass == 0, more_item = L + stride < total, last = !more_pass && !more_item;
        int passn = pass + 1, Ln = L;
        if (!more_pass) { passn = 0; Ln = more_item ? L + stride : L; }
        const int Lr = last ? L : Ln, pr = last ? pass : passn;
        auto nref = [Lr, pr]() { return attn_refW(Lr, pr); };
        att::attn_blockW(F.ws, cur, nref, lds, S);
        if (last) break;
        pass = passn; L = Ln; cur = attn_refW(L, pass);
    }
}

constexpr int NPHASE = 10;
#ifndef MK_BAL
#define MK_BAL 1
#endif
constexpr int MOE_RB = MK_FP8 ? DM : DM * 2;
#ifndef MK_ATT_MASK
#define MK_ATT_MASK 3
#endif
#ifndef MK_DIFFW
#define MK_DIFFW 1
#endif
#ifndef MK_KREP_LOG
#define MK_KREP_LOG 0
#endif
#ifndef MK_KROT
#define MK_KROT 0
#endif
#define MOE_ROT(c, nt) (MK_KROT ? (int)((((((c) >> 3) >> 2) * ((nt) / 8)) + ((((c) >> 3) & 3) * ((nt) / 4))) & ((nt) - 1)) : 0)
#ifndef MK_OVERLAP
#define MK_OVERLAP 1
#endif
__device__ __forceinline__ void ph1(Frame& F, KArgs ka) {
#if MK_FP8 && MK_OVERLAP
    const bool conv_first = ((blockIdx.x >> 3) & 1) != 0;
    if (conv_first) p0b_experts(F, ka, 0, P0B_IGU);
#endif
    p1_scan(F);
    pg8::DenseOrder S; S.init((const bf16_t*)(F.ws + WS_XN), (const bf16_t*)(F.ws + WS_WIN), MTOK, NQKV, DM * 2, F.G, (int)blockIdx.x);
    pg8::EpiQKV E{(bf16_t*)(F.ws + WS_QKV), (const float*)(F.ws + WS_ROPE), (unsigned*)F.ctl, (LAS float*)(F.lds + RING_BYTES + 2048)};
    pg8::gemm_phase<pg8::EpiQKV, pg8::DenseOrder, false>(F.lds, F.lds + LDS_IDX, DM * 2, S, E);
#if MK_FP8 && MK_OVERLAP
    if (!conv_first) p0b_experts(F, ka, 0, P0B_IGU);
#endif
}
__device__ __forceinline__ void ph2(Frame& F, KArgs ka, char* lds) {
#if MK_FP8 && MK_OVERLAP
    const int cshift = (int)(blockIdx.x >> 3) % 3;
    if (cshift == 0) p0b_experts(F, ka, P0B_IGU, P0B_NI);
#endif
    if (MK_ATT_MASK & 1) attn_run<true>(F, lds);
    __syncthreads();
#if MK_FP8 && MK_OVERLAP
    if (cshift == 1) p0b_experts(F, ka, P0B_IGU, P0B_NI);
#endif
#if MK_DIFFW
    if (MK_ATT_MASK & 2) attn_runW(F, lds);
#else
    if (MK_ATT_MASK & 2) attn_run<false>(F, lds);
#endif
#if MK_FP8 && MK_OVERLAP
    if (cshift == 2) p0b_experts(F, ka, P0B_IGU, P0B_NI);
#endif
}
__device__ __forceinline__ void ph4(Frame& F, KArgs ka, float* hbuf) {
    pg8::DenseOrder S; S.init((const bf16_t*)(F.ws + WS_MIX), (const bf16_t*)(F.ws + WS_WOUT), MTOK, DM, DM * 2, F.G, (int)blockIdx.x);
    pg8::EpiOut E{(const float*)KIN(0), hbuf, (bf16_t*)(F.ws + WS_HG), (const float*)KIN(12)};
    pg8::gemm_phase<pg8::EpiOut, pg8::DenseOrder, false>(F.lds, F.lds + LDS_IDX, DM * 2, S, E);
}
__device__ __forceinline__ void ph6(Frame& F, KArgs ka, LAS int* tab) {
    build_tab(F, tab, true);
    pg8::MoeOrder S; S.A = (const void*)(F.ws + WS_HG); S.Bt = (const void*)(F.ws + WS_WGU); S.RB = MOE_RB; S.nN = 16; S.NperE = 4096; S.G = F.G; S.c = (int)blockIdx.x; S.rot = MOE_ROT(blockIdx.x, MOE_RB / 128); S.tab = tab; S.tok = (const int*)(F.ws + WS_TOK);
    pg8::EpiGU E{(bf16_t*)(F.ws + WS_HDN), (const float*)KIN(16), (const float*)KIN(18), (const float*)(F.ws + WS_RSTD), tab, (const LAS float*)(F.lds + LDS_IDX + 2048)}; S.rowsc = (const float*)(F.ws + WS_RSTD);
    pg8::gemm_phase<pg8::EpiGU, pg8::MoeOrder, true, MK_FP8 != 0, 127 - FP8_WSHIFT - MK_KREP_LOG, 127 - FP8_HGSHIFT, (1 << MK_KREP_LOG), (MK_FP8 != 0 && MK_FP6 != 0), (MK_BAL != 0)>(F.lds, F.lds + LDS_IDX, MOE_RB, S, E);
}
__device__ __forceinline__ void ph7(Frame& F, KArgs ka, LAS int* tab) {
    build_tab(F, tab, false);
    pg8::MoeOrderDense S; S.A = (const void*)(F.ws + WS_HDN); S.Bt = (const void*)(F.ws + WS_WD); S.RB = MOE_RB; S.nN = 8; S.NperE = 2048; S.G = F.G; S.c = (int)blockIdx.x; S.rot = MOE_ROT(blockIdx.x, MOE_RB / 128); S.tab = tab; S.tok = nullptr;
    pg8::EpiDown E{(bf16_t*)(F.ws + WS_YS), (const float*)KIN(20), (const float*)(F.ws + WS_GATE), tab, (const LAS float*)(F.lds + LDS_IDX + 2048)}; S.rowsc = (const float*)(F.ws + WS_GATE);
    pg8::gemm_phase<pg8::EpiDown, pg8::MoeOrderDense, false, MK_FP8 != 0, 127 - FP8_WSHIFT - MK_KREP_LOG, 127 - FP8_HDSHIFT, (1 << MK_KREP_LOG), (MK_FP8 != 0 && MK_FP6 != 0), (MK_BAL != 0)>(F.lds, F.lds + LDS_IDX, MOE_RB, S, E);
}
__device__ __forceinline__ Frame make_frame(KArgs ka, LAS unsigned char* lds) {
    Frame F; F.lds = lds; F.wave = __builtin_amdgcn_readfirstlane(((int)threadIdx.x) >> 6);
    F.G = gridDim.x; { const int bx = blockIdx.x; F.vcu = (F.G % 8 == 0) ? (bx % 8) * (F.G / 8) + bx / 8 : bx; }
    unsigned char* ws = ka->ws; F.ws = ws; F.ctl = (gu32*)(ws + WS_CTL);
    return F;
}
__global__ void __launch_bounds__(NTHREADS, 2) mk_fwd(Args args) {
    extern __shared__ __attribute__((aligned(16))) unsigned char lds[];
    const KArgs ka = (KArgs)__builtin_amdgcn_kernarg_segment_ptr();
    { volatile LAS unsigned* MISC = (volatile LAS unsigned*)((LAS unsigned char*)lds + LDS_MISC);
      if (((int)threadIdx.x) < 32) MISC[((int)threadIdx.x)] = 0u;
      __syncthreads();
      if (ka->ph_hi - ka->ph_lo > 1) (void)xcd_barrier_post((unsigned*)((gu32*)(ka->ws + WS_CTL) + CW_BAR), MISC + 8); }
#ifndef MK_PHASE_MASK
#define MK_PHASE_MASK 0x3FF
#endif
#ifndef MK_REP_PHASE
#define MK_REP_PHASE -1
#endif
#define IN(k) ((((MK_PHASE_MASK) >> (k)) & 1) && ka->ph_lo <= (k) && (k) < ka->ph_hi)
#define GRIDBAR() do { XcdBarrier b_; b_.bar = (unsigned*)((gu32*)(ka->ws + WS_CTL) + CW_BAR); b_.x = xb_xcc_id(); b_.st = (volatile LAS unsigned*)((LAS unsigned char*)lds + LDS_MISC) + 8; xcd_barrier(b_); } while (0)
#define SEAM(k) do { if (IN(k) && IN((k) + 1)) GRIDBAR(); } while (0)
#define RUN(k, CALL) do { if (IN(k)) { Frame F = make_frame(ka, (LAS unsigned char*)lds); LAS int* tab = (LAS int*)(F.lds + LDS_TAB); float* hbuf = ka->out; (void)tab; (void)hbuf; CALL; \
        if (MK_REP_PHASE == (k)) { GRIDBAR(); CALL; } } } while (0)
#if MK_FP8 && !MK_OVERLAP
    RUN(0, (p0_prologue(F, ka), p0b_experts(F, ka, 0, P0B_NI)));
#else
    RUN(0, p0_prologue(F, ka));
#endif
#ifdef MK_PROBE_STREAM
    if (IN(0)) { GRIDBAR(); Frame F = make_frame(ka, (LAS unsigned char*)lds); probe_stream(F, ka); }
#endif
    SEAM(0);
    RUN(1, ph1(F, ka)); SEAM(1);
#if MK_FUSE_NORMS
#else
    RUN(2, p_norms(F)); SEAM(2);
#endif
    RUN(3, ph2(F, ka, (char*)lds)); SEAM(3);
    RUN(4, p3_mix(F, ka)); SEAM(4);
    RUN(5, ph4(F, ka, hbuf)); SEAM(5);
    RUN(6, p5_router(F, ka, hbuf)); SEAM(6);
    RUN(7, ph6(F, ka, tab)); SEAM(7);
    RUN(8, ph7(F, ka, tab)); SEAM(8);
    RUN(9, p8_final(F, ka, hbuf));
#undef IN
#undef SEAM
#undef RUN
#undef GRIDBAR
}

#ifndef MK_N_LAUNCHES
#define MK_N_LAUNCHES 1
#endif
extern "C" void kernel_launch(void* const* d_in, const int* in_sizes, int n_in, void* d_out, int out_size, void* d_ws, size_t ws_size, hipStream_t stream) {
    static int grid = 0;
    if (grid == 0) {
        if (n_in != 22 || in_sizes[0] != MTOK * DM || out_size != MTOK * DM || ws_size < WS_END) {
            fprintf(stderr, "kernel_launch: unexpected shapes (n_in %d, in0 %d, out %d, ws %zu; need ws >= %zu); nothing launched\n", n_in, n_in > 0 ? in_sizes[0] : -1, out_size, ws_size, (size_t)WS_END); grid = -1; return; }
        int dev = 0, cus = 0, per_cu = 0;
        if (hipGetDevice(&dev) != hipSuccess || hipDeviceGetAttribute(&cus, hipDeviceAttributeMultiprocessorCount, dev) != hipSuccess) { fprintf(stderr, "kernel_launch: device query failed\n"); grid = -1; return; }
        if (hipFuncSetAttribute((const void*)mk_fwd, hipFuncAttributeMaxDynamicSharedMemorySize, LDS_BYTES) != hipSuccess) { fprintf(stderr, "kernel_launch: hipFuncSetAttribute failed\n"); grid = -1; return; }
        if (hipOccupancyMaxActiveBlocksPerMultiprocessor(&per_cu, (const void*)mk_fwd, NTHREADS, LDS_BYTES) != hipSuccess || per_cu < 1)
            fprintf(stderr, "kernel_launch: note: occupancy query reports %d workgroups per CU\n", per_cu);
        (void)hipGetLastError();
        grid = cus;
    }
    if (grid < 0) return;
    if (hipMemsetAsync((char*)d_ws + WS_CTL, 0, CTL_ZERO_BYTES, stream) != hipSuccess) { fprintf(stderr, "kernel_launch: memset failed\n"); return; }
    Args a{};
    for (int i = 0; i < 22; ++i) a.in[i] = d_in[i];
    a.out = (float*)d_out; a.ws = (unsigned char*)d_ws;
    if (MK_N_LAUNCHES == 1) { a.ph_lo = 0; a.ph_hi = NPHASE; hipLaunchKernelGGL(mk_fwd, dim3(grid), dim3(NTHREADS), LDS_BYTES, stream, a); }
    else for (int p = 0; p < NPHASE; ++p) { a.ph_lo = p; a.ph_hi = p + 1; hipLaunchKernelGGL(mk_fwd, dim3(grid), dim3(NTHREADS), LDS_BYTES, stream, a); }
#ifdef MK_EXTRA_PHASE
    a.ph_lo = MK_EXTRA_PHASE; a.ph_hi = MK_EXTRA_PHASE + 1; hipLaunchKernelGGL(mk_fwd, dim3(grid), dim3(NTHREADS), LDS_BYTES, stream, a);
#endif
    const hipError_t le = hipPeekAtLastError();
    if (le != hipSuccess) fprintf(stderr, "kernel_launch: launch failed: %s\n", hipGetErrorName(le));
}
```

```cpp
#include <hip/hip_runtime.h>
#include <cstdio>
#include <cstdint>

#define LAS __attribute__((address_space(3)))
#define GAS __attribute__((address_space(1)))
typedef unsigned short bf16_t;
typedef short bf16x8 __attribute__((ext_vector_type(8)));
typedef short s16x4 __attribute__((ext_vector_type(4)));
typedef float f32x4 __attribute__((ext_vector_type(4)));
typedef float f32x2 __attribute__((ext_vector_type(2)));
typedef float f32x16 __attribute__((ext_vector_type(16)));
typedef unsigned u32x4 __attribute__((ext_vector_type(4)));
typedef unsigned u32x2 __attribute__((ext_vector_type(2)));
typedef int v4i_t __attribute__((ext_vector_type(4)));
typedef int v8i_t __attribute__((ext_vector_type(8)));

constexpr int DM = 2048, BATCH = 4, SEQ = 4096, MTOK = BATCH * SEQ, INC = 6152, NQKV = 6144, NE = 32, TOPK = 4, ECAP = 16384;
constexpr float EPS = 1e-5f, L2E = 1.4426950408889634f, QSCALE = 0.08838834764831845f * 1.4426950408889634f;
constexpr int NWAVES = 8, NTHREADS = 512;
constexpr size_t MiB = 1u << 20;
constexpr size_t WS_CTL = 0, CTL_ZERO_BYTES = 1 * MiB;
constexpr size_t WS_GWF = 2 * MiB;
constexpr size_t WS_CLOG = 3 * MiB;
constexpr size_t WS_FLOG = 4 * MiB;
constexpr size_t WS_TKE = 5 * MiB;
constexpr size_t WS_TOK = 6 * MiB;
constexpr size_t WS_RSTD = 8 * MiB;
constexpr size_t WS_GATE = 10 * MiB;
constexpr size_t WS_ROPE = 12 * MiB;
constexpr size_t WS_WIN = 20 * MiB;
constexpr size_t WS_WOUT = 44 * MiB;
constexpr size_t WS_TSTART = 52 * MiB;
constexpr size_t WS_WGU = 64 * MiB;
constexpr size_t WS_WD = 576 * MiB;
constexpr size_t WS_XN = 832 * MiB;
constexpr size_t WS_QKV = 896 * MiB;
constexpr size_t WS_O = 1088 * MiB;
constexpr size_t WS_MIX = 1184 * MiB;
constexpr size_t WS_HG = 1248 * MiB;
constexpr size_t WS_HDN = 1312 * MiB;
constexpr size_t WS_YS = 1600 * MiB;
constexpr size_t WS_END = 1888 * MiB;
constexpr int CW_TMO = 0, CW_BAR = 4096, CW_CNT = 8192;
constexpr int CW_QMAX = 12288, CW_KMAX = 12800;
constexpr float FOX_SKIP_T = 30.0f;
constexpr int RING_BYTES = 131072;
constexpr int LDS_IDX = RING_BYTES;
constexpr int LDS_TAB = RING_BYTES + 1024;
constexpr int LDS_MISC = RING_BYTES + 1024 + 512;
constexpr int LDS_BYTES = 147456;

__device__ __forceinline__ unsigned f2bf(float f) { unsigned u = __builtin_bit_cast(unsigned, f); return (u + 0x7fffu + ((u >> 16) & 1u)) >> 16; }
__device__ __forceinline__ unsigned pk2(float lo, float hi) { return f2bf(lo) | (f2bf(hi) << 16); }
__device__ __forceinline__ float bf2f(unsigned short b) { return __builtin_bit_cast(float, (unsigned)b << 16); }
__device__ __forceinline__ unsigned cvt_pk_bf16(float lo, float hi) { unsigned r; asm volatile("v_cvt_pk_bf16_f32 %0, %1, %2" : "=v"(r) : "v"(lo), "v"(hi)); return r; }
__device__ __forceinline__ float wave_sum(float v) {
#pragma unroll
    for (int o = 1; o < 64; o <<= 1) v += __shfl_xor(v, o);
    return v;
}

__device__ __forceinline__ void glds16s(const char* sbase, unsigned voff, unsigned lds_dst) { unsigned keep;
    asm volatile("s_mov_b32 %0, m0\n\ts_mov_b32 m0, %3\n\ts_nop 0\n\tglobal_load_lds_dwordx4 %1, %2\n\ts_mov_b32 m0, %0" : "=&s"(keep) : "v"(voff), "s"(sbase), "s"(lds_dst) : "memory"); }
__device__ __forceinline__ void glds4s(const char* sbase, unsigned voff, unsigned lds_dst) { unsigned keep;
    asm volatile("s_mov_b32 %0, m0\n\ts_mov_b32 m0, %3\n\ts_nop 0\n\tglobal_load_lds_dword %1, %2\n\ts_mov_b32 m0, %0" : "=&s"(keep) : "v"(voff), "s"(sbase), "s"(lds_dst) : "memory"); }
__device__ __forceinline__ const char* uni_ptr(const char* p) { const unsigned long long v = (unsigned long long)p;
    const unsigned lo = (unsigned)__builtin_amdgcn_readfirstlane((int)(unsigned)v), hi = (unsigned)__builtin_amdgcn_readfirstlane((int)(unsigned)(v >> 32)); return (const char*)(((unsigned long long)hi << 32) | lo); }

#ifndef MK_SPLITW
#define MK_SPLITW 1
#endif
#ifndef MK_EPI_LDS
#define MK_EPI_LDS 1
#endif
namespace pg8 {
constexpr int BM = 256, BK = 64, HALF = 128, HTB = HALF * BK * 2, STAGE_BYTES = 8 * HTB, NXCD = 8, WGM = 8;
__host__ __device__ __forceinline__ int lds_byte(int r, int c) { const int st = (r >> 4) * 2 + (c >> 5), rr = r & 15, cc = c & 31, ob = rr * 64 + cc * 2; return st * 1024 + (ob ^ (((ob >> 9) & 1) << 5)); }
__host__ __device__ __forceinline__ void stage_rc(int b, int& R, int& C) { const int st = b / 1024, sb = b % 1024, swz = sb ^ (((sb >> 9) & 1) << 5); R = (st >> 1) * 16 + swz / 64; C = (st & 1) * 32 + (swz % 64) / 2; }
__host__ __device__ __forceinline__ int perm32(int rho) { const int n = rho >> 4, i = rho & 15; return 8 * (i >> 2) + 4 * n + (i & 3); }

struct Unit { int pm, pn, e, rows0; };

struct DenseOrder {
    const bf16_t* A; const bf16_t* Bt; int RB; int nM, nN, nwg, G, c; int rot = 0;
    __device__ void init(const bf16_t* A_, const bf16_t* Bt_, int M, int N, int RB_, int G_, int c_) { A = A_; Bt = Bt_; RB = RB_; nM = M / BM; nN = N / BM; nwg = nM * nN; G = G_; c = c_; }
    __device__ __forceinline__ bool next(int i, Unit& u) const {
        const long L = (long)i * G + c; if (L >= nwg) return false;
        int wgid = (int)L; { const int q = nwg / NXCD, r = nwg % NXCD, xcd = wgid % NXCD, off = wgid / NXCD; wgid = (xcd < r ? xcd * (q + 1) : r * (q + 1) + (xcd - r) * q) + off; }
        const int nig = WGM * nN, gid = wgid / nig, fm = gid * WGM, gsz = (nM - fm) < WGM ? (nM - fm) : WGM;
        u.pm = fm + ((wgid % nig) % gsz); u.pn = (wgid % nig) / gsz; u.e = 0; u.rows0 = 0; return true;
    }
    __device__ __forceinline__ const char* a_base(const Unit& u) const { return (const char*)A + (size_t)u.pm * BM * RB; }
    __device__ __forceinline__ const char* b_base(const Unit& u) const { return (const char*)Bt + (size_t)u.pn * BM * RB; }
};
struct MoeOrder {
    const float* rowsc = nullptr;
    const void* A; const void* Bt; int RB; int nN; int NperE; int G, c; int rot; const LAS int* tab; const int* tok;
    __device__ __forceinline__ bool next(int i, Unit& u) const {
        const int T = __builtin_amdgcn_readfirstlane(tab[NE]);
        int t;
        if (G == 256) {
            const int x = c & 7, j = c >> 3, XP = nN >> 3, tpr = 256 / nN;
            t = i * tpr + (x / XP) * 4 + (j & 3); u.pn = (x % XP) * 8 + (j >> 2);
            if (t >= T) return false;
        } else {
            const int L = i * G + c; if (L >= T * nN) return false;
            t = L / nN; u.pn = L - t * nN;
        }
        u.pm = t;
        int e; { const int ln = (int)(threadIdx.x & 63); const int tv = tab[ln & 31];
                 e = (int)__popcll(__ballot(ln < NE && tv <= t)) - 1; }
        u.e = e; u.rows0 = __builtin_amdgcn_readfirstlane((t - tab[e]) * BM); return true;
    }
    __device__ __forceinline__ int cnt_of(const Unit& u) const { return __builtin_amdgcn_readfirstlane(tab[NE + 1 + u.e]); }
    __device__ __forceinline__ const char* a_base(const Unit& u) const { return (const char*)A; }
    __device__ __forceinline__ const char* a_base_dense(const Unit& u) const { return (const char*)A + (size_t)u.pm * BM * RB; }
    __device__ __forceinline__ const char* b_base(const Unit& u) const { return (const char*)Bt + ((size_t)u.e * NperE + (size_t)u.pn * BM) * RB; }
};
struct MoeOrderDense : MoeOrder {
    __device__ __forceinline__ const char* a_base(const Unit& u) const { return a_base_dense(u); }
};

template <class Epi, class Sched, bool GATHER, bool FP8 = false, int SCW = 127, int SCA = 127, int KREP = 1, bool FP6 = false, bool BAL = false>
__device__ __forceinline__ void gemm_phase(LAS unsigned char* lds, LAS unsigned char* lds_idx, const int RB, const Sched& S, const Epi& E) {
    const int tid = threadIdx.x, wid = __builtin_amdgcn_readfirstlane(tid >> 6), lane = tid & 63, wr = wid >> 2, wc = wid & 3, fr = lane & 15, fq = lane >> 4;
    const int nt = (RB / 128) * KREP;
    unsigned voffA[2], voffB[2]; int RA[2], CA2[2];
#pragma unroll
    for (int i = 0; i < 2; ++i) { int R, C; stage_rc(tid * 16 + i * 8192, R, C); const int Rb = (R & ~31) + perm32(R & 31);
        voffA[i] = (unsigned)(R * RB + C * 2); voffB[i] = (unsigned)(Rb * RB + C * 2); RA[i] = R; CA2[i] = C * 2; }
    const int rot = S.rot, ntm = RB / 128 - 1;
#define PG8_KOFF(t) ((size_t)((((t) + rot) & ntm) * 128))
    const size_t hstep = (size_t)HALF * RB;
    const unsigned ldsw = (unsigned)wid * 1024u;
    const unsigned ldsb = (unsigned)__builtin_amdgcn_readfirstlane((int)(unsigned)(uintptr_t)lds);
    const int aoff = lds_byte(wr * 64 + fr, fq * 8), boff = lds_byte(wc * 32 + fr, fq * 8);
#define PG8_SA(b, h) (((b) * 2 + (h)) * HTB)
#define PG8_SB(b, h) ((4 + (b) * 2 + (h)) * HTB)
#define PG8_GL(bufoff, gptr, v0, v1) do { const char* gp_ = uni_ptr((const char*)(gptr)); \
        glds16s(gp_, (v0), ldsb + (unsigned)(bufoff) + ldsw); glds16s(gp_, (v1), ldsb + (unsigned)(bufoff) + ldsw + 8192u); } while (0)
#define PG8_STAGE_B(bufoff, gbase) PG8_GL(bufoff, gbase, voffB[0], voffB[1])
#define PG8_STAGE_A(bufoff, gbase, h, V) do { if constexpr (GATHER) { PG8_GL(bufoff, gbase, V[h][0], V[h][1]); } else { PG8_GL(bufoff, (gbase) + (h) * hstep, voffA[0], voffA[1]); } } while (0)
#define PG8_LDA(dst, b, h) do { _Pragma("unroll") for (int m = 0; m < 4; ++m) _Pragma("unroll") for (int k = 0; k < 2; ++k) dst[m][k] = *(const LAS bf16x8*)(lds + PG8_SA(b, h) + aoff + m * 2048 + k * 1024); } while (0)
#define PG8_LDB(dst, b, h) do { _Pragma("unroll") for (int n = 0; n < 2; ++n) _Pragma("unroll") for (int k = 0; k < 2; ++k) dst[n][k] = *(const LAS bf16x8*)(lds + PG8_SB(b, h) + boff + n * 2048 + k * 1024); } while (0)
#define PG8_CAT(x, y) __builtin_shufflevector(__builtin_bit_cast(v4i_t, x), __builtin_bit_cast(v4i_t, y), 0, 1, 2, 3, 4, 5, 6, 7)
#define PG8_MMA(ai, bj, At, Bt) do { __builtin_amdgcn_s_setprio(1); _Pragma("unroll") for (int m = 0; m < 4; ++m) _Pragma("unroll") for (int n = 0; n < 2; ++n) { \
        if constexpr (FP6) { acc[ai][bj][m][n] = __builtin_amdgcn_mfma_scale_f32_16x16x128_f8f6f4(PG8_CAT(Bt[n][0], Bt[n][1]), PG8_CAT(At[m][0], At[m][1]), acc[ai][bj][m][n], 2, 2, 0, __builtin_bit_cast(v4i_t, Bt[n][1])[2], 0, __builtin_bit_cast(v4i_t, At[m][1])[2]); } \
        else if constexpr (FP8) { acc[ai][bj][m][n] = __builtin_amdgcn_mfma_scale_f32_16x16x128_f8f6f4(PG8_CAT(Bt[n][0], Bt[n][1]), PG8_CAT(At[m][0], At[m][1]), acc[ai][bj][m][n], 0, 0, 0, (SCW | (SCA << 8)), 1, (SCW | (SCA << 8))); }     \
        else { _Pragma("unroll") for (int k = 0; k < 2; ++k) acc[ai][bj][m][n] = __builtin_amdgcn_mfma_f32_16x16x32_bf16(Bt[n][k], At[m][k], acc[ai][bj][m][n], 0, 0, 0); } } \
        __builtin_amdgcn_s_setprio(0); } while (0)
#define PG8_MMA_H(ai, bj, At, Bt, m0) do { __builtin_amdgcn_s_setprio(1); _Pragma("unroll") for (int m = (m0); m < (m0) + 2; ++m) _Pragma("unroll") for (int n = 0; n < 2; ++n) { \
        if constexpr (FP6) { acc[ai][bj][m][n] = __builtin_amdgcn_mfma_scale_f32_16x16x128_f8f6f4(PG8_CAT(Bt[n][0], Bt[n][1]), PG8_CAT(At[m][0], At[m][1]), acc[ai][bj][m][n], 2, 2, 0, __builtin_bit_cast(v4i_t, Bt[n][1])[2], 0, __builtin_bit_cast(v4i_t, At[m][1])[2]); } } \
        __builtin_amdgcn_s_setprio(0); } while (0)
constexpr bool SPLITW = FP6 && (MK_SPLITW != 0);
#define PG8_WAIT_V(n) asm volatile("s_waitcnt vmcnt(" #n ")" ::: "memory")
#define PG8_WAIT_L(n) asm volatile("s_waitcnt lgkmcnt(" #n ")" ::: "memory")
#define PG8_BAR __builtin_amdgcn_s_barrier()
#define PG8_SCHED __builtin_amdgcn_sched_barrier(0)
    Unit cur, nxt; int ui = 0;
    if (!S.next(0, cur)) return;
    f32x4 acc[2][2][4][2];
#pragma unroll
    for (int a = 0; a < 2; ++a)
#pragma unroll
        for (int b = 0; b < 2; ++b)
#pragma unroll
            for (int m = 0; m < 4; ++m)
#pragma unroll
                for (int n = 0; n < 2; ++n) acc[a][b][m][n] = (f32x4){0.f, 0.f, 0.f, 0.f};
    bf16x8 At[4][2], B0[2][2], B1[2][2];
    unsigned VC[2][2];
    if constexpr (GATHER) {
        const int cnt = S.cnt_of(cur);
#pragma unroll
        for (int h = 0; h < 2; ++h)
#pragma unroll
            for (int i = 0; i < 2; ++i) { const int pos = cur.rows0 + h * HALF + RA[i]; int tk = S.tok[(size_t)cur.e * ECAP + pos]; tk = pos < cnt ? tk : 0; VC[h][i] = (unsigned)tk * (unsigned)RB + (unsigned)CA2[i]; }
    } else {
#pragma unroll
        for (int h = 0; h < 2; ++h)
#pragma unroll
            for (int i = 0; i < 2; ++i) VC[h][i] = 0u;
    }
    const char* cA = S.a_base(cur); const char* cB = S.b_base(cur);
    PG8_STAGE_B(PG8_SB(0, 0), cB + PG8_KOFF(0)); PG8_STAGE_B(PG8_SB(0, 1), cB + hstep + PG8_KOFF(0)); PG8_STAGE_A(PG8_SA(0, 0), cA + PG8_KOFF(0), 0, VC); PG8_STAGE_A(PG8_SA(0, 1), cA + PG8_KOFF(0), 1, VC);
    if (wr == 1) PG8_BAR;
    PG8_WAIT_V(2); PG8_BAR;
    if constexpr (BAL) { PG8_STAGE_B(PG8_SB(1, 0), cB + PG8_KOFF(1)); PG8_STAGE_B(PG8_SB(1, 1), cB + hstep + PG8_KOFF(1)); PG8_WAIT_V(4); PG8_BAR; }
    else { PG8_STAGE_B(PG8_SB(1, 0), cB + PG8_KOFF(1)); PG8_STAGE_A(PG8_SA(1, 0), cA + PG8_KOFF(1), 0, VC); PG8_STAGE_B(PG8_SB(1, 1), cB + hstep + PG8_KOFF(1));
    PG8_WAIT_V(6); PG8_BAR; }
    for (;;) {
        const bool has_next = S.next(ui + 1, nxt);
        const char* nA = has_next ? S.a_base(nxt) : cA; const char* nB = has_next ? S.b_base(nxt) : cB;
        for (int t = 0; t < nt; t += 2) {
            const bool last = (t == nt - 2);
            if constexpr (FP8 && MK_EPI_LDS) {
                if (t == nt - 4 && wid >= 4)
                    glds4s(uni_ptr((const char*)(S.rowsc + (size_t)cur.e * ECAP + cur.rows0 + (wid - 4) * 64)), (unsigned)lane * 4u, (unsigned)__builtin_amdgcn_readfirstlane((int)(unsigned)(uintptr_t)lds_idx) + 2048u + (unsigned)(wid - 4) * 256u);
            }
            if constexpr (GATHER) {
                if (has_next && t == nt - 4 && wid < 4)
                    glds4s(uni_ptr((const char*)(S.tok + (size_t)nxt.e * ECAP + nxt.rows0 + wid * 64)), (unsigned)lane * 4u, (unsigned)__builtin_amdgcn_readfirstlane((int)(unsigned)(uintptr_t)lds_idx) + (unsigned)wid * 256u);
            }
            const char* a1 = cA + PG8_KOFF(t + 1);
            const char* a2 = (last ? nA : cA) + PG8_KOFF(t + 2); const char* b2 = (last ? nB : cB) + PG8_KOFF(t + 2);
            const char* a3 = (last ? nA : cA) + PG8_KOFF(t + 3); const char* b3 = (last ? nB : cB) + PG8_KOFF(t + 3);
            if constexpr (SPLITW) { PG8_LDA(At, 0, 0); PG8_SCHED; PG8_LDB(B0, 0, 0); PG8_SCHED; PG8_LDB(B1, 0, 1); PG8_SCHED; } else { PG8_LDB(B0, 0, 0); PG8_LDB(B1, 0, 1); PG8_SCHED; PG8_LDA(At, 0, 0); }
            if constexpr (BAL) PG8_STAGE_A(PG8_SA(1, 0), a1, 0, VC); PG8_STAGE_A(PG8_SA(1, 1), a1, 1, VC);
            if constexpr (GATHER) {
                if (last && has_next) { const int cntn = S.cnt_of(nxt);
#pragma unroll
                    for (int h = 0; h < 2; ++h)
#pragma unroll
                        for (int i = 0; i < 2; ++i) { const int r = h * HALF + RA[i]; int tk = *(const LAS int*)(lds_idx + r * 4); tk = (nxt.rows0 + r) < cntn ? tk : 0; VC[h][i] = (unsigned)tk * (unsigned)RB + (unsigned)CA2[i]; } }
            }
            PG8_WAIT_V(8); if constexpr (SPLITW) PG8_WAIT_L(4); else PG8_WAIT_L(0); PG8_BAR; PG8_MMA(0, 0, At, B0); PG8_MMA(0, 1, At, B1); PG8_BAR; PG8_SCHED;
            PG8_LDA(At, 0, 1); PG8_STAGE_B(PG8_SB(0, 0), b2); PG8_STAGE_B(PG8_SB(0, 1), b2 + hstep); if constexpr (!BAL) PG8_STAGE_A(PG8_SA(0, 0), a2, 0, VC);
            if constexpr (BAL) PG8_WAIT_V(6); else PG8_WAIT_V(8);
            if constexpr (SPLITW) { PG8_WAIT_L(4); PG8_BAR; PG8_MMA_H(1, 0, At, B0, 0); PG8_MMA_H(1, 1, At, B1, 0); PG8_MMA_H(1, 0, At, B0, 2); PG8_MMA_H(1, 1, At, B1, 2); PG8_BAR; PG8_SCHED; }
            else { PG8_WAIT_L(0); PG8_BAR; PG8_MMA(1, 0, At, B0); PG8_MMA(1, 1, At, B1); PG8_BAR; PG8_SCHED; }
            if constexpr (SPLITW) { PG8_LDA(At, 1, 0); PG8_SCHED; PG8_LDB(B0, 1, 0); PG8_SCHED; PG8_LDB(B1, 1, 1); PG8_SCHED; } else { PG8_LDB(B0, 1, 0); PG8_LDB(B1, 1, 1); PG8_SCHED; PG8_LDA(At, 1, 0); }
            if constexpr (BAL) PG8_STAGE_A(PG8_SA(0, 0), a2, 0, VC); PG8_STAGE_A(PG8_SA(0, 1), a2, 1, VC);
            PG8_WAIT_V(8); if constexpr (SPLITW) PG8_WAIT_L(4); else PG8_WAIT_L(0); PG8_BAR; PG8_MMA(0, 0, At, B0); PG8_MMA(0, 1, At, B1); PG8_BAR; PG8_SCHED;
            PG8_LDA(At, 1, 1); PG8_STAGE_B(PG8_SB(1, 0), b3); PG8_STAGE_B(PG8_SB(1, 1), b3 + hstep); if constexpr (!BAL) PG8_STAGE_A(PG8_SA(1, 0), a3, 0, VC);
            if constexpr (BAL) PG8_WAIT_V(6); else PG8_WAIT_V(8);
            if constexpr (SPLITW) { PG8_WAIT_L(4); PG8_BAR; PG8_MMA_H(1, 0, At, B0, 0); PG8_MMA_H(1, 1, At, B1, 0); PG8_MMA_H(1, 0, At, B0, 2); PG8_MMA_H(1, 1, At, B1, 2); PG8_BAR; PG8_SCHED; }
            else { PG8_WAIT_L(0); PG8_BAR; PG8_MMA(1, 0, At, B0); PG8_MMA(1, 1, At, B1); PG8_BAR; PG8_SCHED; }
        }
        if (wr == 0) PG8_BAR;
        if constexpr (FP6 && KREP > 1) {
#pragma unroll
            for (int a = 0; a < 2; ++a)
#pragma unroll
                for (int b = 0; b < 2; ++b)
#pragma unroll
                    for (int m = 0; m < 4; ++m)
#pragma unroll
                        for (int n = 0; n < 2; ++n) acc[a][b][m][n] = acc[a][b][m][n] * (1.0f / KREP);
        }
        { int ln_; asm volatile("v_mbcnt_lo_u32_b32 %0, -1, 0\n\tv_mbcnt_hi_u32_b32 %0, -1, %0" : "=v"(ln_));
          E(acc, cur, wr, wc, ln_ & 15, ln_ >> 4);
#ifdef MK_PROBE_EPI2
          if constexpr (FP8) { asm volatile("" ::: "memory"); E(acc, cur, wr, wc, ln_ & 15, ln_ >> 4); }
#endif
        }
        if (!has_next) break;
#pragma unroll
        for (int a = 0; a < 2; ++a)
#pragma unroll
            for (int b = 0; b < 2; ++b)
#pragma unroll
                for (int m = 0; m < 4; ++m)
#pragma unroll
                    for (int n = 0; n < 2; ++n) acc[a][b][m][n] = (f32x4){0.f, 0.f, 0.f, 0.f};
        cur = nxt; cA = nA; cB = nB; ++ui;
        if (wr == 1) PG8_BAR;
    }
    PG8_WAIT_V(0);
    PG8_BAR;
#undef PG8_SA
#undef PG8_SB
#undef PG8_GL
#undef PG8_STAGE_A
#undef PG8_STAGE_B
#undef PG8_LDA
#undef PG8_LDB
#undef PG8_MMA
#undef PG8_MMA_H
#undef PG8_CAT
#undef PG8_KOFF
#undef PG8_WAIT_V
#undef PG8_WAIT_L
#undef PG8_BAR
#undef PG8_SCHED
}

}
namespace att {
constexpr int D = 128, NW = 8, QBLK = 32, KVBLK = 64, QB = NW * QBLK;
constexpr int SHM_V = KVBLK * D * 2, SHM_K = KVBLK * D * 2;
constexpr int OFF_WS = 2 * SHM_V + 2 * SHM_K, OFF_CLOG = OFF_WS + NW * 64 * 4, LDS_BYTES = OFF_CLOG + SEQ * 4;
constexpr float THR2 = 8.f * 1.4426950408889634f;
#define KSWZ(row, colB) ((row) * 256 + ((colB) ^ (((row) & 7) << 4)))
#define SBAR() __builtin_amdgcn_sched_barrier(0)
__device__ __forceinline__ int v_st(int k, int c) { const int kk = (k & ~0xC) | ((k & 4) << 1) | ((k & 8) >> 1); return ((kk >> 3) * 4 + (c >> 5)) * 512 + ((kk & 7) * 32 + (c & 31)) * 2; }
__device__ __forceinline__ int v_rd_base(int lane) { return ((lane & 3) << 3) | (((lane >> 2) & 3) << 6) | (((lane >> 4) & 1) << 5) | (((lane >> 5) & 1) << 8); }
constexpr int v_rd_off(int d0, int ks, int half) { return d0 * 512 + ks * 4096 + half * 2048; }
__device__ __forceinline__ int crow(int r, int hi) { return (r & 3) + 8 * (r >> 2) + 4 * hi; }
__device__ __forceinline__ unsigned cvtpk(float lo, float hi) { unsigned r; asm volatile("v_cvt_pk_bf16_f32 %0, %1, %2" : "=v"(r) : "v"(lo), "v"(hi)); return r; }
__device__ __forceinline__ void mask_tile(f32x16& p0, f32x16& p1, int dq) {
    const float NEG = -__builtin_inff();
#pragma unroll
    for (int r = 0; r < 16; ++r) {
        const int c = (r & 3) + 8 * (r >> 2);
        if (dq - c < 0) p0[r] = NEG;
        if (dq - c - 32 < 0) p1[r] = NEG;
    }
}
__device__ __forceinline__ void partialSM(f32x16& p0, f32x16& p1, float& m_reg, float& mn, float& alpha) {
    float pmax = p0[0];
#pragma unroll
    for (int r = 1; r < 16; ++r) pmax = fmaxf(pmax, p0[r]);
#pragma unroll
    for (int r = 0; r < 16; ++r) pmax = fmaxf(pmax, p1[r]);
    { auto rr = __builtin_amdgcn_permlane32_swap(__float_as_uint(pmax), __float_as_uint(pmax), false, false);
      pmax = fmaxf(__uint_as_float(rr[0]), __uint_as_float(rr[1])); }
    if (__builtin_expect(__all((pmax - m_reg) <= THR2), 1)) { mn = m_reg; alpha = 1.f; }
    else { mn = fmaxf(m_reg, pmax); alpha = __builtin_amdgcn_exp2f(m_reg - mn); m_reg = mn; }
#pragma unroll
    for (int r = 0; r < 16; ++r) p0[r] = p0[r] - mn;
#pragma unroll
    for (int r = 0; r < 16; ++r) p1[r] = p1[r] - mn;
#pragma unroll
    for (int r = 0; r < 16; ++r) p0[r] = __builtin_amdgcn_exp2f(p0[r]);
}
__device__ __forceinline__ void finishSM(f32x16& p0, f32x16& p1, float alpha, float& l_reg, bf16x8& pa0, bf16x8& pa1, bf16x8& pa2, bf16x8& pa3) {
#pragma unroll
    for (int r = 0; r < 16; ++r) p1[r] = __builtin_amdgcn_exp2f(p1[r]);
    float ps = 0;
#pragma unroll
    for (int r = 0; r < 16; ++r) ps += p0[r];
#pragma unroll
    for (int r = 0; r < 16; ++r) ps += p1[r];
    { auto rr = __builtin_amdgcn_permlane32_swap(__float_as_uint(ps), __float_as_uint(ps), false, false);
      ps = __uint_as_float(rr[0]) + __uint_as_float(rr[1]); }
    l_reg = l_reg * alpha + ps;
#define PK4(P, B_, OUT) do { unsigned a0 = cvtpk(P[B_+0], P[B_+1]), a1 = cvtpk(P[B_+2], P[B_+3]);                          \
        unsigned b0 = cvtpk(P[B_+4], P[B_+5]), b1 = cvtpk(P[B_+6], P[B_+7]);                                             \
        auto r0 = __builtin_amdgcn_permlane32_swap(a0, b0, false, false); auto r1 = __builtin_amdgcn_permlane32_swap(a1, b1, false, false); \
        u32x4 w = {r0[0], r1[0], r0[1], r1[1]}; OUT = *reinterpret_cast<bf16x8*>(&w); } while (0)
    PK4(p0, 0, pa0); PK4(p0, 8, pa1); PK4(p1, 0, pa2); PK4(p1, 8, pa3);
#undef PK4
}
template <int KB, bool FOX>
__device__ __forceinline__ void qkt(f32x16& p0, f32x16& p1, const char* K_lds, int r32, int hi, const bf16x8* qr, const float* cl  , float cq) {
    if constexpr (FOX) {
#pragma unroll
        for (int g = 0; g < 4; ++g) { const f32x4 c0 = *(const f32x4*)(cl + 8 * g + 4 * hi); const f32x4 c1 = *(const f32x4*)(cl + 32 + 8 * g + 4 * hi);
#pragma unroll
            for (int j = 0; j < 4; ++j) { p0[4 * g + j] = cq - c0[j]; p1[4 * g + j] = cq - c1[j]; } }
    } else { p0 = f32x16{}; p1 = f32x16{}; }
    const char* kb[4];
#pragma unroll
    for (int dd = 0; dd < 4; ++dd) kb[dd] = K_lds + KB * SHM_K + KSWZ(r32, (dd * 16 + hi * 8) * 2);
#pragma unroll
    for (int d0 = 0; d0 < 8; ++d0) { const char* a = kb[d0 & 3] + (d0 >> 2) * 128;
        bf16x8 b0 = *reinterpret_cast<const bf16x8*>(a);
        bf16x8 b1 = *reinterpret_cast<const bf16x8*>(a + 32 * 256);
        p0 = __builtin_amdgcn_mfma_f32_32x32x16_bf16(b0, qr[d0], p0, 0, 0, 0);
        p1 = __builtin_amdgcn_mfma_f32_32x32x16_bf16(b1, qr[d0], p1, 0, 0, 0); }
}
template <int KB>
__device__ __forceinline__ void qkt_lean(f32x16& p0, f32x16& p1, const char* K_lds, int r32, int hi, const bf16x8* qr) {
    p0 = f32x16{}; p1 = f32x16{};
    int kb[4];
#pragma unroll
    for (int dd = 0; dd < 4; ++dd) kb[dd] = (int)(uintptr_t)K_lds + KB * SHM_K + KSWZ(r32, (dd * 16 + hi * 8) * 2);
#define KRD(dst, d0, half) asm volatile("ds_read_b128 %0, %1 offset:%2" : "=&v"(dst) : "v"(kb[(d0) & 3]), "i"(((d0) >> 2) * 128 + (half) * 32 * 256) : "memory")
#define KRD4(P, d0) do { KRD(P##00, d0, 0); KRD(P##01, d0, 1); KRD(P##10, (d0) + 1, 0); KRD(P##11, (d0) + 1, 1); } while (0)
#define KMM(P, d0) do { p0 = __builtin_amdgcn_mfma_f32_32x32x16_bf16(P##00, qr[d0], p0, 0, 0, 0); p1 = __builtin_amdgcn_mfma_f32_32x32x16_bf16(P##01, qr[d0], p1, 0, 0, 0); \
        p0 = __builtin_amdgcn_mfma_f32_32x32x16_bf16(P##10, qr[(d0) + 1], p0, 0, 0, 0); p1 = __builtin_amdgcn_mfma_f32_32x32x16_bf16(P##11, qr[(d0) + 1], p1, 0, 0, 0); } while (0)
#define KW4() do { asm volatile("s_waitcnt lgkmcnt(4)" ::: "memory"); SBAR(); } while (0)
    bf16x8 A00, A01, A10, A11, B00, B01, B10, B11;
    KRD4(A, 0);
    KRD4(B, 2); KW4(); KMM(A, 0); SBAR();
    KRD4(A, 4); KW4(); KMM(B, 2); SBAR();
    KRD4(B, 6); KW4(); KMM(A, 4); SBAR();
    asm volatile("s_waitcnt lgkmcnt(0)" ::: "memory"); SBAR(); KMM(B, 6); SBAR();
#undef KRD
#undef KRD4
#undef KMM
#undef KW4
}
template <int VB>
__device__ __forceinline__ void pv_tile(f32x16* o, int vb0, bf16x8 pa0, bf16x8 pa1, bf16x8 pa2, bf16x8 pa3) {
#define TRRD(dst, off) asm volatile("ds_read_b64_tr_b16 %0, %1 offset:%2" : "=&v"(dst) : "v"(vb0), "i"(off) : "memory")
#define PV_D0(d0) do { s16x4 l0, l1, l2, l3, h0, h1, h2, h3; constexpr int b_ = VB * SHM_V + v_rd_off(d0, 0, 0); \
        TRRD(l0, b_); TRRD(h0, b_ + 2048); TRRD(l1, b_ + 4096); TRRD(h1, b_ + 6144); TRRD(l2, b_ + 8192); TRRD(h2, b_ + 10240); TRRD(l3, b_ + 12288); TRRD(h3, b_ + 14336); \
        asm volatile("s_waitcnt lgkmcnt(0)" ::: "memory"); SBAR();   \
        o[d0] = __builtin_amdgcn_mfma_f32_32x32x16_bf16(pa0, (bf16x8){l0[0], l0[1], l0[2], l0[3], h0[0], h0[1], h0[2], h0[3]}, o[d0], 0, 0, 0);   \
        o[d0] = __builtin_amdgcn_mfma_f32_32x32x16_bf16(pa1, (bf16x8){l1[0], l1[1], l1[2], l1[3], h1[0], h1[1], h1[2], h1[3]}, o[d0], 0, 0, 0);   \
        o[d0] = __builtin_amdgcn_mfma_f32_32x32x16_bf16(pa2, (bf16x8){l2[0], l2[1], l2[2], l2[3], h2[0], h2[1], h2[2], h2[3]}, o[d0], 0, 0, 0);   \
        o[d0] = __builtin_amdgcn_mfma_f32_32x32x16_bf16(pa3, (bf16x8){l3[0], l3[1], l3[2], l3[3], h3[0], h3[1], h3[2], h3[3]}, o[d0], 0, 0, 0); } while (0)
    PV_D0(0); PV_D0(1); PV_D0(2); PV_D0(3);
#undef PV_D0
#undef TRRD
}
constexpr int PV8_V1 = 3 * SHM_V;
__device__ __forceinline__ void pv_pipe8(f32x16* o, int vbA, bf16x8 pa0, bf16x8 pa1, bf16x8 pa2, bf16x8 pa3) {
#define TRR(dst, vb, off) asm volatile("ds_read_b64_tr_b16 %0, %1 offset:%2" : "=&v"(dst) : "v"(vb), "i"(off) : "memory")
#define RD8(P, vb, d0) do { constexpr int b_ = v_rd_off((d0) & 3, 0, 0) + ((d0) >> 2) * PV8_V1; TRR(P##l0, vb, b_); TRR(P##h0, vb, b_ + 2048); TRR(P##l1, vb, b_ + 4096); TRR(P##h1, vb, b_ + 6144); \
        TRR(P##l2, vb, b_ + 8192); TRR(P##h2, vb, b_ + 10240); TRR(P##l3, vb, b_ + 12288); TRR(P##h3, vb, b_ + 14336); } while (0)
#define FR(P, k) (bf16x8){P##l##k[0], P##l##k[1], P##l##k[2], P##l##k[3], P##h##k[0], P##h##k[1], P##h##k[2], P##h##k[3]}
#define MM4(P, oi) do { o[oi] = __builtin_amdgcn_mfma_f32_32x32x16_bf16(pa0, FR(P, 0), o[oi], 0, 0, 0); o[oi] = __builtin_amdgcn_mfma_f32_32x32x16_bf16(pa1, FR(P, 1), o[oi], 0, 0, 0); \
        o[oi] = __builtin_amdgcn_mfma_f32_32x32x16_bf16(pa2, FR(P, 2), o[oi], 0, 0, 0); o[oi] = __builtin_amdgcn_mfma_f32_32x32x16_bf16(pa3, FR(P, 3), o[oi], 0, 0, 0); } while (0)
#define W8() do { asm volatile("s_waitcnt lgkmcnt(8)" ::: "memory"); SBAR(); } while (0)
    s16x4 Al0, Al1, Al2, Al3, Ah0, Ah1, Ah2, Ah3, Bl0, Bl1, Bl2, Bl3, Bh0, Bh1, Bh2, Bh3;
    RD8(A, vbA, 0);
    RD8(B, vbA, 1); W8(); MM4(A, 0); SBAR();
    RD8(A, vbA, 2); W8(); MM4(B, 1); SBAR();
    RD8(B, vbA, 3); W8(); MM4(A, 2); SBAR();
    RD8(A, vbA, 4); W8(); MM4(B, 3); SBAR();
    RD8(B, vbA, 5); W8(); MM4(A, 4); SBAR();
    RD8(A, vbA, 6); W8(); MM4(B, 5); SBAR();
    RD8(B, vbA, 7); W8(); MM4(A, 6); SBAR();
    asm volatile("s_waitcnt lgkmcnt(0)" ::: "memory"); SBAR(); MM4(B, 7);
#undef TRR
#undef RD8
#undef FR
#undef MM4
#undef W8
}
struct BlockRef { unsigned Q, K, V, O; int P0; unsigned clog; int jlo; };
struct Seam { bf16x8 qr[8]; bf16x8 st_v0, st_v1, st_k0, st_k1; };
#define ROWB(p, k0, rr) ((const char*)wsb + (size_t)((p) + (unsigned)((k0) + (rr)) * (unsigned)(D * 2)) + lnoff)
#define VMW() asm volatile("s_waitcnt vmcnt(0)" ::: "memory")
#define VMWN(n) asm volatile("s_waitcnt vmcnt(%0)" :: "i"(n) : "memory")
#define LD8(p) (*reinterpret_cast<const bf16x8*>(p))
#define SLOAD_H(Kp, Vp, k0) do { S.st_v0 = LD8(ROWB(Vp, k0, 0)); S.st_v1 = LD8(ROWB(Vp, k0, 32)); S.st_k0 = LD8(ROWB(Kp, k0, 0)); S.st_k1 = LD8(ROWB(Kp, k0, 32)); } while (0)
#define SWRITE_HK(bf) do { *(bf16x8*)(K_lds + (bf) * SHM_K + kws) = S.st_k0; *(bf16x8*)(K_lds + (bf) * SHM_K + kws + 32 * 256) = S.st_k1; } while (0)
#define SWRITE_HV(bf) do { *(bf16x8*)(V_lds + (bf) * SHM_V + vst0) = S.st_v0; *(bf16x8*)(V_lds + (bf) * SHM_V + vst1) = S.st_v1; } while (0)
#define SWRITE_H(bf) do { SWRITE_HV(bf); SWRITE_HK(bf); } while (0)
__device__ __forceinline__ void attn_prime(const unsigned char* wsb, const BlockRef& cur, char* lds, Seam& S) {
    const int tid = threadIdx.x, wid = __builtin_amdgcn_readfirstlane(tid >> 6), lane = tid & 63, r32 = lane & 31, hi = lane >> 5;
    const int sr = tid >> 4, sc = (tid & 15) * 8, kws = KSWZ(sr, sc * 2); char* K_lds = lds + 2 * SHM_V;
    const unsigned lnoff = (unsigned)(sr * D + sc) * 2u;
#pragma unroll
    for (int d0 = 0; d0 < 8; ++d0) S.qr[d0] = LD8(wsb + (size_t)cur.Q + (unsigned)((wid * QBLK + r32) * D + d0 * 16 + hi * 8) * 2u);
    SLOAD_H(cur.K, cur.V, cur.jlo * KVBLK); VMW(); SWRITE_HK(0);
    __syncthreads();
}
template <bool FOX, class NR>
__device__ __forceinline__ void attn_block(const unsigned char* wsb, const BlockRef& cur, const NR& nref, char* lds, Seam& S) {
    const int tid = threadIdx.x, wid = __builtin_amdgcn_readfirstlane(tid >> 6), lane = tid & 63, r32 = lane & 31, hi = lane >> 5;
    const int j_lo = cur.jlo;
    const int NT = (cur.P0 + QB) / KVBLK - j_lo;
    const int qlo = cur.P0 + wid * QBLK;
    const int qe = FOX ? qlo : (qlo | 63);
    const int qm = (FOX ? (qlo + r32) : (qlo | 63)) - 4 * hi;
    char* V_lds = lds; char* K_lds = lds + 2 * SHM_V;
    float* ws = (float*)(lds + OFF_WS) + wid * 64; float* li_l = ws, * al_l = ws + 32;
    float* cl_lds = (float*)(lds + OFF_CLOG);
    float cq = 0.f;
    if constexpr (FOX) {
        const int nkeys = NT * KVBLK;
        const float* clg = (const float*)(wsb + (size_t)cur.clog);
        for (int i = tid * 4; i < nkeys; i += NTHREADS * 4) *(f32x4*)(cl_lds + i) = *(const f32x4*)(clg + j_lo * KVBLK + i);
        cq = clg[qlo + r32];
        __syncthreads();
    }
    float m_reg = -1e30f, l_reg = 0; f32x16 o[4] = {};
    const int sr = tid >> 4, sc = (tid & 15) * 8, vst0 = v_st(sr, sc), vst1 = v_st(32 + sr, sc), kws = KSWZ(sr, sc * 2);
    const unsigned lnoff = (unsigned)(sr * D + sc) * 2u;
    const int vb0 = (int)(uintptr_t)V_lds + v_rd_base(lane);
    const unsigned Kh = cur.K, Vh = cur.V;
#define RESC(a) do { if (__any((a) < 1.f)) { if (hi == 0) al_l[r32] = (a); asm volatile("s_waitcnt lgkmcnt(0)" ::: "memory");              \
                     for (int d_ = 0; d_ < 4; ++d_) for (int r = 0; r < 16; ++r) o[d_][r] *= al_l[crow(r, hi)]; } } while (0)
#define KBASE(t) ((j_lo + (t)) * KVBLK)
#define CLT(t) (cl_lds + (t) * KVBLK)
#define MASKT(P0_, P1_, t) do { const int kb_ = KBASE(t); if (kb_ + KVBLK - 1 > qe) mask_tile(P0_, P1_, qm - kb_); } while (0)
    f32x16 pA0, pA1, pB0, pB1; float mnA, mnB, alA, alB; bf16x8 pa0, pa1, pa2, pa3;
    SWRITE_HV(0); SBAR();
    if (NT > 1) { SLOAD_H(Kh, Vh, KBASE(1)); }
    SBAR(); qkt<0, FOX>(pA0, pA1, K_lds, r32, hi, S.qr, CLT(0), cq);
    MASKT(pA0, pA1, 0); partialSM(pA0, pA1, m_reg, mnA, alA);
    if (NT > 1) { VMW(); SWRITE_H(1); }
    __syncthreads();
#define HALF_STEP(PX0, PX1, mnX, alX, PY0, PY1, alY, t, KB, VB, SB) do {                                                      \
        SBAR(); qkt<KB, FOX>(PX0, PX1, K_lds, r32, hi, S.qr, CLT(t), cq);                                          \
        finishSM(PY0, PY1, alY, l_reg, pa0, pa1, pa2, pa3); SBAR();                                                           \
        if ((t) + 1 < NT) { SLOAD_H(Kh, Vh, KBASE((t) + 1)); SBAR(); }                                                        \
        pv_tile<VB>(o, vb0, pa0, pa1, pa2, pa3); MASKT(PX0, PX1, (t)); partialSM(PX0, PX1, m_reg, mnX, alX);                  \
        __syncthreads();                                                                                                      \
        if ((t) + 1 < NT) { VMW(); SWRITE_H(SB); }                                                                            \
        RESC(alX); __syncthreads(); } while (0)
    for (int t = 1; t + 1 < NT; t += 2) {
        HALF_STEP(pB0, pB1, mnB, alB, pA0, pA1, alA, t, 1, 0, 0);
        HALF_STEP(pA0, pA1, mnA, alA, pB0, pB1, alB, t + 1, 0, 1, 1);
    }
    constexpr bool even = true;
    if (even) { SBAR(); qkt<1, FOX>(pB0, pB1, K_lds, r32, hi, S.qr, CLT(NT - 1), cq); SBAR(); }
    const BlockRef nxt = nref();
    SLOAD_H(nxt.K, nxt.V, nxt.jlo * KVBLK); SBAR();
#pragma unroll
    for (int d0 = 0; d0 < 8; ++d0) S.qr[d0] = LD8(wsb + (size_t)nxt.Q + (unsigned)((wid * QBLK + r32) * D + d0 * 16 + hi * 8) * 2u);
    SBAR();
    finishSM(pA0, pA1, alA, l_reg, pa0, pa1, pa2, pa3); SBAR();
    pv_tile<0>(o, vb0, pa0, pa1, pa2, pa3);
    if (even) { MASKT(pB0, pB1, NT - 1); partialSM(pB0, pB1, m_reg, mnB, alB); __syncthreads(); RESC(alB);
        finishSM(pB0, pB1, alB, l_reg, pa0, pa1, pa2, pa3); SBAR(); pv_tile<1>(o, vb0, pa0, pa1, pa2, pa3); }
    SBAR(); VMWN(8); SWRITE_HK(0); SBAR();
    if (hi == 0) li_l[r32] = l_reg; asm volatile("s_waitcnt lgkmcnt(0)" ::: "memory");
    float rli[16];
#pragma unroll
    for (int r = 0; r < 16; ++r) rli[r] = __builtin_amdgcn_rcpf(li_l[crow(r, hi)]);
    bf16_t* Ow = (bf16_t*)(const_cast<unsigned char*>(wsb) + (size_t)cur.O) + (size_t)(wid * QBLK) * D;
#pragma unroll
    for (int r = 0; r < 16; ++r) { const int orow = crow(r, hi);
#pragma unroll
        for (int d0 = 0; d0 < 4; ++d0) { const float v = o[d0][r] * rli[r];
            const float vn = __uint_as_float((unsigned)__builtin_amdgcn_update_dpp(0, (int)__float_as_uint(v), 0xB1, 0xF, 0xF, false));
            if ((r32 & 1) == 0) *(unsigned*)(Ow + (size_t)orow * D + d0 * 32 + r32) = cvtpk(v, vn); } }
    __syncthreads();
#undef RESC
#undef KBASE
#undef CLT
#undef MASKT
#undef HALF_STEP
}
constexpr int W_OFF_V1 = 3 * SHM_V, W_OFF_K = 6 * SHM_V, W_OFF_WS = 133120, W_LDS_BYTES = W_OFF_WS + NW * 64 * 4;
struct BlockRefW { unsigned Q, K, V0, V1, O0, O1; int P0; };
struct SeamW { bf16x8 qr[8]; int vs; };
#define DMA_W(R, k0, bf, vsl) do { const unsigned kb_ = (unsigned)(k0) * 256u; \
        const char* gk_ = (const char*)wsb + (size_t)((R).K + kb_); const char* g0_ = (const char*)wsb + (size_t)((R).V0 + kb_); const char* g1_ = (const char*)wsb + (size_t)((R).V1 + kb_); \
        const unsigned lk_ = ldsb + W_OFF_K + (bf) * SHM_K + wid * 2048, lv_ = ldsb + (unsigned)(vsl) * SHM_V + wid * 2048; \
        glds16s(uni_ptr(gk_), vofK0, lk_); glds16s(uni_ptr(gk_), (vofK0 + 1024u) ^ 64u, lk_ + 1024u); \
        glds16s(uni_ptr(g0_), vofV0, lv_); glds16s(uni_ptr(g0_), vofV1, lv_ + 1024u); \
        glds16s(uni_ptr(g1_), vofV0, lv_ + W_OFF_V1); glds16s(uni_ptr(g1_), vofV1, lv_ + W_OFF_V1 + 1024u); } while (0)
#define DMA_OFFS() \
    const unsigned ldsb = (unsigned)__builtin_amdgcn_readfirstlane((int)(unsigned)(uintptr_t)lds); \
    unsigned vofK0, vofV0, vofV1; \
    { int lane; asm volatile("v_mbcnt_lo_u32_b32 %0, -1, 0\n\tv_mbcnt_hi_u32_b32 %0, -1, %0" : "=v"(lane));     \
      const int rk0 = 4 * (2 * wid) + (lane >> 4), rk1 = rk0 + 4; vofK0 = (unsigned)(rk0 * 256 + (((lane & 15) ^ (rk0 & 7)) << 4)); (void)rk1;     \
      const int p0_ = (2 * wid) * 64 + lane, p1_ = p0_ + 64; \
      { const int sub = p0_ >> 5, kk = (sub >> 2) * 8 + ((p0_ >> 2) & 7), k = (kk & ~0xC) | ((kk & 4) << 1) | ((kk & 8) >> 1), c = (sub & 3) * 32 + (p0_ & 3) * 8; vofV0 = (unsigned)(k * 256 + c * 2); } \
      { const int sub = p1_ >> 5, kk = (sub >> 2) * 8 + ((p1_ >> 2) & 7), k = (kk & ~0xC) | ((kk & 4) << 1) | ((kk & 8) >> 1), c = (sub & 3) * 32 + (p1_ & 3) * 8; vofV1 = (unsigned)(k * 256 + c * 2); } }
__device__ __forceinline__ void attn_primeW(const unsigned char* wsb, const BlockRefW& cur, char* lds, SeamW& S) {
    const int tid = threadIdx.x, wid = __builtin_amdgcn_readfirstlane(tid >> 6), lane = tid & 63, r32 = lane & 31, hi = lane >> 5;
    DMA_OFFS();
    S.vs = 0;
    DMA_W(cur, 0, 0, 0);
#pragma unroll
    for (int d0 = 0; d0 < 8; ++d0) S.qr[d0] = LD8(wsb + (size_t)cur.Q + (unsigned)((wid * QBLK + r32) * D + d0 * 16 + hi * 8) * 2u);
    VMW();
    __syncthreads();
}
template <class NR>
__device__ __forceinline__ void attn_blockW(const unsigned char* wsb, const BlockRefW& cur, const NR& nref, char* lds, SeamW& S) {
    const int tid = threadIdx.x, wid = __builtin_amdgcn_readfirstlane(tid >> 6), lane = tid & 63, r32 = lane & 31, hi = lane >> 5;
    const int NT = (cur.P0 + QB) / KVBLK;
    const int qlo = cur.P0 + wid * QBLK, qe = qlo | 63, qm = (qlo | 63) - 4 * hi;
    char* V_lds = lds; char* K_lds = lds + W_OFF_K;
    float* ws = (float*)(lds + W_OFF_WS) + wid * 64; float* li_l = ws, * al_l = ws + 32;
    float m_reg = -1e30f, l_reg = 0; f32x16 o[8] = {};
    DMA_OFFS();
    const int vb0 = (int)(uintptr_t)V_lds + v_rd_base(lane);
    static_assert(PV8_V1 == W_OFF_V1 && v_rd_off(3, 3, 1) + PV8_V1 < 65536, "V1 ring reachable by the 16-bit ds offset");
#define RESCW(a) do { if (__any((a) < 1.f)) { if (hi == 0) al_l[r32] = (a); asm volatile("s_waitcnt lgkmcnt(0)" ::: "memory");              \
                      for (int d_ = 0; d_ < 8; ++d_) for (int r = 0; r < 16; ++r) o[d_][r] *= al_l[crow(r, hi)]; } } while (0)
#define MASKW(P0_, P1_, t) do { const int kb_ = (t) * KVBLK; if (kb_ + KVBLK - 1 > qe) mask_tile(P0_, P1_, qm - kb_); } while (0)
    f32x16 p0, p1; float mn, al; bf16x8 pa0, pa1, pa2, pa3;
    const bool lag = wid >= 4;
    int vs = S.vs;
#define PVW(slot) do { pv_pipe8(o, vb0 + (slot) * SHM_V, pa0, pa1, pa2, pa3); } while (0)
#define STEPW(t, BF) do { const int nvs_ = vs == 2 ? 0 : vs + 1;                                                                \
        DMA_W(cur, ((t) + 1) * KVBLK, 1 - (BF), nvs_);                                                                          \
        if (lag && (t) > 0) { SBAR(); PVW(vs == 0 ? 2 : vs - 1); }                                                               \
        SBAR(); qkt_lean<BF>(p0, p1, K_lds, r32, hi, S.qr); SBAR();                                                            \
        MASKW(p0, p1, (t)); partialSM(p0, p1, m_reg, mn, al); RESCW(al); finishSM(p0, p1, al, l_reg, pa0, pa1, pa2, pa3); SBAR(); \
        if (!lag) { PVW(vs); }                                                                                                   \
        VMW(); __syncthreads(); vs = nvs_; } while (0)
    for (int t = 0; t + 2 < NT; t += 2) { STEPW(t, 0); STEPW(t + 1, 1); }
    STEPW(NT - 2, 0);
    const BlockRefW nxt = nref();
    const int nvs = vs == 2 ? 0 : vs + 1;
    DMA_W(nxt, 0, 0, nvs);
    if (lag) { SBAR(); PVW(vs == 0 ? 2 : vs - 1); }
    SBAR(); qkt_lean<1>(p0, p1, K_lds, r32, hi, S.qr); SBAR();
#pragma unroll
    for (int d0 = 0; d0 < 8; ++d0) S.qr[d0] = LD8(wsb + (size_t)nxt.Q + (unsigned)((wid * QBLK + r32) * D + d0 * 16 + hi * 8) * 2u);
    SBAR();
    MASKW(p0, p1, NT - 1); partialSM(p0, p1, m_reg, mn, al); RESCW(al); finishSM(p0, p1, al, l_reg, pa0, pa1, pa2, pa3); SBAR();
    PVW(vs);
    S.vs = nvs;
    if (hi == 0) li_l[r32] = l_reg; asm volatile("s_waitcnt lgkmcnt(0)" ::: "memory");
    float rli[16];
#pragma unroll
    for (int r = 0; r < 16; ++r) rli[r] = __builtin_amdgcn_rcpf(li_l[crow(r, hi)]);
    { int ln_; asm volatile("v_mbcnt_lo_u32_b32 %0, -1, 0\n\tv_mbcnt_hi_u32_b32 %0, -1, %0" : "=v"(ln_));
      const int r32b = ln_ & 31, hib = ln_ >> 5; const unsigned lo_ = (unsigned)((wid * QBLK + 4 * hib) * D + r32b) * 2u;
#pragma unroll
      for (int hv = 0; hv < 2; ++hv) {
        unsigned char* Ob = const_cast<unsigned char*>(wsb) + (size_t)(hv ? cur.O1 : cur.O0);
#pragma unroll
        for (int r = 0; r < 16; ++r) { const unsigned ro_ = lo_ + (unsigned)(((r & 3) + 8 * (r >> 2)) * D) * 2u;
#pragma unroll
            for (int d0 = 0; d0 < 4; ++d0) { const float v = o[hv * 4 + d0][r] * rli[r];
                const float vn = __uint_as_float((unsigned)__builtin_amdgcn_update_dpp(0, (int)__float_as_uint(v), 0xB1, 0xF, 0xF, false));
                if ((r32b & 1) == 0) *(unsigned*)(Ob + (ro_ + (unsigned)(d0 * 64))) = cvtpk(v, vn); } }
      } }
    VMW(); __syncthreads();
#undef RESCW
#undef MASKW
#undef STEPW
#undef PVW
}
#undef DMA_W
#undef DMA_OFFS
#undef ROWB
#undef VMW
#undef VMWN
#undef LD8
#undef SLOAD_H
#undef SWRITE_HK
#undef SWRITE_HV
#undef SWRITE_H
#undef KSWZ
#undef SBAR
}
#ifndef MK_FP8
#define MK_FP8 1
#endif
constexpr int FP8_WSHIFT = 8, FP8_HGSHIFT = 3, FP8_HDSHIFT = 2, FP8_YSHIFT = 6;
#ifndef MK_YS8
#define MK_YS8 1
#endif
__device__ __forceinline__ float clamp448(float v) { return __builtin_amdgcn_fmed3f(v, -448.0f, 448.0f); }
__device__ __forceinline__ unsigned pk_fp8x4(float a, float b, float c, float d) {
    int w = 0; w = __builtin_amdgcn_cvt_pk_fp8_f32(clamp448(a), clamp448(b), w, false); w = __builtin_amdgcn_cvt_pk_fp8_f32(clamp448(c), clamp448(d), w, true); return (unsigned)w; }
#ifndef MK_FP6
#define MK_FP6 1
#endif
typedef float v16f_t __attribute__((ext_vector_type(16)));
typedef int v6i_t __attribute__((ext_vector_type(6)));
__device__ __forceinline__ void fp6_record(const v16f_t a, const v16f_t b, u32x4& lo, u32x4& hi) {
    float mx = 0.f;
#pragma unroll
    for (int i = 0; i < 16; ++i) asm("v_max3_f32 %0, |%1|, |%2|, %0" : "+v"(mx) : "v"(a[i]), "v"(b[i]));
    int sb = (int)((__float_as_uint(mx) >> 23) & 0xffu) - 2; sb = sb < 1 ? 1 : sb;
    const float scale = __uint_as_float((unsigned)sb << 23);
    const v6i_t r = __builtin_amdgcn_cvt_scalef32_2xpk16_fp6_f32(a, b, scale);
    lo = (u32x4){(unsigned)r[0], (unsigned)r[1], (unsigned)r[2], (unsigned)r[3]}; hi = (u32x4){(unsigned)r[4], (unsigned)r[5], (unsigned)sb, 0u};
}
__device__ __forceinline__ void xpose4(float (&X)[4][8]) {
#pragma unroll
    for (int m = 0; m < 2; ++m)
#pragma unroll
        for (int j = 0; j < 8; ++j) { auto r = __builtin_amdgcn_permlane32_swap(__float_as_uint(X[m][j]), __float_as_uint(X[m + 2][j]), false, false); X[m][j] = __uint_as_float(r[0]); X[m + 2][j] = __uint_as_float(r[1]); }
#pragma unroll
    for (int m = 0; m < 4; m += 2)
#pragma unroll
        for (int j = 0; j < 8; ++j) { auto r = __builtin_amdgcn_permlane16_swap(__float_as_uint(X[m][j]), __float_as_uint(X[m + 1][j]), false, false); X[m][j] = __uint_as_float(r[0]); X[m + 1][j] = __uint_as_float(r[1]); }
}
#define XROW16(X, q) X[q][0], X[q][1], X[q][2], X[q][3], X[q][4], X[q][5], X[q][6], X[q][7]
#ifndef MK_FUSE_NORMS
#define MK_FUSE_NORMS 1
#endif
namespace pg8 {
struct EpiQKV {
    bf16_t* QKV; const float* rope; unsigned* ctl; LAS float* nsc;
    __device__ __forceinline__ void operator()(const f32x4 (&acc)[2][2][4][2], const Unit& u, int wr, int wc, int fr, int fq) const {
        const int pn = u.pn; const bool isrope = pn < 8; const float sc = (pn < 4 || (pn >= 12 && pn < 16)) ? QSCALE : 1.0f;
        const bool isnorm = MK_FUSE_NORMS && pn >= 12 && pn < 20;
        const int cw = wc * 32 + 8 * fq;
#pragma unroll
        for (int ai = 0; ai < 2; ++ai)
#pragma unroll
            for (int m = 0; m < 4; ++m) {
                const int row = u.pm * BM + ai * HALF + wr * 64 + m * 16 + fr;
                f32x4 cs0 = {1.f, 0.f, 1.f, 0.f}, cs1 = {1.f, 0.f, 1.f, 0.f};
                if (isrope) { const float* rp = rope + (size_t)row * 128 + (16 * wc + 4 * fq) * 2; cs0 = *(const f32x4*)rp; cs1 = *(const f32x4*)(rp + 4); }
#pragma unroll
                for (int bj = 0; bj < 2; ++bj) {
                    f32x4 v0 = acc[ai][bj][m][0], v1 = acc[ai][bj][m][1];
                    if (isrope) {
                        const f32x4 a = v0, b = v1;
                        v0[0] = a[0] * cs0[0] - a[1] * cs0[1]; v0[1] = a[1] * cs0[0] + a[0] * cs0[1]; v0[2] = a[2] * cs0[2] - a[3] * cs0[3]; v0[3] = a[3] * cs0[2] + a[2] * cs0[3];
                        v1[0] = b[0] * cs1[0] - b[1] * cs1[1]; v1[1] = b[1] * cs1[0] + b[0] * cs1[1]; v1[2] = b[2] * cs1[2] - b[3] * cs1[3]; v1[3] = b[3] * cs1[2] + b[2] * cs1[3];
                    }
                    v0 = v0 * sc; v1 = v1 * sc;
                    if (isnorm) { float ss = (v0[0] * v0[0] + v0[1] * v0[1]) + (v0[2] * v0[2] + v0[3] * v0[3]) + (v1[0] * v1[0] + v1[1] * v1[1]) + (v1[2] * v1[2] + v1[3] * v1[3]);
                        ss += __shfl_xor(ss, 16); ss += __shfl_xor(ss, 32);
                        if (fq == 0) nsc[((ai * HALF + wr * 64 + m * 16 + fr) * 2 + bj) * 4 + wc] = ss; }
                    u32x4 w; w.x = cvt_pk_bf16(v0[0], v0[1]); w.y = cvt_pk_bf16(v0[2], v0[3]); w.z = cvt_pk_bf16(v1[0], v1[1]); w.w = cvt_pk_bf16(v1[2], v1[3]);
                    *(u32x4*)(QKV + ((size_t)(pn * 2 + bj) * MTOK + row) * 128 + cw) = w;
                }
            }
        if (isnorm) {
            __syncthreads();
            const int t = (int)threadIdx.x; const f32x4 pq = *(const LAS f32x4*)(nsc + t * 4);
            float s = (pq.x + pq.y) + (pq.z + pq.w);
            s = fmaxf(s, __shfl_xor(s, 2)); s = fmaxf(s, __shfl_xor(s, 4)); s = fmaxf(s, __shfl_xor(s, 8)); s = fmaxf(s, __shfl_xor(s, 16)); s = fmaxf(s, __shfl_xor(s, 32));
            if ((t & 63) < 2) { const int isk = pn >= 16, hd = ((pn - (isk ? 16 : 12)) * 2) + (t & 1), bh = (u.pm >> 4) * 8 + hd;
                atomicMax(ctl + (isk ? CW_KMAX + bh : CW_QMAX + bh * 16 + (u.pm & 15)), __float_as_uint(s)); }
        }
    }
};
struct EpiOut {
    const float* x; float* h; bf16_t* hg; const float* gffn;
    __device__ __forceinline__ void operator()(const f32x4 (&acc)[2][2][4][2], const Unit& u, int wr, int wc, int fr, int fq) const {
#pragma unroll
        for (int bj = 0; bj < 2; ++bj) {
            const int col0 = u.pn * BM + bj * HALF + wc * 32 + 8 * fq;
            const f32x4 g0 = *(const f32x4*)(gffn + col0), g1 = *(const f32x4*)(gffn + col0 + 4);
#pragma unroll
            for (int ai = 0; ai < 2; ++ai) {
#if MK_FP8 && MK_FP6
                float X[4][8];
#endif
#pragma unroll
                for (int m = 0; m < 4; ++m) {
                    const size_t off = (size_t)(u.pm * BM + ai * HALF + wr * 64 + m * 16 + fr) * DM + col0;
                    const f32x4 h0 = *(const f32x4*)(x + off) + acc[ai][bj][m][0], h1 = *(const f32x4*)(x + off + 4) + acc[ai][bj][m][1];
                    *(f32x4*)(h + off) = h0; *(f32x4*)(h + off + 4) = h1;
                    const f32x4 a = h0 * g0, b = h1 * g1;
#if MK_FP8 && MK_FP6
                    X[m][0] = a[0]; X[m][1] = a[1]; X[m][2] = a[2]; X[m][3] = a[3]; X[m][4] = b[0]; X[m][5] = b[1]; X[m][6] = b[2]; X[m][7] = b[3];
#elif MK_FP8
                    constexpr float sc8 = (float)(1 << FP8_HGSHIFT);
                    u32x2 w8; w8.x = pk_fp8x4(a[0] * sc8, a[1] * sc8, a[2] * sc8, a[3] * sc8); w8.y = pk_fp8x4(b[0] * sc8, b[1] * sc8, b[2] * sc8, b[3] * sc8);
                    *(u32x2*)((unsigned char*)hg + off) = w8;
#else
                    u32x4 w; w.x = cvt_pk_bf16(a[0], a[1]); w.y = cvt_pk_bf16(a[2], a[3]); w.z = cvt_pk_bf16(b[0], b[1]); w.w = cvt_pk_bf16(b[2], b[3]);
                    *(u32x4*)(hg + off) = w;
#endif
                }
#if MK_FP8 && MK_FP6
                xpose4(X);
                u32x4 lo, hi; fp6_record((v16f_t){XROW16(X, 0), XROW16(X, 1)}, (v16f_t){XROW16(X, 2), XROW16(X, 3)}, lo, hi);
                unsigned char* rp = (unsigned char*)hg + (size_t)(u.pm * BM + ai * HALF + wr * 64 + fq * 16 + fr) * DM + (2 * u.pn + bj) * 128 + 16 * wc;
                *(u32x4*)rp = lo; *(u32x4*)(rp + 64) = hi;
#endif
            }
        }
    }
};
template <int SC> __device__ __forceinline__ f32x2 swiglu_pk(f32x2 g, f32x2 u) {
    g.x = fminf(g.x, 7.0f); g.y = fminf(g.y, 7.0f);
    u.x = __builtin_amdgcn_fmed3f(u.x, -7.0f, 7.0f); u.y = __builtin_amdgcn_fmed3f(u.y, -7.0f, 7.0f);
    const f32x2 t = g * (-1.702f * 1.4426950408889634f);
    f32x2 e; e.x = __builtin_amdgcn_exp2f(t.x); e.y = __builtin_amdgcn_exp2f(t.y);
    const f32x2 d = e + 1.0f;
    f32x2 r; r.x = __builtin_amdgcn_rcpf(d.x); r.y = __builtin_amdgcn_rcpf(d.y);
    const f32x2 us = u * (float)SC + (float)SC;
    return (g * r) * us;
}
__device__ __forceinline__ unsigned pk_fp8x4_nc(f32x2 a, f32x2 b) {
    int w = 0; w = __builtin_amdgcn_cvt_pk_fp8_f32(a.x, a.y, w, false); w = __builtin_amdgcn_cvt_pk_fp8_f32(b.x, b.y, w, true); return (unsigned)w; }
__device__ __forceinline__ float swiglu1(float g, float uu) {
    g = fminf(g, 7.0f); uu = fminf(fmaxf(uu, -7.0f), 7.0f);
    const float e = __builtin_amdgcn_exp2f(g * (-1.702f * 1.4426950408889634f));
    return g * __builtin_amdgcn_rcpf(1.0f + e) * (uu + 1.0f);
}
struct EpiGU {
    bf16_t* hdn; const float* bgate; const float* bup; const float* rstd; const LAS int* tab; const LAS float* rl;
    __device__ __forceinline__ void operator()(const f32x4 (&acc)[2][2][4][2], const Unit& u, int wr, int wc, int fr, int fq) const {
        const int j0 = u.pn * HALF + wc * 32 + 8 * fq; const int cnt = tab[NE + 1 + u.e];
        const f32x4 bg0 = *(const f32x4*)(bgate + (size_t)u.e * DM + j0), bg1 = *(const f32x4*)(bgate + (size_t)u.e * DM + j0 + 4);
        const f32x4 bu0 = *(const f32x4*)(bup + (size_t)u.e * DM + j0), bu1 = *(const f32x4*)(bup + (size_t)u.e * DM + j0 + 4);
#pragma unroll
        for (int ai = 0; ai < 2; ++ai) {
#if MK_FP8 && MK_FP6
            float X[4][8];
#endif
#pragma unroll
            for (int m = 0; m < 4; ++m) {
                const int r = ai * HALF + wr * 64 + m * 16 + fr, pos = u.rows0 + r;
                float rs = MK_EPI_LDS ? rl[r] : rstd[(size_t)u.e * ECAP + pos]; rs = pos < cnt ? rs : 0.f;
                const f32x4 g0 = acc[ai][0][m][0] * rs + bg0, g1 = acc[ai][0][m][1] * rs + bg1, u0 = acc[ai][1][m][0] * rs + bu0, u1 = acc[ai][1][m][1] * rs + bu1;
#if MK_FP8 && MK_FP6
                { const f32x2 h00 = swiglu_pk<1>((f32x2){g0[0], g0[1]}, (f32x2){u0[0], u0[1]}), h01 = swiglu_pk<1>((f32x2){g0[2], g0[3]}, (f32x2){u0[2], u0[3]});
                  const f32x2 h10 = swiglu_pk<1>((f32x2){g1[0], g1[1]}, (f32x2){u1[0], u1[1]}), h11 = swiglu_pk<1>((f32x2){g1[2], g1[3]}, (f32x2){u1[2], u1[3]});
                  X[m][0] = h00.x; X[m][1] = h00.y; X[m][2] = h01.x; X[m][3] = h01.y; X[m][4] = h10.x; X[m][5] = h10.y; X[m][6] = h11.x; X[m][7] = h11.y; }
#elif MK_FP8
                constexpr int SC8 = 1 << FP8_HDSHIFT;
                const f32x2 h00 = swiglu_pk<SC8>((f32x2){g0[0], g0[1]}, (f32x2){u0[0], u0[1]}), h01 = swiglu_pk<SC8>((f32x2){g0[2], g0[3]}, (f32x2){u0[2], u0[3]});
                const f32x2 h10 = swiglu_pk<SC8>((f32x2){g1[0], g1[1]}, (f32x2){u1[0], u1[1]}), h11 = swiglu_pk<SC8>((f32x2){g1[2], g1[3]}, (f32x2){u1[2], u1[3]});
                u32x2 w8; w8.x = pk_fp8x4_nc(h00, h01); w8.y = pk_fp8x4_nc(h10, h11);
                *(u32x2*)((unsigned char*)hdn + (size_t)(u.pm * BM + r) * DM + j0) = w8;
#else
                u32x4 w; w.x = cvt_pk_bf16(swiglu1(g0[0], u0[0]), swiglu1(g0[1], u0[1])); w.y = cvt_pk_bf16(swiglu1(g0[2], u0[2]), swiglu1(g0[3], u0[3]));
                w.z = cvt_pk_bf16(swiglu1(g1[0], u1[0]), swiglu1(g1[1], u1[1])); w.w = cvt_pk_bf16(swiglu1(g1[2], u1[2]), swiglu1(g1[3], u1[3]));
                *(u32x4*)(hdn + (size_t)(u.pm * BM + r) * DM + j0) = w;
#endif
            }
#if MK_FP8 && MK_FP6
            xpose4(X);
            u32x4 lo, hi; fp6_record((v16f_t){XROW16(X, 0), XROW16(X, 1)}, (v16f_t){XROW16(X, 2), XROW16(X, 3)}, lo, hi);
            unsigned char* rp = (unsigned char*)hdn + (size_t)(u.pm * BM + ai * HALF + wr * 64 + fq * 16 + fr) * DM + u.pn * 128 + 16 * wc;
            *(u32x4*)rp = lo; *(u32x4*)(rp + 64) = hi;
#endif
        }
    }
};
struct EpiDown {
    bf16_t* ys; const float* bdown; const float* gate; const LAS int* tab; const LAS float* rl;
    __device__ __forceinline__ void operator()(const f32x4 (&acc)[2][2][4][2], const Unit& u, int wr, int wc, int fr, int fq) const {
        const int cnt = tab[NE + 1 + u.e]; const int c0 = u.pn * BM + wc * 32 + 8 * fq;
        const float* bp = bdown + (size_t)u.e * DM + c0;
        const f32x4 b00 = *(const f32x4*)(bp), b01 = *(const f32x4*)(bp + 4), b10 = *(const f32x4*)(bp + HALF), b11 = *(const f32x4*)(bp + HALF + 4);
#pragma unroll
        for (int ai = 0; ai < 2; ++ai)
#pragma unroll
            for (int m = 0; m < 4; ++m) {
                const int r = ai * HALF + wr * 64 + m * 16 + fr, pos = u.rows0 + r;
                float gt = MK_EPI_LDS ? rl[r] : gate[(size_t)u.e * ECAP + pos]; gt = pos < cnt ? gt : 0.f;
#if MK_YS8
                const float gs = gt * (float)(1 << FP8_YSHIFT);
                unsigned char* yp = (unsigned char*)ys + (size_t)(u.pm * BM + r) * DM + c0;
                { const f32x4 a = (acc[ai][0][m][0] + b00) * gs, b = (acc[ai][0][m][1] + b01) * gs; u32x2 w8; w8.x = pk_fp8x4(a[0], a[1], a[2], a[3]); w8.y = pk_fp8x4(b[0], b[1], b[2], b[3]); *(u32x2*)yp = w8; }
                { const f32x4 a = (acc[ai][1][m][0] + b10) * gs, b = (acc[ai][1][m][1] + b11) * gs; u32x2 w8; w8.x = pk_fp8x4(a[0], a[1], a[2], a[3]); w8.y = pk_fp8x4(b[0], b[1], b[2], b[3]); *(u32x2*)(yp + HALF) = w8; }
#else
                bf16_t* yp = ys + (size_t)(u.pm * BM + r) * DM + c0;
                { const f32x4 a = (acc[ai][0][m][0] + b00) * gt, b = (acc[ai][0][m][1] + b01) * gt; u32x4 w; w.x = cvt_pk_bf16(a[0], a[1]); w.y = cvt_pk_bf16(a[2], a[3]); w.z = cvt_pk_bf16(b[0], b[1]); w.w = cvt_pk_bf16(b[2], b[3]); *(u32x4*)yp = w; }
                { const f32x4 a = (acc[ai][1][m][0] + b10) * gt, b = (acc[ai][1][m][1] + b11) * gt; u32x4 w; w.x = cvt_pk_bf16(a[0], a[1]); w.y = cvt_pk_bf16(a[2], a[3]); w.z = cvt_pk_bf16(b[0], b[1]); w.w = cvt_pk_bf16(b[2], b[3]); *(u32x4*)(yp + HALF) = w; }
#endif
            }
    }
};
}

typedef GAS unsigned gu32;
#define RLX_AGENT __ATOMIC_RELAXED, __HIP_MEMORY_SCOPE_AGENT
#define LDS_WAIT() asm volatile("s_waitcnt lgkmcnt(0)" ::: "memory")
#define VM_WAIT() asm volatile("s_waitcnt vmcnt(0)" ::: "memory")
#define XB_TMO      128
#define XB_XCNT(j)  (256  + 64 * (j))
#define XB_XSUB(j)  (1280 + 64 * (j))
#define XB_XGEN(j)  (2304 + 64 * (j))
#define XB_TOP      3328
#define XB_TOPGEN   3392
#define XCD_BAR_WORDS 3456
#define XB_SPIN_CAP (1u << 18)
__device__ __forceinline__ unsigned xb_ld(unsigned* p)              { return __hip_atomic_load(p, __ATOMIC_RELAXED, __HIP_MEMORY_SCOPE_AGENT); }
__device__ __forceinline__ unsigned xb_add(unsigned* p, unsigned v) { return __hip_atomic_fetch_add(p, v, __ATOMIC_RELAXED, __HIP_MEMORY_SCOPE_AGENT); }
__device__ __forceinline__ unsigned xb_xcc_id() { return (unsigned)__builtin_amdgcn_s_getreg((3 << 11) | 20) & 0xFu; }
#define XB_SPIN(cond, bar) do { unsigned _sp = 0; while (cond) { __builtin_amdgcn_s_sleep(1); \
    if ((++_sp & 255u) == 0u) { if (xb_ld(&(bar)[XB_TMO])) break; if (_sp > XB_SPIN_CAP) { atomicAdd(&(bar)[XB_TMO], 1u); break; } } } } while (0)
struct XcdBarrier { unsigned* bar; unsigned x; volatile LAS unsigned* st; };
__device__ __forceinline__ XcdBarrier xcd_barrier_post(unsigned* bar, volatile LAS unsigned* st) {
    XcdBarrier b; b.bar = bar; b.x = xb_xcc_id(); b.st = st;
    if (threadIdx.x == 0) (void)xb_add(&bar[XB_XCNT(b.x)], 1u);
    return b;
}
__device__ __forceinline__ void xcd_barrier_complete(unsigned* bar, unsigned x, unsigned& nloc, unsigned& nx) {
    const unsigned G = gridDim.x * gridDim.y * gridDim.z;
    unsigned sum, cnt, mine, sp = 0u;
    for (;;) {
        sum = 0u; cnt = 0u; mine = 0u;
#pragma unroll
        for (unsigned j = 0; j < 16; ++j) { const unsigned c = xb_ld(&bar[XB_XCNT(j)]); sum += c; cnt += (c > 0u) ? 1u : 0u; mine = (j == x) ? c : mine; }
        if (sum == G) break;
        __builtin_amdgcn_s_sleep(1);
        if ((++sp & 255u) == 0u) { if (xb_ld(&bar[XB_TMO])) break; if (sp > XB_SPIN_CAP) { atomicAdd(&bar[XB_TMO], 1u); break; } }
    }
    nloc = mine > 0u ? mine : 1u; nx = cnt > 0u ? cnt : 1u;
}
__device__ __forceinline__ void xcd_barrier(const XcdBarrier& b) {
    asm volatile("s_waitcnt vmcnt(0)" ::: "memory");
    __syncthreads();
    if (threadIdx.x == 0) {
        unsigned* bar = b.bar;
        __builtin_amdgcn_s_waitcnt(0);
        unsigned nloc = b.st[0], nx = b.st[1];
        if (nloc == 0u) { xcd_barrier_complete(bar, b.x, nloc, nx); b.st[0] = nloc; b.st[1] = nx; }
        const unsigned old = xb_add(&bar[XB_XSUB(b.x)], 1u);
        const unsigned gen = old / nloc;
        if (old + 1u == (gen + 1u) * nloc) {
            __builtin_amdgcn_fence(__ATOMIC_RELEASE, "agent");
            asm volatile("s_waitcnt vmcnt(0)" ::: "memory");
            const unsigned og = xb_add(&bar[XB_TOP], 1u);
            const unsigned tg = og / nx;
            if (og + 1u == (tg + 1u) * nx) xb_add(&bar[XB_TOPGEN], 1u);
            else XB_SPIN(xb_ld(&bar[XB_TOPGEN]) == tg, bar);
            __builtin_amdgcn_fence(__ATOMIC_ACQUIRE, "agent");
            xb_add(&bar[XB_XGEN(b.x)], 1u);
            asm volatile("s_waitcnt vmcnt(0)" ::: "memory");
        } else {
            XB_SPIN(xb_ld(&bar[XB_XGEN(b.x)]) == gen, bar);
            __builtin_amdgcn_fence(__ATOMIC_ACQUIRE, "agent");
            asm volatile("s_waitcnt vmcnt(0)" ::: "memory");
        }
    }
    __syncthreads();
}

struct Args { const void* in[22]; float* out; unsigned char* ws; int ph_lo, ph_hi; };
typedef __attribute__((address_space(4))) const volatile Args* KArgs;
#define KIN(k) ((const void*)ka->in[k])
struct Frame {
    LAS unsigned char* lds; int wave, G, vcu;
    gu32* ctl; unsigned char* ws;
};

__device__ __forceinline__ void tr_item(const float* W, size_t ldw, int k0, int c0a, int c0b, bool perm, bf16_t* dst  , LAS float* scr, int lane) {
    const int kr = lane >> 4, q = lane & 15; const int col = (q < 8) ? c0a + 4 * q : c0b + 4 * (q - 8);
    f32x4 v[16];
#pragma unroll
    for (int it = 0; it < 16; ++it) v[it] = *(const f32x4*)(W + (size_t)(k0 + 4 * it + kr) * ldw + col);
#pragma unroll
    for (int it = 0; it < 16; ++it) { const int k = 4 * it + kr; *(LAS f32x4*)(scr + k * 64 + 4 * (q ^ ((k >> 3) & 7))) = v[it]; }
    LDS_WAIT(); asm volatile("" ::: "memory");
    const int n0l = lane >> 3, c = lane & 7;
#pragma unroll
    for (int j = 0; j < 8; ++j) { const int n = n0l + 8 * j; const int slot = perm ? ((n >> 1) + 32 * (n & 1)) : n;
        const LAS float* s = scr + (8 * c) * 64 + 4 * ((slot >> 2) ^ c) + (slot & 3);
        u32x4 o; o.x = pk2(s[0 * 64], s[1 * 64]); o.y = pk2(s[2 * 64], s[3 * 64]); o.z = pk2(s[4 * 64], s[5 * 64]); o.w = pk2(s[6 * 64], s[7 * 64]);
        *(u32x4*)(dst + (size_t)n * DM + k0 + 8 * c) = o; }
    LDS_WAIT(); asm volatile("" ::: "memory");
}
__device__ __forceinline__ void tr8_load(f32x4 (&v)[16], const float* W, size_t ldw, int k0, int c0, int lane) {
    const int kr = lane >> 3, q = lane & 7; const float* p = W + (size_t)(k0 + kr) * ldw + c0 + 4 * q;
#pragma unroll
    for (int it = 0; it < 16; ++it) v[it] = __builtin_nontemporal_load((const f32x4*)(p + (size_t)(8 * it) * ldw));
}
__device__ __forceinline__ void tr6_put(const f32x4 (&v)[16], LAS float* scr, int lane) {
    const int kr = lane >> 3, q = lane & 7;
#pragma unroll
    for (int it = 0; it < 16; ++it) { const int k = 8 * it + kr; *(LAS f32x4*)(scr + k * 32 + 4 * (q ^ ((k >> 4) & 7))) = v[it]; }
    LDS_WAIT(); asm volatile("" ::: "memory");
}
__device__ __forceinline__ void tr6_emit(int k0, unsigned char* dst, LAS float* scr, int lane) {
#pragma unroll
    for (int jj = 0; jj < 2; ++jj) { const int p = lane + 64 * jj, n = p >> 2, ch = p & 3;
        v16f_t a, b;
#pragma unroll
        for (int i = 0; i < 16; ++i) { const int ka = 32 * ch + i, kb = ka + 16;
            a[i] = scr[ka * 32 + 4 * ((n >> 2) ^ (2 * ch)) + (n & 3)]; b[i] = scr[kb * 32 + 4 * ((n >> 2) ^ (2 * ch + 1)) + (n & 3)]; }
        u32x4 lo, hi; fp6_record(a, b, lo, hi);
        unsigned char* rp = dst + (size_t)n * DM + k0 + 16 * ch;
        __builtin_nontemporal_store(lo, (u32x4*)rp); __builtin_nontemporal_store(hi, (u32x4*)(rp + 64)); }
    LDS_WAIT(); asm volatile("" ::: "memory");
}
__device__ __forceinline__ void tr6_store(const f32x4 (&v)[16], int k0, unsigned char* dst, LAS float* scr, int lane) { tr6_put(v, scr, lane); tr6_emit(k0, dst, scr, lane); }
__device__ __forceinline__ void tr8_store(const f32x4 (&v)[16], int k0, unsigned char* dst  , LAS float* scr, int lane) {
    const int kr = lane >> 3, q = lane & 7;
#pragma unroll
    for (int it = 0; it < 16; ++it) { const int k = 8 * it + kr; *(LAS f32x4*)(scr + k * 32 + 4 * (q ^ ((k >> 4) & 7))) = v[it]; }
    LDS_WAIT(); asm volatile("" ::: "memory");
    const int n0l = lane >> 3, c = lane & 7; constexpr float sc8 = (float)(1 << FP8_WSHIFT);
#pragma unroll
    for (int j = 0; j < 4; ++j) { const int n = n0l + 8 * j;
        const LAS float* s = scr + (16 * c) * 32 + 4 * ((n >> 2) ^ c) + (n & 3);
        u32x4 o; o.x = pk_fp8x4(s[0 * 32] * sc8, s[1 * 32] * sc8, s[2 * 32] * sc8, s[3 * 32] * sc8); o.y = pk_fp8x4(s[4 * 32] * sc8, s[5 * 32] * sc8, s[6 * 32] * sc8, s[7 * 32] * sc8);
        o.z = pk_fp8x4(s[8 * 32] * sc8, s[9 * 32] * sc8, s[10 * 32] * sc8, s[11 * 32] * sc8); o.w = pk_fp8x4(s[12 * 32] * sc8, s[13 * 32] * sc8, s[14 * 32] * sc8, s[15 * 32] * sc8);
        *(u32x4*)(dst + (size_t)n * DM + k0 + 16 * c) = o; }
    LDS_WAIT(); asm volatile("" ::: "memory");
}
__device__ __forceinline__ float log2_sigmoid(float z) {
    const float az = fabsf(z); const float e = __builtin_amdgcn_exp2f(-az * L2E);
    return fminf(z, 0.f) * L2E - __builtin_amdgcn_logf(1.0f + e) ;
}
__device__ __forceinline__ void p0_prologue(Frame& F, KArgs ka) {
    const float* x = (const float*)KIN(0); const int* pos = (const int*)KIN(1); const float* g_attn = (const float*)KIN(2); const float* w_in = (const float*)KIN(3);
    const float* b_forget = (const float*)KIN(4); const float* w_out = (const float*)KIN(11); const float* g_ffn = (const float*)KIN(12); const float* w_router = (const float*)KIN(13);
    const float* w_gate = (const float*)KIN(15); const float* w_up = (const float*)KIN(17); const float* w_down = (const float*)KIN(19);
    const int gw = F.vcu * NWAVES + F.wave, NGW = F.G * NWAVES; const int gt = F.vcu * NTHREADS + ((int)threadIdx.x), NGT = F.G * NTHREADS;
    { float* rope = (float*)(F.ws + WS_ROPE);
#pragma unroll 8
      for (int p = gt; p < MTOK * 64; p += NGT) { const int m = p >> 6, i = p & 63;
          const float invf = exp2f(-(float)i * 0.20762050593046014f); const float ang = (float)pos[m] * invf;
          const double rv = (double)ang * 0.15915494309189533576888; const float rev = (float)(rv - floor(rv));
          *(f32x2*)(rope + (size_t)p * 2) = (f32x2){__builtin_amdgcn_cosf(rev), __builtin_amdgcn_sinf(rev)}; } }
    { bf16_t* gwf = (bf16_t*)(F.ws + WS_GWF);
      for (int f = gt; f < 64 * 2 * 2 * 64; f += NGT) { const int ln = f & 63, p = (f >> 6) & 1, eh = (f >> 7) & 1, s = f >> 8;
          unsigned o[4];
#pragma unroll
          for (int j2 = 0; j2 < 4; ++j2) { unsigned hv[2];
#pragma unroll
              for (int q = 0; q < 2; ++q) { const int k = 32 * s + 8 * (ln >> 4) + 2 * j2 + q, e = 16 * eh + (ln & 15); const float val = g_ffn[k] * w_router[k * NE + e];
                  const unsigned hi = f2bf(val); const float lo = val - bf2f((unsigned short)hi); hv[q] = p ? f2bf(lo) : hi; }
              o[j2] = hv[0] | (hv[1] << 16); }
          *(u32x4*)(gwf + (size_t)f * 8) = (u32x4){o[0], o[1], o[2], o[3]}; } }
    { LAS float* gwfT = (LAS float*)F.lds;
#pragma unroll 4
      for (int k = ((int)threadIdx.x); k < DM; k += NTHREADS) { const f32x4 w0 = *(const f32x4*)(w_in + (size_t)k * INC + NQKV), w1 = *(const f32x4*)(w_in + (size_t)k * INC + NQKV + 4); const float g = g_attn[k];
          gwfT[0 * DM + k] = g * w0.x; gwfT[1 * DM + k] = g * w0.y; gwfT[2 * DM + k] = g * w0.z; gwfT[3 * DM + k] = g * w0.w; gwfT[4 * DM + k] = g * w1.x; gwfT[5 * DM + k] = g * w1.y; gwfT[6 * DM + k] = g * w1.z; gwfT[7 * DM + k] = g * w1.w; }
      __syncthreads();
      bf16_t* XN = (bf16_t*)(F.ws + WS_XN); float* flog = (float*)(F.ws + WS_FLOG);
      f32x4 gv[8];
#pragma unroll
      for (int j = 0; j < 8; ++j) gv[j] = *((const f32x4*)g_attn + ((int)(threadIdx.x & 63)) + 64 * j);
      f32x4 vn[8];
      if (gw < MTOK) { const f32x4* xr = (const f32x4*)(x + (size_t)gw * DM) + ((int)(threadIdx.x & 63));
#pragma unroll
          for (int j = 0; j < 8; ++j) vn[j] = __builtin_nontemporal_load(xr + 64 * j); }
      for (int m = gw; m < MTOK; m += NGW) {
          f32x4 v[8]; float s = 0.f;
#pragma unroll
          for (int j = 0; j < 8; ++j) { v[j] = vn[j]; s += (v[j].x * v[j].x + v[j].y * v[j].y) + (v[j].z * v[j].z + v[j].w * v[j].w); }
          if (m + NGW < MTOK) { const f32x4* xr = (const f32x4*)(x + (size_t)(m + NGW) * DM) + ((int)(threadIdx.x & 63));
#pragma unroll
              for (int j = 0; j < 8; ++j) vn[j] = __builtin_nontemporal_load(xr + 64 * j); }
          const float rstd = 1.0f / sqrtf(wave_sum(s) * (1.0f / DM) + EPS);
          unsigned long long* o8 = (unsigned long long*)(XN + (size_t)m * DM) + ((int)(threadIdx.x & 63));
#pragma unroll
          for (int j = 0; j < 8; ++j) { const f32x4 t = v[j] * gv[j] * rstd; o8[64 * j] = (unsigned long long)pk2(t.x, t.y) | ((unsigned long long)pk2(t.z, t.w) << 32); }
          float myz = 0.f;
#pragma unroll 1
          for (int jh = 0; jh < 8; ++jh) { float acc = 0.f;
#pragma unroll
              for (int j = 0; j < 8; ++j) { const f32x4 w = *(const LAS f32x4*)(gwfT + jh * DM + 256 * j + 4 * ((int)(threadIdx.x & 63))); acc += (v[j].x * w.x + v[j].y * w.y) + (v[j].z * w.z + v[j].w * w.w); }
              acc = wave_sum(acc); if (((int)(threadIdx.x & 63)) == jh) myz = acc; }
          if (((int)(threadIdx.x & 63)) < 8) flog[(size_t)m * 8 + ((int)(threadIdx.x & 63))] = log2_sigmoid(myz * rstd + b_forget[((int)(threadIdx.x & 63))]);
      }
      __syncthreads();
    }
    { LAS float* scr = (LAS float*)(F.lds + F.wave * 16384);
      bf16_t* Win = (bf16_t*)(F.ws + WS_WIN); bf16_t* Wout = (bf16_t*)(F.ws + WS_WOUT); bf16_t* Wgu = (bf16_t*)(F.ws + WS_WGU); bf16_t* Wd = (bf16_t*)(F.ws + WS_WD);
      constexpr int I_IN = 32 * 96, I_OUT = 32 * 32, I_GU = NE * 32 * 64, I_D = NE * 32 * 32, NITEMS = I_IN + I_OUT + I_GU + I_D;
      for (int it = gw; it < NITEMS; it += NGW) {
          int r = it;
          if (r < I_IN) { const int kb = r / 96, nb = r % 96, n0 = nb * 64;
              if (n0 < 2048) { const int base = n0 & ~127, i0 = ((n0 >> 6) & 1) * 32; tr_item(w_in, INC, kb * 64, base + i0, base + 64 + i0, true, Win + (size_t)n0 * DM, scr, ((int)(threadIdx.x & 63))); }
              else tr_item(w_in, INC, kb * 64, n0, n0 + 32, false, Win + (size_t)n0 * DM, scr, ((int)(threadIdx.x & 63)));
              continue; }
          r -= I_IN;
          if (r < I_OUT) { const int kb = r / 32, nb = r % 32; tr_item(w_out, DM, kb * 64, nb * 64, nb * 64 + 32, false, Wout + (size_t)nb * 64 * DM, scr, ((int)(threadIdx.x & 63))); continue; }
          r -= I_OUT;
#if MK_FP8
          break;
#else
          if (r < I_GU) { const int e = r / (32 * 64), rr = r % (32 * 64), kb = rr / 64, nb = rr % 64;
              const int pn = nb >> 2, w = nb & 3; const float* src = (w < 2 ? w_gate : w_up) + (size_t)e * DM * DM; const int c0 = pn * 128 + (w & 1) * 64;
              tr_item(src, DM, kb * 64, c0, c0 + 32, false, Wgu + ((size_t)e * 4096 + (size_t)nb * 64) * DM, scr, ((int)(threadIdx.x & 63))); continue; }
          r -= I_GU;
          { const int e = r / (32 * 32), rr = r % (32 * 32), kb = rr / 32, nb = rr % 32;
            tr_item(w_down + (size_t)e * DM * DM, DM, kb * 64, nb * 64, nb * 64 + 32, false, Wd + ((size_t)e * DM + (size_t)nb * 64) * DM, scr, ((int)(threadIdx.x & 63))); }
#endif
      }
    }
}

__device__ __forceinline__ void probe_stream(Frame& F, KArgs ka) {
    const float* src[3] = {(const float*)KIN(15), (const float*)KIN(17), (const float*)KIN(19)};
    const size_t n4 = (size_t)NE * DM * DM / 4; const size_t gt = (size_t)F.vcu * NTHREADS + threadIdx.x, NGT = (size_t)F.G * NTHREADS;
#pragma unroll
    for (int m = 0; m < 3; ++m) { unsigned* dst = (unsigned*)(F.ws + WS_HDN) + (size_t)m * n4;
#pragma unroll 8
        for (size_t i = gt; i < n4; i += NGT) { const f32x4 v = __builtin_nontemporal_load((const f32x4*)src[m] + i); dst[i] = pk_fp8x4(v.x * 256.f, v.y * 256.f, v.z * 256.f, v.w * 256.f); } }
}
#if MK_FP8
#if MK_FP6
#define P0B_STORE(v, k0, dst, scr, lane) tr6_store(v, k0, dst, scr, lane)
#else
#define P0B_STORE(v, k0, dst, scr, lane) tr8_store(v, k0, dst, scr, lane)
#endif
constexpr int P0B_ROWB = DM;
constexpr int P0B_IGU = NE * 32 * 64, P0B_ID = NE * 32 * 32, P0B_NI = P0B_IGU + P0B_ID;
__device__ __forceinline__ void p0b_experts(Frame& F, KArgs ka, const int it_lo, const int it_hi) {
    const float* w_gate = (const float*)KIN(15); const float* w_up = (const float*)KIN(17); const float* w_down = (const float*)KIN(19);
    const int gw = F.vcu * NWAVES + F.wave, NGW = F.G * NWAVES;
    constexpr int I_GU = P0B_IGU;
    LAS float* scr = (LAS float*)(F.lds + F.wave * 16384);
    bf16_t* Wgu = (bf16_t*)(F.ws + WS_WGU); bf16_t* Wd = (bf16_t*)(F.ws + WS_WD);
    __syncthreads();
      { const int lane = (int)(threadIdx.x & 63);
#define FP8_DESC(r_, SRC, K0, C0, DST) do { int r2 = (r_); \
          if (r2 < I_GU) { const int e = r2 / (16 * 128), rr = r2 % (16 * 128), kb = rr / 128, nb = rr % 128; const int pn = nb >> 3, w = nb & 7; \
              SRC = (w < 4 ? w_gate : w_up) + (size_t)e * DM * DM; C0 = pn * 128 + (w & 3) * 32; K0 = kb * 128; const size_t row = (size_t)e * 4096 + (size_t)nb * 32; \
              DST = (unsigned char*)Wgu + row * P0B_ROWB; } \
          else { r2 -= I_GU; const int e = r2 / (16 * 64), rr = r2 % (16 * 64), kb = rr / 64, nb = rr % 64; \
              SRC = w_down + (size_t)e * DM * DM; C0 = nb * 32; K0 = kb * 128; const size_t row = (size_t)e * DM + (size_t)nb * 32; \
              DST = (unsigned char*)Wd + row * P0B_ROWB; } } while (0)
        f32x4 va[16], vb[16]; const float* src; int k0 = 0, c0 = 0; unsigned char* dst = nullptr; const float* srcn; int k0n = 0, c0n = 0; unsigned char* dstn = nullptr;
        int it = it_lo + gw;
#if MK_FP6
        if (it < it_hi) { FP8_DESC(it, src, k0, c0, dst); tr8_load(va, src, DM, k0, c0, lane); }
        if (it + NGW < it_hi) { FP8_DESC(it + NGW, srcn, k0n, c0n, dstn); tr8_load(vb, srcn, DM, k0n, c0n, lane); }
        while (it < it_hi) {
            { tr6_put(va, scr, lane); const int ke = k0; unsigned char* de = dst;
              if (it + 2 * NGW < it_hi) { FP8_DESC(it + 2 * NGW, src, k0, c0, dst); tr8_load(va, src, DM, k0, c0, lane); }
              tr6_emit(ke, de, scr, lane); }
            it += NGW; if (it >= it_hi) break;
            { tr6_put(vb, scr, lane); const int ke = k0n; unsigned char* de = dstn;
              if (it + 2 * NGW < it_hi) { FP8_DESC(it + 2 * NGW, srcn, k0n, c0n, dstn); tr8_load(vb, srcn, DM, k0n, c0n, lane); }
              tr6_emit(ke, de, scr, lane); }
            it += NGW;
        }
#else
        if (it < it_hi) { FP8_DESC(it, src, k0, c0, dst); tr8_load(va, src, DM, k0, c0, lane); }
        while (it < it_hi) {
            int itn = it + NGW;
            if (itn < it_hi) { FP8_DESC(itn, srcn, k0n, c0n, dstn); tr8_load(vb, srcn, DM, k0n, c0n, lane); }
            P0B_STORE(va, k0, dst, scr, lane);
            it = itn; if (it >= it_hi) break;
            itn = it + NGW;
            if (itn < it_hi) { FP8_DESC(itn, src, k0, c0, dst); tr8_load(va, src, DM, k0, c0, lane); }
            P0B_STORE(vb, k0n, dstn, scr, lane);
            it = itn;
        }
#endif
#undef FP8_DESC
      }
    __syncthreads();
}
#endif
__device__ __forceinline__ void p1_scan(Frame& F) {
    if (blockIdx.x >= BATCH * 8) return;
    const int bh = blockIdx.x, b = bh >> 3, h = bh & 7, t = ((int)threadIdx.x);
    const float* flog = (const float*)(F.ws + WS_FLOG); float* clog = (float*)(F.ws + WS_CLOG) + (size_t)bh * SEQ;
    LAS double* sc = (LAS double*)F.lds;
    double loc[8]; double run = 0.0;
#pragma unroll
    for (int i = 0; i < 8; ++i) { run += (double)flog[(size_t)(b * SEQ + t * 8 + i) * 8 + h]; loc[i] = run; }
    double v = run; const int ln = t & 63, wv = t >> 6;
#pragma unroll
    for (int o = 1; o < 64; o <<= 1) { const double n = __shfl_up(v, o); v = ln >= o ? v + n : v; }
    if (ln == 63) sc[wv] = v;
    __syncthreads();
    double base = v - run;
#pragma unroll
    for (int w = 0; w < NWAVES - 1; ++w) { const double wt = sc[w]; base += w < wv ? wt : 0.0; }
#pragma unroll
    for (int i = 0; i < 8; ++i) clog[t * 8 + i] = (float)(base + loc[i]);
    __syncthreads();
}

__device__ __forceinline__ void p_norms(Frame& F) {
    const bf16_t* QKV = (const bf16_t*)(F.ws + WS_QKV);
    const int lane = (int)(threadIdx.x & 63), gw = F.vcu * NWAVES + F.wave, NGW = F.G * NWAVES;
    for (int task = gw; task < 2 * 32 * 16; task += NGW) {
        const int isk = task >> 9, bh = (task >> 4) & 31, ch = task & 15, b = bh >> 3, h = bh & 7;
        const bf16_t* base = QKV + ((size_t)((isk ? 32 : 24) + h) * MTOK + (size_t)b * SEQ + ch * 256) * 128 + (lane >> 4) * 128 + (lane & 15) * 8;
        float mx = 0.f;
#pragma unroll 4
        for (int it = 0; it < 64; ++it) {
            const u32x4 w = *(const u32x4*)(base + (size_t)it * 4 * 128);
            float ss = 0.f;
#pragma unroll
            for (int j = 0; j < 4; ++j) { const float a = bf2f((unsigned short)(w[j] & 0xffff)), c = bf2f((unsigned short)(w[j] >> 16)); ss += a * a + c * c; }
            ss += __shfl_xor(ss, 1); ss += __shfl_xor(ss, 2); ss += __shfl_xor(ss, 4); ss += __shfl_xor(ss, 8);
            mx = fmaxf(mx, ss);
        }
        mx = fmaxf(mx, __shfl_xor(mx, 16)); mx = fmaxf(mx, __shfl_xor(mx, 32));
        if (lane == 0) atomicMax((unsigned*)(F.ctl + (isk ? CW_KMAX + bh : CW_QMAX + bh * 16 + ch)), __float_as_uint(mx));
    }
}

__device__ __forceinline__ void p3_mix(Frame& F, KArgs ka) {
    const float* lq1 = (const float*)KIN(5); const float* lk1 = (const float*)KIN(6); const float* lq2 = (const float*)KIN(7); const float* lk2 = (const float*)KIN(8);
    const float* gd = (const float*)KIN(9); const float* gf = (const float*)KIN(10);
    const int l = ((int)(threadIdx.x & 63));
    const float s1 = wave_sum(lq1[l] * lk1[l] + lq1[l + 64] * lk1[l + 64]), s2 = wave_sum(lq2[l] * lk2[l] + lq2[l + 64] * lk2[l + 64]);
    const float lam = expf(s1) - expf(s2) + 0.2f;
    const bf16_t* O = (const bf16_t*)(F.ws + WS_O); bf16_t* mix = (bf16_t*)(F.ws + WS_MIX);
    const f32x2 gd0 = *(const f32x2*)(gd + 2 * l), gd1 = *(const f32x2*)(gd + 128 + 2 * l), gfv = *(const f32x2*)(gf + 2 * l);
    const int gw = F.vcu * NWAVES + F.wave, NGW = F.G * NWAVES;
    for (int m = gw; m < MTOK; m += NGW) {
        unsigned ov[24];
#pragma unroll
        for (int vh = 0; vh < 24; ++vh) ov[vh] = *(const unsigned*)(O + ((size_t)vh * MTOK + m) * 128 + 2 * l);
        unsigned* mrow = (unsigned*)(mix + (size_t)m * DM);
#pragma unroll
        for (int h = 0; h < 4; ++h) {
            const unsigned a0 = ov[8 + h * 4 + 0], a1 = ov[8 + h * 4 + 1], b0 = ov[8 + h * 4 + 2], b1 = ov[8 + h * 4 + 3];
            const float d00 = bf2f(a0 & 0xffff) - lam * bf2f(b0 & 0xffff), d01 = bf2f(a0 >> 16) - lam * bf2f(b0 >> 16);
            const float d10 = bf2f(a1 & 0xffff) - lam * bf2f(b1 & 0xffff), d11 = bf2f(a1 >> 16) - lam * bf2f(b1 >> 16);
            const float ss = wave_sum((d00 * d00 + d01 * d01) + (d10 * d10 + d11 * d11));
            const float rs = 0.8f / sqrtf(ss * (1.0f / 256.0f) + EPS);
            mrow[(h * 256) / 2 + l] = pk2(d00 * rs * gd0.x, d01 * rs * gd0.y);
            mrow[(h * 256 + 128) / 2 + l] = pk2(d10 * rs * gd1.x, d11 * rs * gd1.y);
        }
#pragma unroll
        for (int h = 0; h < 8; ++h) {
            const float f0 = bf2f(ov[h] & 0xffff), f1 = bf2f(ov[h] >> 16);
            const float ss = wave_sum(f0 * f0 + f1 * f1);
            const float rs = 1.0f / sqrtf(ss * (1.0f / 128.0f) + EPS);
            mrow[(1024 + h * 128) / 2 + l] = pk2(f0 * rs * gfv.x, f1 * rs * gfv.y);
        }
    }
}

__device__ __forceinline__ void p5_router(Frame& F, KArgs ka, const float* hbuf) {
    const float* b_router = (const float*)KIN(14);
    const bf16_t* gwf = (const bf16_t*)(F.ws + WS_GWF);
    int* tke = (int*)(F.ws + WS_TKE); int* tokl = (int*)(F.ws + WS_TOK); float* rstdl = (float*)(F.ws + WS_RSTD); float* gatel = (float*)(F.ws + WS_GATE);
    LAS float* sc = (LAS float*)(F.lds + F.wave * 4096);
    const int l = ((int)(threadIdx.x & 63)), r16 = l & 15, kq = l >> 4;
    const int gw = F.vcu * NWAVES + F.wave, NGW = F.G * NWAVES;
    for (int tile = gw; tile < MTOK / 16; tile += NGW) {
        const float* hr = hbuf + (size_t)(tile * 16 + r16) * DM + 8 * kq;
        f32x4 acc0 = {0.f, 0.f, 0.f, 0.f}, acc1 = {0.f, 0.f, 0.f, 0.f}; float ss = 0.f;
#pragma unroll 2
        for (int s = 0; s < 64; ++s) {
            const f32x4 v0 = *(const f32x4*)(hr + 32 * s), v1 = *(const f32x4*)(hr + 32 * s + 4);
            ss += (v0.x * v0.x + v0.y * v0.y) + (v0.z * v0.z + v0.w * v0.w) + (v1.x * v1.x + v1.y * v1.y) + (v1.z * v1.z + v1.w * v1.w);
            unsigned hi[4], lo[4];
#define SPL(i, A, B) do { const unsigned ha = f2bf(A), hb = f2bf(B); hi[i] = ha | (hb << 16); lo[i] = pk2(A - bf2f((unsigned short)ha), B - bf2f((unsigned short)hb)); } while (0)
            SPL(0, v0.x, v0.y); SPL(1, v0.z, v0.w); SPL(2, v1.x, v1.y); SPL(3, v1.z, v1.w);
#undef SPL
            const u32x4 hiv = {hi[0], hi[1], hi[2], hi[3]}, lov = {lo[0], lo[1], lo[2], lo[3]};
            const bf16x8 ah = __builtin_bit_cast(bf16x8, hiv), al = __builtin_bit_cast(bf16x8, lov);
            const bf16x8* bf = (const bf16x8*)(gwf + (size_t)s * 4 * 512) + l;
            const bf16x8 b0h = bf[0], b0l = bf[64], b1h = bf[128], b1l = bf[192];
            acc0 = __builtin_amdgcn_mfma_f32_16x16x32_bf16(ah, b0h, acc0, 0, 0, 0); acc0 = __builtin_amdgcn_mfma_f32_16x16x32_bf16(al, b0h, acc0, 0, 0, 0); acc0 = __builtin_amdgcn_mfma_f32_16x16x32_bf16(ah, b0l, acc0, 0, 0, 0);
            acc1 = __builtin_amdgcn_mfma_f32_16x16x32_bf16(ah, b1h, acc1, 0, 0, 0); acc1 = __builtin_amdgcn_mfma_f32_16x16x32_bf16(al, b1h, acc1, 0, 0, 0); acc1 = __builtin_amdgcn_mfma_f32_16x16x32_bf16(ah, b1l, acc1, 0, 0, 0);
        }
        ss += __shfl_xor(ss, 16); ss += __shfl_xor(ss, 32);
        const float rstd = 1.0f / sqrtf(ss * (1.0f / DM) + EPS);
        if (kq == 0) sc[16 * 33 + r16] = rstd;
        LDS_WAIT(); asm volatile("" ::: "memory");
#pragma unroll
        for (int rg = 0; rg < 4; ++rg) { const int tr = 4 * kq + rg; const float rt = sc[16 * 33 + tr];
            sc[tr * 33 + r16] = acc0[rg] * rt + b_router[r16]; sc[tr * 33 + 16 + r16] = acc1[rg] * rt + b_router[16 + r16]; }
        LDS_WAIT(); asm volatile("" ::: "memory");
        if (l < 16) {
            const int m = tile * 16 + l; float lg[NE];
#pragma unroll
            for (int e = 0; e < NE; ++e) lg[e] = sc[l * 33 + e];
            float tv[TOPK]; int ti[TOPK];
#pragma unroll
            for (int k = 0; k < TOPK; ++k) { float best = -3.4e38f; int bi = 0;
#pragma unroll
                for (int e = 0; e < NE; ++e) { const bool c = lg[e] > best; best = c ? lg[e] : best; bi = c ? e : bi; }
                tv[k] = best; ti[k] = bi;
#pragma unroll
                for (int e = 0; e < NE; ++e) lg[e] = (e == bi) ? -3.4e38f : lg[e]; }
            const float e1 = __expf(tv[1] - tv[0]), e2 = __expf(tv[2] - tv[0]), e3 = __expf(tv[3] - tv[0]); const float inv = 1.0f / (1.0f + e1 + e2 + e3);
            const float gk[TOPK] = {inv, e1 * inv, e2 * inv, e3 * inv}; const float rt = sc[16 * 33 + l];
#pragma unroll
            for (int k = 0; k < TOPK; ++k) { const int e = ti[k];
                const int pos = (int)__hip_atomic_fetch_add((unsigned*)(F.ctl + CW_CNT + 64 * e), 1u, RLX_AGENT);
                tokl[(size_t)e * ECAP + pos] = m; rstdl[(size_t)e * ECAP + pos] = rt; gatel[(size_t)e * ECAP + pos] = gk[k]; tke[m * TOPK + k] = pos * 32 + e; }
        }
        LDS_WAIT(); asm volatile("" ::: "memory");
    }
}

__device__ __forceinline__ void build_tab(Frame& F, LAS int* tab, bool publish) {
    if (((int)threadIdx.x) < NE) tab[NE + 1 + ((int)threadIdx.x)] = (int)__hip_atomic_load(F.ctl + CW_CNT + 64 * ((int)threadIdx.x), RLX_AGENT);
    __syncthreads();
    if (((int)threadIdx.x) == 0) { int s = 0; for (int e = 0; e < NE; ++e) { tab[e] = s; s += (tab[NE + 1 + e] + 255) >> 8; } tab[NE] = s; }
    __syncthreads();
    if (publish && blockIdx.x == 0 && ((int)threadIdx.x) <= NE) ((int*)(F.ws + WS_TSTART))[((int)threadIdx.x)] = tab[((int)threadIdx.x)];
}

__device__ __forceinline__ void p8_final(Frame& F, KArgs ka, float* hout) {
    const float* gfin = (const float*)KIN(21);
    const bf16_t* ys = (const bf16_t*)(F.ws + WS_YS); const int* tke = (const int*)(F.ws + WS_TKE); const int* tstart = (const int*)(F.ws + WS_TSTART);
    const int gw = F.vcu * NWAVES + F.wave, NGW = F.G * NWAVES;
    f32x4 gv[8];
#pragma unroll
    for (int j = 0; j < 8; ++j) gv[j] = *((const f32x4*)gfin + ((int)(threadIdx.x & 63)) + 64 * j);
    for (int m = gw; m < MTOK; m += NGW) {
        f32x4* hr = (f32x4*)(hout + (size_t)m * DM) + ((int)(threadIdx.x & 63));
        f32x4 v[8];
#pragma unroll
        for (int j = 0; j < 8; ++j) v[j] = hr[64 * j];
#pragma unroll
        for (int k = 0; k < TOPK; ++k) { const int code = tke[m * TOPK + k]; const int e = code & 31, pos = code >> 5; const size_t slot = (size_t)tstart[e] * 256 + pos;
#if MK_YS8
            const unsigned* yr = (const unsigned*)((const unsigned char*)ys + slot * DM) + ((int)(threadIdx.x & 63)); constexpr float ysc = 1.0f / (float)(1 << FP8_YSHIFT);
#pragma unroll
            for (int j = 0; j < 8; ++j) { const unsigned w = yr[64 * j]; const f32x2 lo = __builtin_amdgcn_cvt_pk_f32_fp8((int)w, false), hi = __builtin_amdgcn_cvt_pk_f32_fp8((int)w, true);
                v[j].x += lo.x * ysc; v[j].y += lo.y * ysc; v[j].z += hi.x * ysc; v[j].w += hi.y * ysc; } }
#else
            const u32x2* yr = (const u32x2*)(ys + slot * DM) + ((int)(threadIdx.x & 63));
#pragma unroll
            for (int j = 0; j < 8; ++j) { const u32x2 w = yr[64 * j]; v[j].x += bf2f(w.x & 0xffff); v[j].y += bf2f(w.x >> 16); v[j].z += bf2f(w.y & 0xffff); v[j].w += bf2f(w.y >> 16); } }
#endif
        float s = 0.f;
#pragma unroll
        for (int j = 0; j < 8; ++j) s += (v[j].x * v[j].x + v[j].y * v[j].y) + (v[j].z * v[j].z + v[j].w * v[j].w);
        const float rstd = 1.0f / sqrtf(wave_sum(s) * (1.0f / DM) + EPS);
#pragma unroll
        for (int j = 0; j < 8; ++j) hr[64 * j] = v[j] * gv[j] * rstd;
    }
}
template <bool FOX>
__device__ __forceinline__ att::BlockRef attn_ref(const Frame& F, int L, int pass) {
    const int xcd = L & 7, k = L >> 3, x = k & 7, qb = pass ? 15 - x : x;
    att::BlockRef r;
    if constexpr (FOX) {
        const int bh = xcd * 4 + (k >> 3), b = bh >> 3, h = bh & 7;
        r.Q = (unsigned)WS_QKV + (unsigned)(((24 + h) * MTOK + b * SEQ + qb * 256) * 256); r.K = (unsigned)WS_QKV + (unsigned)(((32 + h) * MTOK + b * SEQ) * 256);
        r.V = (unsigned)WS_QKV + (unsigned)(((40 + h) * MTOK + b * SEQ) * 256); r.O = (unsigned)WS_O + (unsigned)((h * MTOK + b * SEQ + qb * 256) * 256);
        r.clog = (unsigned)WS_CLOG + (unsigned)((b * 8 + h) * SEQ * 4);
        { const float qm2 = __uint_as_float(__hip_atomic_load((unsigned*)(F.ctl + CW_QMAX + bh * 16 + qb), RLX_AGENT)), km2 = __uint_as_float(__hip_atomic_load((unsigned*)(F.ctl + CW_KMAX + bh), RLX_AGENT));
          const float bound = (MK_FUSE_NORMS ? 2.02f : 2.002f) * sqrtf(qm2 * km2) + FOX_SKIP_T;       const float* clg = (const float*)(F.ws + WS_CLOG) + (size_t)(b * 8 + h) * SEQ;
          int lane; asm volatile("v_mbcnt_lo_u32_b32 %0, -1, 0\n\tv_mbcnt_hi_u32_b32 %0, -1, %0" : "=v"(lane));
          const int ntb = qb * 4;
          bool skip = false; if (lane < ntb) skip = (bound + clg[qb * 256] - clg[64 * lane + 63]) <= 0.f;
          r.jlo = (int)__popcll(__ballot(skip)) & ~1; }
    } else {
        const int vhb = xcd * 8 + (k >> 3), b = vhb >> 4, vv = vhb & 15, h = vv >> 2, mp = (vv >> 1) & 1, vhalf = vv & 1;
        r.Q = (unsigned)WS_QKV + (unsigned)(((h * 2 + mp) * MTOK + b * SEQ + qb * 256) * 256); r.K = (unsigned)WS_QKV + (unsigned)(((8 + h * 2 + mp) * MTOK + b * SEQ) * 256);
        r.V = (unsigned)WS_QKV + (unsigned)(((16 + h * 2 + vhalf) * MTOK + b * SEQ) * 256); r.O = (unsigned)WS_O + (unsigned)(((8 + vv) * MTOK + b * SEQ + qb * 256) * 256);
        r.clog = 0u; r.jlo = 0;
    }
    r.P0 = qb * 256;
    return r;
}
template <bool FOX>
__device__ __forceinline__ void attn_run(const Frame& F, char* lds) {
    constexpr int total = FOX ? 256 : 512;
    int L = blockIdx.x; if (L >= total) return;
    int pass = 0; const int stride = F.G;
    att::BlockRef cur = attn_ref<FOX>(F, L, 0);
    att::Seam S;
    att::attn_prime(F.ws, cur, lds, S);
    for (;;) {
        const bool more_pass = pass == 0, more_item = L + stride < total, last = !more_pass && !more_item;
        int passn = pass + 1, Ln = L;
        if (!more_pass) { passn = 0; Ln = more_item ? L + stride : L; }
        const int Lr = last ? L : Ln, pr = last ? pass : passn;
        auto nref = [&F, Lr, pr]() { return attn_ref<FOX>(F, Lr, pr); };
        att::attn_block<FOX>(F.ws, cur, nref, lds, S);
        if (last) break;
        pass = passn; L = Ln; cur = attn_ref<FOX>(F, L, pass);
    }
}

__device__ __forceinline__ att::BlockRefW attn_refW(int L, int pass) {
    const int xcd = L & 7, k = L >> 3, x = k & 7, qb = pass ? 15 - x : x;
    const int bhm = xcd * 4 + (k >> 3), b = bhm >> 3, hm = bhm & 7, h = hm >> 1, mp = hm & 1;
    att::BlockRefW r;
    r.Q = (unsigned)WS_QKV + (unsigned)(((h * 2 + mp) * MTOK + b * SEQ + qb * 256) * 256); r.K = (unsigned)WS_QKV + (unsigned)(((8 + h * 2 + mp) * MTOK + b * SEQ) * 256);
    r.V0 = (unsigned)WS_QKV + (unsigned)(((16 + h * 2) * MTOK + b * SEQ) * 256); r.V1 = (unsigned)WS_QKV + (unsigned)(((17 + h * 2) * MTOK + b * SEQ) * 256);
    r.O0 = (unsigned)WS_O + (unsigned)(((8 + h * 4 + mp * 2) * MTOK + b * SEQ + qb * 256) * 256); r.O1 = (unsigned)WS_O + (unsigned)(((9 + h * 4 + mp * 2) * MTOK + b * SEQ + qb * 256) * 256);
    r.P0 = qb * 256;
    return r;
}
__device__ __forceinline__ void attn_runW(const Frame& F, char* lds) {
    constexpr int total = 256;
    int L = blockIdx.x; if (L >= total) return;
    int pass = 0; const int stride = F.G;
    att::BlockRefW cur = attn_refW(L, 0);
    att::SeamW S;
    att::attn_primeW(F.ws, cur, lds, S);
    for (;;) {
        const bool more_pass = pass == 0, more_item = L + stride < total, last = !more_pass && !more_item;
        int passn = pass + 1, Ln = L;
        if (!more_pass) { passn = 0; Ln = more_item ? L + stride : L; }
        const int Lr = last ? L : Ln, pr = last ? pass : passn;
        auto nref = [Lr, pr]() { return attn_refW(Lr, pr); };
        att::attn_blockW(F.ws, cur, nref, lds, S);
        if (last) break;
        pass = passn; L = Ln; cur = attn_refW(L, pass);
    }
}

constexpr int NPHASE = 10;
#ifndef MK_BAL
#define MK_BAL 1
#endif
constexpr int MOE_RB = MK_FP8 ? DM : DM * 2;
#ifndef MK_ATT_MASK
#define MK_ATT_MASK 3
#endif
#ifndef MK_DIFFW
#define MK_DIFFW 1
#endif
#ifndef MK_KREP_LOG
#define MK_KREP_LOG 0
#endif
#ifndef MK_KROT
#define MK_KROT 0
#endif
#define MOE_ROT(c, nt) (MK_KROT ? (int)((((((c) >> 3) >> 2) * ((nt) / 8)) + ((((c) >> 3) & 3) * ((nt) / 4))) & ((nt) - 1)) : 0)
#ifndef MK_OVERLAP
#define MK_OVERLAP 1
#endif
__device__ __forceinline__ void ph1(Frame& F, KArgs ka) {
#if MK_FP8 && MK_OVERLAP
    const bool conv_first = ((blockIdx.x >> 3) & 1) != 0;
    if (conv_first) p0b_experts(F, ka, 0, P0B_IGU);
#endif
    p1_scan(F);
    pg8::DenseOrder S; S.init((const bf16_t*)(F.ws + WS_XN), (const bf16_t*)(F.ws + WS_WIN), MTOK, NQKV, DM * 2, F.G, (int)blockIdx.x);
    pg8::EpiQKV E{(bf16_t*)(F.ws + WS_QKV), (const float*)(F.ws + WS_ROPE), (unsigned*)F.ctl, (LAS float*)(F.lds + RING_BYTES + 2048)};
    pg8::gemm_phase<pg8::EpiQKV, pg8::DenseOrder, false>(F.lds, F.lds + LDS_IDX, DM * 2, S, E);
#if MK_FP8 && MK_OVERLAP
    if (!conv_first) p0b_experts(F, ka, 0, P0B_IGU);
#endif
}
__device__ __forceinline__ void ph2(Frame& F, KArgs ka, char* lds) {
#if MK_FP8 && MK_OVERLAP
    const int cshift = (int)(blockIdx.x >> 3) % 3;
    if (cshift == 0) p0b_experts(F, ka, P0B_IGU, P0B_NI);
#endif
    if (MK_ATT_MASK & 1) attn_run<true>(F, lds);
    __syncthreads();
#if MK_FP8 && MK_OVERLAP
    if (cshift == 1) p0b_experts(F, ka, P0B_IGU, P0B_NI);
#endif
#if MK_DIFFW
    if (MK_ATT_MASK & 2) attn_runW(F, lds);
#else
    if (MK_ATT_MASK & 2) attn_run<false>(F, lds);
#endif
#if MK_FP8 && MK_OVERLAP
    if (cshift == 2) p0b_experts(F, ka, P0B_IGU, P0B_NI);
#endif
}
__device__ __forceinline__ void ph4(Frame& F, KArgs ka, float* hbuf) {
    pg8::DenseOrder S; S.init((const bf16_t*)(F.ws + WS_MIX), (const bf16_t*)(F.ws + WS_WOUT), MTOK, DM, DM * 2, F.G, (int)blockIdx.x);
    pg8::EpiOut E{(const float*)KIN(0), hbuf, (bf16_t*)(F.ws + WS_HG), (const float*)KIN(12)};
    pg8::gemm_phase<pg8::EpiOut, pg8::DenseOrder, false>(F.lds, F.lds + LDS_IDX, DM * 2, S, E);
}
__device__ __forceinline__ void ph6(Frame& F, KArgs ka, LAS int* tab) {
    build_tab(F, tab, true);
    pg8::MoeOrder S; S.A = (const void*)(F.ws + WS_HG); S.Bt = (const void*)(F.ws + WS_WGU); S.RB = MOE_RB; S.nN = 16; S.NperE = 4096; S.G = F.G; S.c = (int)blockIdx.x; S.rot = MOE_ROT(blockIdx.x, MOE_RB / 128); S.tab = tab; S.tok = (const int*)(F.ws + WS_TOK);
    pg8::EpiGU E{(bf16_t*)(F.ws + WS_HDN), (const float*)KIN(16), (const float*)KIN(18), (const float*)(F.ws + WS_RSTD), tab, (const LAS float*)(F.lds + LDS_IDX + 2048)}; S.rowsc = (const float*)(F.ws + WS_RSTD);
    pg8::gemm_phase<pg8::EpiGU, pg8::MoeOrder, true, MK_FP8 != 0, 127 - FP8_WSHIFT - MK_KREP_LOG, 127 - FP8_HGSHIFT, (1 << MK_KREP_LOG), (MK_FP8 != 0 && MK_FP6 != 0), (MK_BAL != 0)>(F.lds, F.lds + LDS_IDX, MOE_RB, S, E);
}
__device__ __forceinline__ void ph7(Frame& F, KArgs ka, LAS int* tab) {
    build_tab(F, tab, false);
    pg8::MoeOrderDense S; S.A = (const void*)(F.ws + WS_HDN); S.Bt = (const void*)(F.ws + WS_WD); S.RB = MOE_RB; S.nN = 8; S.NperE = 2048; S.G = F.G; S.c = (int)blockIdx.x; S.rot = MOE_ROT(blockIdx.x, MOE_RB / 128); S.tab = tab; S.tok = nullptr;
    pg8::EpiDown E{(bf16_t*)(F.ws + WS_YS), (const float*)KIN(20), (const float*)(F.ws + WS_GATE), tab, (const LAS float*)(F.lds + LDS_IDX + 2048)}; S.rowsc = (const float*)(F.ws + WS_GATE);
    pg8::gemm_phase<pg8::EpiDown, pg8::MoeOrderDense, false, MK_FP8 != 0, 127 - FP8_WSHIFT - MK_KREP_LOG, 127 - FP8_HDSHIFT, (1 << MK_KREP_LOG), (MK_FP8 != 0 && MK_FP6 != 0), (MK_BAL != 0)>(F.lds, F.lds + LDS_IDX, MOE_RB, S, E);
}
__device__ __forceinline__ Frame make_frame(KArgs ka, LAS unsigned char* lds) {
    Frame F; F.lds = lds; F.wave = __builtin_amdgcn_readfirstlane(((int)threadIdx.x) >> 6);
    F.G = gridDim.x; { const int bx = blockIdx.x; F.vcu = (F.G % 8 == 0) ? (bx % 8) * (F.G / 8) + bx / 8 : bx; }
    unsigned char* ws = ka->ws; F.ws = ws; F.ctl = (gu32*)(ws + WS_CTL);
    return F;
}
__global__ void __launch_bounds__(NTHREADS, 2) mk_fwd(Args args) {
    extern __shared__ __attribute__((aligned(16))) unsigned char lds[];
    const KArgs ka = (KArgs)__builtin_amdgcn_kernarg_segment_ptr();
    { volatile LAS unsigned* MISC = (volatile LAS unsigned*)((LAS unsigned char*)lds + LDS_MISC);
      if (((int)threadIdx.x) < 32) MISC[((int)threadIdx.x)] = 0u;
      __syncthreads();
      if (ka->ph_hi - ka->ph_lo > 1) (void)xcd_barrier_post((unsigned*)((gu32*)(ka->ws + WS_CTL) + CW_BAR), MISC + 8); }
#ifndef MK_PHASE_MASK
#define MK_PHASE_MASK 0x3FF
#endif
#ifndef MK_REP_PHASE
#define MK_REP_PHASE -1
#endif
#define IN(k) ((((MK_PHASE_MASK) >> (k)) & 1) && ka->ph_lo <= (k) && (k) < ka->ph_hi)
#define GRIDBAR() do { XcdBarrier b_; b_.bar = (unsigned*)((gu32*)(ka->ws + WS_CTL) + CW_BAR); b_.x = xb_xcc_id(); b_.st = (volatile LAS unsigned*)((LAS unsigned char*)lds + LDS_MISC) + 8; xcd_barrier(b_); } while (0)
#define SEAM(k) do { if (IN(k) && IN((k) + 1)) GRIDBAR(); } while (0)
#define RUN(k, CALL) do { if (IN(k)) { Frame F = make_frame(ka, (LAS unsigned char*)lds); LAS int* tab = (LAS int*)(F.lds + LDS_TAB); float* hbuf = ka->out; (void)tab; (void)hbuf; CALL; \
        if (MK_REP_PHASE == (k)) { GRIDBAR(); CALL; } } } while (0)
#if MK_FP8 && !MK_OVERLAP
    RUN(0, (p0_prologue(F, ka), p0b_experts(F, ka, 0, P0B_NI)));
#else
    RUN(0, p0_prologue(F, ka));
#endif
#ifdef MK_PROBE_STREAM
    if (IN(0)) { GRIDBAR(); Frame F = make_frame(ka, (LAS unsigned char*)lds); probe_stream(F, ka); }
#endif
    SEAM(0);
    RUN(1, ph1(F, ka)); SEAM(1);
#if MK_FUSE_NORMS
#else
    RUN(2, p_norms(F)); SEAM(2);
#endif
    RUN(3, ph2(F, ka, (char*)lds)); SEAM(3);
    RUN(4, p3_mix(F, ka)); SEAM(4);
    RUN(5, ph4(F, ka, hbuf)); SEAM(5);
    RUN(6, p5_router(F, ka, hbuf)); SEAM(6);
    RUN(7, ph6(F, ka, tab)); SEAM(7);
    RUN(8, ph7(F, ka, tab)); SEAM(8);
    RUN(9, p8_final(F, ka, hbuf));
#undef IN
#undef SEAM
#undef RUN
#undef GRIDBAR
}

#ifndef MK_N_LAUNCHES
#define MK_N_LAUNCHES 1
#endif
extern "C" void kernel_launch(void* const* d_in, const int* in_sizes, int n_in, void* d_out, int out_size, void* d_ws, size_t ws_size, hipStream_t stream) {
    static int grid = 0;
    if (grid == 0) {
        if (n_in != 22 || in_sizes[0] != MTOK * DM || out_size != MTOK * DM || ws_size < WS_END) {
            fprintf(stderr, "kernel_launch: unexpected shapes (n_in %d, in0 %d, out %d, ws %zu; need ws >= %zu); nothing launched\n", n_in, n_in > 0 ? in_sizes[0] : -1, out_size, ws_size, (size_t)WS_END); grid = -1; return; }
        int dev = 0, cus = 0, per_cu = 0;
        if (hipGetDevice(&dev) != hipSuccess || hipDeviceGetAttribute(&cus, hipDeviceAttributeMultiprocessorCount, dev) != hipSuccess) { fprintf(stderr, "kernel_launch: device query failed\n"); grid = -1; return; }
        if (hipFuncSetAttribute((const void*)mk_fwd, hipFuncAttributeMaxDynamicSharedMemorySize, LDS_BYTES) != hipSuccess) { fprintf(stderr, "kernel_launch: hipFuncSetAttribute failed\n"); grid = -1; return; }
        if (hipOccupancyMaxActiveBlocksPerMultiprocessor(&per_cu, (const void*)mk_fwd, NTHREADS, LDS_BYTES) != hipSuccess || per_cu < 1)
            fprintf(stderr, "kernel_launch: note: occupancy query reports %d workgroups per CU\n", per_cu);
        (void)hipGetLastError();
        grid = cus;
    }
    if (grid < 0) return;
    if (hipMemsetAsync((char*)d_ws + WS_CTL, 0, CTL_ZERO_BYTES, stream) != hipSuccess) { fprintf(stderr, "kernel_launch: memset failed\n"); return; }
    Args a{};
    for (int i = 0; i < 22; ++i) a.in[i] = d_in[i];
    a.out = (float*)d_out; a.ws = (unsigned char*)d_ws;
    if (MK_N_LAUNCHES == 1) { a.ph_lo = 0; a.ph_hi = NPHASE; hipLaunchKernelGGL(mk_fwd, dim3(grid), dim3(NTHREADS), LDS_BYTES, stream, a); }
    else for (int p = 0; p < NPHASE; ++p) { a.ph_lo = p; a.ph_hi = p + 1; hipLaunchKernelGGL(mk_fwd, dim3(grid), dim3(NTHREADS), LDS_BYTES, stream, a); }
#ifdef MK_EXTRA_PHASE
    a.ph_lo = MK_EXTRA_PHASE; a.ph_hi = MK_EXTRA_PHASE + 1; hipLaunchKernelGGL(mk_fwd, dim3(grid), dim3(NTHREADS), LDS_BYTES, stream, a);
#endif
    const hipError_t le = hipPeekAtLastError();
    if (le != hipSuccess) fprintf(stderr, "kernel_launch: launch failed: %s\n", hipGetErrorName(le));
}
```

```cpp
#include <hip/hip_runtime.h>
#include <cstdio>
#include <cstdint>

#define LAS __attribute__((address_space(3)))
#define GAS __attribute__((address_space(1)))
typedef unsigned short bf16_t;
typedef short bf16x8 __attribute__((ext_vector_type(8)));
typedef short s16x4 __attribute__((ext_vector_type(4)));
typedef float f32x4 __attribute__((ext_vector_type(4)));
typedef float f32x2 __attribute__((ext_vector_type(2)));
typedef float f32x16 __attribute__((ext_vector_type(16)));
typedef unsigned u32x4 __attribute__((ext_vector_type(4)));
typedef unsigned u32x2 __attribute__((ext_vector_type(2)));
typedef int v4i_t __attribute__((ext_vector_type(4)));
typedef int v8i_t __attribute__((ext_vector_type(8)));

constexpr int DM = 2048, BATCH = 4, SEQ = 4096, MTOK = BATCH * SEQ, INC = 6152, NQKV = 6144, NE = 32, TOPK = 4, ECAP = 16384;
constexpr float EPS = 1e-5f, L2E = 1.4426950408889634f, QSCALE = 0.08838834764831845f * 1.4426950408889634f;
constexpr int NWAVES = 8, NTHREADS = 512;
constexpr size_t MiB = 1u << 20;
constexpr size_t WS_CTL = 0, CTL_ZERO_BYTES = 1 * MiB;
constexpr size_t WS_GWF = 2 * MiB;
constexpr size_t WS_CLOG = 3 * MiB;
constexpr size_t WS_FLOG = 4 * MiB;
constexpr size_t WS_TKE = 5 * MiB;
constexpr size_t WS_TOK = 6 * MiB;
constexpr size_t WS_RSTD = 8 * MiB;
constexpr size_t WS_GATE = 10 * MiB;
constexpr size_t WS_ROPE = 12 * MiB;
constexpr size_t WS_WIN = 20 * MiB;
constexpr size_t WS_WOUT = 44 * MiB;
constexpr size_t WS_TSTART = 52 * MiB;
constexpr size_t WS_WGU = 64 * MiB;
constexpr size_t WS_WD = 576 * MiB;
constexpr size_t WS_XN = 832 * MiB;
constexpr size_t WS_QKV = 896 * MiB;
constexpr size_t WS_O = 1088 * MiB;
constexpr size_t WS_MIX = 1184 * MiB;
constexpr size_t WS_HG = 1248 * MiB;
constexpr size_t WS_HDN = 1312 * MiB;
constexpr size_t WS_YS = 1600 * MiB;
constexpr size_t WS_END = 1888 * MiB;
constexpr int CW_TMO = 0, CW_BAR = 4096, CW_CNT = 8192;
constexpr int CW_QMAX = 12288, CW_KMAX = 12800;
constexpr float FOX_SKIP_T = 30.0f;
constexpr int RING_BYTES = 131072;
constexpr int LDS_IDX = RING_BYTES;
constexpr int LDS_TAB = RING_BYTES + 1024;
constexpr int LDS_MISC = RING_BYTES + 1024 + 512;
constexpr int LDS_BYTES = 147456;

__device__ __forceinline__ unsigned f2bf(float f) { unsigned u = __builtin_bit_cast(unsigned, f); return (u + 0x7fffu + ((u >> 16) & 1u)) >> 16; }
__device__ __forceinline__ unsigned pk2(float lo, float hi) { return f2bf(lo) | (f2bf(hi) << 16); }
__device__ __forceinline__ float bf2f(unsigned short b) { return __builtin_bit_cast(float, (unsigned)b << 16); }
__device__ __forceinline__ unsigned cvt_pk_bf16(float lo, float hi) { unsigned r; asm volatile("v_cvt_pk_bf16_f32 %0, %1, %2" : "=v"(r) : "v"(lo), "v"(hi)); return r; }
__device__ __forceinline__ float wave_sum(float v) {
#pragma unroll
    for (int o = 1; o < 64; o <<= 1) v += __shfl_xor(v, o);
    return v;
}

__device__ __forceinline__ void glds16s(const char* sbase, unsigned voff, unsigned lds_dst) { unsigned keep;
    asm volatile("s_mov_b32 %0, m0\n\ts_mov_b32 m0, %3\n\ts_nop 0\n\tglobal_load_lds_dwordx4 %1, %2\n\ts_mov_b32 m0, %0" : "=&s"(keep) : "v"(voff), "s"(sbase), "s"(lds_dst) : "memory"); }
__device__ __forceinline__ void glds4s(const char* sbase, unsigned voff, unsigned lds_dst) { unsigned keep;
    asm volatile("s_mov_b32 %0, m0\n\ts_mov_b32 m0, %3\n\ts_nop 0\n\tglobal_load_lds_dword %1, %2\n\ts_mov_b32 m0, %0" : "=&s"(keep) : "v"(voff), "s"(sbase), "s"(lds_dst) : "memory"); }
__device__ __forceinline__ const char* uni_ptr(const char* p) { const unsigned long long v = (unsigned long long)p;
    const unsigned lo = (unsigned)__builtin_amdgcn_readfirstlane((int)(unsigned)v), hi = (unsigned)__builtin_amdgcn_readfirstlane((int)(unsigned)(v >> 32)); return (const char*)(((unsigned long long)hi << 32) | lo); }

#ifndef MK_EPI_LDS
#define MK_EPI_LDS 1
#endif
namespace pg8 {
constexpr int BM = 256, BK = 64, HALF = 128, HTB = HALF * BK * 2, STAGE_BYTES = 8 * HTB, NXCD = 8, WGM = 8;
__host__ __device__ __forceinline__ int lds_byte(int r, int c) { const int st = (r >> 4) * 2 + (c >> 5), rr = r & 15, cc = c & 31, ob = rr * 64 + cc * 2; return st * 1024 + (ob ^ (((ob >> 9) & 1) << 5)); }
__host__ __device__ __forceinline__ void stage_rc(int b, int& R, int& C) { const int st = b / 1024, sb = b % 1024, swz = sb ^ (((sb >> 9) & 1) << 5); R = (st >> 1) * 16 + swz / 64; C = (st & 1) * 32 + (swz % 64) / 2; }
__host__ __device__ __forceinline__ int perm32(int rho) { const int n = rho >> 4, i = rho & 15; return 8 * (i >> 2) + 4 * n + (i & 3); }

struct Unit { int pm, pn, e, rows0; };

struct DenseOrder {
    const bf16_t* A; const bf16_t* Bt; int RB; int nM, nN, nwg, G, c; int rot = 0;
    __device__ void init(const bf16_t* A_, const bf16_t* Bt_, int M, int N, int RB_, int G_, int c_) { A = A_; Bt = Bt_; RB = RB_; nM = M / BM; nN = N / BM; nwg = nM * nN; G = G_; c = c_; }
    __device__ __forceinline__ bool next(int i, Unit& u) const {
        const long L = (long)i * G + c; if (L >= nwg) return false;
        int wgid = (int)L; { const int q = nwg / NXCD, r = nwg % NXCD, xcd = wgid % NXCD, off = wgid / NXCD; wgid = (xcd < r ? xcd * (q + 1) : r * (q + 1) + (xcd - r) * q) + off; }
        const int nig = WGM * nN, gid = wgid / nig, fm = gid * WGM, gsz = (nM - fm) < WGM ? (nM - fm) : WGM;
        u.pm = fm + ((wgid % nig) % gsz); u.pn = (wgid % nig) / gsz; u.e = 0; u.rows0 = 0; return true;
    }
    __device__ __forceinline__ const char* a_base(const Unit& u) const { return (const char*)A + (size_t)u.pm * BM * RB; }
    __device__ __forceinline__ const char* b_base(const Unit& u) const { return (const char*)Bt + (size_t)u.pn * BM * RB; }
};
struct MoeOrder {
    const float* rowsc = nullptr;
    const void* A; const void* Bt; int RB; int nN; int NperE; int G, c; int rot; const LAS int* tab; const int* tok;
    __device__ __forceinline__ bool next(int i, Unit& u) const {
        const int T = __builtin_amdgcn_readfirstlane(tab[NE]);
        int t;
        if (G == 256) {
            const int x = c & 7, j = c >> 3, XP = nN >> 3, tpr = 256 / nN;
            t = i * tpr + (x / XP) * 4 + (j & 3); u.pn = (x % XP) * 8 + (j >> 2);
            if (t >= T) return false;
        } else {
            const int L = i * G + c; if (L >= T * nN) return false;
            t = L / nN; u.pn = L - t * nN;
        }
        u.pm = t;
        int e; { const int ln = (int)(threadIdx.x & 63); const int tv = tab[ln & 31];
                 e = (int)__popcll(__ballot(ln < NE && tv <= t)) - 1; }
        u.e = e; u.rows0 = __builtin_amdgcn_readfirstlane((t - tab[e]) * BM); return true;
    }
    __device__ __forceinline__ int cnt_of(const Unit& u) const { return __builtin_amdgcn_readfirstlane(tab[NE + 1 + u.e]); }
    __device__ __forceinline__ const char* a_base(const Unit& u) const { return (const char*)A; }
    __device__ __forceinline__ const char* a_base_dense(const Unit& u) const { return (const char*)A + (size_t)u.pm * BM * RB; }
    __device__ __forceinline__ const char* b_base(const Unit& u) const { return (const char*)Bt + ((size_t)u.e * NperE + (size_t)u.pn * BM) * RB; }
};
struct MoeOrderDense : MoeOrder {
    __device__ __forceinline__ const char* a_base(const Unit& u) const { return a_base_dense(u); }
};

template <class Epi, class Sched, bool GATHER, bool FP8 = false, int SCW = 127, int SCA = 127, int KREP = 1, bool FP6 = false, bool BAL = false, bool XINIT = false>
__device__ __forceinline__ void gemm_phase(LAS unsigned char* lds, LAS unsigned char* lds_idx, const int RB, const Sched& S, const Epi& E) {
    const int tid = threadIdx.x, wid = __builtin_amdgcn_readfirstlane(tid >> 6), lane = tid & 63, wr = wid >> 2, wc = wid & 3, fr = lane & 15, fq = lane >> 4;
    const int nt = (RB / 128) * KREP;
    unsigned voffA[2], voffB[2]; int RA[2], CA2[2];
#pragma unroll
    for (int i = 0; i < 2; ++i) { int R, C; stage_rc(tid * 16 + i * 8192, R, C); const int Rb = (R & ~31) + perm32(R & 31);
        voffA[i] = (unsigned)(R * RB + C * 2); voffB[i] = (unsigned)(Rb * RB + C * 2); RA[i] = R; CA2[i] = C * 2; }
    const int rot = S.rot, ntm = RB / 128 - 1;
#define PG8_KOFF(t) ((size_t)((((t) + rot) & ntm) * 128))
    const size_t hstep = (size_t)HALF * RB;
    const unsigned ldsw = (unsigned)wid * 1024u;
    const unsigned ldsb = (unsigned)__builtin_amdgcn_readfirstlane((int)(unsigned)(uintptr_t)lds);
    const int aoff = lds_byte(wr * 64 + fr, fq * 8), boff = lds_byte(wc * 32 + fr, fq * 8);
#define PG8_SA(b, h) (((b) * 2 + (h)) * HTB)
#define PG8_SB(b, h) ((4 + (b) * 2 + (h)) * HTB)
#define PG8_GL(bufoff, gptr, v0, v1) do { const char* gp_ = uni_ptr((const char*)(gptr)); \
        glds16s(gp_, (v0), ldsb + (unsigned)(bufoff) + ldsw); glds16s(gp_, (v1), ldsb + (unsigned)(bufoff) + ldsw + 8192u); } while (0)
#define PG8_STAGE_B(bufoff, gbase) PG8_GL(bufoff, gbase, voffB[0], voffB[1])
#define PG8_STAGE_A(bufoff, gbase, h, V) do { if constexpr (GATHER) { PG8_GL(bufoff, gbase, V[h][0], V[h][1]); } else { PG8_GL(bufoff, (gbase) + (h) * hstep, voffA[0], voffA[1]); } } while (0)
#define PG8_LDA(dst, b, h) do { _Pragma("unroll") for (int m = 0; m < 4; ++m) _Pragma("unroll") for (int k = 0; k < 2; ++k) dst[m][k] = *(const LAS bf16x8*)(lds + PG8_SA(b, h) + aoff + m * 2048 + k * 1024); } while (0)
#define PG8_LDB(dst, b, h) do { _Pragma("unroll") for (int n = 0; n < 2; ++n) _Pragma("unroll") for (int k = 0; k < 2; ++k) dst[n][k] = *(const LAS bf16x8*)(lds + PG8_SB(b, h) + boff + n * 2048 + k * 1024); } while (0)
#define PG8_CAT(x, y) __builtin_shufflevector(__builtin_bit_cast(v4i_t, x), __builtin_bit_cast(v4i_t, y), 0, 1, 2, 3, 4, 5, 6, 7)
#define PG8_MMA(ai, bj, At, Bt) do { __builtin_amdgcn_s_setprio(1); _Pragma("unroll") for (int m = 0; m < 4; ++m) _Pragma("unroll") for (int n = 0; n < 2; ++n) { \
        if constexpr (FP6) { acc[ai][bj][m][n] = __builtin_amdgcn_mfma_scale_f32_16x16x128_f8f6f4(PG8_CAT(Bt[n][0], Bt[n][1]), PG8_CAT(At[m][0], At[m][1]), acc[ai][bj][m][n], 2, 2, 0, __builtin_bit_cast(v4i_t, Bt[n][1])[2], 0, __builtin_bit_cast(v4i_t, At[m][1])[2]); } \
        else if constexpr (FP8) { acc[ai][bj][m][n] = __builtin_amdgcn_mfma_scale_f32_16x16x128_f8f6f4(PG8_CAT(Bt[n][0], Bt[n][1]), PG8_CAT(At[m][0], At[m][1]), acc[ai][bj][m][n], 0, 0, 0, (SCW | (SCA << 8)), 1, (SCW | (SCA << 8))); }     \
        else { _Pragma("unroll") for (int k = 0; k < 2; ++k) acc[ai][bj][m][n] = __builtin_amdgcn_mfma_f32_16x16x32_bf16(Bt[n][k], At[m][k], acc[ai][bj][m][n], 0, 0, 0); } } \
        __builtin_amdgcn_s_setprio(0); } while (0)
#define PG8_WAIT_V(n) asm volatile("s_waitcnt vmcnt(" #n ")" ::: "memory")
#define PG8_WAIT_L(n) asm volatile("s_waitcnt lgkmcnt(" #n ")" ::: "memory")
#define PG8_BAR __builtin_amdgcn_s_barrier()
#define PG8_SCHED __builtin_amdgcn_sched_barrier(0)
    Unit cur, nxt; int ui = 0;
    if (!S.next(0, cur)) return;
    f32x4 acc[2][2][4][2];
    if constexpr (XINIT) E.load_init(acc, cur, wr, wc, fr, fq);
    else {
#pragma unroll
    for (int a = 0; a < 2; ++a)
#pragma unroll
        for (int b = 0; b < 2; ++b)
#pragma unroll
            for (int m = 0; m < 4; ++m)
#pragma unroll
                for (int n = 0; n < 2; ++n) acc[a][b][m][n] = (f32x4){0.f, 0.f, 0.f, 0.f};
    }
    bf16x8 At[4][2], B0[2][2], B1[2][2];
    unsigned VC[2][2];
    if constexpr (GATHER) {
        const int cnt = S.cnt_of(cur);
#pragma unroll
        for (int h = 0; h < 2; ++h)
#pragma unroll
            for (int i = 0; i < 2; ++i) { const int pos = cur.rows0 + h * HALF + RA[i]; int tk = S.tok[(size_t)cur.e * ECAP + pos]; tk = pos < cnt ? tk : 0; VC[h][i] = (unsigned)tk * (unsigned)RB + (unsigned)CA2[i]; }
    } else {
#pragma unroll
        for (int h = 0; h < 2; ++h)
#pragma unroll
            for (int i = 0; i < 2; ++i) VC[h][i] = 0u;
    }
    const char* cA = S.a_base(cur); const char* cB = S.b_base(cur);
    PG8_STAGE_B(PG8_SB(0, 0), cB + PG8_KOFF(0)); PG8_STAGE_B(PG8_SB(0, 1), cB + hstep + PG8_KOFF(0)); PG8_STAGE_A(PG8_SA(0, 0), cA + PG8_KOFF(0), 0, VC); PG8_STAGE_A(PG8_SA(0, 1), cA + PG8_KOFF(0), 1, VC);
    if (wr == 1) PG8_BAR;
    PG8_WAIT_V(2); PG8_BAR;
    if constexpr (BAL) { PG8_STAGE_B(PG8_SB(1, 0), cB + PG8_KOFF(1)); PG8_STAGE_B(PG8_SB(1, 1), cB + hstep + PG8_KOFF(1)); PG8_WAIT_V(4); PG8_BAR; }
    else { PG8_STAGE_B(PG8_SB(1, 0), cB + PG8_KOFF(1)); PG8_STAGE_A(PG8_SA(1, 0), cA + PG8_KOFF(1), 0, VC); PG8_STAGE_B(PG8_SB(1, 1), cB + hstep + PG8_KOFF(1));
    PG8_WAIT_V(6); PG8_BAR; }
    for (;;) {
        const bool has_next = S.next(ui + 1, nxt);
        const char* nA = has_next ? S.a_base(nxt) : cA; const char* nB = has_next ? S.b_base(nxt) : cB;
        for (int t = 0; t < nt; t += 2) {
            const bool last = (t == nt - 2);
            if constexpr (FP8 && MK_EPI_LDS) {
                if (t == nt - 4 && wid >= 4)
                    glds4s(uni_ptr((const char*)(S.rowsc + (size_t)cur.e * ECAP + cur.rows0 + (wid - 4) * 64)), (unsigned)lane * 4u, (unsigned)__builtin_amdgcn_readfirstlane((int)(unsigned)(uintptr_t)lds_idx) + 2048u + (unsigned)(wid - 4) * 256u);
            }
            if constexpr (GATHER) {
                if (has_next && t == nt - 4 && wid < 4)
                    glds4s(uni_ptr((const char*)(S.tok + (size_t)nxt.e * ECAP + nxt.rows0 + wid * 64)), (unsigned)lane * 4u, (unsigned)__builtin_amdgcn_readfirstlane((int)(unsigned)(uintptr_t)lds_idx) + (unsigned)wid * 256u);
            }
            const char* a1 = cA + PG8_KOFF(t + 1);
            const char* a2 = (last ? nA : cA) + PG8_KOFF(t + 2); const char* b2 = (last ? nB : cB) + PG8_KOFF(t + 2);
            const char* a3 = (last ? nA : cA) + PG8_KOFF(t + 3); const char* b3 = (last ? nB : cB) + PG8_KOFF(t + 3);
            PG8_LDB(B0, 0, 0); PG8_LDB(B1, 0, 1); PG8_SCHED; PG8_LDA(At, 0, 0); if constexpr (BAL) PG8_STAGE_A(PG8_SA(1, 0), a1, 0, VC); PG8_STAGE_A(PG8_SA(1, 1), a1, 1, VC);
            if constexpr (GATHER) {
                if (last && has_next) { const int cntn = S.cnt_of(nxt);
#pragma unroll
                    for (int h = 0; h < 2; ++h)
#pragma unroll
                        for (int i = 0; i < 2; ++i) { const int r = h * HALF + RA[i]; int tk = *(const LAS int*)(lds_idx + r * 4); tk = (nxt.rows0 + r) < cntn ? tk : 0; VC[h][i] = (unsigned)tk * (unsigned)RB + (unsigned)CA2[i]; } }
            }
            PG8_WAIT_V(8); PG8_WAIT_L(0); PG8_BAR; PG8_MMA(0, 0, At, B0); PG8_MMA(0, 1, At, B1); PG8_BAR; PG8_SCHED;
            PG8_LDA(At, 0, 1); PG8_STAGE_B(PG8_SB(0, 0), b2); PG8_STAGE_B(PG8_SB(0, 1), b2 + hstep); if constexpr (!BAL) PG8_STAGE_A(PG8_SA(0, 0), a2, 0, VC);
            if constexpr (BAL) PG8_WAIT_V(6); else PG8_WAIT_V(8); PG8_WAIT_L(0); PG8_BAR; PG8_MMA(1, 0, At, B0); PG8_MMA(1, 1, At, B1); PG8_BAR; PG8_SCHED;
            PG8_LDB(B0, 1, 0); PG8_LDB(B1, 1, 1); PG8_SCHED; PG8_LDA(At, 1, 0); if constexpr (BAL) PG8_STAGE_A(PG8_SA(0, 0), a2, 0, VC); PG8_STAGE_A(PG8_SA(0, 1), a2, 1, VC);
            PG8_WAIT_V(8); PG8_WAIT_L(0); PG8_BAR; PG8_MMA(0, 0, At, B0); PG8_MMA(0, 1, At, B1); PG8_BAR; PG8_SCHED;
            PG8_LDA(At, 1, 1); PG8_STAGE_B(PG8_SB(1, 0), b3); PG8_STAGE_B(PG8_SB(1, 1), b3 + hstep); if constexpr (!BAL) PG8_STAGE_A(PG8_SA(1, 0), a3, 0, VC);
            if constexpr (BAL) PG8_WAIT_V(6); else PG8_WAIT_V(8); PG8_WAIT_L(0); PG8_BAR; PG8_MMA(1, 0, At, B0); PG8_MMA(1, 1, At, B1); PG8_BAR; PG8_SCHED;
        }
        if (wr == 0) PG8_BAR;
        if constexpr (FP6 && KREP > 1) {
#pragma unroll
            for (int a = 0; a < 2; ++a)
#pragma unroll
                for (int b = 0; b < 2; ++b)
#pragma unroll
                    for (int m = 0; m < 4; ++m)
#pragma unroll
                        for (int n = 0; n < 2; ++n) acc[a][b][m][n] = acc[a][b][m][n] * (1.0f / KREP);
        }
        { int ln_; asm volatile("v_mbcnt_lo_u32_b32 %0, -1, 0\n\tv_mbcnt_hi_u32_b32 %0, -1, %0" : "=v"(ln_));
          E(acc, cur, wr, wc, ln_ & 15, ln_ >> 4);
#ifdef MK_PROBE_EPI2
          if constexpr (FP8) { asm volatile("" ::: "memory"); E(acc, cur, wr, wc, ln_ & 15, ln_ >> 4); }
#endif
        }
        if (!has_next) break;
        if constexpr (XINIT) { int ln_; asm volatile("v_mbcnt_lo_u32_b32 %0, -1, 0\n\tv_mbcnt_hi_u32_b32 %0, -1, %0" : "=v"(ln_)); E.load_init(acc, nxt, wr, wc, ln_ & 15, ln_ >> 4); }
        else {
#pragma unroll
        for (int a = 0; a < 2; ++a)
#pragma unroll
            for (int b = 0; b < 2; ++b)
#pragma unroll
                for (int m = 0; m < 4; ++m)
#pragma unroll
                    for (int n = 0; n < 2; ++n) acc[a][b][m][n] = (f32x4){0.f, 0.f, 0.f, 0.f};
        }
        cur = nxt; cA = nA; cB = nB; ++ui;
        if (wr == 1) PG8_BAR;
    }
    PG8_WAIT_V(0);
    PG8_BAR;
#undef PG8_SA
#undef PG8_SB
#undef PG8_GL
#undef PG8_STAGE_A
#undef PG8_STAGE_B
#undef PG8_LDA
#undef PG8_LDB
#undef PG8_MMA
#undef PG8_CAT
#undef PG8_KOFF
#undef PG8_WAIT_V
#undef PG8_WAIT_L
#undef PG8_BAR
#undef PG8_SCHED
}

}
namespace att {
constexpr int D = 128, NW = 8, QBLK = 32, KVBLK = 64, QB = NW * QBLK;
constexpr int SHM_V = KVBLK * D * 2, SHM_K = KVBLK * D * 2;
constexpr int OFF_WS = 2 * SHM_V + 2 * SHM_K, OFF_CLOG = OFF_WS + NW * 64 * 4, LDS_BYTES = OFF_CLOG + SEQ * 4;
constexpr float THR2 = 8.f * 1.4426950408889634f;
#define KSWZ(row, colB) ((row) * 256 + ((colB) ^ (((row) & 7) << 4)))
#define SBAR() __builtin_amdgcn_sched_barrier(0)
__device__ __forceinline__ int v_st(int k, int c) { const int kk = (k & ~0xC) | ((k & 4) << 1) | ((k & 8) >> 1); return ((kk >> 3) * 4 + (c >> 5)) * 512 + ((kk & 7) * 32 + (c & 31)) * 2; }
__device__ __forceinline__ int v_rd_base(int lane) { return ((lane & 3) << 3) | (((lane >> 2) & 3) << 6) | (((lane >> 4) & 1) << 5) | (((lane >> 5) & 1) << 8); }
constexpr int v_rd_off(int d0, int ks, int half) { return d0 * 512 + ks * 4096 + half * 2048; }
__device__ __forceinline__ int crow(int r, int hi) { return (r & 3) + 8 * (r >> 2) + 4 * hi; }
__device__ __forceinline__ unsigned cvtpk(float lo, float hi) { unsigned r; asm volatile("v_cvt_pk_bf16_f32 %0, %1, %2" : "=v"(r) : "v"(lo), "v"(hi)); return r; }
__device__ __forceinline__ void mask_tile(f32x16& p0, f32x16& p1, int dq) {
    const float NEG = -__builtin_inff();
#pragma unroll
    for (int r = 0; r < 16; ++r) {
        const int c = (r & 3) + 8 * (r >> 2);
        if (dq - c < 0) p0[r] = NEG;
        if (dq - c - 32 < 0) p1[r] = NEG;
    }
}
__device__ __forceinline__ void partialSM(f32x16& p0, f32x16& p1, float& m_reg, float& mn, float& alpha) {
    float pmax = p0[0];
#pragma unroll
    for (int r = 1; r < 16; ++r) pmax = fmaxf(pmax, p0[r]);
#pragma unroll
    for (int r = 0; r < 16; ++r) pmax = fmaxf(pmax, p1[r]);
    { auto rr = __builtin_amdgcn_permlane32_swap(__float_as_uint(pmax), __float_as_uint(pmax), false, false);
      pmax = fmaxf(__uint_as_float(rr[0]), __uint_as_float(rr[1])); }
    if (__builtin_expect(__all((pmax - m_reg) <= THR2), 1)) { mn = m_reg; alpha = 1.f; }
    else { mn = fmaxf(m_reg, pmax); alpha = __builtin_amdgcn_exp2f(m_reg - mn); m_reg = mn; }
#pragma unroll
    for (int r = 0; r < 16; ++r) p0[r] = p0[r] - mn;
#pragma unroll
    for (int r = 0; r < 16; ++r) p1[r] = p1[r] - mn;
#pragma unroll
    for (int r = 0; r < 16; ++r) p0[r] = __builtin_amdgcn_exp2f(p0[r]);
}
__device__ __forceinline__ void finishSM(f32x16& p0, f32x16& p1, float alpha, float& l_reg, bf16x8& pa0, bf16x8& pa1, bf16x8& pa2, bf16x8& pa3) {
#pragma unroll
    for (int r = 0; r < 16; ++r) p1[r] = __builtin_amdgcn_exp2f(p1[r]);
    float ps = 0;
#pragma unroll
    for (int r = 0; r < 16; ++r) ps += p0[r];
#pragma unroll
    for (int r = 0; r < 16; ++r) ps += p1[r];
    { auto rr = __builtin_amdgcn_permlane32_swap(__float_as_uint(ps), __float_as_uint(ps), false, false);
      ps = __uint_as_float(rr[0]) + __uint_as_float(rr[1]); }
    l_reg = l_reg * alpha + ps;
#define PK4(P, B_, OUT) do { unsigned a0 = cvtpk(P[B_+0], P[B_+1]), a1 = cvtpk(P[B_+2], P[B_+3]);                          \
        unsigned b0 = cvtpk(P[B_+4], P[B_+5]), b1 = cvtpk(P[B_+6], P[B_+7]);                                             \
        auto r0 = __builtin_amdgcn_permlane32_swap(a0, b0, false, false); auto r1 = __builtin_amdgcn_permlane32_swap(a1, b1, false, false); \
        u32x4 w = {r0[0], r1[0], r0[1], r1[1]}; OUT = *reinterpret_cast<bf16x8*>(&w); } while (0)
    PK4(p0, 0, pa0); PK4(p0, 8, pa1); PK4(p1, 0, pa2); PK4(p1, 8, pa3);
#undef PK4
}
template <int KB, bool FOX>
__device__ __forceinline__ void qkt(f32x16& p0, f32x16& p1, const char* K_lds, int r32, int hi, const bf16x8* qr, const float* cl  , float cq) {
    if constexpr (FOX) {
#pragma unroll
        for (int g = 0; g < 4; ++g) { const f32x4 c0 = *(const f32x4*)(cl + 8 * g + 4 * hi); const f32x4 c1 = *(const f32x4*)(cl + 32 + 8 * g + 4 * hi);
#pragma unroll
            for (int j = 0; j < 4; ++j) { p0[4 * g + j] = cq - c0[j]; p1[4 * g + j] = cq - c1[j]; } }
    } else { p0 = f32x16{}; p1 = f32x16{}; }
    const char* kb[4];
#pragma unroll
    for (int dd = 0; dd < 4; ++dd) kb[dd] = K_lds + KB * SHM_K + KSWZ(r32, (dd * 16 + hi * 8) * 2);
#pragma unroll
    for (int d0 = 0; d0 < 8; ++d0) { const char* a = kb[d0 & 3] + (d0 >> 2) * 128;
        bf16x8 b0 = *reinterpret_cast<const bf16x8*>(a);
        bf16x8 b1 = *reinterpret_cast<const bf16x8*>(a + 32 * 256);
        p0 = __builtin_amdgcn_mfma_f32_32x32x16_bf16(b0, qr[d0], p0, 0, 0, 0);
        p1 = __builtin_amdgcn_mfma_f32_32x32x16_bf16(b1, qr[d0], p1, 0, 0, 0); }
}
template <int KB>
__device__ __forceinline__ void qkt_lean(f32x16& p0, f32x16& p1, const char* K_lds, int r32, int hi, const bf16x8* qr) {
    p0 = f32x16{}; p1 = f32x16{};
    int kb[4];
#pragma unroll
    for (int dd = 0; dd < 4; ++dd) kb[dd] = (int)(uintptr_t)K_lds + KB * SHM_K + KSWZ(r32, (dd * 16 + hi * 8) * 2);
#define KRD(dst, d0, half) asm volatile("ds_read_b128 %0, %1 offset:%2" : "=&v"(dst) : "v"(kb[(d0) & 3]), "i"(((d0) >> 2) * 128 + (half) * 32 * 256) : "memory")
#define KRD4(P, d0) do { KRD(P##00, d0, 0); KRD(P##01, d0, 1); KRD(P##10, (d0) + 1, 0); KRD(P##11, (d0) + 1, 1); } while (0)
#define KMM(P, d0) do { p0 = __builtin_amdgcn_mfma_f32_32x32x16_bf16(P##00, qr[d0], p0, 0, 0, 0); p1 = __builtin_amdgcn_mfma_f32_32x32x16_bf16(P##01, qr[d0], p1, 0, 0, 0); \
        p0 = __builtin_amdgcn_mfma_f32_32x32x16_bf16(P##10, qr[(d0) + 1], p0, 0, 0, 0); p1 = __builtin_amdgcn_mfma_f32_32x32x16_bf16(P##11, qr[(d0) + 1], p1, 0, 0, 0); } while (0)
#define KW4() do { asm volatile("s_waitcnt lgkmcnt(4)" ::: "memory"); SBAR(); } while (0)
    bf16x8 A00, A01, A10, A11, B00, B01, B10, B11;
    KRD4(A, 0);
    KRD4(B, 2); KW4(); KMM(A, 0); SBAR();
    KRD4(A, 4); KW4(); KMM(B, 2); SBAR();
    KRD4(B, 6); KW4(); KMM(A, 4); SBAR();
    asm volatile("s_waitcnt lgkmcnt(0)" ::: "memory"); SBAR(); KMM(B, 6); SBAR();
#undef KRD
#undef KRD4
#undef KMM
#undef KW4
}
template <int VB>
__device__ __forceinline__ void pv_tile(f32x16* o, int vb0, bf16x8 pa0, bf16x8 pa1, bf16x8 pa2, bf16x8 pa3) {
#define TRRD(dst, off) asm volatile("ds_read_b64_tr_b16 %0, %1 offset:%2" : "=&v"(dst) : "v"(vb0), "i"(off) : "memory")
#define PV_D0(d0) do { s16x4 l0, l1, l2, l3, h0, h1, h2, h3; constexpr int b_ = VB * SHM_V + v_rd_off(d0, 0, 0); \
        TRRD(l0, b_); TRRD(h0, b_ + 2048); TRRD(l1, b_ + 4096); TRRD(h1, b_ + 6144); TRRD(l2, b_ + 8192); TRRD(h2, b_ + 10240); TRRD(l3, b_ + 12288); TRRD(h3, b_ + 14336); \
        asm volatile("s_waitcnt lgkmcnt(0)" ::: "memory"); SBAR();   \
        o[d0] = __builtin_amdgcn_mfma_f32_32x32x16_bf16(pa0, (bf16x8){l0[0], l0[1], l0[2], l0[3], h0[0], h0[1], h0[2], h0[3]}, o[d0], 0, 0, 0);   \
        o[d0] = __builtin_amdgcn_mfma_f32_32x32x16_bf16(pa1, (bf16x8){l1[0], l1[1], l1[2], l1[3], h1[0], h1[1], h1[2], h1[3]}, o[d0], 0, 0, 0);   \
        o[d0] = __builtin_amdgcn_mfma_f32_32x32x16_bf16(pa2, (bf16x8){l2[0], l2[1], l2[2], l2[3], h2[0], h2[1], h2[2], h2[3]}, o[d0], 0, 0, 0);   \
        o[d0] = __builtin_amdgcn_mfma_f32_32x32x16_bf16(pa3, (bf16x8){l3[0], l3[1], l3[2], l3[3], h3[0], h3[1], h3[2], h3[3]}, o[d0], 0, 0, 0); } while (0)
    PV_D0(0); PV_D0(1); PV_D0(2); PV_D0(3);
#undef PV_D0
#undef TRRD
}
constexpr int PV8_V1 = 3 * SHM_V;
__device__ __forceinline__ void pv_pipe8(f32x16* o, int vbA, bf16x8 pa0, bf16x8 pa1, bf16x8 pa2, bf16x8 pa3) {
#define TRR(dst, vb, off) asm volatile("ds_read_b64_tr_b16 %0, %1 offset:%2" : "=&v"(dst) : "v"(vb), "i"(off) : "memory")
#define RD8(P, vb, d0) do { constexpr int b_ = v_rd_off((d0) & 3, 0, 0) + ((d0) >> 2) * PV8_V1; TRR(P##l0, vb, b_); TRR(P##h0, vb, b_ + 2048); TRR(P##l1, vb, b_ + 4096); TRR(P##h1, vb, b_ + 6144); \
        TRR(P##l2, vb, b_ + 8192); TRR(P##h2, vb, b_ + 10240); TRR(P##l3, vb, b_ + 12288); TRR(P##h3, vb, b_ + 14336); } while (0)
#define FR(P, k) (bf16x8){P##l##k[0], P##l##k[1], P##l##k[2], P##l##k[3], P##h##k[0], P##h##k[1], P##h##k[2], P##h##k[3]}
#define MM4(P, oi) do { o[oi] = __builtin_amdgcn_mfma_f32_32x32x16_bf16(pa0, FR(P, 0), o[oi], 0, 0, 0); o[oi] = __builtin_amdgcn_mfma_f32_32x32x16_bf16(pa1, FR(P, 1), o[oi], 0, 0, 0); \
        o[oi] = __builtin_amdgcn_mfma_f32_32x32x16_bf16(pa2, FR(P, 2), o[oi], 0, 0, 0); o[oi] = __builtin_amdgcn_mfma_f32_32x32x16_bf16(pa3, FR(P, 3), o[oi], 0, 0, 0); } while (0)
#define W8() do { asm volatile("s_waitcnt lgkmcnt(8)" ::: "memory"); SBAR(); } while (0)
    s16x4 Al0, Al1, Al2, Al3, Ah0, Ah1, Ah2, Ah3, Bl0, Bl1, Bl2, Bl3, Bh0, Bh1, Bh2, Bh3;
    RD8(A, vbA, 0);
    RD8(B, vbA, 1); W8(); MM4(A, 0); SBAR();
    RD8(A, vbA, 2); W8(); MM4(B, 1); SBAR();
    RD8(B, vbA, 3); W8(); MM4(A, 2); SBAR();
    RD8(A, vbA, 4); W8(); MM4(B, 3); SBAR();
    RD8(B, vbA, 5); W8(); MM4(A, 4); SBAR();
    RD8(A, vbA, 6); W8(); MM4(B, 5); SBAR();
    RD8(B, vbA, 7); W8(); MM4(A, 6); SBAR();
    asm volatile("s_waitcnt lgkmcnt(0)" ::: "memory"); SBAR(); MM4(B, 7);
#undef TRR
#undef RD8
#undef FR
#undef MM4
#undef W8
}
struct BlockRef { unsigned Q, K, V, O; int P0; unsigned clog; int jlo; };
struct Seam { bf16x8 qr[8]; bf16x8 st_v0, st_v1, st_k0, st_k1; };
#define ROWB(p, k0, rr) ((const char*)wsb + (size_t)((p) + (unsigned)((k0) + (rr)) * (unsigned)(D * 2)) + lnoff)
#define VMW() asm volatile("s_waitcnt vmcnt(0)" ::: "memory")
#define VMWN(n) asm volatile("s_waitcnt vmcnt(%0)" :: "i"(n) : "memory")
#define LD8(p) (*reinterpret_cast<const bf16x8*>(p))
#define SLOAD_H(Kp, Vp, k0) do { S.st_v0 = LD8(ROWB(Vp, k0, 0)); S.st_v1 = LD8(ROWB(Vp, k0, 32)); S.st_k0 = LD8(ROWB(Kp, k0, 0)); S.st_k1 = LD8(ROWB(Kp, k0, 32)); } while (0)
#define SWRITE_HK(bf) do { *(bf16x8*)(K_lds + (bf) * SHM_K + kws) = S.st_k0; *(bf16x8*)(K_lds + (bf) * SHM_K + kws + 32 * 256) = S.st_k1; } while (0)
#define SWRITE_HV(bf) do { *(bf16x8*)(V_lds + (bf) * SHM_V + vst0) = S.st_v0; *(bf16x8*)(V_lds + (bf) * SHM_V + vst1) = S.st_v1; } while (0)
#define SWRITE_H(bf) do { SWRITE_HV(bf); SWRITE_HK(bf); } while (0)
__device__ __forceinline__ void attn_prime(const unsigned char* wsb, const BlockRef& cur, char* lds, Seam& S) {
    const int tid = threadIdx.x, wid = __builtin_amdgcn_readfirstlane(tid >> 6), lane = tid & 63, r32 = lane & 31, hi = lane >> 5;
    const int sr = tid >> 4, sc = (tid & 15) * 8, kws = KSWZ(sr, sc * 2); char* K_lds = lds + 2 * SHM_V;
    const unsigned lnoff = (unsigned)(sr * D + sc) * 2u;
#pragma unroll
    for (int d0 = 0; d0 < 8; ++d0) S.qr[d0] = LD8(wsb + (size_t)cur.Q + (unsigned)((wid * QBLK + r32) * D + d0 * 16 + hi * 8) * 2u);
    SLOAD_H(cur.K, cur.V, cur.jlo * KVBLK); VMW(); SWRITE_HK(0);
    __syncthreads();
}
template <bool FOX, class NR>
__device__ __forceinline__ void attn_block(const unsigned char* wsb, const BlockRef& cur, const NR& nref, char* lds, Seam& S) {
    const int tid = threadIdx.x, wid = __builtin_amdgcn_readfirstlane(tid >> 6), lane = tid & 63, r32 = lane & 31, hi = lane >> 5;
    const int j_lo = cur.jlo;
    const int NT = (cur.P0 + QB) / KVBLK - j_lo;
    const int qlo = cur.P0 + wid * QBLK;
    const int qe = FOX ? qlo : (qlo | 63);
    const int qm = (FOX ? (qlo + r32) : (qlo | 63)) - 4 * hi;
    char* V_lds = lds; char* K_lds = lds + 2 * SHM_V;
    float* ws = (float*)(lds + OFF_WS) + wid * 64; float* li_l = ws, * al_l = ws + 32;
    float* cl_lds = (float*)(lds + OFF_CLOG);
    float cq = 0.f;
    if constexpr (FOX) {
        const int nkeys = NT * KVBLK;
        const float* clg = (const float*)(wsb + (size_t)cur.clog);
        for (int i = tid * 4; i < nkeys; i += NTHREADS * 4) *(f32x4*)(cl_lds + i) = *(const f32x4*)(clg + j_lo * KVBLK + i);
        cq = clg[qlo + r32];
        __syncthreads();
    }
    float m_reg = -1e30f, l_reg = 0; f32x16 o[4] = {};
    const int sr = tid >> 4, sc = (tid & 15) * 8, vst0 = v_st(sr, sc), vst1 = v_st(32 + sr, sc), kws = KSWZ(sr, sc * 2);
    const unsigned lnoff = (unsigned)(sr * D + sc) * 2u;
    const int vb0 = (int)(uintptr_t)V_lds + v_rd_base(lane);
    const unsigned Kh = cur.K, Vh = cur.V;
#define RESC(a) do { if (__any((a) < 1.f)) { if (hi == 0) al_l[r32] = (a); asm volatile("s_waitcnt lgkmcnt(0)" ::: "memory");              \
                     for (int d_ = 0; d_ < 4; ++d_) for (int r = 0; r < 16; ++r) o[d_][r] *= al_l[crow(r, hi)]; } } while (0)
#define KBASE(t) ((j_lo + (t)) * KVBLK)
#define CLT(t) (cl_lds + (t) * KVBLK)
#define MASKT(P0_, P1_, t) do { const int kb_ = KBASE(t); if (kb_ + KVBLK - 1 > qe) mask_tile(P0_, P1_, qm - kb_); } while (0)
    f32x16 pA0, pA1, pB0, pB1; float mnA, mnB, alA, alB; bf16x8 pa0, pa1, pa2, pa3;
    SWRITE_HV(0); SBAR();
    if (NT > 1) { SLOAD_H(Kh, Vh, KBASE(1)); }
    SBAR(); qkt<0, FOX>(pA0, pA1, K_lds, r32, hi, S.qr, CLT(0), cq);
    MASKT(pA0, pA1, 0); partialSM(pA0, pA1, m_reg, mnA, alA);
    if (NT > 1) { VMW(); SWRITE_H(1); }
    __syncthreads();
#define HALF_STEP(PX0, PX1, mnX, alX, PY0, PY1, alY, t, KB, VB, SB) do {                                                      \
        SBAR(); qkt<KB, FOX>(PX0, PX1, K_lds, r32, hi, S.qr, CLT(t), cq);                                          \
        finishSM(PY0, PY1, alY, l_reg, pa0, pa1, pa2, pa3); SBAR();                                                           \
        if ((t) + 1 < NT) { SLOAD_H(Kh, Vh, KBASE((t) + 1)); SBAR(); }                                                        \
        pv_tile<VB>(o, vb0, pa0, pa1, pa2, pa3); MASKT(PX0, PX1, (t)); partialSM(PX0, PX1, m_reg, mnX, alX);                  \
        __syncthreads();                                                                                                      \
        if ((t) + 1 < NT) { VMW(); SWRITE_H(SB); }                                                                            \
        RESC(alX); __syncthreads(); } while (0)
    for (int t = 1; t + 1 < NT; t += 2) {
        HALF_STEP(pB0, pB1, mnB, alB, pA0, pA1, alA, t, 1, 0, 0);
        HALF_STEP(pA0, pA1, mnA, alA, pB0, pB1, alB, t + 1, 0, 1, 1);
    }
    constexpr bool even = true;
    if (even) { SBAR(); qkt<1, FOX>(pB0, pB1, K_lds, r32, hi, S.qr, CLT(NT - 1), cq); SBAR(); }
    const BlockRef nxt = nref();
    SLOAD_H(nxt.K, nxt.V, nxt.jlo * KVBLK); SBAR();
#pragma unroll
    for (int d0 = 0; d0 < 8; ++d0) S.qr[d0] = LD8(wsb + (size_t)nxt.Q + (unsigned)((wid * QBLK + r32) * D + d0 * 16 + hi * 8) * 2u);
    SBAR();
    finishSM(pA0, pA1, alA, l_reg, pa0, pa1, pa2, pa3); SBAR();
    pv_tile<0>(o, vb0, pa0, pa1, pa2, pa3);
    if (even) { MASKT(pB0, pB1, NT - 1); partialSM(pB0, pB1, m_reg, mnB, alB); __syncthreads(); RESC(alB);
        finishSM(pB0, pB1, alB, l_reg, pa0, pa1, pa2, pa3); SBAR(); pv_tile<1>(o, vb0, pa0, pa1, pa2, pa3); }
    SBAR(); VMWN(8); SWRITE_HK(0); SBAR();
    if (hi == 0) li_l[r32] = l_reg; asm volatile("s_waitcnt lgkmcnt(0)" ::: "memory");
    float rli[16];
#pragma unroll
    for (int r = 0; r < 16; ++r) rli[r] = __builtin_amdgcn_rcpf(li_l[crow(r, hi)]);
    bf16_t* Ow = (bf16_t*)(const_cast<unsigned char*>(wsb) + (size_t)cur.O) + (size_t)(wid * QBLK) * D;
#pragma unroll
    for (int r = 0; r < 16; ++r) { const int orow = crow(r, hi);
#pragma unroll
        for (int d0 = 0; d0 < 4; ++d0) { const float v = o[d0][r] * rli[r];
            const float vn = __uint_as_float((unsigned)__builtin_amdgcn_update_dpp(0, (int)__float_as_uint(v), 0xB1, 0xF, 0xF, false));
            if ((r32 & 1) == 0) *(unsigned*)(Ow + (size_t)orow * D + d0 * 32 + r32) = cvtpk(v, vn); } }
    __syncthreads();
#undef RESC
#undef KBASE
#undef CLT
#undef MASKT
#undef HALF_STEP
}
constexpr int W_OFF_V1 = 3 * SHM_V, W_OFF_K = 6 * SHM_V, W_OFF_WS = 133120, W_LDS_BYTES = W_OFF_WS + NW * 64 * 4;
struct BlockRefW { unsigned Q, K, V0, V1, O0, O1; int P0; };
struct SeamW { bf16x8 qr[8]; int vs; };
#define DMA_W(R, k0, bf, vsl) do { const unsigned kb_ = (unsigned)(k0) * 256u; \
        const char* gk_ = (const char*)wsb + (size_t)((R).K + kb_); const char* g0_ = (const char*)wsb + (size_t)((R).V0 + kb_); const char* g1_ = (const char*)wsb + (size_t)((R).V1 + kb_); \
        const unsigned lk_ = ldsb + W_OFF_K + (bf) * SHM_K + wid * 2048, lv_ = ldsb + (unsigned)(vsl) * SHM_V + wid * 2048; \
        glds16s(uni_ptr(gk_), vofK0, lk_); glds16s(uni_ptr(gk_), (vofK0 + 1024u) ^ 64u, lk_ + 1024u); \
        glds16s(uni_ptr(g0_), vofV0, lv_); glds16s(uni_ptr(g0_), vofV1, lv_ + 1024u); \
        glds16s(uni_ptr(g1_), vofV0, lv_ + W_OFF_V1); glds16s(uni_ptr(g1_), vofV1, lv_ + W_OFF_V1 + 1024u); } while (0)
#define DMA_OFFS() \
    const unsigned ldsb = (unsigned)__builtin_amdgcn_readfirstlane((int)(unsigned)(uintptr_t)lds); \
    unsigned vofK0, vofV0, vofV1; \
    { int lane; asm volatile("v_mbcnt_lo_u32_b32 %0, -1, 0\n\tv_mbcnt_hi_u32_b32 %0, -1, %0" : "=v"(lane));     \
      const int rk0 = 4 * (2 * wid) + (lane >> 4), rk1 = rk0 + 4; vofK0 = (unsigned)(rk0 * 256 + (((lane & 15) ^ (rk0 & 7)) << 4)); (void)rk1;     \
      const int p0_ = (2 * wid) * 64 + lane, p1_ = p0_ + 64; \
      { const int sub = p0_ >> 5, kk = (sub >> 2) * 8 + ((p0_ >> 2) & 7), k = (kk & ~0xC) | ((kk & 4) << 1) | ((kk & 8) >> 1), c = (sub & 3) * 32 + (p0_ & 3) * 8; vofV0 = (unsigned)(k * 256 + c * 2); } \
      { const int sub = p1_ >> 5, kk = (sub >> 2) * 8 + ((p1_ >> 2) & 7), k = (kk & ~0xC) | ((kk & 4) << 1) | ((kk & 8) >> 1), c = (sub & 3) * 32 + (p1_ & 3) * 8; vofV1 = (unsigned)(k * 256 + c * 2); } }
__device__ __forceinline__ void attn_primeW(const unsigned char* wsb, const BlockRefW& cur, char* lds, SeamW& S) {
    const int tid = threadIdx.x, wid = __builtin_amdgcn_readfirstlane(tid >> 6), lane = tid & 63, r32 = lane & 31, hi = lane >> 5;
    DMA_OFFS();
    S.vs = 0;
    DMA_W(cur, 0, 0, 0);
#pragma unroll
    for (int d0 = 0; d0 < 8; ++d0) S.qr[d0] = LD8(wsb + (size_t)cur.Q + (unsigned)((wid * QBLK + r32) * D + d0 * 16 + hi * 8) * 2u);
    VMW();
    __syncthreads();
}
template <class NR>
__device__ __forceinline__ void attn_blockW(const unsigned char* wsb, const BlockRefW& cur, const NR& nref, char* lds, SeamW& S) {
    const int tid = threadIdx.x, wid = __builtin_amdgcn_readfirstlane(tid >> 6), lane = tid & 63, r32 = lane & 31, hi = lane >> 5;
    const int NT = (cur.P0 + QB) / KVBLK;
    const int qlo = cur.P0 + wid * QBLK, qe = qlo | 63, qm = (qlo | 63) - 4 * hi;
    char* V_lds = lds; char* K_lds = lds + W_OFF_K;
    float* ws = (float*)(lds + W_OFF_WS) + wid * 64; float* li_l = ws, * al_l = ws + 32;
    float m_reg = -1e30f, l_reg = 0; f32x16 o[8] = {};
    DMA_OFFS();
    const int vb0 = (int)(uintptr_t)V_lds + v_rd_base(lane);
    static_assert(PV8_V1 == W_OFF_V1 && v_rd_off(3, 3, 1) + PV8_V1 < 65536, "V1 ring reachable by the 16-bit ds offset");
#define RESCW(a) do { if (__any((a) < 1.f)) { if (hi == 0) al_l[r32] = (a); asm volatile("s_waitcnt lgkmcnt(0)" ::: "memory");              \
                      for (int d_ = 0; d_ < 8; ++d_) for (int r = 0; r < 16; ++r) o[d_][r] *= al_l[crow(r, hi)]; } } while (0)
#define MASKW(P0_, P1_, t) do { const int kb_ = (t) * KVBLK; if (kb_ + KVBLK - 1 > qe) mask_tile(P0_, P1_, qm - kb_); } while (0)
    f32x16 p0, p1; float mn, al; bf16x8 pa0, pa1, pa2, pa3;
    const bool lag = wid >= 4;
    int vs = S.vs;
#define PVW(slot) do { pv_pipe8(o, vb0 + (slot) * SHM_V, pa0, pa1, pa2, pa3); } while (0)
#define STEPW(t, BF) do { const int nvs_ = vs == 2 ? 0 : vs + 1;                                                                \
        DMA_W(cur, ((t) + 1) * KVBLK, 1 - (BF), nvs_);                                                                          \
        if (lag && (t) > 0) { SBAR(); PVW(vs == 0 ? 2 : vs - 1); }                                                               \
        SBAR(); qkt_lean<BF>(p0, p1, K_lds, r32, hi, S.qr); SBAR();                                                            \
        MASKW(p0, p1, (t)); partialSM(p0, p1, m_reg, mn, al); RESCW(al); finishSM(p0, p1, al, l_reg, pa0, pa1, pa2, pa3); SBAR(); \
        if (!lag) { PVW(vs); }                                                                                                   \
        VMW(); __syncthreads(); vs = nvs_; } while (0)
    for (int t = 0; t + 2 < NT; t += 2) { STEPW(t, 0); STEPW(t + 1, 1); }
    STEPW(NT - 2, 0);
    const BlockRefW nxt = nref();
    const int nvs = vs == 2 ? 0 : vs + 1;
    DMA_W(nxt, 0, 0, nvs);
    if (lag) { SBAR(); PVW(vs == 0 ? 2 : vs - 1); }
    SBAR(); qkt_lean<1>(p0, p1, K_lds, r32, hi, S.qr); SBAR();
#pragma unroll
    for (int d0 = 0; d0 < 8; ++d0) S.qr[d0] = LD8(wsb + (size_t)nxt.Q + (unsigned)((wid * QBLK + r32) * D + d0 * 16 + hi * 8) * 2u);
    SBAR();
    MASKW(p0, p1, NT - 1); partialSM(p0, p1, m_reg, mn, al); RESCW(al); finishSM(p0, p1, al, l_reg, pa0, pa1, pa2, pa3); SBAR();
    PVW(vs);
    S.vs = nvs;
    if (hi == 0) li_l[r32] = l_reg; asm volatile("s_waitcnt lgkmcnt(0)" ::: "memory");
    float rli[16];
#pragma unroll
    for (int r = 0; r < 16; ++r) rli[r] = __builtin_amdgcn_rcpf(li_l[crow(r, hi)]);
    { int ln_; asm volatile("v_mbcnt_lo_u32_b32 %0, -1, 0\n\tv_mbcnt_hi_u32_b32 %0, -1, %0" : "=v"(ln_));
      const int r32b = ln_ & 31, hib = ln_ >> 5; const unsigned lo_ = (unsigned)((wid * QBLK + 4 * hib) * D + r32b) * 2u;
#pragma unroll
      for (int hv = 0; hv < 2; ++hv) {
        unsigned char* Ob = const_cast<unsigned char*>(wsb) + (size_t)(hv ? cur.O1 : cur.O0);
#pragma unroll
        for (int r = 0; r < 16; ++r) { const unsigned ro_ = lo_ + (unsigned)(((r & 3) + 8 * (r >> 2)) * D) * 2u;
#pragma unroll
            for (int d0 = 0; d0 < 4; ++d0) { const float v = o[hv * 4 + d0][r] * rli[r];
                const float vn = __uint_as_float((unsigned)__builtin_amdgcn_update_dpp(0, (int)__float_as_uint(v), 0xB1, 0xF, 0xF, false));
                if ((r32b & 1) == 0) *(unsigned*)(Ob + (ro_ + (unsigned)(d0 * 64))) = cvtpk(v, vn); } }
      } }
    VMW(); __syncthreads();
#undef RESCW
#undef MASKW
#undef STEPW
#undef PVW
}
#undef DMA_W
#undef DMA_OFFS
#undef ROWB
#undef VMW
#undef VMWN
#undef LD8
#undef SLOAD_H
#undef SWRITE_HK
#undef SWRITE_HV
#undef SWRITE_H
#undef KSWZ
#undef SBAR
}
#ifndef MK_FP8
#define MK_FP8 1
#endif
constexpr int FP8_WSHIFT = 8, FP8_HGSHIFT = 3, FP8_HDSHIFT = 2, FP8_YSHIFT = 6;
#ifndef MK_YS8
#define MK_YS8 1
#endif
__device__ __forceinline__ float clamp448(float v) { return __builtin_amdgcn_fmed3f(v, -448.0f, 448.0f); }
__device__ __forceinline__ unsigned pk_fp8x4(float a, float b, float c, float d) {
    int w = 0; w = __builtin_amdgcn_cvt_pk_fp8_f32(clamp448(a), clamp448(b), w, false); w = __builtin_amdgcn_cvt_pk_fp8_f32(clamp448(c), clamp448(d), w, true); return (unsigned)w; }
#ifndef MK_FP6
#define MK_FP6 1
#endif
typedef float v16f_t __attribute__((ext_vector_type(16)));
typedef int v6i_t __attribute__((ext_vector_type(6)));
__device__ __forceinline__ void fp6_record(const v16f_t a, const v16f_t b, u32x4& lo, u32x4& hi) {
    float mx = 0.f;
#pragma unroll
    for (int i = 0; i < 16; ++i) asm("v_max3_f32 %0, |%1|, |%2|, %0" : "+v"(mx) : "v"(a[i]), "v"(b[i]));
    int sb = (int)((__float_as_uint(mx) >> 23) & 0xffu) - 2; sb = sb < 1 ? 1 : sb;
    const float scale = __uint_as_float((unsigned)sb << 23);
    const v6i_t r = __builtin_amdgcn_cvt_scalef32_2xpk16_fp6_f32(a, b, scale);
    lo = (u32x4){(unsigned)r[0], (unsigned)r[1], (unsigned)r[2], (unsigned)r[3]}; hi = (u32x4){(unsigned)r[4], (unsigned)r[5], (unsigned)sb, 0u};
}
__device__ __forceinline__ void xpose4(float (&X)[4][8]) {
#pragma unroll
    for (int m = 0; m < 2; ++m)
#pragma unroll
        for (int j = 0; j < 8; ++j) { auto r = __builtin_amdgcn_permlane32_swap(__float_as_uint(X[m][j]), __float_as_uint(X[m + 2][j]), false, false); X[m][j] = __uint_as_float(r[0]); X[m + 2][j] = __uint_as_float(r[1]); }
#pragma unroll
    for (int m = 0; m < 4; m += 2)
#pragma unroll
        for (int j = 0; j < 8; ++j) { auto r = __builtin_amdgcn_permlane16_swap(__float_as_uint(X[m][j]), __float_as_uint(X[m + 1][j]), false, false); X[m][j] = __uint_as_float(r[0]); X[m + 1][j] = __uint_as_float(r[1]); }
}
#define XROW16(X, q) X[q][0], X[q][1], X[q][2], X[q][3], X[q][4], X[q][5], X[q][6], X[q][7]
#ifndef MK_XINIT
#define MK_XINIT 1
#endif
#ifndef MK_FUSE_NORMS
#define MK_FUSE_NORMS 1
#endif
namespace pg8 {
struct EpiQKV {
    bf16_t* QKV; const float* rope; unsigned* ctl; LAS float* nsc;
    __device__ __forceinline__ void operator()(const f32x4 (&acc)[2][2][4][2], const Unit& u, int wr, int wc, int fr, int fq) const {
        const int pn = u.pn; const bool isrope = pn < 8; const float sc = (pn < 4 || (pn >= 12 && pn < 16)) ? QSCALE : 1.0f;
        const bool isnorm = MK_FUSE_NORMS && pn >= 12 && pn < 20;
        const int cw = wc * 32 + 8 * fq;
#pragma unroll
        for (int ai = 0; ai < 2; ++ai)
#pragma unroll
            for (int m = 0; m < 4; ++m) {
                const int row = u.pm * BM + ai * HALF + wr * 64 + m * 16 + fr;
                f32x4 cs0 = {1.f, 0.f, 1.f, 0.f}, cs1 = {1.f, 0.f, 1.f, 0.f};
                if (isrope) { const float* rp = rope + (size_t)row * 128 + (16 * wc + 4 * fq) * 2; cs0 = *(const f32x4*)rp; cs1 = *(const f32x4*)(rp + 4); }
#pragma unroll
                for (int bj = 0; bj < 2; ++bj) {
                    f32x4 v0 = acc[ai][bj][m][0], v1 = acc[ai][bj][m][1];
                    if (isrope) {
                        const f32x4 a = v0, b = v1;
                        v0[0] = a[0] * cs0[0] - a[1] * cs0[1]; v0[1] = a[1] * cs0[0] + a[0] * cs0[1]; v0[2] = a[2] * cs0[2] - a[3] * cs0[3]; v0[3] = a[3] * cs0[2] + a[2] * cs0[3];
                        v1[0] = b[0] * cs1[0] - b[1] * cs1[1]; v1[1] = b[1] * cs1[0] + b[0] * cs1[1]; v1[2] = b[2] * cs1[2] - b[3] * cs1[3]; v1[3] = b[3] * cs1[2] + b[2] * cs1[3];
                    }
                    v0 = v0 * sc; v1 = v1 * sc;
                    if (isnorm) { float ss = (v0[0] * v0[0] + v0[1] * v0[1]) + (v0[2] * v0[2] + v0[3] * v0[3]) + (v1[0] * v1[0] + v1[1] * v1[1]) + (v1[2] * v1[2] + v1[3] * v1[3]);
                        ss += __shfl_xor(ss, 16); ss += __shfl_xor(ss, 32);
                        if (fq == 0) nsc[((ai * HALF + wr * 64 + m * 16 + fr) * 2 + bj) * 4 + wc] = ss; }
                    u32x4 w; w.x = cvt_pk_bf16(v0[0], v0[1]); w.y = cvt_pk_bf16(v0[2], v0[3]); w.z = cvt_pk_bf16(v1[0], v1[1]); w.w = cvt_pk_bf16(v1[2], v1[3]);
                    *(u32x4*)(QKV + ((size_t)(pn * 2 + bj) * MTOK + row) * 128 + cw) = w;
                }
            }
        if (isnorm) {
            __syncthreads();
            const int t = (int)threadIdx.x; const f32x4 pq = *(const LAS f32x4*)(nsc + t * 4);
            float s = (pq.x + pq.y) + (pq.z + pq.w);
            s = fmaxf(s, __shfl_xor(s, 2)); s = fmaxf(s, __shfl_xor(s, 4)); s = fmaxf(s, __shfl_xor(s, 8)); s = fmaxf(s, __shfl_xor(s, 16)); s = fmaxf(s, __shfl_xor(s, 32));
            if ((t & 63) < 2) { const int isk = pn >= 16, hd = ((pn - (isk ? 16 : 12)) * 2) + (t & 1), bh = (u.pm >> 4) * 8 + hd;
                atomicMax(ctl + (isk ? CW_KMAX + bh : CW_QMAX + bh * 16 + (u.pm & 15)), __float_as_uint(s)); }
        }
    }
};
struct EpiOut {
    const float* x; float* h; bf16_t* hg; const float* gffn;
    __device__ __forceinline__ void load_init(f32x4 (&acc)[2][2][4][2], const Unit& u, int wr, int wc, int fr, int fq) const {
#pragma unroll
        for (int bj = 0; bj < 2; ++bj)
#pragma unroll
            for (int ai = 0; ai < 2; ++ai)
#pragma unroll
                for (int m = 0; m < 4; ++m) { const size_t off = (size_t)(u.pm * BM + ai * HALF + wr * 64 + m * 16 + fr) * DM + u.pn * BM + bj * HALF + wc * 32 + 8 * fq;
                    acc[ai][bj][m][0] = *(const f32x4*)(x + off); acc[ai][bj][m][1] = *(const f32x4*)(x + off + 4); }
    }
    __device__ __forceinline__ void operator()(const f32x4 (&acc)[2][2][4][2], const Unit& u, int wr, int wc, int fr, int fq) const {
#pragma unroll
        for (int bj = 0; bj < 2; ++bj) {
            const int col0 = u.pn * BM + bj * HALF + wc * 32 + 8 * fq;
            const f32x4 g0 = *(const f32x4*)(gffn + col0), g1 = *(const f32x4*)(gffn + col0 + 4);
#pragma unroll
            for (int ai = 0; ai < 2; ++ai) {
#if MK_FP8 && MK_FP6
                float X[4][8];
#endif
#pragma unroll
                for (int m = 0; m < 4; ++m) {
                    const size_t off = (size_t)(u.pm * BM + ai * HALF + wr * 64 + m * 16 + fr) * DM + col0;
                    const f32x4 h0 = MK_XINIT ? acc[ai][bj][m][0] : *(const f32x4*)(x + off) + acc[ai][bj][m][0], h1 = MK_XINIT ? acc[ai][bj][m][1] : *(const f32x4*)(x + off + 4) + acc[ai][bj][m][1];
                    *(f32x4*)(h + off) = h0; *(f32x4*)(h + off + 4) = h1;
                    const f32x4 a = h0 * g0, b = h1 * g1;
#if MK_FP8 && MK_FP6
                    X[m][0] = a[0]; X[m][1] = a[1]; X[m][2] = a[2]; X[m][3] = a[3]; X[m][4] = b[0]; X[m][5] = b[1]; X[m][6] = b[2]; X[m][7] = b[3];
#elif MK_FP8
                    constexpr float sc8 = (float)(1 << FP8_HGSHIFT);
                    u32x2 w8; w8.x = pk_fp8x4(a[0] * sc8, a[1] * sc8, a[2] * sc8, a[3] * sc8); w8.y = pk_fp8x4(b[0] * sc8, b[1] * sc8, b[2] * sc8, b[3] * sc8);
                    *(u32x2*)((unsigned char*)hg + off) = w8;
#else
                    u32x4 w; w.x = cvt_pk_bf16(a[0], a[1]); w.y = cvt_pk_bf16(a[2], a[3]); w.z = cvt_pk_bf16(b[0], b[1]); w.w = cvt_pk_bf16(b[2], b[3]);
                    *(u32x4*)(hg + off) = w;
#endif
                }
#if MK_FP8 && MK_FP6
                xpose4(X);
                u32x4 lo, hi; fp6_record((v16f_t){XROW16(X, 0), XROW16(X, 1)}, (v16f_t){XROW16(X, 2), XROW16(X, 3)}, lo, hi);
                unsigned char* rp = (unsigned char*)hg + (size_t)(u.pm * BM + ai * HALF + wr * 64 + fq * 16 + fr) * DM + (2 * u.pn + bj) * 128 + 16 * wc;
                *(u32x4*)rp = lo; *(u32x4*)(rp + 64) = hi;
#endif
            }
        }
    }
};
template <int SC> __device__ __forceinline__ f32x2 swiglu_pk(f32x2 g, f32x2 u) {
    g.x = fminf(g.x, 7.0f); g.y = fminf(g.y, 7.0f);
    u.x = __builtin_amdgcn_fmed3f(u.x, -7.0f, 7.0f); u.y = __builtin_amdgcn_fmed3f(u.y, -7.0f, 7.0f);
    const f32x2 t = g * (-1.702f * 1.4426950408889634f);
    f32x2 e; e.x = __builtin_amdgcn_exp2f(t.x); e.y = __builtin_amdgcn_exp2f(t.y);
    const f32x2 d = e + 1.0f;
    f32x2 r; r.x = __builtin_amdgcn_rcpf(d.x); r.y = __builtin_amdgcn_rcpf(d.y);
    const f32x2 us = u * (float)SC + (float)SC;
    return (g * r) * us;
}
__device__ __forceinline__ unsigned pk_fp8x4_nc(f32x2 a, f32x2 b) {
    int w = 0; w = __builtin_amdgcn_cvt_pk_fp8_f32(a.x, a.y, w, false); w = __builtin_amdgcn_cvt_pk_fp8_f32(b.x, b.y, w, true); return (unsigned)w; }
__device__ __forceinline__ float swiglu1(float g, float uu) {
    g = fminf(g, 7.0f); uu = fminf(fmaxf(uu, -7.0f), 7.0f);
    const float e = __builtin_amdgcn_exp2f(g * (-1.702f * 1.4426950408889634f));
    return g * __builtin_amdgcn_rcpf(1.0f + e) * (uu + 1.0f);
}
struct EpiGU {
    bf16_t* hdn; const float* bgate; const float* bup; const float* rstd; const LAS int* tab; const LAS float* rl;
    __device__ __forceinline__ void operator()(const f32x4 (&acc)[2][2][4][2], const Unit& u, int wr, int wc, int fr, int fq) const {
        const int j0 = u.pn * HALF + wc * 32 + 8 * fq; const int cnt = tab[NE + 1 + u.e];
        const f32x4 bg0 = *(const f32x4*)(bgate + (size_t)u.e * DM + j0), bg1 = *(const f32x4*)(bgate + (size_t)u.e * DM + j0 + 4);
        const f32x4 bu0 = *(const f32x4*)(bup + (size_t)u.e * DM + j0), bu1 = *(const f32x4*)(bup + (size_t)u.e * DM + j0 + 4);
#pragma unroll
        for (int ai = 0; ai < 2; ++ai) {
#if MK_FP8 && MK_FP6
            float X[4][8];
#endif
#pragma unroll
            for (int m = 0; m < 4; ++m) {
                const int r = ai * HALF + wr * 64 + m * 16 + fr, pos = u.rows0 + r;
                float rs = MK_EPI_LDS ? rl[r] : rstd[(size_t)u.e * ECAP + pos]; rs = pos < cnt ? rs : 0.f;
                const f32x4 g0 = acc[ai][0][m][0] * rs + bg0, g1 = acc[ai][0][m][1] * rs + bg1, u0 = acc[ai][1][m][0] * rs + bu0, u1 = acc[ai][1][m][1] * rs + bu1;
#if MK_FP8 && MK_FP6
                { const f32x2 h00 = swiglu_pk<1>((f32x2){g0[0], g0[1]}, (f32x2){u0[0], u0[1]}), h01 = swiglu_pk<1>((f32x2){g0[2], g0[3]}, (f32x2){u0[2], u0[3]});
                  const f32x2 h10 = swiglu_pk<1>((f32x2){g1[0], g1[1]}, (f32x2){u1[0], u1[1]}), h11 = swiglu_pk<1>((f32x2){g1[2], g1[3]}, (f32x2){u1[2], u1[3]});
                  X[m][0] = h00.x; X[m][1] = h00.y; X[m][2] = h01.x; X[m][3] = h01.y; X[m][4] = h10.x; X[m][5] = h10.y; X[m][6] = h11.x; X[m][7] = h11.y; }
#elif MK_FP8
                constexpr int SC8 = 1 << FP8_HDSHIFT;
                const f32x2 h00 = swiglu_pk<SC8>((f32x2){g0[0], g0[1]}, (f32x2){u0[0], u0[1]}), h01 = swiglu_pk<SC8>((f32x2){g0[2], g0[3]}, (f32x2){u0[2], u0[3]});
                const f32x2 h10 = swiglu_pk<SC8>((f32x2){g1[0], g1[1]}, (f32x2){u1[0], u1[1]}), h11 = swiglu_pk<SC8>((f32x2){g1[2], g1[3]}, (f32x2){u1[2], u1[3]});
                u32x2 w8; w8.x = pk_fp8x4_nc(h00, h01); w8.y = pk_fp8x4_nc(h10, h11);
                *(u32x2*)((unsigned char*)hdn + (size_t)(u.pm * BM + r) * DM + j0) = w8;
#else
                u32x4 w; w.x = cvt_pk_bf16(swiglu1(g0[0], u0[0]), swiglu1(g0[1], u0[1])); w.y = cvt_pk_bf16(swiglu1(g0[2], u0[2]), swiglu1(g0[3], u0[3]));
                w.z = cvt_pk_bf16(swiglu1(g1[0], u1[0]), swiglu1(g1[1], u1[1])); w.w = cvt_pk_bf16(swiglu1(g1[2], u1[2]), swiglu1(g1[3], u1[3]));
                *(u32x4*)(hdn + (size_t)(u.pm * BM + r) * DM + j0) = w;
#endif
            }
#if MK_FP8 && MK_FP6
            xpose4(X);
            u32x4 lo, hi; fp6_record((v16f_t){XROW16(X, 0), XROW16(X, 1)}, (v16f_t){XROW16(X, 2), XROW16(X, 3)}, lo, hi);
            unsigned char* rp = (unsigned char*)hdn + (size_t)(u.pm * BM + ai * HALF + wr * 64 + fq * 16 + fr) * DM + u.pn * 128 + 16 * wc;
            *(u32x4*)rp = lo; *(u32x4*)(rp + 64) = hi;
#endif
        }
    }
};
struct EpiDown {
    bf16_t* ys; const float* bdown; const float* gate; const LAS int* tab; const LAS float* rl;
    __device__ __forceinline__ void operator()(const f32x4 (&acc)[2][2][4][2], const Unit& u, int wr, int wc, int fr, int fq) const {
        const int cnt = tab[NE + 1 + u.e]; const int c0 = u.pn * BM + wc * 32 + 8 * fq;
        const float* bp = bdown + (size_t)u.e * DM + c0;
        const f32x4 b00 = *(const f32x4*)(bp), b01 = *(const f32x4*)(bp + 4), b10 = *(const f32x4*)(bp + HALF), b11 = *(const f32x4*)(bp + HALF + 4);
#pragma unroll
        for (int ai = 0; ai < 2; ++ai)
#pragma unroll
            for (int m = 0; m < 4; ++m) {
                const int r = ai * HALF + wr * 64 + m * 16 + fr, pos = u.rows0 + r;
                float gt = MK_EPI_LDS ? rl[r] : gate[(size_t)u.e * ECAP + pos]; gt = pos < cnt ? gt : 0.f;
#if MK_YS8
                const float gs = gt * (float)(1 << FP8_YSHIFT);
                unsigned char* yp = (unsigned char*)ys + (size_t)(u.pm * BM + r) * DM + c0;
                { const f32x4 a = (acc[ai][0][m][0] + b00) * gs, b = (acc[ai][0][m][1] + b01) * gs; u32x2 w8; w8.x = pk_fp8x4(a[0], a[1], a[2], a[3]); w8.y = pk_fp8x4(b[0], b[1], b[2], b[3]); *(u32x2*)yp = w8; }
                { const f32x4 a = (acc[ai][1][m][0] + b10) * gs, b = (acc[ai][1][m][1] + b11) * gs; u32x2 w8; w8.x = pk_fp8x4(a[0], a[1], a[2], a[3]); w8.y = pk_fp8x4(b[0], b[1], b[2], b[3]); *(u32x2*)(yp + HALF) = w8; }
#else
                bf16_t* yp = ys + (size_t)(u.pm * BM + r) * DM + c0;
                { const f32x4 a = (acc[ai][0][m][0] + b00) * gt, b = (acc[ai][0][m][1] + b01) * gt; u32x4 w; w.x = cvt_pk_bf16(a[0], a[1]); w.y = cvt_pk_bf16(a[2], a[3]); w.z = cvt_pk_bf16(b[0], b[1]); w.w = cvt_pk_bf16(b[2], b[3]); *(u32x4*)yp = w; }
                { const f32x4 a = (acc[ai][1][m][0] + b10) * gt, b = (acc[ai][1][m][1] + b11) * gt; u32x4 w; w.x = cvt_pk_bf16(a[0], a[1]); w.y = cvt_pk_bf16(a[2], a[3]); w.z = cvt_pk_bf16(b[0], b[1]); w.w = cvt_pk_bf16(b[2], b[3]); *(u32x4*)(yp + HALF) = w; }
#endif
            }
    }
};
}

typedef GAS unsigned gu32;
#define RLX_AGENT __ATOMIC_RELAXED, __HIP_MEMORY_SCOPE_AGENT
#define LDS_WAIT() asm volatile("s_waitcnt lgkmcnt(0)" ::: "memory")
#define VM_WAIT() asm volatile("s_waitcnt vmcnt(0)" ::: "memory")
#define XB_TMO      128
#define XB_XCNT(j)  (256  + 64 * (j))
#define XB_XSUB(j)  (1280 + 64 * (j))
#define XB_XGEN(j)  (2304 + 64 * (j))
#define XB_TOP      3328
#define XB_TOPGEN   3392
#define XCD_BAR_WORDS 3456
#define XB_SPIN_CAP (1u << 18)
__device__ __forceinline__ unsigned xb_ld(unsigned* p)              { return __hip_atomic_load(p, __ATOMIC_RELAXED, __HIP_MEMORY_SCOPE_AGENT); }
__device__ __forceinline__ unsigned xb_add(unsigned* p, unsigned v) { return __hip_atomic_fetch_add(p, v, __ATOMIC_RELAXED, __HIP_MEMORY_SCOPE_AGENT); }
__device__ __forceinline__ unsigned xb_xcc_id() { return (unsigned)__builtin_amdgcn_s_getreg((3 << 11) | 20) & 0xFu; }
#define XB_SPIN(cond, bar) do { unsigned _sp = 0; while (cond) { __builtin_amdgcn_s_sleep(1); \
    if ((++_sp & 255u) == 0u) { if (xb_ld(&(bar)[XB_TMO])) break; if (_sp > XB_SPIN_CAP) { atomicAdd(&(bar)[XB_TMO], 1u); break; } } } } while (0)
struct XcdBarrier { unsigned* bar; unsigned x; volatile LAS unsigned* st; };
__device__ __forceinline__ XcdBarrier xcd_barrier_post(unsigned* bar, volatile LAS unsigned* st) {
    XcdBarrier b; b.bar = bar; b.x = xb_xcc_id(); b.st = st;
    if (threadIdx.x == 0) (void)xb_add(&bar[XB_XCNT(b.x)], 1u);
    return b;
}
__device__ __forceinline__ void xcd_barrier_complete(unsigned* bar, unsigned x, unsigned& nloc, unsigned& nx) {
    const unsigned G = gridDim.x * gridDim.y * gridDim.z;
    unsigned sum, cnt, mine, sp = 0u;
    for (;;) {
        sum = 0u; cnt = 0u; mine = 0u;
#pragma unroll
        for (unsigned j = 0; j < 16; ++j) { const unsigned c = xb_ld(&bar[XB_XCNT(j)]); sum += c; cnt += (c > 0u) ? 1u : 0u; mine = (j == x) ? c : mine; }
        if (sum == G) break;
        __builtin_amdgcn_s_sleep(1);
        if ((++sp & 255u) == 0u) { if (xb_ld(&bar[XB_TMO])) break; if (sp > XB_SPIN_CAP) { atomicAdd(&bar[XB_TMO], 1u); break; } }
    }
    nloc = mine > 0u ? mine : 1u; nx = cnt > 0u ? cnt : 1u;
}
__device__ __forceinline__ void xcd_barrier(const XcdBarrier& b) {
    asm volatile("s_waitcnt vmcnt(0)" ::: "memory");
    __syncthreads();
    if (threadIdx.x == 0) {
        unsigned* bar = b.bar;
        __builtin_amdgcn_s_waitcnt(0);
        unsigned nloc = b.st[0], nx = b.st[1];
        if (nloc == 0u) { xcd_barrier_complete(bar, b.x, nloc, nx); b.st[0] = nloc; b.st[1] = nx; }
        const unsigned old = xb_add(&bar[XB_XSUB(b.x)], 1u);
        const unsigned gen = old / nloc;
        if (old + 1u == (gen + 1u) * nloc) {
            __builtin_amdgcn_fence(__ATOMIC_RELEASE, "agent");
            asm volatile("s_waitcnt vmcnt(0)" ::: "memory");
            const unsigned og = xb_add(&bar[XB_TOP], 1u);
            const unsigned tg = og / nx;
            if (og + 1u == (tg + 1u) * nx) xb_add(&bar[XB_TOPGEN], 1u);
            else XB_SPIN(xb_ld(&bar[XB_TOPGEN]) == tg, bar);
            __builtin_amdgcn_fence(__ATOMIC_ACQUIRE, "agent");
            xb_add(&bar[XB_XGEN(b.x)], 1u);
            asm volatile("s_waitcnt vmcnt(0)" ::: "memory");
        } else {
            XB_SPIN(xb_ld(&bar[XB_XGEN(b.x)]) == gen, bar);
            __builtin_amdgcn_fence(__ATOMIC_ACQUIRE, "agent");
            asm volatile("s_waitcnt vmcnt(0)" ::: "memory");
        }
    }
    __syncthreads();
}

struct Args { const void* in[22]; float* out; unsigned char* ws; int ph_lo, ph_hi; };
typedef __attribute__((address_space(4))) const volatile Args* KArgs;
#define KIN(k) ((const void*)ka->in[k])
struct Frame {
    LAS unsigned char* lds; int wave, G, vcu;
    gu32* ctl; unsigned char* ws;
};

__device__ __forceinline__ void tr_item(const float* W, size_t ldw, int k0, int c0a, int c0b, bool perm, bf16_t* dst  , LAS float* scr, int lane) {
    const int kr = lane >> 4, q = lane & 15; const int col = (q < 8) ? c0a + 4 * q : c0b + 4 * (q - 8);
    f32x4 v[16];
#pragma unroll
    for (int it = 0; it < 16; ++it) v[it] = *(const f32x4*)(W + (size_t)(k0 + 4 * it + kr) * ldw + col);
#pragma unroll
    for (int it = 0; it < 16; ++it) { const int k = 4 * it + kr; *(LAS f32x4*)(scr + k * 64 + 4 * (q ^ ((k >> 3) & 7))) = v[it]; }
    LDS_WAIT(); asm volatile("" ::: "memory");
    const int n0l = lane >> 3, c = lane & 7;
#pragma unroll
    for (int j = 0; j < 8; ++j) { const int n = n0l + 8 * j; const int slot = perm ? ((n >> 1) + 32 * (n & 1)) : n;
        const LAS float* s = scr + (8 * c) * 64 + 4 * ((slot >> 2) ^ c) + (slot & 3);
        u32x4 o; o.x = pk2(s[0 * 64], s[1 * 64]); o.y = pk2(s[2 * 64], s[3 * 64]); o.z = pk2(s[4 * 64], s[5 * 64]); o.w = pk2(s[6 * 64], s[7 * 64]);
        *(u32x4*)(dst + (size_t)n * DM + k0 + 8 * c) = o; }
    LDS_WAIT(); asm volatile("" ::: "memory");
}
__device__ __forceinline__ void tr8_load(f32x4 (&v)[16], const float* W, size_t ldw, int k0, int c0, int lane) {
    const int kr = lane >> 3, q = lane & 7; const float* p = W + (size_t)(k0 + kr) * ldw + c0 + 4 * q;
#pragma unroll
    for (int it = 0; it < 16; ++it) v[it] = __builtin_nontemporal_load((const f32x4*)(p + (size_t)(8 * it) * ldw));
}
__device__ __forceinline__ void tr6_put(const f32x4 (&v)[16], LAS float* scr, int lane) {
    const int kr = lane >> 3, q = lane & 7;
#pragma unroll
    for (int it = 0; it < 16; ++it) { const int k = 8 * it + kr; *(LAS f32x4*)(scr + k * 32 + 4 * (q ^ ((k >> 4) & 7))) = v[it]; }
    LDS_WAIT(); asm volatile("" ::: "memory");
}
__device__ __forceinline__ void tr6_emit(int k0, unsigned char* dst, LAS float* scr, int lane) {
#pragma unroll
    for (int jj = 0; jj < 2; ++jj) { const int p = lane + 64 * jj, n = p >> 2, ch = p & 3;
        v16f_t a, b;
#pragma unroll
        for (int i = 0; i < 16; ++i) { const int ka = 32 * ch + i, kb = ka + 16;
            a[i] = scr[ka * 32 + 4 * ((n >> 2) ^ (2 * ch)) + (n & 3)]; b[i] = scr[kb * 32 + 4 * ((n >> 2) ^ (2 * ch + 1)) + (n & 3)]; }
        u32x4 lo, hi; fp6_record(a, b, lo, hi);
        unsigned char* rp = dst + (size_t)n * DM + k0 + 16 * ch;
        __builtin_nontemporal_store(lo, (u32x4*)rp); __builtin_nontemporal_store(hi, (u32x4*)(rp + 64)); }
    LDS_WAIT(); asm volatile("" ::: "memory");
}
__device__ __forceinline__ void tr6_store(const f32x4 (&v)[16], int k0, unsigned char* dst, LAS float* scr, int lane) { tr6_put(v, scr, lane); tr6_emit(k0, dst, scr, lane); }
__device__ __forceinline__ void tr8_store(const f32x4 (&v)[16], int k0, unsigned char* dst  , LAS float* scr, int lane) {
    const int kr = lane >> 3, q = lane & 7;
#pragma unroll
    for (int it = 0; it < 16; ++it) { const int k = 8 * it + kr; *(LAS f32x4*)(scr + k * 32 + 4 * (q ^ ((k >> 4) & 7))) = v[it]; }
    LDS_WAIT(); asm volatile("" ::: "memory");
    const int n0l = lane >> 3, c = lane & 7; constexpr float sc8 = (float)(1 << FP8_WSHIFT);
#pragma unroll
    for (int j = 0; j < 4; ++j) { const int n = n0l + 8 * j;
        const LAS float* s = scr + (16 * c) * 32 + 4 * ((n >> 2) ^ c) + (n & 3);
        u32x4 o; o.x = pk_fp8x4(s[0 * 32] * sc8, s[1 * 32] * sc8, s[2 * 32] * sc8, s[3 * 32] * sc8); o.y = pk_fp8x4(s[4 * 32] * sc8, s[5 * 32] * sc8, s[6 * 32] * sc8, s[7 * 32] * sc8);
        o.z = pk_fp8x4(s[8 * 32] * sc8, s[9 * 32] * sc8, s[10 * 32] * sc8, s[11 * 32] * sc8); o.w = pk_fp8x4(s[12 * 32] * sc8, s[13 * 32] * sc8, s[14 * 32] * sc8, s[15 * 32] * sc8);
        *(u32x4*)(dst + (size_t)n * DM + k0 + 16 * c) = o; }
    LDS_WAIT(); asm volatile("" ::: "memory");
}
__device__ __forceinline__ float log2_sigmoid(float z) {
    const float az = fabsf(z); const float e = __builtin_amdgcn_exp2f(-az * L2E);
    return fminf(z, 0.f) * L2E - __builtin_amdgcn_logf(1.0f + e) ;
}
__device__ __forceinline__ void p0_prologue(Frame& F, KArgs ka) {
    const float* x = (const float*)KIN(0); const int* pos = (const int*)KIN(1); const float* g_attn = (const float*)KIN(2); const float* w_in = (const float*)KIN(3);
    const float* b_forget = (const float*)KIN(4); const float* w_out = (const float*)KIN(11); const float* g_ffn = (const float*)KIN(12); const float* w_router = (const float*)KIN(13);
    const float* w_gate = (const float*)KIN(15); const float* w_up = (const float*)KIN(17); const float* w_down = (const float*)KIN(19);
    const int gw = F.vcu * NWAVES + F.wave, NGW = F.G * NWAVES; const int gt = F.vcu * NTHREADS + ((int)threadIdx.x), NGT = F.G * NTHREADS;
    { float* rope = (float*)(F.ws + WS_ROPE);
#pragma unroll 8
      for (int p = gt; p < MTOK * 64; p += NGT) { const int m = p >> 6, i = p & 63;
          const float invf = exp2f(-(float)i * 0.20762050593046014f); const float ang = (float)pos[m] * invf;
          const double rv = (double)ang * 0.15915494309189533576888; const float rev = (float)(rv - floor(rv));
          *(f32x2*)(rope + (size_t)p * 2) = (f32x2){__builtin_amdgcn_cosf(rev), __builtin_amdgcn_sinf(rev)}; } }
    { bf16_t* gwf = (bf16_t*)(F.ws + WS_GWF);
      for (int f = gt; f < 64 * 2 * 2 * 64; f += NGT) { const int ln = f & 63, p = (f >> 6) & 1, eh = (f >> 7) & 1, s = f >> 8;
          unsigned o[4];
#pragma unroll
          for (int j2 = 0; j2 < 4; ++j2) { unsigned hv[2];
#pragma unroll
              for (int q = 0; q < 2; ++q) { const int k = 32 * s + 8 * (ln >> 4) + 2 * j2 + q, e = 16 * eh + (ln & 15); const float val = g_ffn[k] * w_router[k * NE + e];
                  const unsigned hi = f2bf(val); const float lo = val - bf2f((unsigned short)hi); hv[q] = p ? f2bf(lo) : hi; }
              o[j2] = hv[0] | (hv[1] << 16); }
          *(u32x4*)(gwf + (size_t)f * 8) = (u32x4){o[0], o[1], o[2], o[3]}; } }
    { LAS float* gwfT = (LAS float*)F.lds;
#pragma unroll 4
      for (int k = ((int)threadIdx.x); k < DM; k += NTHREADS) { const f32x4 w0 = *(const f32x4*)(w_in + (size_t)k * INC + NQKV), w1 = *(const f32x4*)(w_in + (size_t)k * INC + NQKV + 4); const float g = g_attn[k];
          gwfT[0 * DM + k] = g * w0.x; gwfT[1 * DM + k] = g * w0.y; gwfT[2 * DM + k] = g * w0.z; gwfT[3 * DM + k] = g * w0.w; gwfT[4 * DM + k] = g * w1.x; gwfT[5 * DM + k] = g * w1.y; gwfT[6 * DM + k] = g * w1.z; gwfT[7 * DM + k] = g * w1.w; }
      __syncthreads();
      bf16_t* XN = (bf16_t*)(F.ws + WS_XN); float* flog = (float*)(F.ws + WS_FLOG);
      f32x4 gv[8];
#pragma unroll
      for (int j = 0; j < 8; ++j) gv[j] = *((const f32x4*)g_attn + ((int)(threadIdx.x & 63)) + 64 * j);
      f32x4 vn[8];
      if (gw < MTOK) { const f32x4* xr = (const f32x4*)(x + (size_t)gw * DM) + ((int)(threadIdx.x & 63));
#pragma unroll
          for (int j = 0; j < 8; ++j) vn[j] = __builtin_nontemporal_load(xr + 64 * j); }
      for (int m = gw; m < MTOK; m += NGW) {
          f32x4 v[8]; float s = 0.f;
#pragma unroll
          for (int j = 0; j < 8; ++j) { v[j] = vn[j]; s += (v[j].x * v[j].x + v[j].y * v[j].y) + (v[j].z * v[j].z + v[j].w * v[j].w); }
          if (m + NGW < MTOK) { const f32x4* xr = (const f32x4*)(x + (size_t)(m + NGW) * DM) + ((int)(threadIdx.x & 63));
#pragma unroll
              for (int j = 0; j < 8; ++j) vn[j] = __builtin_nontemporal_load(xr + 64 * j); }
          const float rstd = 1.0f / sqrtf(wave_sum(s) * (1.0f / DM) + EPS);
          unsigned long long* o8 = (unsigned long long*)(XN + (size_t)m * DM) + ((int)(threadIdx.x & 63));
#pragma unroll
          for (int j = 0; j < 8; ++j) { const f32x4 t = v[j] * gv[j] * rstd; o8[64 * j] = (unsigned long long)pk2(t.x, t.y) | ((unsigned long long)pk2(t.z, t.w) << 32); }
          float myz = 0.f;
#pragma unroll 1
          for (int jh = 0; jh < 8; ++jh) { float acc = 0.f;
#pragma unroll
              for (int j = 0; j < 8; ++j) { const f32x4 w = *(const LAS f32x4*)(gwfT + jh * DM + 256 * j + 4 * ((int)(threadIdx.x & 63))); acc += (v[j].x * w.x + v[j].y * w.y) + (v[j].z * w.z + v[j].w * w.w); }
              acc = wave_sum(acc); if (((int)(threadIdx.x & 63)) == jh) myz = acc; }
          if (((int)(threadIdx.x & 63)) < 8) flog[(size_t)m * 8 + ((int)(threadIdx.x & 63))] = log2_sigmoid(myz * rstd + b_forget[((int)(threadIdx.x & 63))]);
      }
      __syncthreads();
    }
    { LAS float* scr = (LAS float*)(F.lds + F.wave * 16384);
      bf16_t* Win = (bf16_t*)(F.ws + WS_WIN); bf16_t* Wout = (bf16_t*)(F.ws + WS_WOUT); bf16_t* Wgu = (bf16_t*)(F.ws + WS_WGU); bf16_t* Wd = (bf16_t*)(F.ws + WS_WD);
      constexpr int I_IN = 32 * 96, I_OUT = 32 * 32, I_GU = NE * 32 * 64, I_D = NE * 32 * 32, NITEMS = I_IN + I_OUT + I_GU + I_D;
      for (int it = gw; it < NITEMS; it += NGW) {
          int r = it;
          if (r < I_IN) { const int kb = r / 96, nb = r % 96, n0 = nb * 64;
              if (n0 < 2048) { const int base = n0 & ~127, i0 = ((n0 >> 6) & 1) * 32; tr_item(w_in, INC, kb * 64, base + i0, base + 64 + i0, true, Win + (size_t)n0 * DM, scr, ((int)(threadIdx.x & 63))); }
              else tr_item(w_in, INC, kb * 64, n0, n0 + 32, false, Win + (size_t)n0 * DM, scr, ((int)(threadIdx.x & 63)));
              continue; }
          r -= I_IN;
          if (r < I_OUT) { const int kb = r / 32, nb = r % 32; tr_item(w_out, DM, kb * 64, nb * 64, nb * 64 + 32, false, Wout + (size_t)nb * 64 * DM, scr, ((int)(threadIdx.x & 63))); continue; }
          r -= I_OUT;
#if MK_FP8
          break;
#else
          if (r < I_GU) { const int e = r / (32 * 64), rr = r % (32 * 64), kb = rr / 64, nb = rr % 64;
              const int pn = nb >> 2, w = nb & 3; const float* src = (w < 2 ? w_gate : w_up) + (size_t)e * DM * DM; const int c0 = pn * 128 + (w & 1) * 64;
              tr_item(src, DM, kb * 64, c0, c0 + 32, false, Wgu + ((size_t)e * 4096 + (size_t)nb * 64) * DM, scr, ((int)(threadIdx.x & 63))); continue; }
          r -= I_GU;
          { const int e = r / (32 * 32), rr = r % (32 * 32), kb = rr / 32, nb = rr % 32;
            tr_item(w_down + (size_t)e * DM * DM, DM, kb * 64, nb * 64, nb * 64 + 32, false, Wd + ((size_t)e * DM + (size_t)nb * 64) * DM, scr, ((int)(threadIdx.x & 63))); }
#endif
      }
    }
}

__device__ __forceinline__ void probe_stream(Frame& F, KArgs ka) {
    const float* src[3] = {(const float*)KIN(15), (const float*)KIN(17), (const float*)KIN(19)};
    const size_t n4 = (size_t)NE * DM * DM / 4; const size_t gt = (size_t)F.vcu * NTHREADS + threadIdx.x, NGT = (size_t)F.G * NTHREADS;
#pragma unroll
    for (int m = 0; m < 3; ++m) { unsigned* dst = (unsigned*)(F.ws + WS_HDN) + (size_t)m * n4;
#pragma unroll 8
        for (size_t i = gt; i < n4; i += NGT) { const f32x4 v = __builtin_nontemporal_load((const f32x4*)src[m] + i); dst[i] = pk_fp8x4(v.x * 256.f, v.y * 256.f, v.z * 256.f, v.w * 256.f); } }
}
#if MK_FP8
#if MK_FP6
#define P0B_STORE(v, k0, dst, scr, lane) tr6_store(v, k0, dst, scr, lane)
#else
#define P0B_STORE(v, k0, dst, scr, lane) tr8_store(v, k0, dst, scr, lane)
#endif
constexpr int P0B_ROWB = DM;
constexpr int P0B_IGU = NE * 32 * 64, P0B_ID = NE * 32 * 32, P0B_NI = P0B_IGU + P0B_ID;
__device__ __forceinline__ void p0b_experts(Frame& F, KArgs ka, const int it_lo, const int it_hi, const int rankw, const int nw, unsigned* dyn) {
    const float* w_gate = (const float*)KIN(15); const float* w_up = (const float*)KIN(17); const float* w_down = (const float*)KIN(19);
    constexpr int I_GU = P0B_IGU;
    LAS float* scr = (LAS float*)(F.lds + F.wave * 16384);
    bf16_t* Wgu = (bf16_t*)(F.ws + WS_WGU); bf16_t* Wd = (bf16_t*)(F.ws + WS_WD);
    __syncthreads();
      { const int lane = (int)(threadIdx.x & 63);
#define FP8_DESC(r_, SRC, K0, C0, DST) do { int r2 = (r_); \
          if (r2 < I_GU) { const int e = r2 / (16 * 128), rr = r2 % (16 * 128), kb = rr / 128, nb = rr % 128; const int pn = nb >> 3, w = nb & 7; \
              SRC = (w < 4 ? w_gate : w_up) + (size_t)e * DM * DM; C0 = pn * 128 + (w & 3) * 32; K0 = kb * 128; const size_t row = (size_t)e * 4096 + (size_t)nb * 32; \
              DST = (unsigned char*)Wgu + row * P0B_ROWB; } \
          else { r2 -= I_GU; const int e = r2 / (16 * 64), rr = r2 % (16 * 64), kb = rr / 64, nb = rr % 64; \
              SRC = w_down + (size_t)e * DM * DM; C0 = nb * 32; K0 = kb * 128; const size_t row = (size_t)e * DM + (size_t)nb * 32; \
              DST = (unsigned char*)Wd + row * P0B_ROWB; } } while (0)
        f32x4 va[16], vb[16]; const float* src; int k0 = 0, c0 = 0; unsigned char* dst = nullptr; const float* srcn; int k0n = 0, c0n = 0; unsigned char* dstn = nullptr;
#if MK_FP6
#define P0B_NEXT(last) (dyn != nullptr ? it_lo + __builtin_amdgcn_readfirstlane(lane == 0 ? (int)__hip_atomic_fetch_add(dyn, 1u, __ATOMIC_RELAXED, __HIP_MEMORY_SCOPE_AGENT) : 0) : (last) + nw)
        int last = P0B_NEXT(it_lo + rankw - nw), ia = last;
        if (ia < it_hi) { FP8_DESC(ia, src, k0, c0, dst); tr8_load(va, src, DM, k0, c0, lane); }
        last = P0B_NEXT(last); int ib = last;
        if (ib < it_hi) { FP8_DESC(ib, srcn, k0n, c0n, dstn); tr8_load(vb, srcn, DM, k0n, c0n, lane); }
        for (;;) {
            if (ia >= it_hi) break;
            { tr6_put(va, scr, lane); const int ke = k0; unsigned char* de = dst;
              last = P0B_NEXT(last); ia = last;
              if (ia < it_hi) { FP8_DESC(ia, src, k0, c0, dst); tr8_load(va, src, DM, k0, c0, lane); }
              tr6_emit(ke, de, scr, lane); }
            if (ib >= it_hi) break;
            { tr6_put(vb, scr, lane); const int ke = k0n; unsigned char* de = dstn;
              last = P0B_NEXT(last); ib = last;
              if (ib < it_hi) { FP8_DESC(ib, srcn, k0n, c0n, dstn); tr8_load(vb, srcn, DM, k0n, c0n, lane); }
              tr6_emit(ke, de, scr, lane); }
        }
#undef P0B_NEXT
#else
        const int NGW = nw; int it = it_lo + rankw;
        if (it < it_hi) { FP8_DESC(it, src, k0, c0, dst); tr8_load(va, src, DM, k0, c0, lane); }
        while (it < it_hi) {
            int itn = it + NGW;
            if (itn < it_hi) { FP8_DESC(itn, srcn, k0n, c0n, dstn); tr8_load(vb, srcn, DM, k0n, c0n, lane); }
            P0B_STORE(va, k0, dst, scr, lane);
            it = itn; if (it >= it_hi) break;
            itn = it + NGW;
            if (itn < it_hi) { FP8_DESC(itn, src, k0, c0, dst); tr8_load(va, src, DM, k0, c0, lane); }
            P0B_STORE(vb, k0n, dstn, scr, lane);
            it = itn;
        }
#endif
#undef FP8_DESC
      }
    __syncthreads();
}
#endif
__device__ __forceinline__ void p1_scan(Frame& F) {
    if (blockIdx.x >= BATCH * 8) return;
    const int bh = blockIdx.x, b = bh >> 3, h = bh & 7, t = ((int)threadIdx.x);
    const float* flog = (const float*)(F.ws + WS_FLOG); float* clog = (float*)(F.ws + WS_CLOG) + (size_t)bh * SEQ;
    LAS double* sc = (LAS double*)F.lds;
    double loc[8]; double run = 0.0;
#pragma unroll
    for (int i = 0; i < 8; ++i) { run += (double)flog[(size_t)(b * SEQ + t * 8 + i) * 8 + h]; loc[i] = run; }
    double v = run; const int ln = t & 63, wv = t >> 6;
#pragma unroll
    for (int o = 1; o < 64; o <<= 1) { const double n = __shfl_up(v, o); v = ln >= o ? v + n : v; }
    if (ln == 63) sc[wv] = v;
    __syncthreads();
    double base = v - run;
#pragma unroll
    for (int w = 0; w < NWAVES - 1; ++w) { const double wt = sc[w]; base += w < wv ? wt : 0.0; }
#pragma unroll
    for (int i = 0; i < 8; ++i) clog[t * 8 + i] = (float)(base + loc[i]);
    __syncthreads();
}

__device__ __forceinline__ void p_norms(Frame& F) {
    const bf16_t* QKV = (const bf16_t*)(F.ws + WS_QKV);
    const int lane = (int)(threadIdx.x & 63), gw = F.vcu * NWAVES + F.wave, NGW = F.G * NWAVES;
    for (int task = gw; task < 2 * 32 * 16; task += NGW) {
        const int isk = task >> 9, bh = (task >> 4) & 31, ch = task & 15, b = bh >> 3, h = bh & 7;
        const bf16_t* base = QKV + ((size_t)((isk ? 32 : 24) + h) * MTOK + (size_t)b * SEQ + ch * 256) * 128 + (lane >> 4) * 128 + (lane & 15) * 8;
        float mx = 0.f;
#pragma unroll 4
        for (int it = 0; it < 64; ++it) {
            const u32x4 w = *(const u32x4*)(base + (size_t)it * 4 * 128);
            float ss = 0.f;
#pragma unroll
            for (int j = 0; j < 4; ++j) { const float a = bf2f((unsigned short)(w[j] & 0xffff)), c = bf2f((unsigned short)(w[j] >> 16)); ss += a * a + c * c; }
            ss += __shfl_xor(ss, 1); ss += __shfl_xor(ss, 2); ss += __shfl_xor(ss, 4); ss += __shfl_xor(ss, 8);
            mx = fmaxf(mx, ss);
        }
        mx = fmaxf(mx, __shfl_xor(mx, 16)); mx = fmaxf(mx, __shfl_xor(mx, 32));
        if (lane == 0) atomicMax((unsigned*)(F.ctl + (isk ? CW_KMAX + bh : CW_QMAX + bh * 16 + ch)), __float_as_uint(mx));
    }
}

__device__ __forceinline__ void p3_mix(Frame& F, KArgs ka) {
    const float* lq1 = (const float*)KIN(5); const float* lk1 = (const float*)KIN(6); const float* lq2 = (const float*)KIN(7); const float* lk2 = (const float*)KIN(8);
    const float* gd = (const float*)KIN(9); const float* gf = (const float*)KIN(10);
    const int l = ((int)(threadIdx.x & 63));
    const float s1 = wave_sum(lq1[l] * lk1[l] + lq1[l + 64] * lk1[l + 64]), s2 = wave_sum(lq2[l] * lk2[l] + lq2[l + 64] * lk2[l + 64]);
    const float lam = expf(s1) - expf(s2) + 0.2f;
    const bf16_t* O = (const bf16_t*)(F.ws + WS_O); bf16_t* mix = (bf16_t*)(F.ws + WS_MIX);
    const f32x2 gd0 = *(const f32x2*)(gd + 2 * l), gd1 = *(const f32x2*)(gd + 128 + 2 * l), gfv = *(const f32x2*)(gf + 2 * l);
    const int gw = F.vcu * NWAVES + F.wave, NGW = F.G * NWAVES;
    for (int m = gw; m < MTOK; m += NGW) {
        unsigned ov[24];
#pragma unroll
        for (int vh = 0; vh < 24; ++vh) ov[vh] = *(const unsigned*)(O + ((size_t)vh * MTOK + m) * 128 + 2 * l);
        unsigned* mrow = (unsigned*)(mix + (size_t)m * DM);
#pragma unroll
        for (int h = 0; h < 4; ++h) {
            const unsigned a0 = ov[8 + h * 4 + 0], a1 = ov[8 + h * 4 + 1], b0 = ov[8 + h * 4 + 2], b1 = ov[8 + h * 4 + 3];
            const float d00 = bf2f(a0 & 0xffff) - lam * bf2f(b0 & 0xffff), d01 = bf2f(a0 >> 16) - lam * bf2f(b0 >> 16);
            const float d10 = bf2f(a1 & 0xffff) - lam * bf2f(b1 & 0xffff), d11 = bf2f(a1 >> 16) - lam * bf2f(b1 >> 16);
            const float ss = wave_sum((d00 * d00 + d01 * d01) + (d10 * d10 + d11 * d11));
            const float rs = 0.8f / sqrtf(ss * (1.0f / 256.0f) + EPS);
            mrow[(h * 256) / 2 + l] = pk2(d00 * rs * gd0.x, d01 * rs * gd0.y);
            mrow[(h * 256 + 128) / 2 + l] = pk2(d10 * rs * gd1.x, d11 * rs * gd1.y);
        }
#pragma unroll
        for (int h = 0; h < 8; ++h) {
            const float f0 = bf2f(ov[h] & 0xffff), f1 = bf2f(ov[h] >> 16);
            const float ss = wave_sum(f0 * f0 + f1 * f1);
            const float rs = 1.0f / sqrtf(ss * (1.0f / 128.0f) + EPS);
            mrow[(1024 + h * 128) / 2 + l] = pk2(f0 * rs * gfv.x, f1 * rs * gfv.y);
        }
    }
}

__device__ __forceinline__ void p5_router(Frame& F, KArgs ka, const float* hbuf) {
    const float* b_router = (const float*)KIN(14);
    const bf16_t* gwf = (const bf16_t*)(F.ws + WS_GWF);
    int* tke = (int*)(F.ws + WS_TKE); int* tokl = (int*)(F.ws + WS_TOK); float* rstdl = (float*)(F.ws + WS_RSTD); float* gatel = (float*)(F.ws + WS_GATE);
    LAS float* sc = (LAS float*)(F.lds + F.wave * 4096);
    const int l = ((int)(threadIdx.x & 63)), r16 = l & 15, kq = l >> 4;
    const int gw = F.vcu * NWAVES + F.wave, NGW = F.G * NWAVES;
    if (((int)threadIdx.x) < NE) ((LAS int*)(F.lds + 8 * 4096))[((int)threadIdx.x)] = 0;
    __syncthreads();
    for (int item = gw; item < MTOK / 8; item += NGW) {
        const int tile = item >> 1, kh = item & 1;
        const float* hr = hbuf + (size_t)(tile * 16 + r16) * DM + 8 * kq + 1024 * kh;
        f32x4 acc0 = {0.f, 0.f, 0.f, 0.f}, acc1 = {0.f, 0.f, 0.f, 0.f}; float ss = 0.f;
        f32x4 va[2][4], vb[2][4];
#define P5_LOAD(bf_, s4_) do { _Pragma("unroll") for (int u = 0; u < 4; ++u) { va[bf_][u] = __builtin_nontemporal_load((const f32x4*)(hr + 32 * (4 * (s4_) + u))); vb[bf_][u] = __builtin_nontemporal_load((const f32x4*)(hr + 32 * (4 * (s4_) + u) + 4)); } } while (0)
        P5_LOAD(0, 0);
#pragma unroll 1
        for (int s8 = 0; s8 < 8; s8 += 2) {
#pragma unroll
          for (int hb_ = 0; hb_ < 2; ++hb_) { const int s4 = s8 + hb_;
            if (hb_ == 0) P5_LOAD(1, s4 + 1); else if (s4 < 7) P5_LOAD(0, s4 + 1);
#pragma unroll
            for (int u = 0; u < 4; ++u) { const f32x4 v0 = va[hb_][u], v1 = vb[hb_][u];
            ss += (v0.x * v0.x + v0.y * v0.y) + (v0.z * v0.z + v0.w * v0.w) + (v1.x * v1.x + v1.y * v1.y) + (v1.z * v1.z + v1.w * v1.w);
            unsigned hi[4], lo[4];
#define SPL(i, A, B) do { const unsigned ha = f2bf(A), hb = f2bf(B); hi[i] = ha | (hb << 16); lo[i] = pk2(A - bf2f((unsigned short)ha), B - bf2f((unsigned short)hb)); } while (0)
            SPL(0, v0.x, v0.y); SPL(1, v0.z, v0.w); SPL(2, v1.x, v1.y); SPL(3, v1.z, v1.w);
#undef SPL
            const u32x4 hiv = {hi[0], hi[1], hi[2], hi[3]}, lov = {lo[0], lo[1], lo[2], lo[3]};
            const bf16x8 ah = __builtin_bit_cast(bf16x8, hiv), al = __builtin_bit_cast(bf16x8, lov);
            const bf16x8* bf = (const bf16x8*)(gwf + (size_t)(32 * kh + 4 * s4 + u) * 4 * 512) + l;
            const bf16x8 b0h = bf[0], b0l = bf[64], b1h = bf[128], b1l = bf[192];
            acc0 = __builtin_amdgcn_mfma_f32_16x16x32_bf16(ah, b0h, acc0, 0, 0, 0); acc0 = __builtin_amdgcn_mfma_f32_16x16x32_bf16(al, b0h, acc0, 0, 0, 0); acc0 = __builtin_amdgcn_mfma_f32_16x16x32_bf16(ah, b0l, acc0, 0, 0, 0);
            acc1 = __builtin_amdgcn_mfma_f32_16x16x32_bf16(ah, b1h, acc1, 0, 0, 0); acc1 = __builtin_amdgcn_mfma_f32_16x16x32_bf16(al, b1h, acc1, 0, 0, 0); acc1 = __builtin_amdgcn_mfma_f32_16x16x32_bf16(ah, b1l, acc1, 0, 0, 0);
            }
          }
        }
#undef P5_LOAD
        { LAS float* px = (LAS float*)(F.lds + (F.wave | 1) * 4096) + 9 * l;
          if (kh) { px[0] = acc0[0]; px[1] = acc0[1]; px[2] = acc0[2]; px[3] = acc0[3]; px[4] = acc1[0]; px[5] = acc1[1]; px[6] = acc1[2]; px[7] = acc1[3]; px[8] = ss; }
          __syncthreads();
          if (!kh) { acc0[0] += px[0]; acc0[1] += px[1]; acc0[2] += px[2]; acc0[3] += px[3]; acc1[0] += px[4]; acc1[1] += px[5]; acc1[2] += px[6]; acc1[3] += px[7]; ss += px[8]; } }
        if (kh == 0) {
        ss += __shfl_xor(ss, 16); ss += __shfl_xor(ss, 32);
        const float rstd = 1.0f / sqrtf(ss * (1.0f / DM) + EPS);
        if (kq == 0) sc[16 * 33 + r16] = rstd;
        LDS_WAIT(); asm volatile("" ::: "memory");
#pragma unroll
        for (int rg = 0; rg < 4; ++rg) { const int tr = 4 * kq + rg; const float rt = sc[16 * 33 + tr];
            sc[tr * 33 + r16] = acc0[rg] * rt + b_router[r16]; sc[tr * 33 + 16 + r16] = acc1[rg] * rt + b_router[16 + r16]; }
        LDS_WAIT(); asm volatile("" ::: "memory");
        }
        LAS int* cntL = (LAS int*)(F.lds + 8 * 4096); LAS int* baseL = cntL + 32;
        int m = 0, ti[TOPK] = {0, 0, 0, 0}, rk[TOPK] = {0, 0, 0, 0}; float gk[TOPK] = {0.f, 0.f, 0.f, 0.f}, rt = 0.f;
        const bool sel = kh == 0 && l < 16;
        if (sel) {
            m = tile * 16 + l; float lg[NE];
#pragma unroll
            for (int e = 0; e < NE; ++e) lg[e] = sc[l * 33 + e];
            float tv[TOPK];
#pragma unroll
            for (int k = 0; k < TOPK; ++k) { float best = -3.4e38f; int bi = 0;
#pragma unroll
                for (int e = 0; e < NE; ++e) { const bool c = lg[e] > best; best = c ? lg[e] : best; bi = c ? e : bi; }
                tv[k] = best; ti[k] = bi;
#pragma unroll
                for (int e = 0; e < NE; ++e) lg[e] = (e == bi) ? -3.4e38f : lg[e]; }
            const float e1 = __expf(tv[1] - tv[0]), e2 = __expf(tv[2] - tv[0]), e3 = __expf(tv[3] - tv[0]); const float inv = 1.0f / (1.0f + e1 + e2 + e3);
            gk[0] = inv; gk[1] = e1 * inv; gk[2] = e2 * inv; gk[3] = e3 * inv; rt = sc[16 * 33 + l];
#pragma unroll
            for (int k = 0; k < TOPK; ++k) rk[k] = __hip_atomic_fetch_add((int*)(cntL + ti[k]), 1, __ATOMIC_RELAXED, __HIP_MEMORY_SCOPE_WORKGROUP);
        }
        LDS_WAIT(); asm volatile("" ::: "memory");
        __syncthreads();
        if (((int)threadIdx.x) < NE) { const int c = cntL[((int)threadIdx.x)]; int b = 0;
            if (c > 0) b = (int)__hip_atomic_fetch_add((unsigned*)(F.ctl + CW_CNT + 64 * ((int)threadIdx.x)), (unsigned)c, RLX_AGENT);
            baseL[((int)threadIdx.x)] = b; cntL[((int)threadIdx.x)] = 0; }
        LDS_WAIT(); asm volatile("" ::: "memory");
        __syncthreads();
        if (sel) {
#pragma unroll
            for (int k = 0; k < TOPK; ++k) { const int e = ti[k]; const int pos = baseL[e] + rk[k];
                tokl[(size_t)e * ECAP + pos] = m; rstdl[(size_t)e * ECAP + pos] = rt; gatel[(size_t)e * ECAP + pos] = gk[k]; tke[m * TOPK + k] = pos * 32 + e; }
        }
        LDS_WAIT(); asm volatile("" ::: "memory");
        __syncthreads();
    }
}

__device__ __forceinline__ void build_tab(Frame& F, LAS int* tab, bool publish) {
    if (((int)threadIdx.x) < NE) tab[NE + 1 + ((int)threadIdx.x)] = (int)__hip_atomic_load(F.ctl + CW_CNT + 64 * ((int)threadIdx.x), RLX_AGENT);
    __syncthreads();
    if (((int)threadIdx.x) == 0) { int s = 0; for (int e = 0; e < NE; ++e) { tab[e] = s; s += (tab[NE + 1 + e] + 255) >> 8; } tab[NE] = s; }
    __syncthreads();
    if (publish && blockIdx.x == 0 && ((int)threadIdx.x) <= NE) ((int*)(F.ws + WS_TSTART))[((int)threadIdx.x)] = tab[((int)threadIdx.x)];
}

__device__ __forceinline__ void p8_final(Frame& F, KArgs ka, float* hout) {
    const float* gfin = (const float*)KIN(21);
    const bf16_t* ys = (const bf16_t*)(F.ws + WS_YS); const int* tke = (const int*)(F.ws + WS_TKE); const int* tstart = (const int*)(F.ws + WS_TSTART);
    const int gw = F.vcu * NWAVES + F.wave, NGW = F.G * NWAVES;
    f32x4 gv[8];
#pragma unroll
    for (int j = 0; j < 8; ++j) gv[j] = *((const f32x4*)gfin + ((int)(threadIdx.x & 63)) + 64 * j);
    for (int m = gw; m < MTOK; m += NGW) {
        f32x4* hr = (f32x4*)(hout + (size_t)m * DM) + ((int)(threadIdx.x & 63));
        f32x4 v[8];
#pragma unroll
        for (int j = 0; j < 8; ++j) v[j] = hr[64 * j];
#pragma unroll
        for (int k = 0; k < TOPK; ++k) { const int code = tke[m * TOPK + k]; const int e = code & 31, pos = code >> 5; const size_t slot = (size_t)tstart[e] * 256 + pos;
#if MK_YS8
            const unsigned* yr = (const unsigned*)((const unsigned char*)ys + slot * DM) + ((int)(threadIdx.x & 63)); constexpr float ysc = 1.0f / (float)(1 << FP8_YSHIFT);
#pragma unroll
            for (int j = 0; j < 8; ++j) { const unsigned w = yr[64 * j]; const f32x2 lo = __builtin_amdgcn_cvt_pk_f32_fp8((int)w, false), hi = __builtin_amdgcn_cvt_pk_f32_fp8((int)w, true);
                v[j].x += lo.x * ysc; v[j].y += lo.y * ysc; v[j].z += hi.x * ysc; v[j].w += hi.y * ysc; } }
#else
            const u32x2* yr = (const u32x2*)(ys + slot * DM) + ((int)(threadIdx.x & 63));
#pragma unroll
            for (int j = 0; j < 8; ++j) { const u32x2 w = yr[64 * j]; v[j].x += bf2f(w.x & 0xffff); v[j].y += bf2f(w.x >> 16); v[j].z += bf2f(w.y & 0xffff); v[j].w += bf2f(w.y >> 16); } }
#endif
        float s = 0.f;
#pragma unroll
        for (int j = 0; j < 8; ++j) s += (v[j].x * v[j].x + v[j].y * v[j].y) + (v[j].z * v[j].z + v[j].w * v[j].w);
        const float rstd = 1.0f / sqrtf(wave_sum(s) * (1.0f / DM) + EPS);
#pragma unroll
        for (int j = 0; j < 8; ++j) hr[64 * j] = v[j] * gv[j] * rstd;
    }
}
template <bool FOX>
__device__ __forceinline__ att::BlockRef attn_ref(const Frame& F, int L, int pass) {
    const int xcd = L & 7, k = L >> 3, x = k & 7, qb = pass ? 15 - x : x;
    att::BlockRef r;
    if constexpr (FOX) {
        const int bh = xcd * 4 + (k >> 3), b = bh >> 3, h = bh & 7;
        r.Q = (unsigned)WS_QKV + (unsigned)(((24 + h) * MTOK + b * SEQ + qb * 256) * 256); r.K = (unsigned)WS_QKV + (unsigned)(((32 + h) * MTOK + b * SEQ) * 256);
        r.V = (unsigned)WS_QKV + (unsigned)(((40 + h) * MTOK + b * SEQ) * 256); r.O = (unsigned)WS_O + (unsigned)((h * MTOK + b * SEQ + qb * 256) * 256);
        r.clog = (unsigned)WS_CLOG + (unsigned)((b * 8 + h) * SEQ * 4);
        { const float qm2 = __uint_as_float(__hip_atomic_load((unsigned*)(F.ctl + CW_QMAX + bh * 16 + qb), RLX_AGENT)), km2 = __uint_as_float(__hip_atomic_load((unsigned*)(F.ctl + CW_KMAX + bh), RLX_AGENT));
          const float bound = (MK_FUSE_NORMS ? 2.02f : 2.002f) * sqrtf(qm2 * km2) + FOX_SKIP_T;       const float* clg = (const float*)(F.ws + WS_CLOG) + (size_t)(b * 8 + h) * SEQ;
          int lane; asm volatile("v_mbcnt_lo_u32_b32 %0, -1, 0\n\tv_mbcnt_hi_u32_b32 %0, -1, %0" : "=v"(lane));
          const int ntb = qb * 4;
          bool skip = false; if (lane < ntb) skip = (bound + clg[qb * 256] - clg[64 * lane + 63]) <= 0.f;
          r.jlo = (int)__popcll(__ballot(skip)) & ~1; }
    } else {
        const int vhb = xcd * 8 + (k >> 3), b = vhb >> 4, vv = vhb & 15, h = vv >> 2, mp = (vv >> 1) & 1, vhalf = vv & 1;
        r.Q = (unsigned)WS_QKV + (unsigned)(((h * 2 + mp) * MTOK + b * SEQ + qb * 256) * 256); r.K = (unsigned)WS_QKV + (unsigned)(((8 + h * 2 + mp) * MTOK + b * SEQ) * 256);
        r.V = (unsigned)WS_QKV + (unsigned)(((16 + h * 2 + vhalf) * MTOK + b * SEQ) * 256); r.O = (unsigned)WS_O + (unsigned)(((8 + vv) * MTOK + b * SEQ + qb * 256) * 256);
        r.clog = 0u; r.jlo = 0;
    }
    r.P0 = qb * 256;
    return r;
}
template <bool FOX>
__device__ __forceinline__ void attn_run(const Frame& F, char* lds) {
    constexpr int total = FOX ? 256 : 512;
    int L = blockIdx.x; if (L >= total) return;
    int pass = 0; const int stride = F.G;
    att::BlockRef cur = attn_ref<FOX>(F, L, 0);
    att::Seam S;
    att::attn_prime(F.ws, cur, lds, S);
    for (;;) {
        const bool more_pass = pass == 0, more_item = L + stride < total, last = !more_pass && !more_item;
        int passn = pass + 1, Ln = L;
        if (!more_pass) { passn = 0; Ln = more_item ? L + stride : L; }
        const int Lr = last ? L : Ln, pr = last ? pass : passn;
        auto nref = [&F, Lr, pr]() { return attn_ref<FOX>(F, Lr, pr); };
        att::attn_block<FOX>(F.ws, cur, nref, lds, S);
        if (last) break;
        pass = passn; L = Ln; cur = attn_ref<FOX>(F, L, pass);
    }
}

__device__ __forceinline__ att::BlockRefW attn_refW(int L, int pass) {
    const int xcd = L & 7, k = L >> 3, x = k & 7, qb = pass ? 15 - x : x;
    const int bhm = xcd * 4 + (k >> 3), b = bhm >> 3, hm = bhm & 7, h = hm >> 1, mp = hm & 1;
    att::BlockRefW r;
    r.Q = (unsigned)WS_QKV + (unsigned)(((h * 2 + mp) * MTOK + b * SEQ + qb * 256) * 256); r.K = (unsigned)WS_QKV + (unsigned)(((8 + h * 2 + mp) * MTOK + b * SEQ) * 256);
    r.V0 = (unsigned)WS_QKV + (unsigned)(((16 + h * 2) * MTOK + b * SEQ) * 256); r.V1 = (unsigned)WS_QKV + (unsigned)(((17 + h * 2) * MTOK + b * SEQ) * 256);
    r.O0 = (unsigned)WS_O + (unsigned)(((8 + h * 4 + mp * 2) * MTOK + b * SEQ + qb * 256) * 256); r.O1 = (unsigned)WS_O + (unsigned)(((9 + h * 4 + mp * 2) * MTOK + b * SEQ + qb * 256) * 256);
    r.P0 = qb * 256;
    return r;
}
__device__ __forceinline__ void attn_runW(const Frame& F, char* lds) {
    constexpr int total = 256;
    int L = blockIdx.x; if (L >= total) return;
    int pass = 0; const int stride = F.G;
    att::BlockRefW cur = attn_refW(L, 0);
    att::SeamW S;
    att::attn_primeW(F.ws, cur, lds, S);
    for (;;) {
        const bool more_pass = pass == 0, more_item = L + stride < total, last = !more_pass && !more_item;
        int passn = pass + 1, Ln = L;
        if (!more_pass) { passn = 0; Ln = more_item ? L + stride : L; }
        const int Lr = last ? L : Ln, pr = last ? pass : passn;
        auto nref = [Lr, pr]() { return attn_refW(Lr, pr); };
        att::attn_blockW(F.ws, cur, nref, lds, S);
        if (last) break;
        pass = passn; L = Ln; cur = attn_refW(L, pass);
    }
}

constexpr int NPHASE = 10;
#ifndef MK_BAL
#define MK_BAL 1
#endif
constexpr int MOE_RB = MK_FP8 ? DM : DM * 2;
#ifndef MK_ATT_MASK
#define MK_ATT_MASK 3
#endif
#ifndef MK_DIFFW
#define MK_DIFFW 1
#endif
#ifndef MK_KREP_LOG
#define MK_KREP_LOG 0
#endif
#ifndef MK_KROT
#define MK_KROT 0
#endif
#define MOE_ROT(c, nt) (MK_KROT ? (int)((((((c) >> 3) >> 2) * ((nt) / 8)) + ((((c) >> 3) & 3) * ((nt) / 4))) & ((nt) - 1)) : 0)
#ifndef MK_OVERLAP
#define MK_OVERLAP 1
#endif
#ifndef MK_P1_S1
#define MK_P1_S1 0.50
#define MK_P1_S2 1.0
#define MK_P3_S0 0.33
#define MK_P3_S1 0.66
#define MK_P3_S2 1.0
#endif
constexpr int CW_DYN = 48;
__device__ __forceinline__ void ph1(Frame& F, KArgs ka) {
#if MK_FP8 && MK_OVERLAP
    const int bx = (int)blockIdx.x, grp = (bx >> 3) & 1;
    const int rw = (((bx & 7) * 16 + (bx >> 4)) * NWAVES) + F.wave, nw = (F.G / 2) * NWAVES;
    constexpr int X1 = (int)(P0B_IGU * MK_P1_S1), X2 = (int)(P0B_IGU * MK_P1_S2);
    if (grp == 1) p0b_experts(F, ka, 0, X1, rw, nw, nullptr);
#endif
    p1_scan(F);
    pg8::DenseOrder S; S.init((const bf16_t*)(F.ws + WS_XN), (const bf16_t*)(F.ws + WS_WIN), MTOK, NQKV, DM * 2, F.G, (int)blockIdx.x);
    pg8::EpiQKV E{(bf16_t*)(F.ws + WS_QKV), (const float*)(F.ws + WS_ROPE), (unsigned*)F.ctl, (LAS float*)(F.lds + RING_BYTES + 2048)};
    pg8::gemm_phase<pg8::EpiQKV, pg8::DenseOrder, false>(F.lds, F.lds + LDS_IDX, DM * 2, S, E);
#if MK_FP8 && MK_OVERLAP
    if (grp == 0) p0b_experts(F, ka, X1, X2, rw, nw, nullptr);
    if constexpr (X2 < P0B_IGU) p0b_experts(F, ka, X2, P0B_IGU, 0, 1, (unsigned*)F.ctl + CW_DYN);
#endif
}
__device__ __forceinline__ void ph2(Frame& F, KArgs ka, char* lds) {
#if MK_FP8 && MK_OVERLAP
    const int bx = (int)blockIdx.x, j = bx >> 3, cshift = j % 3, ng = cshift < 2 ? 11 : 10;
    const int rw = (((bx & 7) * ng + j / 3) * NWAVES) + F.wave, nw = 8 * ng * NWAVES;
    constexpr int L = P0B_NI - P0B_IGU, Y0 = P0B_IGU + (int)(L * MK_P3_S0), Y1 = P0B_IGU + (int)(L * MK_P3_S1), Y2 = P0B_IGU + (int)(L * MK_P3_S2);
    if (cshift == 0) p0b_experts(F, ka, P0B_IGU, Y0, rw, nw, nullptr);
#endif
    if (MK_ATT_MASK & 1) attn_run<true>(F, lds);
    __syncthreads();
#if MK_FP8 && MK_OVERLAP
    if (cshift == 1) p0b_experts(F, ka, Y0, Y1, rw, nw, nullptr);
#endif
#if MK_DIFFW
    if (MK_ATT_MASK & 2) attn_runW(F, lds);
#else
    if (MK_ATT_MASK & 2) attn_run<false>(F, lds);
#endif
#if MK_FP8 && MK_OVERLAP
    if (cshift == 2) p0b_experts(F, ka, Y1, Y2, rw, nw, nullptr);
    if constexpr (Y2 < P0B_NI) p0b_experts(F, ka, Y2, P0B_NI, 0, 1, (unsigned*)F.ctl + CW_DYN + 1);
#endif
}
__device__ __forceinline__ void ph4(Frame& F, KArgs ka, float* hbuf) {
    pg8::DenseOrder S; S.init((const bf16_t*)(F.ws + WS_MIX), (const bf16_t*)(F.ws + WS_WOUT), MTOK, DM, DM * 2, F.G, (int)blockIdx.x);
    pg8::EpiOut E{(const float*)KIN(0), hbuf, (bf16_t*)(F.ws + WS_HG), (const float*)KIN(12)};
    pg8::gemm_phase<pg8::EpiOut, pg8::DenseOrder, false, false, 127, 127, 1, false, false, (MK_XINIT != 0)>(F.lds, F.lds + LDS_IDX, DM * 2, S, E);
}
__device__ __forceinline__ void ph6(Frame& F, KArgs ka, LAS int* tab) {
    build_tab(F, tab, true);
    pg8::MoeOrder S; S.A = (const void*)(F.ws + WS_HG); S.Bt = (const void*)(F.ws + WS_WGU); S.RB = MOE_RB; S.nN = 16; S.NperE = 4096; S.G = F.G; S.c = (int)blockIdx.x; S.rot = MOE_ROT(blockIdx.x, MOE_RB / 128); S.tab = tab; S.tok = (const int*)(F.ws + WS_TOK);
    pg8::EpiGU E{(bf16_t*)(F.ws + WS_HDN), (const float*)KIN(16), (const float*)KIN(18), (const float*)(F.ws + WS_RSTD), tab, (const LAS float*)(F.lds + LDS_IDX + 2048)}; S.rowsc = (const float*)(F.ws + WS_RSTD);
    pg8::gemm_phase<pg8::EpiGU, pg8::MoeOrder, true, MK_FP8 != 0, 127 - FP8_WSHIFT - MK_KREP_LOG, 127 - FP8_HGSHIFT, (1 << MK_KREP_LOG), (MK_FP8 != 0 && MK_FP6 != 0), (MK_BAL != 0)>(F.lds, F.lds + LDS_IDX, MOE_RB, S, E);
}
__device__ __forceinline__ void ph7(Frame& F, KArgs ka, LAS int* tab) {
    build_tab(F, tab, false);
    pg8::MoeOrderDense S; S.A = (const void*)(F.ws + WS_HDN); S.Bt = (const void*)(F.ws + WS_WD); S.RB = MOE_RB; S.nN = 8; S.NperE = 2048; S.G = F.G; S.c = (int)blockIdx.x; S.rot = MOE_ROT(blockIdx.x, MOE_RB / 128); S.tab = tab; S.tok = nullptr;
    pg8::EpiDown E{(bf16_t*)(F.ws + WS_YS), (const float*)KIN(20), (const float*)(F.ws + WS_GATE), tab, (const LAS float*)(F.lds + LDS_IDX + 2048)}; S.rowsc = (const float*)(F.ws + WS_GATE);
    pg8::gemm_phase<pg8::EpiDown, pg8::MoeOrderDense, false, MK_FP8 != 0, 127 - FP8_WSHIFT - MK_KREP_LOG, 127 - FP8_HDSHIFT, (1 << MK_KREP_LOG), (MK_FP8 != 0 && MK_FP6 != 0), (MK_BAL != 0)>(F.lds, F.lds + LDS_IDX, MOE_RB, S, E);
}
__device__ __forceinline__ Frame make_frame(KArgs ka, LAS unsigned char* lds) {
    Frame F; F.lds = lds; F.wave = __builtin_amdgcn_readfirstlane(((int)threadIdx.x) >> 6);
    F.G = gridDim.x; { const int bx = blockIdx.x; F.vcu = (F.G % 8 == 0) ? (bx % 8) * (F.G / 8) + bx / 8 : bx; }
    unsigned char* ws = ka->ws; F.ws = ws; F.ctl = (gu32*)(ws + WS_CTL);
    return F;
}
__global__ void __launch_bounds__(NTHREADS, 2) mk_fwd(Args args) {
    extern __shared__ __attribute__((aligned(16))) unsigned char lds[];
    const KArgs ka = (KArgs)__builtin_amdgcn_kernarg_segment_ptr();
    { volatile LAS unsigned* MISC = (volatile LAS unsigned*)((LAS unsigned char*)lds + LDS_MISC);
      if (((int)threadIdx.x) < 32) MISC[((int)threadIdx.x)] = 0u;
      __syncthreads();
      if (ka->ph_hi - ka->ph_lo > 1) (void)xcd_barrier_post((unsigned*)((gu32*)(ka->ws + WS_CTL) + CW_BAR), MISC + 8); }
#ifndef MK_PHASE_MASK
#define MK_PHASE_MASK 0x3FF
#endif
#ifndef MK_REP_PHASE
#define MK_REP_PHASE -1
#endif
#define IN(k) ((((MK_PHASE_MASK) >> (k)) & 1) && ka->ph_lo <= (k) && (k) < ka->ph_hi)
#define GRIDBAR() do { XcdBarrier b_; b_.bar = (unsigned*)((gu32*)(ka->ws + WS_CTL) + CW_BAR); b_.x = xb_xcc_id(); b_.st = (volatile LAS unsigned*)((LAS unsigned char*)lds + LDS_MISC) + 8; xcd_barrier(b_); } while (0)
#ifdef MK_STAMP
#define SEAM(k) do { if (IN(k) && IN((k) + 1)) { unsigned long long ta_ = 0; if (threadIdx.x == 0) ta_ = wall_clock64(); GRIDBAR(); \
        if (threadIdx.x == 0) { const unsigned d_ = (unsigned)(wall_clock64() - ta_); atomicMax((unsigned*)((gu32*)(ka->ws + WS_CTL)) + 192 + (k), 0xffffffffu - d_); } } } while (0)
#else
#define SEAM(k) do { if (IN(k) && IN((k) + 1)) GRIDBAR(); } while (0)
#endif
#ifdef MK_STAMP
#ifndef MK_STAMP_GRP
#define MK_STAMP_GRP 0
#endif
#if MK_STAMP_GRP == 1
#define ST_GRP(k) ((int)(blockIdx.x & 7))
#elif MK_STAMP_GRP == 2
#define ST_GRP(k) ((int)(blockIdx.x < 32))
#else
#define ST_GRP(k) ((k) == 1 ? (int)((blockIdx.x >> 3) & 1) : (k) == 3 ? (int)((blockIdx.x >> 3) % 3) : 0)
#endif
#define RUN(k, CALL) do { if (IN(k)) { if (threadIdx.x == 0) { const unsigned long long t_ = wall_clock64(); volatile LAS unsigned* M_ = (volatile LAS unsigned*)((LAS unsigned char*)lds + LDS_MISC); M_[24] = (unsigned)t_; M_[25] = (unsigned)(t_ >> 32); } \
        { Frame F = make_frame(ka, (LAS unsigned char*)lds); LAS int* tab = (LAS int*)(F.lds + LDS_TAB); float* hbuf = ka->out; (void)tab; (void)hbuf; CALL; } \
        __syncthreads(); \
        if (threadIdx.x == 0) { volatile LAS unsigned* M_ = (volatile LAS unsigned*)((LAS unsigned char*)lds + LDS_MISC); const unsigned long long t0_ = (unsigned long long)M_[24] | ((unsigned long long)M_[25] << 32); \
            const unsigned d_ = (unsigned)(wall_clock64() - t0_); unsigned* c_ = (unsigned*)((gu32*)(ka->ws + WS_CTL)); atomicMax(c_ + 64 + (k), d_); atomicAdd(c_ + 80 + (k), d_); atomicAdd(c_ + 96 + 8 * (k) + ST_GRP(k), d_); } } } while (0)
#else
#define RUN(k, CALL) do { if (IN(k)) { Frame F = make_frame(ka, (LAS unsigned char*)lds); LAS int* tab = (LAS int*)(F.lds + LDS_TAB); float* hbuf = ka->out; (void)tab; (void)hbuf; CALL; \
        if (MK_REP_PHASE == (k)) { GRIDBAR(); CALL; } } } while (0)
#endif
#if MK_FP8 && !MK_OVERLAP
    RUN(0, (p0_prologue(F, ka), p0b_experts(F, ka, 0, P0B_NI, F.vcu * NWAVES + F.wave, F.G * NWAVES, nullptr)));
#else
    RUN(0, p0_prologue(F, ka));
#endif
#ifdef MK_PROBE_STREAM
    if (IN(0)) { GRIDBAR(); Frame F = make_frame(ka, (LAS unsigned char*)lds); probe_stream(F, ka); }
#endif
    SEAM(0);
    RUN(1, ph1(F, ka)); SEAM(1);
#if MK_FUSE_NORMS
#else
    RUN(2, p_norms(F)); SEAM(2);
#endif
    RUN(3, ph2(F, ka, (char*)lds)); SEAM(3);
    RUN(4, p3_mix(F, ka)); SEAM(4);
    RUN(5, ph4(F, ka, hbuf)); SEAM(5);
    RUN(6, p5_router(F, ka, hbuf)); SEAM(6);
    RUN(7, ph6(F, ka, tab)); SEAM(7);
    RUN(8, ph7(F, ka, tab)); SEAM(8);
    RUN(9, p8_final(F, ka, hbuf));
#ifdef MK_STAMP
    GRIDBAR();
    if (blockIdx.x == 0 && threadIdx.x == 0) { unsigned* c_ = (unsigned*)((gu32*)(ka->ws + WS_CTL)); constexpr int K_ = (MK_STAMP_SEL) / 100, J_ = (MK_STAMP_SEL) % 100;
        const float mx = 0.01f * (float)__hip_atomic_load(c_ + 64 + K_, __ATOMIC_RELAXED, __HIP_MEMORY_SCOPE_AGENT), mean = 0.01f * (float)__hip_atomic_load(c_ + 80 + K_, __ATOMIC_RELAXED, __HIP_MEMORY_SCOPE_AGENT) / (float)gridDim.x;
        float v;
        if (J_ == 0) v = mx; else if (J_ == 1) v = mx - mean; else if (J_ == 2) v = mean;
        else if (J_ == 70) v = 0.01f * (float)(0xffffffffu - __hip_atomic_load(c_ + 192 + K_, __ATOMIC_RELAXED, __HIP_MEMORY_SCOPE_AGENT));
        else if (J_ == 60 || J_ == 61) { float hi = 0.f, lo = 1e9f; for (int g = 0; g < 8; ++g) { const float m = 0.01f * (float)__hip_atomic_load(c_ + 96 + 8 * K_ + g, __ATOMIC_RELAXED, __HIP_MEMORY_SCOPE_AGENT) / 32.f; hi = m > hi ? m : hi; lo = m < lo ? m : lo; }
            v = J_ == 60 ? hi - mean : mean - lo; }
        else if (J_ == 62 || J_ == 63) { const float ms = 0.01f * (float)__hip_atomic_load(c_ + 96 + 8 * K_ + 1, __ATOMIC_RELAXED, __HIP_MEMORY_SCOPE_AGENT) / 32.f, mr = 0.01f * (float)__hip_atomic_load(c_ + 96 + 8 * K_ + 0, __ATOMIC_RELAXED, __HIP_MEMORY_SCOPE_AGENT) / 224.f;
            v = J_ == 62 ? ms - mr : mr - ms; v = v > 0.f ? v : 0.f; }
        else { constexpr int A_ = (J_ - 3) / 10, B_ = (J_ - 3) % 10; const float na = (K_ == 1) ? 128.f : (K_ == 3 ? (A_ == 2 ? 80.f : 88.f) : 256.f), nb = (K_ == 1) ? 128.f : (K_ == 3 ? (B_ == 2 ? 80.f : 88.f) : 256.f);
            const float ga = 0.01f * (float)__hip_atomic_load(c_ + 96 + 8 * K_ + A_, __ATOMIC_RELAXED, __HIP_MEMORY_SCOPE_AGENT) / na, gb = 0.01f * (float)__hip_atomic_load(c_ + 96 + 8 * K_ + B_, __ATOMIC_RELAXED, __HIP_MEMORY_SCOPE_AGENT) / nb;
            v = ga - gb; v = v > 0.f ? v : 0.f; }
#ifndef MK_STAMP_Q
#define MK_STAMP_Q 8.0f
#endif
        if (J_ == 0 || J_ == 2) v = MK_STAMP_Q * floorf(v / MK_STAMP_Q + 0.5f);
        ka->out[0] = v + 10.0f; }
#endif
#undef IN
#undef SEAM
#undef RUN
#undef GRIDBAR
}

#ifndef MK_N_LAUNCHES
#define MK_N_LAUNCHES 1
#endif
extern "C" void kernel_launch(void* const* d_in, const int* in_sizes, int n_in, void* d_out, int out_size, void* d_ws, size_t ws_size, hipStream_t stream) {
    static int grid = 0;
    if (grid == 0) {
        if (n_in != 22 || in_sizes[0] != MTOK * DM || out_size != MTOK * DM || ws_size < WS_END) {
            fprintf(stderr, "kernel_launch: unexpected shapes (n_in %d, in0 %d, out %d, ws %zu; need ws >= %zu); nothing launched\n", n_in, n_in > 0 ? in_sizes[0] : -1, out_size, ws_size, (size_t)WS_END); grid = -1; return; }
        int dev = 0, cus = 0, per_cu = 0;
        if (hipGetDevice(&dev) != hipSuccess || hipDeviceGetAttribute(&cus, hipDeviceAttributeMultiprocessorCount, dev) != hipSuccess) { fprintf(stderr, "kernel_launch: device query failed\n"); grid = -1; return; }
        if (hipFuncSetAttribute((const void*)mk_fwd, hipFuncAttributeMaxDynamicSharedMemorySize, LDS_BYTES) != hipSuccess) { fprintf(stderr, "kernel_launch: hipFuncSetAttribute failed\n"); grid = -1; return; }
        if (hipOccupancyMaxActiveBlocksPerMultiprocessor(&per_cu, (const void*)mk_fwd, NTHREADS, LDS_BYTES) != hipSuccess || per_cu < 1)
            fprintf(stderr, "kernel_launch: note: occupancy query reports %d workgroups per CU\n", per_cu);
        (void)hipGetLastError();
        grid = 1; while (grid * 2 <= cus && grid < 256) grid *= 2;
    }
    if (grid < 0) return;
    if (hipMemsetAsync((char*)d_ws + WS_CTL, 0, CTL_ZERO_BYTES, stream) != hipSuccess) { fprintf(stderr, "kernel_launch: memset failed\n"); return; }
    Args a{};
    for (int i = 0; i < 22; ++i) a.in[i] = d_in[i];
    a.out = (float*)d_out; a.ws = (unsigned char*)d_ws;
    if (MK_N_LAUNCHES == 1) { a.ph_lo = 0; a.ph_hi = NPHASE; hipLaunchKernelGGL(mk_fwd, dim3(grid), dim3(NTHREADS), LDS_BYTES, stream, a); }
    else for (int p = 0; p < NPHASE; ++p) { a.ph_lo = p; a.ph_hi = p + 1; hipLaunchKernelGGL(mk_fwd, dim3(grid), dim3(NTHREADS), LDS_BYTES, stream, a); }
#ifdef MK_EXTRA_PHASE
    a.ph_lo = MK_EXTRA_PHASE; a.ph_hi = MK_EXTRA_PHASE + 1; hipLaunchKernelGGL(mk_fwd, dim3(grid), dim3(NTHREADS), LDS_BYTES, stream, a);
#endif
    const hipError_t le = hipPeekAtLastError();
    if (le != hipSuccess) fprintf(stderr, "kernel_launch: launch failed: %s\n", hipGetErrorName(le));
}
```

```cpp
#include <hip/hip_runtime.h>
#include <cstdio>
#include <cstdint>

#define LAS __attribute__((address_space(3)))
#define GAS __attribute__((address_space(1)))
typedef unsigned short bf16_t;
typedef short bf16x8 __attribute__((ext_vector_type(8)));
typedef short s16x4 __attribute__((ext_vector_type(4)));
typedef float f32x4 __attribute__((ext_vector_type(4)));
typedef float f32x2 __attribute__((ext_vector_type(2)));
typedef float f32x16 __attribute__((ext_vector_type(16)));
typedef unsigned u32x4 __attribute__((ext_vector_type(4)));
typedef unsigned u32x2 __attribute__((ext_vector_type(2)));
typedef int v4i_t __attribute__((ext_vector_type(4)));
typedef int v8i_t __attribute__((ext_vector_type(8)));

constexpr int DM = 2048, BATCH = 4, SEQ = 4096, MTOK = BATCH * SEQ, INC = 6152, NQKV = 6144, NE = 32, TOPK = 4, ECAP = 16384;
constexpr float EPS = 1e-5f, L2E = 1.4426950408889634f, QSCALE = 0.08838834764831845f * 1.4426950408889634f;
constexpr int NWAVES = 8, NTHREADS = 512;
constexpr size_t MiB = 1u << 20;
constexpr size_t WS_CTL = 0, CTL_ZERO_BYTES = 1 * MiB;
constexpr size_t WS_GWF = 2 * MiB;
constexpr size_t WS_CLOG = 3 * MiB;
constexpr size_t WS_FLOG = 4 * MiB;
constexpr size_t WS_TKE = 5 * MiB;
constexpr size_t WS_TOK = 6 * MiB;
constexpr size_t WS_RSTD = 8 * MiB;
constexpr size_t WS_GATE = 10 * MiB;
constexpr size_t WS_ROPE = 12 * MiB;
constexpr size_t WS_WIN = 20 * MiB;
constexpr size_t WS_WOUT = 44 * MiB;
constexpr size_t WS_TSTART = 52 * MiB;
constexpr size_t WS_WGU = 64 * MiB;
constexpr size_t WS_WD = 576 * MiB;
constexpr size_t WS_XN = 832 * MiB;
constexpr size_t WS_QKV = 896 * MiB;
constexpr size_t WS_O = 1088 * MiB;
constexpr size_t WS_MIX = 1184 * MiB;
constexpr size_t WS_HG = 1248 * MiB;
constexpr size_t WS_HDN = 1312 * MiB;
constexpr size_t WS_YS = 1600 * MiB;
constexpr size_t WS_END = 1888 * MiB;
constexpr int CW_TMO = 0, CW_BAR = 4096, CW_CNT = 8192;
constexpr int CW_QMAX = 12288, CW_KMAX = 12800;
constexpr float FOX_SKIP_T = 30.0f;
constexpr int RING_BYTES = 131072;
constexpr int LDS_IDX = RING_BYTES;
constexpr int LDS_TAB = RING_BYTES + 1024;
constexpr int LDS_MISC = RING_BYTES + 1024 + 512;
constexpr int LDS_BYTES = 147456;

__device__ __forceinline__ unsigned f2bf(float f) { unsigned u = __builtin_bit_cast(unsigned, f); return (u + 0x7fffu + ((u >> 16) & 1u)) >> 16; }
__device__ __forceinline__ unsigned pk2(float lo, float hi) { return f2bf(lo) | (f2bf(hi) << 16); }
__device__ __forceinline__ float bf2f(unsigned short b) { return __builtin_bit_cast(float, (unsigned)b << 16); }
__device__ __forceinline__ unsigned cvt_pk_bf16(float lo, float hi) { unsigned r; asm volatile("v_cvt_pk_bf16_f32 %0, %1, %2" : "=v"(r) : "v"(lo), "v"(hi)); return r; }
__device__ __forceinline__ float wave_sum(float v) {
#pragma unroll
    for (int o = 1; o < 64; o <<= 1) v += __shfl_xor(v, o);
    return v;
}

__device__ __forceinline__ void glds16s(const char* sbase, unsigned voff, unsigned lds_dst) { unsigned keep;
    asm volatile("s_mov_b32 %0, m0\n\ts_mov_b32 m0, %3\n\ts_nop 0\n\tglobal_load_lds_dwordx4 %1, %2\n\ts_mov_b32 m0, %0" : "=&s"(keep) : "v"(voff), "s"(sbase), "s"(lds_dst) : "memory"); }
__device__ __forceinline__ void glds4s(const char* sbase, unsigned voff, unsigned lds_dst) { unsigned keep;
    asm volatile("s_mov_b32 %0, m0\n\ts_mov_b32 m0, %3\n\ts_nop 0\n\tglobal_load_lds_dword %1, %2\n\ts_mov_b32 m0, %0" : "=&s"(keep) : "v"(voff), "s"(sbase), "s"(lds_dst) : "memory"); }
__device__ __forceinline__ const char* uni_ptr(const char* p) { const unsigned long long v = (unsigned long long)p;
    const unsigned lo = (unsigned)__builtin_amdgcn_readfirstlane((int)(unsigned)v), hi = (unsigned)__builtin_amdgcn_readfirstlane((int)(unsigned)(v >> 32)); return (const char*)(((unsigned long long)hi << 32) | lo); }

#ifndef MK_EPI_LDS
#define MK_EPI_LDS 1
#endif
namespace pg8 {
constexpr int BM = 256, BK = 64, HALF = 128, HTB = HALF * BK * 2, STAGE_BYTES = 8 * HTB, NXCD = 8, WGM = 8;
__host__ __device__ __forceinline__ int lds_byte(int r, int c) { const int st = (r >> 4) * 2 + (c >> 5), rr = r & 15, cc = c & 31, ob = rr * 64 + cc * 2; return st * 1024 + (ob ^ (((ob >> 9) & 1) << 5)); }
__host__ __device__ __forceinline__ void stage_rc(int b, int& R, int& C) { const int st = b / 1024, sb = b % 1024, swz = sb ^ (((sb >> 9) & 1) << 5); R = (st >> 1) * 16 + swz / 64; C = (st & 1) * 32 + (swz % 64) / 2; }
__host__ __device__ __forceinline__ int perm32(int rho) { const int n = rho >> 4, i = rho & 15; return 8 * (i >> 2) + 4 * n + (i & 3); }

struct Unit { int pm, pn, e, rows0; };

struct DenseOrder {
    const bf16_t* A; const bf16_t* Bt; int RB; int nM, nN, nwg, G, c; int rot = 0;
    __device__ void init(const bf16_t* A_, const bf16_t* Bt_, int M, int N, int RB_, int G_, int c_) { A = A_; Bt = Bt_; RB = RB_; nM = M / BM; nN = N / BM; nwg = nM * nN; G = G_; c = c_; }
    __device__ __forceinline__ bool next(int i, Unit& u) const {
        const long L = (long)i * G + c; if (L >= nwg) return false;
        int wgid = (int)L; { const int q = nwg / NXCD, r = nwg % NXCD, xcd = wgid % NXCD, off = wgid / NXCD; wgid = (xcd < r ? xcd * (q + 1) : r * (q + 1) + (xcd - r) * q) + off; }
        const int nig = WGM * nN, gid = wgid / nig, fm = gid * WGM, gsz = (nM - fm) < WGM ? (nM - fm) : WGM;
        u.pm = fm + ((wgid % nig) % gsz); u.pn = (wgid % nig) / gsz; u.e = 0; u.rows0 = 0; return true;
    }
    __device__ __forceinline__ const char* a_base(const Unit& u) const { return (const char*)A + (size_t)u.pm * BM * RB; }
    __device__ __forceinline__ const char* b_base(const Unit& u) const { return (const char*)Bt + (size_t)u.pn * BM * RB; }
};
struct MoeOrder {
    const float* bA = nullptr; const float* bB = nullptr; int bcols = 0;
    const float* rowsc = nullptr;
    const void* A; const void* Bt; int RB; int nN; int NperE; int G, c; int rot; const LAS int* tab; const int* tok;
    __device__ __forceinline__ bool next(int i, Unit& u) const {
        const int T = __builtin_amdgcn_readfirstlane(tab[NE]);
        int t;
        if (G == 256) {
            const int x = c & 7, j = c >> 3, XP = nN >> 3, tpr = 256 / nN;
            t = i * tpr + (x / XP) * 4 + (j & 3); u.pn = (x % XP) * 8 + (j >> 2);
            if (t >= T) return false;
        } else {
            const int L = i * G + c; if (L >= T * nN) return false;
            t = L / nN; u.pn = L - t * nN;
        }
        u.pm = t;
        int e; { const int ln = (int)(threadIdx.x & 63); const int tv = tab[ln & 31];
                 e = (int)__popcll(__ballot(ln < NE && tv <= t)) - 1; }
        u.e = e; u.rows0 = __builtin_amdgcn_readfirstlane((t - tab[e]) * BM); return true;
    }
    __device__ __forceinline__ int cnt_of(const Unit& u) const { return __builtin_amdgcn_readfirstlane(tab[NE + 1 + u.e]); }
    __device__ __forceinline__ const char* a_base(const Unit& u) const { return (const char*)A; }
    __device__ __forceinline__ const char* a_base_dense(const Unit& u) const { return (const char*)A + (size_t)u.pm * BM * RB; }
    __device__ __forceinline__ const char* b_base(const Unit& u) const { return (const char*)Bt + ((size_t)u.e * NperE + (size_t)u.pn * BM) * RB; }
};
struct MoeOrderDense : MoeOrder {
    __device__ __forceinline__ const char* a_base(const Unit& u) const { return a_base_dense(u); }
};

template <class Epi, class Sched, bool GATHER, bool FP8 = false, int SCW = 127, int SCA = 127, int KREP = 1, bool FP6 = false, bool BAL = false, bool XINIT = false>
__device__ __forceinline__ void gemm_phase(LAS unsigned char* lds, LAS unsigned char* lds_idx, const int RB, const Sched& S, const Epi& E) {
    const int tid = threadIdx.x, wid = __builtin_amdgcn_readfirstlane(tid >> 6), lane = tid & 63, wr = wid >> 2, wc = wid & 3, fr = lane & 15, fq = lane >> 4;
    const int nt = (RB / 128) * KREP;
    unsigned voffA[2], voffB[2]; int RA[2], CA2[2];
#pragma unroll
    for (int i = 0; i < 2; ++i) { int R, C; stage_rc(tid * 16 + i * 8192, R, C); const int Rb = (R & ~31) + perm32(R & 31);
        voffA[i] = (unsigned)(R * RB + C * 2); voffB[i] = (unsigned)(Rb * RB + C * 2); RA[i] = R; CA2[i] = C * 2; }
    const int rot = S.rot, ntm = RB / 128 - 1;
#define PG8_KOFF(t) ((size_t)((((t) + rot) & ntm) * 128))
    const size_t hstep = (size_t)HALF * RB;
    const unsigned ldsw = (unsigned)wid * 1024u;
    const unsigned ldsb = (unsigned)__builtin_amdgcn_readfirstlane((int)(unsigned)(uintptr_t)lds);
    const int aoff = lds_byte(wr * 64 + fr, fq * 8), boff = lds_byte(wc * 32 + fr, fq * 8);
#define PG8_SA(b, h) (((b) * 2 + (h)) * HTB)
#define PG8_SB(b, h) ((4 + (b) * 2 + (h)) * HTB)
#define PG8_GL(bufoff, gptr, v0, v1) do { const char* gp_ = uni_ptr((const char*)(gptr)); \
        glds16s(gp_, (v0), ldsb + (unsigned)(bufoff) + ldsw); glds16s(gp_, (v1), ldsb + (unsigned)(bufoff) + ldsw + 8192u); } while (0)
#define PG8_STAGE_B(bufoff, gbase) PG8_GL(bufoff, gbase, voffB[0], voffB[1])
#define PG8_STAGE_A(bufoff, gbase, h, V) do { if constexpr (GATHER) { PG8_GL(bufoff, gbase, V[h][0], V[h][1]); } else { PG8_GL(bufoff, (gbase) + (h) * hstep, voffA[0], voffA[1]); } } while (0)
#define PG8_LDA(dst, b, h) do { _Pragma("unroll") for (int m = 0; m < 4; ++m) _Pragma("unroll") for (int k = 0; k < 2; ++k) dst[m][k] = *(const LAS bf16x8*)(lds + PG8_SA(b, h) + aoff + m * 2048 + k * 1024); } while (0)
#define PG8_LDB(dst, b, h) do { _Pragma("unroll") for (int n = 0; n < 2; ++n) _Pragma("unroll") for (int k = 0; k < 2; ++k) dst[n][k] = *(const LAS bf16x8*)(lds + PG8_SB(b, h) + boff + n * 2048 + k * 1024); } while (0)
#define PG8_CAT(x, y) __builtin_shufflevector(__builtin_bit_cast(v4i_t, x), __builtin_bit_cast(v4i_t, y), 0, 1, 2, 3, 4, 5, 6, 7)
#define PG8_MMA(ai, bj, At, Bt) do { __builtin_amdgcn_s_setprio(1); _Pragma("unroll") for (int m = 0; m < 4; ++m) _Pragma("unroll") for (int n = 0; n < 2; ++n) { \
        if constexpr (FP6) { acc[ai][bj][m][n] = __builtin_amdgcn_mfma_scale_f32_16x16x128_f8f6f4(PG8_CAT(Bt[n][0], Bt[n][1]), PG8_CAT(At[m][0], At[m][1]), acc[ai][bj][m][n], 2, 2, 0, __builtin_bit_cast(v4i_t, Bt[n][1])[2], 0, __builtin_bit_cast(v4i_t, At[m][1])[2]); } \
        else if constexpr (FP8) { acc[ai][bj][m][n] = __builtin_amdgcn_mfma_scale_f32_16x16x128_f8f6f4(PG8_CAT(Bt[n][0], Bt[n][1]), PG8_CAT(At[m][0], At[m][1]), acc[ai][bj][m][n], 0, 0, 0, (SCW | (SCA << 8)), 1, (SCW | (SCA << 8))); }     \
        else { _Pragma("unroll") for (int k = 0; k < 2; ++k) acc[ai][bj][m][n] = __builtin_amdgcn_mfma_f32_16x16x32_bf16(Bt[n][k], At[m][k], acc[ai][bj][m][n], 0, 0, 0); } } \
        __builtin_amdgcn_s_setprio(0); } while (0)
#define PG8_WAIT_V(n) asm volatile("s_waitcnt vmcnt(" #n ")" ::: "memory")
#define PG8_WAIT_L(n) asm volatile("s_waitcnt lgkmcnt(" #n ")" ::: "memory")
#define PG8_BAR __builtin_amdgcn_s_barrier()
#define PG8_SCHED __builtin_amdgcn_sched_barrier(0)
    Unit cur, nxt; int ui = 0;
    if (!S.next(0, cur)) return;
    f32x4 acc[2][2][4][2];
    if constexpr (XINIT) E.load_init(acc, cur, wr, wc, fr, fq);
    else {
#pragma unroll
    for (int a = 0; a < 2; ++a)
#pragma unroll
        for (int b = 0; b < 2; ++b)
#pragma unroll
            for (int m = 0; m < 4; ++m)
#pragma unroll
                for (int n = 0; n < 2; ++n) acc[a][b][m][n] = (f32x4){0.f, 0.f, 0.f, 0.f};
    }
    bf16x8 At[4][2], B0[2][2], B1[2][2];
    unsigned VC[2][2];
    if constexpr (GATHER) {
        const int cnt = S.cnt_of(cur);
#pragma unroll
        for (int h = 0; h < 2; ++h)
#pragma unroll
            for (int i = 0; i < 2; ++i) { const int pos = cur.rows0 + h * HALF + RA[i]; int tk = S.tok[(size_t)cur.e * ECAP + pos]; tk = pos < cnt ? tk : 0; VC[h][i] = (unsigned)tk * (unsigned)RB + (unsigned)CA2[i]; }
    } else {
#pragma unroll
        for (int h = 0; h < 2; ++h)
#pragma unroll
            for (int i = 0; i < 2; ++i) VC[h][i] = 0u;
    }
    const char* cA = S.a_base(cur); const char* cB = S.b_base(cur);
    PG8_STAGE_B(PG8_SB(0, 0), cB + PG8_KOFF(0)); PG8_STAGE_B(PG8_SB(0, 1), cB + hstep + PG8_KOFF(0)); PG8_STAGE_A(PG8_SA(0, 0), cA + PG8_KOFF(0), 0, VC); PG8_STAGE_A(PG8_SA(0, 1), cA + PG8_KOFF(0), 1, VC);
    if (wr == 1) PG8_BAR;
    PG8_WAIT_V(2); PG8_BAR;
    if constexpr (BAL) { PG8_STAGE_B(PG8_SB(1, 0), cB + PG8_KOFF(1)); PG8_STAGE_B(PG8_SB(1, 1), cB + hstep + PG8_KOFF(1)); PG8_WAIT_V(4); PG8_BAR; }
    else { PG8_STAGE_B(PG8_SB(1, 0), cB + PG8_KOFF(1)); PG8_STAGE_A(PG8_SA(1, 0), cA + PG8_KOFF(1), 0, VC); PG8_STAGE_B(PG8_SB(1, 1), cB + hstep + PG8_KOFF(1));
    PG8_WAIT_V(6); PG8_BAR; }
    for (;;) {
        const bool has_next = S.next(ui + 1, nxt);
        const char* nA = has_next ? S.a_base(nxt) : cA; const char* nB = has_next ? S.b_base(nxt) : cB;
        for (int t = 0; t < nt; t += 2) {
            const bool last = (t == nt - 2);
            if constexpr (FP8 && MK_EPI_LDS) {
                if (t == nt - 6 && wid < 4)
                    glds4s(uni_ptr((const char*)((wid < 2 ? S.bA : S.bB) + (size_t)cur.e * DM + cur.pn * S.bcols + (wid & 1) * 64)), (unsigned)lane * 4u, (unsigned)__builtin_amdgcn_readfirstlane((int)(unsigned)(uintptr_t)lds_idx) + 3072u + (unsigned)wid * 256u);
                if (t == nt - 4 && wid >= 4)
                    glds4s(uni_ptr((const char*)(S.rowsc + (size_t)cur.e * ECAP + cur.rows0 + (wid - 4) * 64)), (unsigned)lane * 4u, (unsigned)__builtin_amdgcn_readfirstlane((int)(unsigned)(uintptr_t)lds_idx) + 2048u + (unsigned)(wid - 4) * 256u);
            }
            if constexpr (GATHER) {
                if (has_next && t == nt - 4 && wid < 4)
                    glds4s(uni_ptr((const char*)(S.tok + (size_t)nxt.e * ECAP + nxt.rows0 + wid * 64)), (unsigned)lane * 4u, (unsigned)__builtin_amdgcn_readfirstlane((int)(unsigned)(uintptr_t)lds_idx) + (unsigned)wid * 256u);
            }
            const char* a1 = cA + PG8_KOFF(t + 1);
            const char* a2 = (last ? nA : cA) + PG8_KOFF(t + 2); const char* b2 = (last ? nB : cB) + PG8_KOFF(t + 2);
            const char* a3 = (last ? nA : cA) + PG8_KOFF(t + 3); const char* b3 = (last ? nB : cB) + PG8_KOFF(t + 3);
            PG8_LDB(B0, 0, 0); PG8_LDB(B1, 0, 1); PG8_SCHED; PG8_LDA(At, 0, 0); if constexpr (BAL) PG8_STAGE_A(PG8_SA(1, 0), a1, 0, VC); PG8_STAGE_A(PG8_SA(1, 1), a1, 1, VC);
            if constexpr (GATHER) {
                if (last && has_next) { const int cntn = S.cnt_of(nxt);
#pragma unroll
                    for (int h = 0; h < 2; ++h)
#pragma unroll
                        for (int i = 0; i < 2; ++i) { const int r = h * HALF + RA[i]; int tk = *(const LAS int*)(lds_idx + r * 4); tk = (nxt.rows0 + r) < cntn ? tk : 0; VC[h][i] = (unsigned)tk * (unsigned)RB + (unsigned)CA2[i]; } }
            }
            PG8_WAIT_V(8); PG8_WAIT_L(0); PG8_BAR; PG8_MMA(0, 0, At, B0); PG8_MMA(0, 1, At, B1); PG8_BAR; PG8_SCHED;
            PG8_LDA(At, 0, 1); PG8_STAGE_B(PG8_SB(0, 0), b2); PG8_STAGE_B(PG8_SB(0, 1), b2 + hstep); if constexpr (!BAL) PG8_STAGE_A(PG8_SA(0, 0), a2, 0, VC);
            if constexpr (BAL) PG8_WAIT_V(6); else PG8_WAIT_V(8); PG8_WAIT_L(0); PG8_BAR; PG8_MMA(1, 0, At, B0); PG8_MMA(1, 1, At, B1); PG8_BAR; PG8_SCHED;
            PG8_LDB(B0, 1, 0); PG8_LDB(B1, 1, 1); PG8_SCHED; PG8_LDA(At, 1, 0); if constexpr (BAL) PG8_STAGE_A(PG8_SA(0, 0), a2, 0, VC); PG8_STAGE_A(PG8_SA(0, 1), a2, 1, VC);
            PG8_WAIT_V(8); PG8_WAIT_L(0); PG8_BAR; PG8_MMA(0, 0, At, B0); PG8_MMA(0, 1, At, B1); PG8_BAR; PG8_SCHED;
            PG8_LDA(At, 1, 1); PG8_STAGE_B(PG8_SB(1, 0), b3); PG8_STAGE_B(PG8_SB(1, 1), b3 + hstep); if constexpr (!BAL) PG8_STAGE_A(PG8_SA(1, 0), a3, 0, VC);
            if constexpr (BAL) PG8_WAIT_V(6); else PG8_WAIT_V(8); PG8_WAIT_L(0); PG8_BAR; PG8_MMA(1, 0, At, B0); PG8_MMA(1, 1, At, B1); PG8_BAR; PG8_SCHED;
        }
        if (wr == 0) PG8_BAR;
        if constexpr (FP6 && KREP > 1) {
#pragma unroll
            for (int a = 0; a < 2; ++a)
#pragma unroll
                for (int b = 0; b < 2; ++b)
#pragma unroll
                    for (int m = 0; m < 4; ++m)
#pragma unroll
                        for (int n = 0; n < 2; ++n) acc[a][b][m][n] = acc[a][b][m][n] * (1.0f / KREP);
        }
        { int ln_; asm volatile("v_mbcnt_lo_u32_b32 %0, -1, 0\n\tv_mbcnt_hi_u32_b32 %0, -1, %0" : "=v"(ln_));
          E(acc, cur, wr, wc, ln_ & 15, ln_ >> 4);
#ifdef MK_PROBE_EPI2
          if constexpr (FP8) { asm volatile("" ::: "memory"); E(acc, cur, wr, wc, ln_ & 15, ln_ >> 4); }
#endif
        }
        if (!has_next) break;
        if constexpr (XINIT) { int ln_; asm volatile("v_mbcnt_lo_u32_b32 %0, -1, 0\n\tv_mbcnt_hi_u32_b32 %0, -1, %0" : "=v"(ln_)); E.load_init(acc, nxt, wr, wc, ln_ & 15, ln_ >> 4); }
        else {
#pragma unroll
        for (int a = 0; a < 2; ++a)
#pragma unroll
            for (int b = 0; b < 2; ++b)
#pragma unroll
                for (int m = 0; m < 4; ++m)
#pragma unroll
                    for (int n = 0; n < 2; ++n) acc[a][b][m][n] = (f32x4){0.f, 0.f, 0.f, 0.f};
        }
        cur = nxt; cA = nA; cB = nB; ++ui;
        if (wr == 1) PG8_BAR;
    }
    PG8_WAIT_V(0);
    PG8_BAR;
#undef PG8_SA
#undef PG8_SB
#undef PG8_GL
#undef PG8_STAGE_A
#undef PG8_STAGE_B
#undef PG8_LDA
#undef PG8_LDB
#undef PG8_MMA
#undef PG8_CAT
#undef PG8_KOFF
#undef PG8_WAIT_V
#undef PG8_WAIT_L
#undef PG8_BAR
#undef PG8_SCHED
}

}
namespace att {
constexpr int D = 128, NW = 8, QBLK = 32, KVBLK = 64, QB = NW * QBLK;
constexpr int SHM_V = KVBLK * D * 2, SHM_K = KVBLK * D * 2;
constexpr int OFF_WS = 2 * SHM_V + 2 * SHM_K, OFF_CLOG = OFF_WS + NW * 64 * 4, LDS_BYTES = OFF_CLOG + SEQ * 4;
constexpr float THR2 = 8.f * 1.4426950408889634f;
#define KSWZ(row, colB) ((row) * 256 + ((colB) ^ (((row) & 7) << 4)))
#define SBAR() __builtin_amdgcn_sched_barrier(0)
__device__ __forceinline__ int v_st(int k, int c) { const int kk = (k & ~0xC) | ((k & 4) << 1) | ((k & 8) >> 1); return ((kk >> 3) * 4 + (c >> 5)) * 512 + ((kk & 7) * 32 + (c & 31)) * 2; }
__device__ __forceinline__ int v_rd_base(int lane) { return ((lane & 3) << 3) | (((lane >> 2) & 3) << 6) | (((lane >> 4) & 1) << 5) | (((lane >> 5) & 1) << 8); }
constexpr int v_rd_off(int d0, int ks, int half) { return d0 * 512 + ks * 4096 + half * 2048; }
__device__ __forceinline__ int crow(int r, int hi) { return (r & 3) + 8 * (r >> 2) + 4 * hi; }
__device__ __forceinline__ unsigned cvtpk(float lo, float hi) { unsigned r; asm volatile("v_cvt_pk_bf16_f32 %0, %1, %2" : "=v"(r) : "v"(lo), "v"(hi)); return r; }
__device__ __forceinline__ void mask_tile(f32x16& p0, f32x16& p1, int dq) {
    const float NEG = -__builtin_inff();
#pragma unroll
    for (int r = 0; r < 16; ++r) {
        const int c = (r & 3) + 8 * (r >> 2);
        if (dq - c < 0) p0[r] = NEG;
        if (dq - c - 32 < 0) p1[r] = NEG;
    }
}
__device__ __forceinline__ void partialSM(f32x16& p0, f32x16& p1, float& m_reg, float& mn, float& alpha) {
    float pmax = p0[0];
#pragma unroll
    for (int r = 1; r < 16; ++r) pmax = fmaxf(pmax, p0[r]);
#pragma unroll
    for (int r = 0; r < 16; ++r) pmax = fmaxf(pmax, p1[r]);
    { auto rr = __builtin_amdgcn_permlane32_swap(__float_as_uint(pmax), __float_as_uint(pmax), false, false);
      pmax = fmaxf(__uint_as_float(rr[0]), __uint_as_float(rr[1])); }
    if (__builtin_expect(__all((pmax - m_reg) <= THR2), 1)) { mn = m_reg; alpha = 1.f; }
    else { mn = fmaxf(m_reg, pmax); alpha = __builtin_amdgcn_exp2f(m_reg - mn); m_reg = mn; }
#pragma unroll
    for (int r = 0; r < 16; ++r) p0[r] = p0[r] - mn;
#pragma unroll
    for (int r = 0; r < 16; ++r) p1[r] = p1[r] - mn;
#pragma unroll
    for (int r = 0; r < 16; ++r) p0[r] = __builtin_amdgcn_exp2f(p0[r]);
}
__device__ __forceinline__ void finishSM(f32x16& p0, f32x16& p1, float alpha, float& l_reg, bf16x8& pa0, bf16x8& pa1, bf16x8& pa2, bf16x8& pa3) {
#pragma unroll
    for (int r = 0; r < 16; ++r) p1[r] = __builtin_amdgcn_exp2f(p1[r]);
    float ps = 0;
#pragma unroll
    for (int r = 0; r < 16; ++r) ps += p0[r];
#pragma unroll
    for (int r = 0; r < 16; ++r) ps += p1[r];
    { auto rr = __builtin_amdgcn_permlane32_swap(__float_as_uint(ps), __float_as_uint(ps), false, false);
      ps = __uint_as_float(rr[0]) + __uint_as_float(rr[1]); }
    l_reg = l_reg * alpha + ps;
#define PK4(P, B_, OUT) do { unsigned a0 = cvtpk(P[B_+0], P[B_+1]), a1 = cvtpk(P[B_+2], P[B_+3]);                          \
        unsigned b0 = cvtpk(P[B_+4], P[B_+5]), b1 = cvtpk(P[B_+6], P[B_+7]);                                             \
        auto r0 = __builtin_amdgcn_permlane32_swap(a0, b0, false, false); auto r1 = __builtin_amdgcn_permlane32_swap(a1, b1, false, false); \
        u32x4 w = {r0[0], r1[0], r0[1], r1[1]}; OUT = *reinterpret_cast<bf16x8*>(&w); } while (0)
    PK4(p0, 0, pa0); PK4(p0, 8, pa1); PK4(p1, 0, pa2); PK4(p1, 8, pa3);
#undef PK4
}
template <int KB, bool FOX>
__device__ __forceinline__ void qkt(f32x16& p0, f32x16& p1, const char* K_lds, int r32, int hi, const bf16x8* qr, const float* cl  , float cq) {
    if constexpr (FOX) {
#pragma unroll
        for (int g = 0; g < 4; ++g) { const f32x4 c0 = *(const f32x4*)(cl + 8 * g + 4 * hi); const f32x4 c1 = *(const f32x4*)(cl + 32 + 8 * g + 4 * hi);
#pragma unroll
            for (int j = 0; j < 4; ++j) { p0[4 * g + j] = cq - c0[j]; p1[4 * g + j] = cq - c1[j]; } }
    } else { p0 = f32x16{}; p1 = f32x16{}; }
    const char* kb[4];
#pragma unroll
    for (int dd = 0; dd < 4; ++dd) kb[dd] = K_lds + KB * SHM_K + KSWZ(r32, (dd * 16 + hi * 8) * 2);
#pragma unroll
    for (int d0 = 0; d0 < 8; ++d0) { const char* a = kb[d0 & 3] + (d0 >> 2) * 128;
        bf16x8 b0 = *reinterpret_cast<const bf16x8*>(a);
        bf16x8 b1 = *reinterpret_cast<const bf16x8*>(a + 32 * 256);
        p0 = __builtin_amdgcn_mfma_f32_32x32x16_bf16(b0, qr[d0], p0, 0, 0, 0);
        p1 = __builtin_amdgcn_mfma_f32_32x32x16_bf16(b1, qr[d0], p1, 0, 0, 0); }
}
template <int KB>
__device__ __forceinline__ void qkt_lean(f32x16& p0, f32x16& p1, const char* K_lds, int r32, int hi, const bf16x8* qr) {
    p0 = f32x16{}; p1 = f32x16{};
    int kb[4];
#pragma unroll
    for (int dd = 0; dd < 4; ++dd) kb[dd] = (int)(uintptr_t)K_lds + KB * SHM_K + KSWZ(r32, (dd * 16 + hi * 8) * 2);
#define KRD(dst, d0, half) asm volatile("ds_read_b128 %0, %1 offset:%2" : "=&v"(dst) : "v"(kb[(d0) & 3]), "i"(((d0) >> 2) * 128 + (half) * 32 * 256) : "memory")
#define KRD4(P, d0) do { KRD(P##00, d0, 0); KRD(P##01, d0, 1); KRD(P##10, (d0) + 1, 0); KRD(P##11, (d0) + 1, 1); } while (0)
#define KMM(P, d0) do { p0 = __builtin_amdgcn_mfma_f32_32x32x16_bf16(P##00, qr[d0], p0, 0, 0, 0); p1 = __builtin_amdgcn_mfma_f32_32x32x16_bf16(P##01, qr[d0], p1, 0, 0, 0); \
        p0 = __builtin_amdgcn_mfma_f32_32x32x16_bf16(P##10, qr[(d0) + 1], p0, 0, 0, 0); p1 = __builtin_amdgcn_mfma_f32_32x32x16_bf16(P##11, qr[(d0) + 1], p1, 0, 0, 0); } while (0)
#define KW4() do { asm volatile("s_waitcnt lgkmcnt(4)" ::: "memory"); SBAR(); } while (0)
    bf16x8 A00, A01, A10, A11, B00, B01, B10, B11;
    KRD4(A, 0);
    KRD4(B, 2); KW4(); KMM(A, 0); SBAR();
    KRD4(A, 4); KW4(); KMM(B, 2); SBAR();
    KRD4(B, 6); KW4(); KMM(A, 4); SBAR();
    asm volatile("s_waitcnt lgkmcnt(0)" ::: "memory"); SBAR(); KMM(B, 6); SBAR();
#undef KRD
#undef KRD4
#undef KMM
#undef KW4
}
template <int VB>
__device__ __forceinline__ void pv_tile(f32x16* o, int vb0, bf16x8 pa0, bf16x8 pa1, bf16x8 pa2, bf16x8 pa3) {
#define TRRD(dst, off) asm volatile("ds_read_b64_tr_b16 %0, %1 offset:%2" : "=&v"(dst) : "v"(vb0), "i"(off) : "memory")
#define PV_D0(d0) do { s16x4 l0, l1, l2, l3, h0, h1, h2, h3; constexpr int b_ = VB * SHM_V + v_rd_off(d0, 0, 0); \
        TRRD(l0, b_); TRRD(h0, b_ + 2048); TRRD(l1, b_ + 4096); TRRD(h1, b_ + 6144); TRRD(l2, b_ + 8192); TRRD(h2, b_ + 10240); TRRD(l3, b_ + 12288); TRRD(h3, b_ + 14336); \
        asm volatile("s_waitcnt lgkmcnt(0)" ::: "memory"); SBAR();   \
        o[d0] = __builtin_amdgcn_mfma_f32_32x32x16_bf16(pa0, (bf16x8){l0[0], l0[1], l0[2], l0[3], h0[0], h0[1], h0[2], h0[3]}, o[d0], 0, 0, 0);   \
        o[d0] = __builtin_amdgcn_mfma_f32_32x32x16_bf16(pa1, (bf16x8){l1[0], l1[1], l1[2], l1[3], h1[0], h1[1], h1[2], h1[3]}, o[d0], 0, 0, 0);   \
        o[d0] = __builtin_amdgcn_mfma_f32_32x32x16_bf16(pa2, (bf16x8){l2[0], l2[1], l2[2], l2[3], h2[0], h2[1], h2[2], h2[3]}, o[d0], 0, 0, 0);   \
        o[d0] = __builtin_amdgcn_mfma_f32_32x32x16_bf16(pa3, (bf16x8){l3[0], l3[1], l3[2], l3[3], h3[0], h3[1], h3[2], h3[3]}, o[d0], 0, 0, 0); } while (0)
    PV_D0(0); PV_D0(1); PV_D0(2); PV_D0(3);
#undef PV_D0
#undef TRRD
}
constexpr int PV8_V1 = 3 * SHM_V;
__device__ __forceinline__ void pv_pipe8(f32x16* o, int vbA, bf16x8 pa0, bf16x8 pa1, bf16x8 pa2, bf16x8 pa3) {
#define TRR(dst, vb, off) asm volatile("ds_read_b64_tr_b16 %0, %1 offset:%2" : "=&v"(dst) : "v"(vb), "i"(off) : "memory")
#define RD8(P, vb, d0) do { constexpr int b_ = v_rd_off((d0) & 3, 0, 0) + ((d0) >> 2) * PV8_V1; TRR(P##l0, vb, b_); TRR(P##h0, vb, b_ + 2048); TRR(P##l1, vb, b_ + 4096); TRR(P##h1, vb, b_ + 6144); \
        TRR(P##l2, vb, b_ + 8192); TRR(P##h2, vb, b_ + 10240); TRR(P##l3, vb, b_ + 12288); TRR(P##h3, vb, b_ + 14336); } while (0)
#define FR(P, k) (bf16x8){P##l##k[0], P##l##k[1], P##l##k[2], P##l##k[3], P##h##k[0], P##h##k[1], P##h##k[2], P##h##k[3]}
#define MM4(P, oi) do { o[oi] = __builtin_amdgcn_mfma_f32_32x32x16_bf16(pa0, FR(P, 0), o[oi], 0, 0, 0); o[oi] = __builtin_amdgcn_mfma_f32_32x32x16_bf16(pa1, FR(P, 1), o[oi], 0, 0, 0); \
        o[oi] = __builtin_amdgcn_mfma_f32_32x32x16_bf16(pa2, FR(P, 2), o[oi], 0, 0, 0); o[oi] = __builtin_amdgcn_mfma_f32_32x32x16_bf16(pa3, FR(P, 3), o[oi], 0, 0, 0); } while (0)
#define W8() do { asm volatile("s_waitcnt lgkmcnt(8)" ::: "memory"); SBAR(); } while (0)
    s16x4 Al0, Al1, Al2, Al3, Ah0, Ah1, Ah2, Ah3, Bl0, Bl1, Bl2, Bl3, Bh0, Bh1, Bh2, Bh3;
    RD8(A, vbA, 0);
    RD8(B, vbA, 1); W8(); MM4(A, 0); SBAR();
    RD8(A, vbA, 2); W8(); MM4(B, 1); SBAR();
    RD8(B, vbA, 3); W8(); MM4(A, 2); SBAR();
    RD8(A, vbA, 4); W8(); MM4(B, 3); SBAR();
    RD8(B, vbA, 5); W8(); MM4(A, 4); SBAR();
    RD8(A, vbA, 6); W8(); MM4(B, 5); SBAR();
    RD8(B, vbA, 7); W8(); MM4(A, 6); SBAR();
    asm volatile("s_waitcnt lgkmcnt(0)" ::: "memory"); SBAR(); MM4(B, 7);
#undef TRR
#undef RD8
#undef FR
#undef MM4
#undef W8
}
struct BlockRef { unsigned Q, K, V, O; int P0; unsigned clog; int jlo; };
struct Seam { bf16x8 qr[8]; bf16x8 st_v0, st_v1, st_k0, st_k1; };
#define ROWB(p, k0, rr) ((const char*)wsb + (size_t)((p) + (unsigned)((k0) + (rr)) * (unsigned)(D * 2)) + lnoff)
#define VMW() asm volatile("s_waitcnt vmcnt(0)" ::: "memory")
#define VMWN(n) asm volatile("s_waitcnt vmcnt(%0)" :: "i"(n) : "memory")
#define LD8(p) (*reinterpret_cast<const bf16x8*>(p))
#define SLOAD_H(Kp, Vp, k0) do { S.st_v0 = LD8(ROWB(Vp, k0, 0)); S.st_v1 = LD8(ROWB(Vp, k0, 32)); S.st_k0 = LD8(ROWB(Kp, k0, 0)); S.st_k1 = LD8(ROWB(Kp, k0, 32)); } while (0)
#define SWRITE_HK(bf) do { *(bf16x8*)(K_lds + (bf) * SHM_K + kws) = S.st_k0; *(bf16x8*)(K_lds + (bf) * SHM_K + kws + 32 * 256) = S.st_k1; } while (0)
#define SWRITE_HV(bf) do { *(bf16x8*)(V_lds + (bf) * SHM_V + vst0) = S.st_v0; *(bf16x8*)(V_lds + (bf) * SHM_V + vst1) = S.st_v1; } while (0)
#define SWRITE_H(bf) do { SWRITE_HV(bf); SWRITE_HK(bf); } while (0)
__device__ __forceinline__ void attn_prime(const unsigned char* wsb, const BlockRef& cur, char* lds, Seam& S) {
    const int tid = threadIdx.x, wid = __builtin_amdgcn_readfirstlane(tid >> 6), lane = tid & 63, r32 = lane & 31, hi = lane >> 5;
    const int sr = tid >> 4, sc = (tid & 15) * 8, kws = KSWZ(sr, sc * 2); char* K_lds = lds + 2 * SHM_V;
    const unsigned lnoff = (unsigned)(sr * D + sc) * 2u;
#pragma unroll
    for (int d0 = 0; d0 < 8; ++d0) S.qr[d0] = LD8(wsb + (size_t)cur.Q + (unsigned)((wid * QBLK + r32) * D + d0 * 16 + hi * 8) * 2u);
    SLOAD_H(cur.K, cur.V, cur.jlo * KVBLK); VMW(); SWRITE_HK(0);
    __syncthreads();
}
template <bool FOX, class NR>
__device__ __forceinline__ void attn_block(const unsigned char* wsb, const BlockRef& cur, const NR& nref, char* lds, Seam& S) {
    const int tid = threadIdx.x, wid = __builtin_amdgcn_readfirstlane(tid >> 6), lane = tid & 63, r32 = lane & 31, hi = lane >> 5;
    const int j_lo = cur.jlo;
    const int NT = (cur.P0 + QB) / KVBLK - j_lo;
    const int qlo = cur.P0 + wid * QBLK;
    const int qe = FOX ? qlo : (qlo | 63);
    const int qm = (FOX ? (qlo + r32) : (qlo | 63)) - 4 * hi;
    char* V_lds = lds; char* K_lds = lds + 2 * SHM_V;
    float* ws = (float*)(lds + OFF_WS) + wid * 64; float* li_l = ws, * al_l = ws + 32;
    float* cl_lds = (float*)(lds + OFF_CLOG);
    float cq = 0.f;
    if constexpr (FOX) {
        const int nkeys = NT * KVBLK;
        const float* clg = (const float*)(wsb + (size_t)cur.clog);
        for (int i = tid * 4; i < nkeys; i += NTHREADS * 4) *(f32x4*)(cl_lds + i) = *(const f32x4*)(clg + j_lo * KVBLK + i);
        cq = clg[qlo + r32];
        __syncthreads();
    }
    float m_reg = -1e30f, l_reg = 0; f32x16 o[4] = {};
    const int sr = tid >> 4, sc = (tid & 15) * 8, vst0 = v_st(sr, sc), vst1 = v_st(32 + sr, sc), kws = KSWZ(sr, sc * 2);
    const unsigned lnoff = (unsigned)(sr * D + sc) * 2u;
    const int vb0 = (int)(uintptr_t)V_lds + v_rd_base(lane);
    const unsigned Kh = cur.K, Vh = cur.V;
#define RESC(a) do { if (__any((a) < 1.f)) { if (hi == 0) al_l[r32] = (a); asm volatile("s_waitcnt lgkmcnt(0)" ::: "memory");              \
                     for (int d_ = 0; d_ < 4; ++d_) for (int r = 0; r < 16; ++r) o[d_][r] *= al_l[crow(r, hi)]; } } while (0)
#define KBASE(t) ((j_lo + (t)) * KVBLK)
#define CLT(t) (cl_lds + (t) * KVBLK)
#define MASKT(P0_, P1_, t) do { const int kb_ = KBASE(t); if (kb_ + KVBLK - 1 > qe) mask_tile(P0_, P1_, qm - kb_); } while (0)
    f32x16 pA0, pA1, pB0, pB1; float mnA, mnB, alA, alB; bf16x8 pa0, pa1, pa2, pa3;
    SWRITE_HV(0); SBAR();
    if (NT > 1) { SLOAD_H(Kh, Vh, KBASE(1)); }
    SBAR(); qkt<0, FOX>(pA0, pA1, K_lds, r32, hi, S.qr, CLT(0), cq);
    MASKT(pA0, pA1, 0); partialSM(pA0, pA1, m_reg, mnA, alA);
    if (NT > 1) { VMW(); SWRITE_H(1); }
    __syncthreads();
#define HALF_STEP(PX0, PX1, mnX, alX, PY0, PY1, alY, t, KB, VB, SB) do {                                                      \
        SBAR(); qkt<KB, FOX>(PX0, PX1, K_lds, r32, hi, S.qr, CLT(t), cq);                                          \
        finishSM(PY0, PY1, alY, l_reg, pa0, pa1, pa2, pa3); SBAR();                                                           \
        if ((t) + 1 < NT) { SLOAD_H(Kh, Vh, KBASE((t) + 1)); SBAR(); }                                                        \
        pv_tile<VB>(o, vb0, pa0, pa1, pa2, pa3); MASKT(PX0, PX1, (t)); partialSM(PX0, PX1, m_reg, mnX, alX);                  \
        __syncthreads();                                                                                                      \
        if ((t) + 1 < NT) { VMW(); SWRITE_H(SB); }                                                                            \
        RESC(alX); __syncthreads(); } while (0)
    for (int t = 1; t + 1 < NT; t += 2) {
        HALF_STEP(pB0, pB1, mnB, alB, pA0, pA1, alA, t, 1, 0, 0);
        HALF_STEP(pA0, pA1, mnA, alA, pB0, pB1, alB, t + 1, 0, 1, 1);
    }
    constexpr bool even = true;
    if (even) { SBAR(); qkt<1, FOX>(pB0, pB1, K_lds, r32, hi, S.qr, CLT(NT - 1), cq); SBAR(); }
    const BlockRef nxt = nref();
    SLOAD_H(nxt.K, nxt.V, nxt.jlo * KVBLK); SBAR();
#pragma unroll
    for (int d0 = 0; d0 < 8; ++d0) S.qr[d0] = LD8(wsb + (size_t)nxt.Q + (unsigned)((wid * QBLK + r32) * D + d0 * 16 + hi * 8) * 2u);
    SBAR();
    finishSM(pA0, pA1, alA, l_reg, pa0, pa1, pa2, pa3); SBAR();
    pv_tile<0>(o, vb0, pa0, pa1, pa2, pa3);
    if (even) { MASKT(pB0, pB1, NT - 1); partialSM(pB0, pB1, m_reg, mnB, alB); __syncthreads(); RESC(alB);
        finishSM(pB0, pB1, alB, l_reg, pa0, pa1, pa2, pa3); SBAR(); pv_tile<1>(o, vb0, pa0, pa1, pa2, pa3); }
    SBAR(); VMWN(8); SWRITE_HK(0); SBAR();
    if (hi == 0) li_l[r32] = l_reg; asm volatile("s_waitcnt lgkmcnt(0)" ::: "memory");
    float rli[16];
#pragma unroll
    for (int r = 0; r < 16; ++r) rli[r] = __builtin_amdgcn_rcpf(li_l[crow(r, hi)]);
    bf16_t* Ow = (bf16_t*)(const_cast<unsigned char*>(wsb) + (size_t)cur.O) + (size_t)(wid * QBLK) * D;
#pragma unroll
    for (int r = 0; r < 16; ++r) { const int orow = crow(r, hi);
#pragma unroll
        for (int d0 = 0; d0 < 4; ++d0) { const float v = o[d0][r] * rli[r];
            const float vn = __uint_as_float((unsigned)__builtin_amdgcn_update_dpp(0, (int)__float_as_uint(v), 0xB1, 0xF, 0xF, false));
            if ((r32 & 1) == 0) *(unsigned*)(Ow + (size_t)orow * D + d0 * 32 + r32) = cvtpk(v, vn); } }
    __syncthreads();
#undef RESC
#undef KBASE
#undef CLT
#undef MASKT
#undef HALF_STEP
}
constexpr int W_OFF_V1 = 3 * SHM_V, W_OFF_K = 6 * SHM_V, W_OFF_WS = 133120, W_LDS_BYTES = W_OFF_WS + NW * 64 * 4;
struct BlockRefW { unsigned Q, K, V0, V1, O0, O1; int P0; };
struct SeamW { bf16x8 qr[8]; int vs; };
#define DMA_W(R, k0, bf, vsl) do { const unsigned kb_ = (unsigned)(k0) * 256u; \
        const char* gk_ = (const char*)wsb + (size_t)((R).K + kb_); const char* g0_ = (const char*)wsb + (size_t)((R).V0 + kb_); const char* g1_ = (const char*)wsb + (size_t)((R).V1 + kb_); \
        const unsigned lk_ = ldsb + W_OFF_K + (bf) * SHM_K + wid * 2048, lv_ = ldsb + (unsigned)(vsl) * SHM_V + wid * 2048; \
        glds16s(uni_ptr(gk_), vofK0, lk_); glds16s(uni_ptr(gk_), (vofK0 + 1024u) ^ 64u, lk_ + 1024u); \
        glds16s(uni_ptr(g0_), vofV0, lv_); glds16s(uni_ptr(g0_), vofV1, lv_ + 1024u); \
        glds16s(uni_ptr(g1_), vofV0, lv_ + W_OFF_V1); glds16s(uni_ptr(g1_), vofV1, lv_ + W_OFF_V1 + 1024u); } while (0)
#define DMA_OFFS() \
    const unsigned ldsb = (unsigned)__builtin_amdgcn_readfirstlane((int)(unsigned)(uintptr_t)lds); \
    unsigned vofK0, vofV0, vofV1; \
    { int lane; asm volatile("v_mbcnt_lo_u32_b32 %0, -1, 0\n\tv_mbcnt_hi_u32_b32 %0, -1, %0" : "=v"(lane));     \
      const int rk0 = 4 * (2 * wid) + (lane >> 4), rk1 = rk0 + 4; vofK0 = (unsigned)(rk0 * 256 + (((lane & 15) ^ (rk0 & 7)) << 4)); (void)rk1;     \
      const int p0_ = (2 * wid) * 64 + lane, p1_ = p0_ + 64; \
      { const int sub = p0_ >> 5, kk = (sub >> 2) * 8 + ((p0_ >> 2) & 7), k = (kk & ~0xC) | ((kk & 4) << 1) | ((kk & 8) >> 1), c = (sub & 3) * 32 + (p0_ & 3) * 8; vofV0 = (unsigned)(k * 256 + c * 2); } \
      { const int sub = p1_ >> 5, kk = (sub >> 2) * 8 + ((p1_ >> 2) & 7), k = (kk & ~0xC) | ((kk & 4) << 1) | ((kk & 8) >> 1), c = (sub & 3) * 32 + (p1_ & 3) * 8; vofV1 = (unsigned)(k * 256 + c * 2); } }
__device__ __forceinline__ void attn_primeW(const unsigned char* wsb, const BlockRefW& cur, char* lds, SeamW& S) {
    const int tid = threadIdx.x, wid = __builtin_amdgcn_readfirstlane(tid >> 6), lane = tid & 63, r32 = lane & 31, hi = lane >> 5;
    DMA_OFFS();
    S.vs = 0;
    DMA_W(cur, 0, 0, 0);
#pragma unroll
    for (int d0 = 0; d0 < 8; ++d0) S.qr[d0] = LD8(wsb + (size_t)cur.Q + (unsigned)((wid * QBLK + r32) * D + d0 * 16 + hi * 8) * 2u);
    VMW();
    __syncthreads();
}
template <class NR>
__device__ __forceinline__ void attn_blockW(const unsigned char* wsb, const BlockRefW& cur, const NR& nref, char* lds, SeamW& S) {
    const int tid = threadIdx.x, wid = __builtin_amdgcn_readfirstlane(tid >> 6), lane = tid & 63, r32 = lane & 31, hi = lane >> 5;
    const int NT = (cur.P0 + QB) / KVBLK;
    const int qlo = cur.P0 + wid * QBLK, qe = qlo | 63, qm = (qlo | 63) - 4 * hi;
    char* V_lds = lds; char* K_lds = lds + W_OFF_K;
    float* ws = (float*)(lds + W_OFF_WS) + wid * 64; float* li_l = ws, * al_l = ws + 32;
    float m_reg = -1e30f, l_reg = 0; f32x16 o[8] = {};
    DMA_OFFS();
    const int vb0 = (int)(uintptr_t)V_lds + v_rd_base(lane);
    static_assert(PV8_V1 == W_OFF_V1 && v_rd_off(3, 3, 1) + PV8_V1 < 65536, "V1 ring reachable by the 16-bit ds offset");
#define RESCW(a) do { if (__any((a) < 1.f)) { if (hi == 0) al_l[r32] = (a); asm volatile("s_waitcnt lgkmcnt(0)" ::: "memory");              \
                      for (int d_ = 0; d_ < 8; ++d_) for (int r = 0; r < 16; ++r) o[d_][r] *= al_l[crow(r, hi)]; } } while (0)
#define MASKW(P0_, P1_, t) do { const int kb_ = (t) * KVBLK; if (kb_ + KVBLK - 1 > qe) mask_tile(P0_, P1_, qm - kb_); } while (0)
    f32x16 p0, p1; float mn, al; bf16x8 pa0, pa1, pa2, pa3;
    const bool lag = wid >= 4;
    int vs = S.vs;
#define PVW(slot) do { pv_pipe8(o, vb0 + (slot) * SHM_V, pa0, pa1, pa2, pa3); } while (0)
#define STEPW(t, BF) do { const int nvs_ = vs == 2 ? 0 : vs + 1;                                                                \
        DMA_W(cur, ((t) + 1) * KVBLK, 1 - (BF), nvs_);                                                                          \
        if (lag && (t) > 0) { SBAR(); PVW(vs == 0 ? 2 : vs - 1); }                                                               \
        SBAR(); qkt_lean<BF>(p0, p1, K_lds, r32, hi, S.qr); SBAR();                                                            \
        MASKW(p0, p1, (t)); partialSM(p0, p1, m_reg, mn, al); RESCW(al); finishSM(p0, p1, al, l_reg, pa0, pa1, pa2, pa3); SBAR(); \
        if (!lag) { PVW(vs); }                                                                                                   \
        VMW(); __syncthreads(); vs = nvs_; } while (0)
    for (int t = 0; t + 2 < NT; t += 2) { STEPW(t, 0); STEPW(t + 1, 1); }
    STEPW(NT - 2, 0);
    const BlockRefW nxt = nref();
    const int nvs = vs == 2 ? 0 : vs + 1;
    DMA_W(nxt, 0, 0, nvs);
    if (lag) { SBAR(); PVW(vs == 0 ? 2 : vs - 1); }
    SBAR(); qkt_lean<1>(p0, p1, K_lds, r32, hi, S.qr); SBAR();
#pragma unroll
    for (int d0 = 0; d0 < 8; ++d0) S.qr[d0] = LD8(wsb + (size_t)nxt.Q + (unsigned)((wid * QBLK + r32) * D + d0 * 16 + hi * 8) * 2u);
    SBAR();
    MASKW(p0, p1, NT - 1); partialSM(p0, p1, m_reg, mn, al); RESCW(al); finishSM(p0, p1, al, l_reg, pa0, pa1, pa2, pa3); SBAR();
    PVW(vs);
    S.vs = nvs;
    if (hi == 0) li_l[r32] = l_reg; asm volatile("s_waitcnt lgkmcnt(0)" ::: "memory");
    float rli[16];
#pragma unroll
    for (int r = 0; r < 16; ++r) rli[r] = __builtin_amdgcn_rcpf(li_l[crow(r, hi)]);
    { int ln_; asm volatile("v_mbcnt_lo_u32_b32 %0, -1, 0\n\tv_mbcnt_hi_u32_b32 %0, -1, %0" : "=v"(ln_));
      const int r32b = ln_ & 31, hib = ln_ >> 5; const unsigned lo_ = (unsigned)((wid * QBLK + 4 * hib) * D + r32b) * 2u;
#pragma unroll
      for (int hv = 0; hv < 2; ++hv) {
        unsigned char* Ob = const_cast<unsigned char*>(wsb) + (size_t)(hv ? cur.O1 : cur.O0);
#pragma unroll
        for (int r = 0; r < 16; ++r) { const unsigned ro_ = lo_ + (unsigned)(((r & 3) + 8 * (r >> 2)) * D) * 2u;
#pragma unroll
            for (int d0 = 0; d0 < 4; ++d0) { const float v = o[hv * 4 + d0][r] * rli[r];
                const float vn = __uint_as_float((unsigned)__builtin_amdgcn_update_dpp(0, (int)__float_as_uint(v), 0xB1, 0xF, 0xF, false));
                if ((r32b & 1) == 0) *(unsigned*)(Ob + (ro_ + (unsigned)(d0 * 64))) = cvtpk(v, vn); } }
      } }
    VMW(); __syncthreads();
#undef RESCW
#undef MASKW
#undef STEPW
#undef PVW
}
#undef DMA_W
#undef DMA_OFFS
#undef ROWB
#undef VMW
#undef VMWN
#undef LD8
#undef SLOAD_H
#undef SWRITE_HK
#undef SWRITE_HV
#undef SWRITE_H
#undef KSWZ
#undef SBAR
}
#ifndef MK_FP8
#define MK_FP8 1
#endif
constexpr int FP8_WSHIFT = 8, FP8_HGSHIFT = 3, FP8_HDSHIFT = 2, FP8_YSHIFT = 6;
#ifndef MK_YS8
#define MK_YS8 1
#endif
__device__ __forceinline__ float clamp448(float v) { return __builtin_amdgcn_fmed3f(v, -448.0f, 448.0f); }
__device__ __forceinline__ unsigned pk_fp8x4(float a, float b, float c, float d) {
    int w = 0; w = __builtin_amdgcn_cvt_pk_fp8_f32(clamp448(a), clamp448(b), w, false); w = __builtin_amdgcn_cvt_pk_fp8_f32(clamp448(c), clamp448(d), w, true); return (unsigned)w; }
#ifndef MK_FP6
#define MK_FP6 1
#endif
typedef float v16f_t __attribute__((ext_vector_type(16)));
typedef int v6i_t __attribute__((ext_vector_type(6)));
__device__ __forceinline__ void fp6_record(const v16f_t a, const v16f_t b, u32x4& lo, u32x4& hi) {
    float mx = 0.f;
#pragma unroll
    for (int i = 0; i < 16; ++i) asm("v_max3_f32 %0, |%1|, |%2|, %0" : "+v"(mx) : "v"(a[i]), "v"(b[i]));
    int sb = (int)((__float_as_uint(mx) >> 23) & 0xffu) - 2; sb = sb < 1 ? 1 : sb;
    const float scale = __uint_as_float((unsigned)sb << 23);
    const v6i_t r = __builtin_amdgcn_cvt_scalef32_2xpk16_fp6_f32(a, b, scale);
    lo = (u32x4){(unsigned)r[0], (unsigned)r[1], (unsigned)r[2], (unsigned)r[3]}; hi = (u32x4){(unsigned)r[4], (unsigned)r[5], (unsigned)sb, 0u};
}
__device__ __forceinline__ void xpose4(float (&X)[4][8]) {
#pragma unroll
    for (int m = 0; m < 2; ++m)
#pragma unroll
        for (int j = 0; j < 8; ++j) { auto r = __builtin_amdgcn_permlane32_swap(__float_as_uint(X[m][j]), __float_as_uint(X[m + 2][j]), false, false); X[m][j] = __uint_as_float(r[0]); X[m + 2][j] = __uint_as_float(r[1]); }
#pragma unroll
    for (int m = 0; m < 4; m += 2)
#pragma unroll
        for (int j = 0; j < 8; ++j) { auto r = __builtin_amdgcn_permlane16_swap(__float_as_uint(X[m][j]), __float_as_uint(X[m + 1][j]), false, false); X[m][j] = __uint_as_float(r[0]); X[m + 1][j] = __uint_as_float(r[1]); }
}
#define XROW16(X, q) X[q][0], X[q][1], X[q][2], X[q][3], X[q][4], X[q][5], X[q][6], X[q][7]
#ifndef MK_XINIT
#define MK_XINIT 1
#endif
#ifndef MK_FUSE_NORMS
#define MK_FUSE_NORMS 1
#endif
namespace pg8 {
struct EpiQKV {
    bf16_t* QKV; const float* rope; unsigned* ctl; LAS float* nsc;
    __device__ __forceinline__ void operator()(const f32x4 (&acc)[2][2][4][2], const Unit& u, int wr, int wc, int fr, int fq) const {
        const int pn = u.pn; const bool isrope = pn < 8; const float sc = (pn < 4 || (pn >= 12 && pn < 16)) ? QSCALE : 1.0f;
        const bool isnorm = MK_FUSE_NORMS && pn >= 12 && pn < 20;
        const int cw = wc * 32 + 8 * fq;
#pragma unroll
        for (int ai = 0; ai < 2; ++ai)
#pragma unroll
            for (int m = 0; m < 4; ++m) {
                const int row = u.pm * BM + ai * HALF + wr * 64 + m * 16 + fr;
                f32x4 cs0 = {1.f, 0.f, 1.f, 0.f}, cs1 = {1.f, 0.f, 1.f, 0.f};
                if (isrope) { const float* rp = rope + (size_t)row * 128 + (16 * wc + 4 * fq) * 2; cs0 = *(const f32x4*)rp; cs1 = *(const f32x4*)(rp + 4); }
#pragma unroll
                for (int bj = 0; bj < 2; ++bj) {
                    f32x4 v0 = acc[ai][bj][m][0], v1 = acc[ai][bj][m][1];
                    if (isrope) {
                        const f32x4 a = v0, b = v1;
                        v0[0] = a[0] * cs0[0] - a[1] * cs0[1]; v0[1] = a[1] * cs0[0] + a[0] * cs0[1]; v0[2] = a[2] * cs0[2] - a[3] * cs0[3]; v0[3] = a[3] * cs0[2] + a[2] * cs0[3];
                        v1[0] = b[0] * cs1[0] - b[1] * cs1[1]; v1[1] = b[1] * cs1[0] + b[0] * cs1[1]; v1[2] = b[2] * cs1[2] - b[3] * cs1[3]; v1[3] = b[3] * cs1[2] + b[2] * cs1[3];
                    }
                    v0 = v0 * sc; v1 = v1 * sc;
                    if (isnorm) { float ss = (v0[0] * v0[0] + v0[1] * v0[1]) + (v0[2] * v0[2] + v0[3] * v0[3]) + (v1[0] * v1[0] + v1[1] * v1[1]) + (v1[2] * v1[2] + v1[3] * v1[3]);
                        ss += __shfl_xor(ss, 16); ss += __shfl_xor(ss, 32);
                        if (fq == 0) nsc[((ai * HALF + wr * 64 + m * 16 + fr) * 2 + bj) * 4 + wc] = ss; }
                    u32x4 w; w.x = cvt_pk_bf16(v0[0], v0[1]); w.y = cvt_pk_bf16(v0[2], v0[3]); w.z = cvt_pk_bf16(v1[0], v1[1]); w.w = cvt_pk_bf16(v1[2], v1[3]);
                    *(u32x4*)(QKV + ((size_t)(pn * 2 + bj) * MTOK + row) * 128 + cw) = w;
                }
            }
        if (isnorm) {
            __syncthreads();
            const int t = (int)threadIdx.x; const f32x4 pq = *(const LAS f32x4*)(nsc + t * 4);
            float s = (pq.x + pq.y) + (pq.z + pq.w);
            s = fmaxf(s, __shfl_xor(s, 2)); s = fmaxf(s, __shfl_xor(s, 4)); s = fmaxf(s, __shfl_xor(s, 8)); s = fmaxf(s, __shfl_xor(s, 16)); s = fmaxf(s, __shfl_xor(s, 32));
            if ((t & 63) < 2) { const int isk = pn >= 16, hd = ((pn - (isk ? 16 : 12)) * 2) + (t & 1), bh = (u.pm >> 4) * 8 + hd;
                atomicMax(ctl + (isk ? CW_KMAX + bh : CW_QMAX + bh * 16 + (u.pm & 15)), __float_as_uint(s)); }
        }
    }
};
struct EpiOut {
    const float* x; float* h; bf16_t* hg; const float* gffn;
    __device__ __forceinline__ void load_init(f32x4 (&acc)[2][2][4][2], const Unit& u, int wr, int wc, int fr, int fq) const {
#pragma unroll
        for (int bj = 0; bj < 2; ++bj)
#pragma unroll
            for (int ai = 0; ai < 2; ++ai)
#pragma unroll
                for (int m = 0; m < 4; ++m) { const size_t off = (size_t)(u.pm * BM + ai * HALF + wr * 64 + m * 16 + fr) * DM + u.pn * BM + bj * HALF + wc * 32 + 8 * fq;
                    acc[ai][bj][m][0] = *(const f32x4*)(x + off); acc[ai][bj][m][1] = *(const f32x4*)(x + off + 4); }
    }
    __device__ __forceinline__ void operator()(const f32x4 (&acc)[2][2][4][2], const Unit& u, int wr, int wc, int fr, int fq) const {
#pragma unroll
        for (int bj = 0; bj < 2; ++bj) {
            const int col0 = u.pn * BM + bj * HALF + wc * 32 + 8 * fq;
            const f32x4 g0 = *(const f32x4*)(gffn + col0), g1 = *(const f32x4*)(gffn + col0 + 4);
#pragma unroll
            for (int ai = 0; ai < 2; ++ai) {
#if MK_FP8 && MK_FP6
                float X[4][8];
#endif
#pragma unroll
                for (int m = 0; m < 4; ++m) {
                    const size_t off = (size_t)(u.pm * BM + ai * HALF + wr * 64 + m * 16 + fr) * DM + col0;
                    const f32x4 h0 = MK_XINIT ? acc[ai][bj][m][0] : *(const f32x4*)(x + off) + acc[ai][bj][m][0], h1 = MK_XINIT ? acc[ai][bj][m][1] : *(const f32x4*)(x + off + 4) + acc[ai][bj][m][1];
                    *(f32x4*)(h + off) = h0; *(f32x4*)(h + off + 4) = h1;
                    const f32x4 a = h0 * g0, b = h1 * g1;
#if MK_FP8 && MK_FP6
                    X[m][0] = a[0]; X[m][1] = a[1]; X[m][2] = a[2]; X[m][3] = a[3]; X[m][4] = b[0]; X[m][5] = b[1]; X[m][6] = b[2]; X[m][7] = b[3];
#elif MK_FP8
                    constexpr float sc8 = (float)(1 << FP8_HGSHIFT);
                    u32x2 w8; w8.x = pk_fp8x4(a[0] * sc8, a[1] * sc8, a[2] * sc8, a[3] * sc8); w8.y = pk_fp8x4(b[0] * sc8, b[1] * sc8, b[2] * sc8, b[3] * sc8);
                    *(u32x2*)((unsigned char*)hg + off) = w8;
#else
                    u32x4 w; w.x = cvt_pk_bf16(a[0], a[1]); w.y = cvt_pk_bf16(a[2], a[3]); w.z = cvt_pk_bf16(b[0], b[1]); w.w = cvt_pk_bf16(b[2], b[3]);
                    *(u32x4*)(hg + off) = w;
#endif
                }
#if MK_FP8 && MK_FP6
                xpose4(X);
                u32x4 lo, hi; fp6_record((v16f_t){XROW16(X, 0), XROW16(X, 1)}, (v16f_t){XROW16(X, 2), XROW16(X, 3)}, lo, hi);
                unsigned char* rp = (unsigned char*)hg + (size_t)(u.pm * BM + ai * HALF + wr * 64 + fq * 16 + fr) * DM + (2 * u.pn + bj) * 128 + 16 * wc;
                *(u32x4*)rp = lo; *(u32x4*)(rp + 64) = hi;
#endif
            }
        }
    }
};
template <int SC> __device__ __forceinline__ f32x2 swiglu_pk(f32x2 g, f32x2 u) {
    g.x = fminf(g.x, 7.0f); g.y = fminf(g.y, 7.0f);
    u.x = __builtin_amdgcn_fmed3f(u.x, -7.0f, 7.0f); u.y = __builtin_amdgcn_fmed3f(u.y, -7.0f, 7.0f);
    const f32x2 t = g * (-1.702f * 1.4426950408889634f);
    f32x2 e; e.x = __builtin_amdgcn_exp2f(t.x); e.y = __builtin_amdgcn_exp2f(t.y);
    const f32x2 d = e + 1.0f;
    f32x2 r; r.x = __builtin_amdgcn_rcpf(d.x); r.y = __builtin_amdgcn_rcpf(d.y);
    const f32x2 us = u * (float)SC + (float)SC;
    return (g * r) * us;
}
__device__ __forceinline__ unsigned pk_fp8x4_nc(f32x2 a, f32x2 b) {
    int w = 0; w = __builtin_amdgcn_cvt_pk_fp8_f32(a.x, a.y, w, false); w = __builtin_amdgcn_cvt_pk_fp8_f32(b.x, b.y, w, true); return (unsigned)w; }
__device__ __forceinline__ float swiglu1(float g, float uu) {
    g = fminf(g, 7.0f); uu = fminf(fmaxf(uu, -7.0f), 7.0f);
    const float e = __builtin_amdgcn_exp2f(g * (-1.702f * 1.4426950408889634f));
    return g * __builtin_amdgcn_rcpf(1.0f + e) * (uu + 1.0f);
}
struct EpiGU {
    bf16_t* hdn; const float* bgate; const float* bup; const float* rstd; const LAS int* tab; const LAS float* rl;
    __device__ __forceinline__ void operator()(const f32x4 (&acc)[2][2][4][2], const Unit& u, int wr, int wc, int fr, int fq) const {
        const int j0 = u.pn * HALF + wc * 32 + 8 * fq; const int cnt = tab[NE + 1 + u.e];
#if MK_EPI_LDS
        const LAS float* bl = rl + 256 + wc * 32 + 8 * fq;
        const f32x4 bg0 = *(const LAS f32x4*)(bl), bg1 = *(const LAS f32x4*)(bl + 4), bu0 = *(const LAS f32x4*)(bl + 128), bu1 = *(const LAS f32x4*)(bl + 132);
#else
        const f32x4 bg0 = *(const f32x4*)(bgate + (size_t)u.e * DM + j0), bg1 = *(const f32x4*)(bgate + (size_t)u.e * DM + j0 + 4);
        const f32x4 bu0 = *(const f32x4*)(bup + (size_t)u.e * DM + j0), bu1 = *(const f32x4*)(bup + (size_t)u.e * DM + j0 + 4);
#endif
#pragma unroll
        for (int ai = 0; ai < 2; ++ai) {
#if MK_FP8 && MK_FP6
            float X[4][8];
#endif
#pragma unroll
            for (int m = 0; m < 4; ++m) {
                const int r = ai * HALF + wr * 64 + m * 16 + fr, pos = u.rows0 + r;
                float rs = MK_EPI_LDS ? rl[r] : rstd[(size_t)u.e * ECAP + pos]; rs = pos < cnt ? rs : 0.f;
                const f32x4 g0 = acc[ai][0][m][0] * rs + bg0, g1 = acc[ai][0][m][1] * rs + bg1, u0 = acc[ai][1][m][0] * rs + bu0, u1 = acc[ai][1][m][1] * rs + bu1;
#if MK_FP8 && MK_FP6
                { const f32x2 h00 = swiglu_pk<1>((f32x2){g0[0], g0[1]}, (f32x2){u0[0], u0[1]}), h01 = swiglu_pk<1>((f32x2){g0[2], g0[3]}, (f32x2){u0[2], u0[3]});
                  const f32x2 h10 = swiglu_pk<1>((f32x2){g1[0], g1[1]}, (f32x2){u1[0], u1[1]}), h11 = swiglu_pk<1>((f32x2){g1[2], g1[3]}, (f32x2){u1[2], u1[3]});
                  X[m][0] = h00.x; X[m][1] = h00.y; X[m][2] = h01.x; X[m][3] = h01.y; X[m][4] = h10.x; X[m][5] = h10.y; X[m][6] = h11.x; X[m][7] = h11.y; }
#elif MK_FP8
                constexpr int SC8 = 1 << FP8_HDSHIFT;
                const f32x2 h00 = swiglu_pk<SC8>((f32x2){g0[0], g0[1]}, (f32x2){u0[0], u0[1]}), h01 = swiglu_pk<SC8>((f32x2){g0[2], g0[3]}, (f32x2){u0[2], u0[3]});
                const f32x2 h10 = swiglu_pk<SC8>((f32x2){g1[0], g1[1]}, (f32x2){u1[0], u1[1]}), h11 = swiglu_pk<SC8>((f32x2){g1[2], g1[3]}, (f32x2){u1[2], u1[3]});
                u32x2 w8; w8.x = pk_fp8x4_nc(h00, h01); w8.y = pk_fp8x4_nc(h10, h11);
                *(u32x2*)((unsigned char*)hdn + (size_t)(u.pm * BM + r) * DM + j0) = w8;
#else
                u32x4 w; w.x = cvt_pk_bf16(swiglu1(g0[0], u0[0]), swiglu1(g0[1], u0[1])); w.y = cvt_pk_bf16(swiglu1(g0[2], u0[2]), swiglu1(g0[3], u0[3]));
                w.z = cvt_pk_bf16(swiglu1(g1[0], u1[0]), swiglu1(g1[1], u1[1])); w.w = cvt_pk_bf16(swiglu1(g1[2], u1[2]), swiglu1(g1[3], u1[3]));
                *(u32x4*)(hdn + (size_t)(u.pm * BM + r) * DM + j0) = w;
#endif
            }
#if MK_FP8 && MK_FP6
            xpose4(X);
            u32x4 lo, hi; fp6_record((v16f_t){XROW16(X, 0), XROW16(X, 1)}, (v16f_t){XROW16(X, 2), XROW16(X, 3)}, lo, hi);
            unsigned char* rp = (unsigned char*)hdn + (size_t)(u.pm * BM + ai * HALF + wr * 64 + fq * 16 + fr) * DM + u.pn * 128 + 16 * wc;
            *(u32x4*)rp = lo; *(u32x4*)(rp + 64) = hi;
#endif
        }
    }
};
struct EpiDown {
    bf16_t* ys; const float* bdown; const float* gate; const LAS int* tab; const LAS float* rl;
    __device__ __forceinline__ void operator()(const f32x4 (&acc)[2][2][4][2], const Unit& u, int wr, int wc, int fr, int fq) const {
        const int cnt = tab[NE + 1 + u.e]; const int c0 = u.pn * BM + wc * 32 + 8 * fq;
#if MK_EPI_LDS
        const LAS float* bl = rl + 256 + wc * 32 + 8 * fq;
        const f32x4 b00 = *(const LAS f32x4*)(bl), b01 = *(const LAS f32x4*)(bl + 4), b10 = *(const LAS f32x4*)(bl + HALF), b11 = *(const LAS f32x4*)(bl + HALF + 4);
#else
        const float* bp = bdown + (size_t)u.e * DM + c0;
        const f32x4 b00 = *(const f32x4*)(bp), b01 = *(const f32x4*)(bp + 4), b10 = *(const f32x4*)(bp + HALF), b11 = *(const f32x4*)(bp + HALF + 4);
#endif
#pragma unroll
        for (int ai = 0; ai < 2; ++ai)
#pragma unroll
            for (int m = 0; m < 4; ++m) {
                const int r = ai * HALF + wr * 64 + m * 16 + fr, pos = u.rows0 + r;
                float gt = MK_EPI_LDS ? rl[r] : gate[(size_t)u.e * ECAP + pos]; gt = pos < cnt ? gt : 0.f;
#if MK_YS8
                const float gs = gt * (float)(1 << FP8_YSHIFT);
                unsigned char* yp = (unsigned char*)ys + (size_t)(u.pm * BM + r) * DM + c0;
                { const f32x4 a = (acc[ai][0][m][0] + b00) * gs, b = (acc[ai][0][m][1] + b01) * gs; u32x2 w8; w8.x = pk_fp8x4(a[0], a[1], a[2], a[3]); w8.y = pk_fp8x4(b[0], b[1], b[2], b[3]); *(u32x2*)yp = w8; }
                { const f32x4 a = (acc[ai][1][m][0] + b10) * gs, b = (acc[ai][1][m][1] + b11) * gs; u32x2 w8; w8.x = pk_fp8x4(a[0], a[1], a[2], a[3]); w8.y = pk_fp8x4(b[0], b[1], b[2], b[3]); *(u32x2*)(yp + HALF) = w8; }
#else
                bf16_t* yp = ys + (size_t)(u.pm * BM + r) * DM + c0;
                { const f32x4 a = (acc[ai][0][m][0] + b00) * gt, b = (acc[ai][0][m][1] + b01) * gt; u32x4 w; w.x = cvt_pk_bf16(a[0], a[1]); w.y = cvt_pk_bf16(a[2], a[3]); w.z = cvt_pk_bf16(b[0], b[1]); w.w = cvt_pk_bf16(b[2], b[3]); *(u32x4*)yp = w; }
                { const f32x4 a = (acc[ai][1][m][0] + b10) * gt, b = (acc[ai][1][m][1] + b11) * gt; u32x4 w; w.x = cvt_pk_bf16(a[0], a[1]); w.y = cvt_pk_bf16(a[2], a[3]); w.z = cvt_pk_bf16(b[0], b[1]); w.w = cvt_pk_bf16(b[2], b[3]); *(u32x4*)(yp + HALF) = w; }
#endif
            }
    }
};
}

typedef GAS unsigned gu32;
#define RLX_AGENT __ATOMIC_RELAXED, __HIP_MEMORY_SCOPE_AGENT
#define LDS_WAIT() asm volatile("s_waitcnt lgkmcnt(0)" ::: "memory")
#define VM_WAIT() asm volatile("s_waitcnt vmcnt(0)" ::: "memory")
#define XB_TMO      128
#define XB_XCNT(j)  (256  + 64 * (j))
#define XB_XSUB(j)  (1280 + 64 * (j))
#define XB_XGEN(j)  (2304 + 64 * (j))
#define XB_TOP      3328
#define XB_TOPGEN   3392
#define XCD_BAR_WORDS 3456
#define XB_SPIN_CAP (1u << 18)
__device__ __forceinline__ unsigned xb_ld(unsigned* p)              { return __hip_atomic_load(p, __ATOMIC_RELAXED, __HIP_MEMORY_SCOPE_AGENT); }
__device__ __forceinline__ unsigned xb_add(unsigned* p, unsigned v) { return __hip_atomic_fetch_add(p, v, __ATOMIC_RELAXED, __HIP_MEMORY_SCOPE_AGENT); }
__device__ __forceinline__ unsigned xb_xcc_id() { return (unsigned)__builtin_amdgcn_s_getreg((3 << 11) | 20) & 0xFu; }
#define XB_SPIN(cond, bar) do { unsigned _sp = 0; while (cond) { __builtin_amdgcn_s_sleep(1); \
    if ((++_sp & 255u) == 0u) { if (xb_ld(&(bar)[XB_TMO])) break; if (_sp > XB_SPIN_CAP) { atomicAdd(&(bar)[XB_TMO], 1u); break; } } } } while (0)
struct XcdBarrier { unsigned* bar; unsigned x; volatile LAS unsigned* st; };
__device__ __forceinline__ XcdBarrier xcd_barrier_post(unsigned* bar, volatile LAS unsigned* st) {
    XcdBarrier b; b.bar = bar; b.x = xb_xcc_id(); b.st = st;
    if (threadIdx.x == 0) (void)xb_add(&bar[XB_XCNT(b.x)], 1u);
    return b;
}
__device__ __forceinline__ void xcd_barrier_complete(unsigned* bar, unsigned x, unsigned& nloc, unsigned& nx) {
    const unsigned G = gridDim.x * gridDim.y * gridDim.z;
    unsigned sum, cnt, mine, sp = 0u;
    for (;;) {
        sum = 0u; cnt = 0u; mine = 0u;
#pragma unroll
        for (unsigned j = 0; j < 16; ++j) { const unsigned c = xb_ld(&bar[XB_XCNT(j)]); sum += c; cnt += (c > 0u) ? 1u : 0u; mine = (j == x) ? c : mine; }
        if (sum == G) break;
        __builtin_amdgcn_s_sleep(1);
        if ((++sp & 255u) == 0u) { if (xb_ld(&bar[XB_TMO])) break; if (sp > XB_SPIN_CAP) { atomicAdd(&bar[XB_TMO], 1u); break; } }
    }
    nloc = mine > 0u ? mine : 1u; nx = cnt > 0u ? cnt : 1u;
}
__device__ __forceinline__ void xcd_barrier(const XcdBarrier& b) {
    asm volatile("s_waitcnt vmcnt(0)" ::: "memory");
    __syncthreads();
    if (threadIdx.x == 0) {
        unsigned* bar = b.bar;
        __builtin_amdgcn_s_waitcnt(0);
        unsigned nloc = b.st[0], nx = b.st[1];
        if (nloc == 0u) { xcd_barrier_complete(bar, b.x, nloc, nx); b.st[0] = nloc; b.st[1] = nx; }
        const unsigned old = xb_add(&bar[XB_XSUB(b.x)], 1u);
        const unsigned gen = old / nloc;
        if (old + 1u == (gen + 1u) * nloc) {
            __builtin_amdgcn_fence(__ATOMIC_RELEASE, "agent");
            asm volatile("s_waitcnt vmcnt(0)" ::: "memory");
            const unsigned og = xb_add(&bar[XB_TOP], 1u);
            const unsigned tg = og / nx;
            if (og + 1u == (tg + 1u) * nx) xb_add(&bar[XB_TOPGEN], 1u);
            else XB_SPIN(xb_ld(&bar[XB_TOPGEN]) == tg, bar);
            __builtin_amdgcn_fence(__ATOMIC_ACQUIRE, "agent");
            xb_add(&bar[XB_XGEN(b.x)], 1u);
            asm volatile("s_waitcnt vmcnt(0)" ::: "memory");
        } else {
            XB_SPIN(xb_ld(&bar[XB_XGEN(b.x)]) == gen, bar);
            __builtin_amdgcn_fence(__ATOMIC_ACQUIRE, "agent");
            asm volatile("s_waitcnt vmcnt(0)" ::: "memory");
        }
    }
    __syncthreads();
}

struct Args { const void* in[22]; float* out; unsigned char* ws; int ph_lo, ph_hi; };
typedef __attribute__((address_space(4))) const volatile Args* KArgs;
#define KIN(k) ((const void*)ka->in[k])
struct Frame {
    LAS unsigned char* lds; int wave, G, vcu;
    gu32* ctl; unsigned char* ws;
};

__device__ __forceinline__ void tr_item(const float* W, size_t ldw, int k0, int c0a, int c0b, bool perm, bf16_t* dst  , LAS float* scr, int lane) {
    const int kr = lane >> 4, q = lane & 15; const int col = (q < 8) ? c0a + 4 * q : c0b + 4 * (q - 8);
    f32x4 v[16];
#pragma unroll
    for (int it = 0; it < 16; ++it) v[it] = *(const f32x4*)(W + (size_t)(k0 + 4 * it + kr) * ldw + col);
#pragma unroll
    for (int it = 0; it < 16; ++it) { const int k = 4 * it + kr; *(LAS f32x4*)(scr + k * 64 + 4 * (q ^ ((k >> 3) & 7))) = v[it]; }
    LDS_WAIT(); asm volatile("" ::: "memory");
    const int n0l = lane >> 3, c = lane & 7;
#pragma unroll
    for (int j = 0; j < 8; ++j) { const int n = n0l + 8 * j; const int slot = perm ? ((n >> 1) + 32 * (n & 1)) : n;
        const LAS float* s = scr + (8 * c) * 64 + 4 * ((slot >> 2) ^ c) + (slot & 3);
        u32x4 o; o.x = pk2(s[0 * 64], s[1 * 64]); o.y = pk2(s[2 * 64], s[3 * 64]); o.z = pk2(s[4 * 64], s[5 * 64]); o.w = pk2(s[6 * 64], s[7 * 64]);
        *(u32x4*)(dst + (size_t)n * DM + k0 + 8 * c) = o; }
    LDS_WAIT(); asm volatile("" ::: "memory");
}
__device__ __forceinline__ void tr8_load(f32x4 (&v)[16], const float* W, size_t ldw, int k0, int c0, int lane) {
    const int kr = lane >> 3, q = lane & 7; const float* p = W + (size_t)(k0 + kr) * ldw + c0 + 4 * q;
#pragma unroll
    for (int it = 0; it < 16; ++it) v[it] = __builtin_nontemporal_load((const f32x4*)(p + (size_t)(8 * it) * ldw));
}
__device__ __forceinline__ void tr6_put(const f32x4 (&v)[16], LAS float* scr, int lane) {
    const int kr = lane >> 3, q = lane & 7;
#pragma unroll
    for (int it = 0; it < 16; ++it) { const int k = 8 * it + kr; *(LAS f32x4*)(scr + k * 32 + 4 * (q ^ ((k >> 4) & 7))) = v[it]; }
    LDS_WAIT(); asm volatile("" ::: "memory");
}
__device__ __forceinline__ void tr6_emit(int k0, unsigned char* dst, LAS float* scr, int lane) {
#pragma unroll
    for (int jj = 0; jj < 2; ++jj) { const int p = lane + 64 * jj, n = p >> 2, ch = p & 3;
        v16f_t a, b;
#pragma unroll
        for (int i = 0; i < 16; ++i) { const int ka = 32 * ch + i, kb = ka + 16;
            a[i] = scr[ka * 32 + 4 * ((n >> 2) ^ (2 * ch)) + (n & 3)]; b[i] = scr[kb * 32 + 4 * ((n >> 2) ^ (2 * ch + 1)) + (n & 3)]; }
        u32x4 lo, hi; fp6_record(a, b, lo, hi);
        unsigned char* rp = dst + (size_t)n * DM + k0 + 16 * ch;
        __builtin_nontemporal_store(lo, (u32x4*)rp); __builtin_nontemporal_store(hi, (u32x4*)(rp + 64)); }
    LDS_WAIT(); asm volatile("" ::: "memory");
}
__device__ __forceinline__ void tr6_store(const f32x4 (&v)[16], int k0, unsigned char* dst, LAS float* scr, int lane) { tr6_put(v, scr, lane); tr6_emit(k0, dst, scr, lane); }
__device__ __forceinline__ void tr8_store(const f32x4 (&v)[16], int k0, unsigned char* dst  , LAS float* scr, int lane) {
    const int kr = lane >> 3, q = lane & 7;
#pragma unroll
    for (int it = 0; it < 16; ++it) { const int k = 8 * it + kr; *(LAS f32x4*)(scr + k * 32 + 4 * (q ^ ((k >> 4) & 7))) = v[it]; }
    LDS_WAIT(); asm volatile("" ::: "memory");
    const int n0l = lane >> 3, c = lane & 7; constexpr float sc8 = (float)(1 << FP8_WSHIFT);
#pragma unroll
    for (int j = 0; j < 4; ++j) { const int n = n0l + 8 * j;
        const LAS float* s = scr + (16 * c) * 32 + 4 * ((n >> 2) ^ c) + (n & 3);
        u32x4 o; o.x = pk_fp8x4(s[0 * 32] * sc8, s[1 * 32] * sc8, s[2 * 32] * sc8, s[3 * 32] * sc8); o.y = pk_fp8x4(s[4 * 32] * sc8, s[5 * 32] * sc8, s[6 * 32] * sc8, s[7 * 32] * sc8);
        o.z = pk_fp8x4(s[8 * 32] * sc8, s[9 * 32] * sc8, s[10 * 32] * sc8, s[11 * 32] * sc8); o.w = pk_fp8x4(s[12 * 32] * sc8, s[13 * 32] * sc8, s[14 * 32] * sc8, s[15 * 32] * sc8);
        *(u32x4*)(dst + (size_t)n * DM + k0 + 16 * c) = o; }
    LDS_WAIT(); asm volatile("" ::: "memory");
}
__device__ __forceinline__ float log2_sigmoid(float z) {
    const float az = fabsf(z); const float e = __builtin_amdgcn_exp2f(-az * L2E);
    return fminf(z, 0.f) * L2E - __builtin_amdgcn_logf(1.0f + e) ;
}
__device__ __forceinline__ void p0_prologue(Frame& F, KArgs ka) {
    const float* x = (const float*)KIN(0); const int* pos = (const int*)KIN(1); const float* g_attn = (const float*)KIN(2); const float* w_in = (const float*)KIN(3);
    const float* b_forget = (const float*)KIN(4); const float* w_out = (const float*)KIN(11); const float* g_ffn = (const float*)KIN(12); const float* w_router = (const float*)KIN(13);
    const float* w_gate = (const float*)KIN(15); const float* w_up = (const float*)KIN(17); const float* w_down = (const float*)KIN(19);
    const int gw = F.vcu * NWAVES + F.wave, NGW = F.G * NWAVES; const int gt = F.vcu * NTHREADS + ((int)threadIdx.x), NGT = F.G * NTHREADS;
    { float* rope = (float*)(F.ws + WS_ROPE);
#pragma unroll 8
      for (int p = gt; p < MTOK * 64; p += NGT) { const int m = p >> 6, i = p & 63;
          const float invf = exp2f(-(float)i * 0.20762050593046014f); const float ang = (float)pos[m] * invf;
          const double rv = (double)ang * 0.15915494309189533576888; const float rev = (float)(rv - floor(rv));
          *(f32x2*)(rope + (size_t)p * 2) = (f32x2){__builtin_amdgcn_cosf(rev), __builtin_amdgcn_sinf(rev)}; } }
    { bf16_t* gwf = (bf16_t*)(F.ws + WS_GWF);
      for (int f = gt; f < 64 * 2 * 2 * 64; f += NGT) { const int ln = f & 63, p = (f >> 6) & 1, eh = (f >> 7) & 1, s = f >> 8;
          unsigned o[4];
#pragma unroll
          for (int j2 = 0; j2 < 4; ++j2) { unsigned hv[2];
#pragma unroll
              for (int q = 0; q < 2; ++q) { const int k = 32 * s + 8 * (ln >> 4) + 2 * j2 + q, e = 16 * eh + (ln & 15); const float val = g_ffn[k] * w_router[k * NE + e];
                  const unsigned hi = f2bf(val); const float lo = val - bf2f((unsigned short)hi); hv[q] = p ? f2bf(lo) : hi; }
              o[j2] = hv[0] | (hv[1] << 16); }
          *(u32x4*)(gwf + (size_t)f * 8) = (u32x4){o[0], o[1], o[2], o[3]}; } }
    { LAS float* gwfT = (LAS float*)F.lds;
#pragma unroll 4
      for (int k = ((int)threadIdx.x); k < DM; k += NTHREADS) { const f32x4 w0 = *(const f32x4*)(w_in + (size_t)k * INC + NQKV), w1 = *(const f32x4*)(w_in + (size_t)k * INC + NQKV + 4); const float g = g_attn[k];
          gwfT[0 * DM + k] = g * w0.x; gwfT[1 * DM + k] = g * w0.y; gwfT[2 * DM + k] = g * w0.z; gwfT[3 * DM + k] = g * w0.w; gwfT[4 * DM + k] = g * w1.x; gwfT[5 * DM + k] = g * w1.y; gwfT[6 * DM + k] = g * w1.z; gwfT[7 * DM + k] = g * w1.w; }
      __syncthreads();
      bf16_t* XN = (bf16_t*)(F.ws + WS_XN); float* flog = (float*)(F.ws + WS_FLOG);
      f32x4 gv[8];
#pragma unroll
      for (int j = 0; j < 8; ++j) gv[j] = *((const f32x4*)g_attn + ((int)(threadIdx.x & 63)) + 64 * j);
      f32x4 vn[8];
      if (gw < MTOK) { const f32x4* xr = (const f32x4*)(x + (size_t)gw * DM) + ((int)(threadIdx.x & 63));
#pragma unroll
          for (int j = 0; j < 8; ++j) vn[j] = __builtin_nontemporal_load(xr + 64 * j); }
      for (int m = gw; m < MTOK; m += NGW) {
          f32x4 v[8]; float s = 0.f;
#pragma unroll
          for (int j = 0; j < 8; ++j) { v[j] = vn[j]; s += (v[j].x * v[j].x + v[j].y * v[j].y) + (v[j].z * v[j].z + v[j].w * v[j].w); }
          if (m + NGW < MTOK) { const f32x4* xr = (const f32x4*)(x + (size_t)(m + NGW) * DM) + ((int)(threadIdx.x & 63));
#pragma unroll
              for (int j = 0; j < 8; ++j) vn[j] = __builtin_nontemporal_load(xr + 64 * j); }
          const float rstd = 1.0f / sqrtf(wave_sum(s) * (1.0f / DM) + EPS);
          unsigned long long* o8 = (unsigned long long*)(XN + (size_t)m * DM) + ((int)(threadIdx.x & 63));
#pragma unroll
          for (int j = 0; j < 8; ++j) { const f32x4 t = v[j] * gv[j] * rstd; o8[64 * j] = (unsigned long long)pk2(t.x, t.y) | ((unsigned long long)pk2(t.z, t.w) << 32); }
          float myz = 0.f;
#pragma unroll 1
          for (int jh = 0; jh < 8; ++jh) { float acc = 0.f;
#pragma unroll
              for (int j = 0; j < 8; ++j) { const f32x4 w = *(const LAS f32x4*)(gwfT + jh * DM + 256 * j + 4 * ((int)(threadIdx.x & 63))); acc += (v[j].x * w.x + v[j].y * w.y) + (v[j].z * w.z + v[j].w * w.w); }
              acc = wave_sum(acc); if (((int)(threadIdx.x & 63)) == jh) myz = acc; }
          if (((int)(threadIdx.x & 63)) < 8) flog[(size_t)m * 8 + ((int)(threadIdx.x & 63))] = log2_sigmoid(myz * rstd + b_forget[((int)(threadIdx.x & 63))]);
      }
      __syncthreads();
    }
    { LAS float* scr = (LAS float*)(F.lds + F.wave * 16384);
      bf16_t* Win = (bf16_t*)(F.ws + WS_WIN); bf16_t* Wout = (bf16_t*)(F.ws + WS_WOUT); bf16_t* Wgu = (bf16_t*)(F.ws + WS_WGU); bf16_t* Wd = (bf16_t*)(F.ws + WS_WD);
      constexpr int I_IN = 32 * 96, I_OUT = 32 * 32, I_GU = NE * 32 * 64, I_D = NE * 32 * 32, NITEMS = I_IN + I_OUT + I_GU + I_D;
      for (int it = gw; it < NITEMS; it += NGW) {
          int r = it;
          if (r < I_IN) { const int kb = r / 96, nb = r % 96, n0 = nb * 64;
              if (n0 < 2048) { const int base = n0 & ~127, i0 = ((n0 >> 6) & 1) * 32; tr_item(w_in, INC, kb * 64, base + i0, base + 64 + i0, true, Win + (size_t)n0 * DM, scr, ((int)(threadIdx.x & 63))); }
              else tr_item(w_in, INC, kb * 64, n0, n0 + 32, false, Win + (size_t)n0 * DM, scr, ((int)(threadIdx.x & 63)));
              continue; }
          r -= I_IN;
          if (r < I_OUT) { const int kb = r / 32, nb = r % 32; tr_item(w_out, DM, kb * 64, nb * 64, nb * 64 + 32, false, Wout + (size_t)nb * 64 * DM, scr, ((int)(threadIdx.x & 63))); continue; }
          r -= I_OUT;
#if MK_FP8
          break;
#else
          if (r < I_GU) { const int e = r / (32 * 64), rr = r % (32 * 64), kb = rr / 64, nb = rr % 64;
              const int pn = nb >> 2, w = nb & 3; const float* src = (w < 2 ? w_gate : w_up) + (size_t)e * DM * DM; const int c0 = pn * 128 + (w & 1) * 64;
              tr_item(src, DM, kb * 64, c0, c0 + 32, false, Wgu + ((size_t)e * 4096 + (size_t)nb * 64) * DM, scr, ((int)(threadIdx.x & 63))); continue; }
          r -= I_GU;
          { const int e = r / (32 * 32), rr = r % (32 * 32), kb = rr / 32, nb = rr % 32;
            tr_item(w_down + (size_t)e * DM * DM, DM, kb * 64, nb * 64, nb * 64 + 32, false, Wd + ((size_t)e * DM + (size_t)nb * 64) * DM, scr, ((int)(threadIdx.x & 63))); }
#endif
      }
    }
}

__device__ __forceinline__ void probe_stream(Frame& F, KArgs ka) {
    const float* src[3] = {(const float*)KIN(15), (const float*)KIN(17), (const float*)KIN(19)};
    const size_t n4 = (size_t)NE * DM * DM / 4; const size_t gt = (size_t)F.vcu * NTHREADS + threadIdx.x, NGT = (size_t)F.G * NTHREADS;
#pragma unroll
    for (int m = 0; m < 3; ++m) { unsigned* dst = (unsigned*)(F.ws + WS_HDN) + (size_t)m * n4;
#pragma unroll 8
        for (size_t i = gt; i < n4; i += NGT) { const f32x4 v = __builtin_nontemporal_load((const f32x4*)src[m] + i); dst[i] = pk_fp8x4(v.x * 256.f, v.y * 256.f, v.z * 256.f, v.w * 256.f); } }
}
#if MK_FP8
#if MK_FP6
#define P0B_STORE(v, k0, dst, scr, lane) tr6_store(v, k0, dst, scr, lane)
#else
#define P0B_STORE(v, k0, dst, scr, lane) tr8_store(v, k0, dst, scr, lane)
#endif
constexpr int P0B_ROWB = DM;
constexpr int P0B_IGU = NE * 32 * 64, P0B_ID = NE * 32 * 32, P0B_NI = P0B_IGU + P0B_ID;
__device__ __forceinline__ void p0b_experts(Frame& F, KArgs ka, const int it_lo, const int it_hi, const int rankw, const int nw, unsigned* dyn) {
    const float* w_gate = (const float*)KIN(15); const float* w_up = (const float*)KIN(17); const float* w_down = (const float*)KIN(19);
    constexpr int I_GU = P0B_IGU;
    LAS float* scr = (LAS float*)(F.lds + F.wave * 16384);
    bf16_t* Wgu = (bf16_t*)(F.ws + WS_WGU); bf16_t* Wd = (bf16_t*)(F.ws + WS_WD);
    __syncthreads();
      { const int lane = (int)(threadIdx.x & 63);
#define FP8_DESC(r_, SRC, K0, C0, DST) do { int r2 = (r_); \
          if (r2 < I_GU) { const int e = r2 / (16 * 128), rr = r2 % (16 * 128), kb = rr / 128, nb = rr % 128; const int pn = nb >> 3, w = nb & 7; \
              SRC = (w < 4 ? w_gate : w_up) + (size_t)e * DM * DM; C0 = pn * 128 + (w & 3) * 32; K0 = kb * 128; const size_t row = (size_t)e * 4096 + (size_t)nb * 32; \
              DST = (unsigned char*)Wgu + row * P0B_ROWB; } \
          else { r2 -= I_GU; const int e = r2 / (16 * 64), rr = r2 % (16 * 64), kb = rr / 64, nb = rr % 64; \
              SRC = w_down + (size_t)e * DM * DM; C0 = nb * 32; K0 = kb * 128; const size_t row = (size_t)e * DM + (size_t)nb * 32; \
              DST = (unsigned char*)Wd + row * P0B_ROWB; } } while (0)
        f32x4 va[16], vb[16]; const float* src; int k0 = 0, c0 = 0; unsigned char* dst = nullptr; const float* srcn; int k0n = 0, c0n = 0; unsigned char* dstn = nullptr;
#if MK_FP6
#define P0B_NEXT(last) (dyn != nullptr ? it_lo + __builtin_amdgcn_readfirstlane(lane == 0 ? (int)__hip_atomic_fetch_add(dyn, 1u, __ATOMIC_RELAXED, __HIP_MEMORY_SCOPE_AGENT) : 0) : (last) + nw)
        int last = P0B_NEXT(it_lo + rankw - nw), ia = last;
        if (ia < it_hi) { FP8_DESC(ia, src, k0, c0, dst); tr8_load(va, src, DM, k0, c0, lane); }
        last = P0B_NEXT(last); int ib = last;
        if (ib < it_hi) { FP8_DESC(ib, srcn, k0n, c0n, dstn); tr8_load(vb, srcn, DM, k0n, c0n, lane); }
        for (;;) {
            if (ia >= it_hi) break;
            { tr6_put(va, scr, lane); const int ke = k0; unsigned char* de = dst;
              last = P0B_NEXT(last); ia = last;
              if (ia < it_hi) { FP8_DESC(ia, src, k0, c0, dst); tr8_load(va, src, DM, k0, c0, lane); }
              tr6_emit(ke, de, scr, lane); }
            if (ib >= it_hi) break;
            { tr6_put(vb, scr, lane); const int ke = k0n; unsigned char* de = dstn;
              last = P0B_NEXT(last); ib = last;
              if (ib < it_hi) { FP8_DESC(ib, srcn, k0n, c0n, dstn); tr8_load(vb, srcn, DM, k0n, c0n, lane); }
              tr6_emit(ke, de, scr, lane); }
        }
#undef P0B_NEXT
#else
        const int NGW = nw; int it = it_lo + rankw;
        if (it < it_hi) { FP8_DESC(it, src, k0, c0, dst); tr8_load(va, src, DM, k0, c0, lane); }
        while (it < it_hi) {
            int itn = it + NGW;
            if (itn < it_hi) { FP8_DESC(itn, srcn, k0n, c0n, dstn); tr8_load(vb, srcn, DM, k0n, c0n, lane); }
            P0B_STORE(va, k0, dst, scr, lane);
            it = itn; if (it >= it_hi) break;
            itn = it + NGW;
            if (itn < it_hi) { FP8_DESC(itn, src, k0, c0, dst); tr8_load(va, src, DM, k0, c0, lane); }
            P0B_STORE(vb, k0n, dstn, scr, lane);
            it = itn;
        }
#endif
#undef FP8_DESC
      }
    __syncthreads();
}
#endif
__device__ __forceinline__ void p1_scan(Frame& F) {
    if (blockIdx.x >= BATCH * 8) return;
    const int bh = blockIdx.x, b = bh >> 3, h = bh & 7, t = ((int)threadIdx.x);
    const float* flog = (const float*)(F.ws + WS_FLOG); float* clog = (float*)(F.ws + WS_CLOG) + (size_t)bh * SEQ;
    LAS double* sc = (LAS double*)F.lds;
    double loc[8]; double run = 0.0;
#pragma unroll
    for (int i = 0; i < 8; ++i) { run += (double)flog[(size_t)(b * SEQ + t * 8 + i) * 8 + h]; loc[i] = run; }
    double v = run; const int ln = t & 63, wv = t >> 6;
#pragma unroll
    for (int o = 1; o < 64; o <<= 1) { const double n = __shfl_up(v, o); v = ln >= o ? v + n : v; }
    if (ln == 63) sc[wv] = v;
    __syncthreads();
    double base = v - run;
#pragma unroll
    for (int w = 0; w < NWAVES - 1; ++w) { const double wt = sc[w]; base += w < wv ? wt : 0.0; }
#pragma unroll
    for (int i = 0; i < 8; ++i) clog[t * 8 + i] = (float)(base + loc[i]);
    __syncthreads();
}

__device__ __forceinline__ void p_norms(Frame& F) {
    const bf16_t* QKV = (const bf16_t*)(F.ws + WS_QKV);
    const int lane = (int)(threadIdx.x & 63), gw = F.vcu * NWAVES + F.wave, NGW = F.G * NWAVES;
    for (int task = gw; task < 2 * 32 * 16; task += NGW) {
        const int isk = task >> 9, bh = (task >> 4) & 31, ch = task & 15, b = bh >> 3, h = bh & 7;
        const bf16_t* base = QKV + ((size_t)((isk ? 32 : 24) + h) * MTOK + (size_t)b * SEQ + ch * 256) * 128 + (lane >> 4) * 128 + (lane & 15) * 8;
        float mx = 0.f;
#pragma unroll 4
        for (int it = 0; it < 64; ++it) {
            const u32x4 w = *(const u32x4*)(base + (size_t)it * 4 * 128);
            float ss = 0.f;
#pragma unroll
            for (int j = 0; j < 4; ++j) { const float a = bf2f((unsigned short)(w[j] & 0xffff)), c = bf2f((unsigned short)(w[j] >> 16)); ss += a * a + c * c; }
            ss += __shfl_xor(ss, 1); ss += __shfl_xor(ss, 2); ss += __shfl_xor(ss, 4); ss += __shfl_xor(ss, 8);
            mx = fmaxf(mx, ss);
        }
        mx = fmaxf(mx, __shfl_xor(mx, 16)); mx = fmaxf(mx, __shfl_xor(mx, 32));
        if (lane == 0) atomicMax((unsigned*)(F.ctl + (isk ? CW_KMAX + bh : CW_QMAX + bh * 16 + ch)), __float_as_uint(mx));
    }
}

__device__ __forceinline__ void p3_mix(Frame& F, KArgs ka) {
    const float* lq1 = (const float*)KIN(5); const float* lk1 = (const float*)KIN(6); const float* lq2 = (const float*)KIN(7); const float* lk2 = (const float*)KIN(8);
    const float* gd = (const float*)KIN(9); const float* gf = (const float*)KIN(10);
    const int l = ((int)(threadIdx.x & 63));
    const float s1 = wave_sum(lq1[l] * lk1[l] + lq1[l + 64] * lk1[l + 64]), s2 = wave_sum(lq2[l] * lk2[l] + lq2[l + 64] * lk2[l + 64]);
    const float lam = expf(s1) - expf(s2) + 0.2f;
    const bf16_t* O = (const bf16_t*)(F.ws + WS_O); bf16_t* mix = (bf16_t*)(F.ws + WS_MIX);
    const f32x2 gd0 = *(const f32x2*)(gd + 2 * l), gd1 = *(const f32x2*)(gd + 128 + 2 * l), gfv = *(const f32x2*)(gf + 2 * l);
    const int gw = F.vcu * NWAVES + F.wave, NGW = F.G * NWAVES;
    for (int m = gw; m < MTOK; m += NGW) {
        unsigned ov[24];
#pragma unroll
        for (int vh = 0; vh < 24; ++vh) ov[vh] = *(const unsigned*)(O + ((size_t)vh * MTOK + m) * 128 + 2 * l);
        unsigned* mrow = (unsigned*)(mix + (size_t)m * DM);
#pragma unroll
        for (int h = 0; h < 4; ++h) {
            const unsigned a0 = ov[8 + h * 4 + 0], a1 = ov[8 + h * 4 + 1], b0 = ov[8 + h * 4 + 2], b1 = ov[8 + h * 4 + 3];
            const float d00 = bf2f(a0 & 0xffff) - lam * bf2f(b0 & 0xffff), d01 = bf2f(a0 >> 16) - lam * bf2f(b0 >> 16);
            const float d10 = bf2f(a1 & 0xffff) - lam * bf2f(b1 & 0xffff), d11 = bf2f(a1 >> 16) - lam * bf2f(b1 >> 16);
            const float ss = wave_sum((d00 * d00 + d01 * d01) + (d10 * d10 + d11 * d11));
            const float rs = 0.8f / sqrtf(ss * (1.0f / 256.0f) + EPS);
            mrow[(h * 256) / 2 + l] = pk2(d00 * rs * gd0.x, d01 * rs * gd0.y);
            mrow[(h * 256 + 128) / 2 + l] = pk2(d10 * rs * gd1.x, d11 * rs * gd1.y);
        }
#pragma unroll
        for (int h = 0; h < 8; ++h) {
            const float f0 = bf2f(ov[h] & 0xffff), f1 = bf2f(ov[h] >> 16);
            const float ss = wave_sum(f0 * f0 + f1 * f1);
            const float rs = 1.0f / sqrtf(ss * (1.0f / 128.0f) + EPS);
            mrow[(1024 + h * 128) / 2 + l] = pk2(f0 * rs * gfv.x, f1 * rs * gfv.y);
        }
    }
}

__device__ __forceinline__ void p5_router(Frame& F, KArgs ka, const float* hbuf) {
    const float* b_router = (const float*)KIN(14);
    const bf16_t* gwf = (const bf16_t*)(F.ws + WS_GWF);
    int* tke = (int*)(F.ws + WS_TKE); int* tokl = (int*)(F.ws + WS_TOK); float* rstdl = (float*)(F.ws + WS_RSTD); float* gatel = (float*)(F.ws + WS_GATE);
    LAS float* sc = (LAS float*)(F.lds + F.wave * 4096);
    const int l = ((int)(threadIdx.x & 63)), r16 = l & 15, kq = l >> 4;
    const int gw = F.vcu * NWAVES + F.wave, NGW = F.G * NWAVES;
    if (((int)threadIdx.x) < NE) ((LAS int*)(F.lds + 8 * 4096))[((int)threadIdx.x)] = 0;
    __syncthreads();
    for (int item = gw; item < MTOK / 8; item += NGW) {
        const int tile = item >> 1, kh = item & 1;
        const float* hr = hbuf + (size_t)(tile * 16 + r16) * DM + 8 * kq + 1024 * kh;
        f32x4 acc0 = {0.f, 0.f, 0.f, 0.f}, acc1 = {0.f, 0.f, 0.f, 0.f}; float ss = 0.f;
        f32x4 va[2][4], vb[2][4];
#define P5_LOAD(bf_, s4_) do { _Pragma("unroll") for (int u = 0; u < 4; ++u) { va[bf_][u] = __builtin_nontemporal_load((const f32x4*)(hr + 32 * (4 * (s4_) + u))); vb[bf_][u] = __builtin_nontemporal_load((const f32x4*)(hr + 32 * (4 * (s4_) + u) + 4)); } } while (0)
        P5_LOAD(0, 0);
#pragma unroll 1
        for (int s8 = 0; s8 < 8; s8 += 2) {
#pragma unroll
          for (int hb_ = 0; hb_ < 2; ++hb_) { const int s4 = s8 + hb_;
            if (hb_ == 0) P5_LOAD(1, s4 + 1); else if (s4 < 7) P5_LOAD(0, s4 + 1);
#pragma unroll
            for (int u = 0; u < 4; ++u) { const f32x4 v0 = va[hb_][u], v1 = vb[hb_][u];
            ss += (v0.x * v0.x + v0.y * v0.y) + (v0.z * v0.z + v0.w * v0.w) + (v1.x * v1.x + v1.y * v1.y) + (v1.z * v1.z + v1.w * v1.w);
            unsigned hi[4], lo[4];
#define SPL(i, A, B) do { const unsigned ha = f2bf(A), hb = f2bf(B); hi[i] = ha | (hb << 16); lo[i] = pk2(A - bf2f((unsigned short)ha), B - bf2f((unsigned short)hb)); } while (0)
            SPL(0, v0.x, v0.y); SPL(1, v0.z, v0.w); SPL(2, v1.x, v1.y); SPL(3, v1.z, v1.w);
#undef SPL
            const u32x4 hiv = {hi[0], hi[1], hi[2], hi[3]}, lov = {lo[0], lo[1], lo[2], lo[3]};
            const bf16x8 ah = __builtin_bit_cast(bf16x8, hiv), al = __builtin_bit_cast(bf16x8, lov);
            const bf16x8* bf = (const bf16x8*)(gwf + (size_t)(32 * kh + 4 * s4 + u) * 4 * 512) + l;
            const bf16x8 b0h = bf[0], b0l = bf[64], b1h = bf[128], b1l = bf[192];
            acc0 = __builtin_amdgcn_mfma_f32_16x16x32_bf16(ah, b0h, acc0, 0, 0, 0); acc0 = __builtin_amdgcn_mfma_f32_16x16x32_bf16(al, b0h, acc0, 0, 0, 0); acc0 = __builtin_amdgcn_mfma_f32_16x16x32_bf16(ah, b0l, acc0, 0, 0, 0);
            acc1 = __builtin_amdgcn_mfma_f32_16x16x32_bf16(ah, b1h, acc1, 0, 0, 0); acc1 = __builtin_amdgcn_mfma_f32_16x16x32_bf16(al, b1h, acc1, 0, 0, 0); acc1 = __builtin_amdgcn_mfma_f32_16x16x32_bf16(ah, b1l, acc1, 0, 0, 0);
            }
          }
        }
#undef P5_LOAD
        { LAS float* px = (LAS float*)(F.lds + (F.wave | 1) * 4096) + 9 * l;
          if (kh) { px[0] = acc0[0]; px[1] = acc0[1]; px[2] = acc0[2]; px[3] = acc0[3]; px[4] = acc1[0]; px[5] = acc1[1]; px[6] = acc1[2]; px[7] = acc1[3]; px[8] = ss; }
          __syncthreads();
          if (!kh) { acc0[0] += px[0]; acc0[1] += px[1]; acc0[2] += px[2]; acc0[3] += px[3]; acc1[0] += px[4]; acc1[1] += px[5]; acc1[2] += px[6]; acc1[3] += px[7]; ss += px[8]; } }
        if (kh == 0) {
        ss += __shfl_xor(ss, 16); ss += __shfl_xor(ss, 32);
        const float rstd = 1.0f / sqrtf(ss * (1.0f / DM) + EPS);
        if (kq == 0) sc[16 * 33 + r16] = rstd;
        LDS_WAIT(); asm volatile("" ::: "memory");
#pragma unroll
        for (int rg = 0; rg < 4; ++rg) { const int tr = 4 * kq + rg; const float rt = sc[16 * 33 + tr];
            sc[tr * 33 + r16] = acc0[rg] * rt + b_router[r16]; sc[tr * 33 + 16 + r16] = acc1[rg] * rt + b_router[16 + r16]; }
        LDS_WAIT(); asm volatile("" ::: "memory");
        }
        LAS int* cntL = (LAS int*)(F.lds + 8 * 4096); LAS int* baseL = cntL + 32;
        int m = 0, ti[TOPK] = {0, 0, 0, 0}, rk[TOPK] = {0, 0, 0, 0}; float gk[TOPK] = {0.f, 0.f, 0.f, 0.f}, rt = 0.f;
        const bool sel = kh == 0 && l < 16;
        if (sel) {
            m = tile * 16 + l; float lg[NE];
#pragma unroll
            for (int e = 0; e < NE; ++e) lg[e] = sc[l * 33 + e];
            float tv[TOPK];
#pragma unroll
            for (int k = 0; k < TOPK; ++k) { float best = -3.4e38f; int bi = 0;
#pragma unroll
                for (int e = 0; e < NE; ++e) { const bool c = lg[e] > best; best = c ? lg[e] : best; bi = c ? e : bi; }
                tv[k] = best; ti[k] = bi;
#pragma unroll
                for (int e = 0; e < NE; ++e) lg[e] = (e == bi) ? -3.4e38f : lg[e]; }
            const float e1 = __expf(tv[1] - tv[0]), e2 = __expf(tv[2] - tv[0]), e3 = __expf(tv[3] - tv[0]); const float inv = 1.0f / (1.0f + e1 + e2 + e3);
            gk[0] = inv; gk[1] = e1 * inv; gk[2] = e2 * inv; gk[3] = e3 * inv; rt = sc[16 * 33 + l];
#pragma unroll
            for (int k = 0; k < TOPK; ++k) rk[k] = __hip_atomic_fetch_add((int*)(cntL + ti[k]), 1, __ATOMIC_RELAXED, __HIP_MEMORY_SCOPE_WORKGROUP);
        }
        LDS_WAIT(); asm volatile("" ::: "memory");
        __syncthreads();
        if (((int)threadIdx.x) < NE) { const int c = cntL[((int)threadIdx.x)]; int b = 0;
            if (c > 0) b = (int)__hip_atomic_fetch_add((unsigned*)(F.ctl + CW_CNT + 64 * ((int)threadIdx.x)), (unsigned)c, RLX_AGENT);
            baseL[((int)threadIdx.x)] = b; cntL[((int)threadIdx.x)] = 0; }
        LDS_WAIT(); asm volatile("" ::: "memory");
        __syncthreads();
        if (sel) {
#pragma unroll
            for (int k = 0; k < TOPK; ++k) { const int e = ti[k]; const int pos = baseL[e] + rk[k];
                tokl[(size_t)e * ECAP + pos] = m; rstdl[(size_t)e * ECAP + pos] = rt; gatel[(size_t)e * ECAP + pos] = gk[k]; tke[m * TOPK + k] = pos * 32 + e; }
        }
        LDS_WAIT(); asm volatile("" ::: "memory");
        __syncthreads();
    }
}

__device__ __forceinline__ void build_tab(Frame& F, LAS int* tab, bool publish) {
    if (((int)threadIdx.x) < NE) tab[NE + 1 + ((int)threadIdx.x)] = (int)__hip_atomic_load(F.ctl + CW_CNT + 64 * ((int)threadIdx.x), RLX_AGENT);
    __syncthreads();
    if (((int)threadIdx.x) == 0) { int s = 0; for (int e = 0; e < NE; ++e) { tab[e] = s; s += (tab[NE + 1 + e] + 255) >> 8; } tab[NE] = s; }
    __syncthreads();
    if (publish && blockIdx.x == 0 && ((int)threadIdx.x) <= NE) ((int*)(F.ws + WS_TSTART))[((int)threadIdx.x)] = tab[((int)threadIdx.x)];
}

__device__ __forceinline__ void p8_final(Frame& F, KArgs ka, float* hout) {
    const float* gfin = (const float*)KIN(21);
    const bf16_t* ys = (const bf16_t*)(F.ws + WS_YS); const int* tke = (const int*)(F.ws + WS_TKE); const int* tstart = (const int*)(F.ws + WS_TSTART);
    const int gw = F.vcu * NWAVES + F.wave, NGW = F.G * NWAVES;
    f32x4 gv[8];
#pragma unroll
    for (int j = 0; j < 8; ++j) gv[j] = *((const f32x4*)gfin + ((int)(threadIdx.x & 63)) + 64 * j);
    for (int m = gw; m < MTOK; m += NGW) {
        f32x4* hr = (f32x4*)(hout + (size_t)m * DM) + ((int)(threadIdx.x & 63));
        f32x4 v[8];
#pragma unroll
        for (int j = 0; j < 8; ++j) v[j] = hr[64 * j];
#pragma unroll
        for (int k = 0; k < TOPK; ++k) { const int code = tke[m * TOPK + k]; const int e = code & 31, pos = code >> 5; const size_t slot = (size_t)tstart[e] * 256 + pos;
#if MK_YS8
            const unsigned* yr = (const unsigned*)((const unsigned char*)ys + slot * DM) + ((int)(threadIdx.x & 63)); constexpr float ysc = 1.0f / (float)(1 << FP8_YSHIFT);
#pragma unroll
            for (int j = 0; j < 8; ++j) { const unsigned w = yr[64 * j]; const f32x2 lo = __builtin_amdgcn_cvt_pk_f32_fp8((int)w, false), hi = __builtin_amdgcn_cvt_pk_f32_fp8((int)w, true);
                v[j].x += lo.x * ysc; v[j].y += lo.y * ysc; v[j].z += hi.x * ysc; v[j].w += hi.y * ysc; } }
#else
            const u32x2* yr = (const u32x2*)(ys + slot * DM) + ((int)(threadIdx.x & 63));
#pragma unroll
            for (int j = 0; j < 8; ++j) { const u32x2 w = yr[64 * j]; v[j].x += bf2f(w.x & 0xffff); v[j].y += bf2f(w.x >> 16); v[j].z += bf2f(w.y & 0xffff); v[j].w += bf2f(w.y >> 16); } }
#endif
        float s = 0.f;
#pragma unroll
        for (int j = 0; j < 8; ++j) s += (v[j].x * v[j].x + v[j].y * v[j].y) + (v[j].z * v[j].z + v[j].w * v[j].w);
        const float rstd = 1.0f / sqrtf(wave_sum(s) * (1.0f / DM) + EPS);
#pragma unroll
        for (int j = 0; j < 8; ++j) hr[64 * j] = v[j] * gv[j] * rstd;
    }
}
template <bool FOX>
__device__ __forceinline__ att::BlockRef attn_ref(const Frame& F, int L, int pass) {
    const int xcd = L & 7, k = L >> 3, x = k & 7, qb = pass ? 15 - x : x;
    att::BlockRef r;
    if constexpr (FOX) {
        const int bh = xcd * 4 + (k >> 3), b = bh >> 3, h = bh & 7;
        r.Q = (unsigned)WS_QKV + (unsigned)(((24 + h) * MTOK + b * SEQ + qb * 256) * 256); r.K = (unsigned)WS_QKV + (unsigned)(((32 + h) * MTOK + b * SEQ) * 256);
        r.V = (unsigned)WS_QKV + (unsigned)(((40 + h) * MTOK + b * SEQ) * 256); r.O = (unsigned)WS_O + (unsigned)((h * MTOK + b * SEQ + qb * 256) * 256);
        r.clog = (unsigned)WS_CLOG + (unsigned)((b * 8 + h) * SEQ * 4);
        { const float qm2 = __uint_as_float(__hip_atomic_load((unsigned*)(F.ctl + CW_QMAX + bh * 16 + qb), RLX_AGENT)), km2 = __uint_as_float(__hip_atomic_load((unsigned*)(F.ctl + CW_KMAX + bh), RLX_AGENT));
          const float bound = (MK_FUSE_NORMS ? 2.02f : 2.002f) * sqrtf(qm2 * km2) + FOX_SKIP_T;       const float* clg = (const float*)(F.ws + WS_CLOG) + (size_t)(b * 8 + h) * SEQ;
          int lane; asm volatile("v_mbcnt_lo_u32_b32 %0, -1, 0\n\tv_mbcnt_hi_u32_b32 %0, -1, %0" : "=v"(lane));
          const int ntb = qb * 4;
          bool skip = false; if (lane < ntb) skip = (bound + clg[qb * 256] - clg[64 * lane + 63]) <= 0.f;
          r.jlo = (int)__popcll(__ballot(skip)) & ~1; }
    } else {
        const int vhb = xcd * 8 + (k >> 3), b = vhb >> 4, vv = vhb & 15, h = vv >> 2, mp = (vv >> 1) & 1, vhalf = vv & 1;
        r.Q = (unsigned)WS_QKV + (unsigned)(((h * 2 + mp) * MTOK + b * SEQ + qb * 256) * 256); r.K = (unsigned)WS_QKV + (unsigned)(((8 + h * 2 + mp) * MTOK + b * SEQ) * 256);
        r.V = (unsigned)WS_QKV + (unsigned)(((16 + h * 2 + vhalf) * MTOK + b * SEQ) * 256); r.O = (unsigned)WS_O + (unsigned)(((8 + vv) * MTOK + b * SEQ + qb * 256) * 256);
        r.clog = 0u; r.jlo = 0;
    }
    r.P0 = qb * 256;
    return r;
}
template <bool FOX>
__device__ __forceinline__ void attn_run(const Frame& F, char* lds) {
    constexpr int total = FOX ? 256 : 512;
    int L = blockIdx.x; if (L >= total) return;
    int pass = 0; const int stride = F.G;
    att::BlockRef cur = attn_ref<FOX>(F, L, 0);
    att::Seam S;
    att::attn_prime(F.ws, cur, lds, S);
    for (;;) {
        const bool more_pass = pass == 0, more_item = L + stride < total, last = !more_pass && !more_item;
        int passn = pass + 1, Ln = L;
        if (!more_pass) { passn = 0; Ln = more_item ? L + stride : L; }
        const int Lr = last ? L : Ln, pr = last ? pass : passn;
        auto nref = [&F, Lr, pr]() { return attn_ref<FOX>(F, Lr, pr); };
        att::attn_block<FOX>(F.ws, cur, nref, lds, S);
        if (last) break;
        pass = passn; L = Ln; cur = attn_ref<FOX>(F, L, pass);
    }
}

__device__ __forceinline__ att::BlockRefW attn_refW(int L, int pass) {
    const int xcd = L & 7, k = L >> 3, x = k & 7, qb = pass ? 15 - x : x;
    const int bhm = xcd * 4 + (k >> 3), b = bhm >> 3, hm = bhm & 7, h = hm >> 1, mp = hm & 1;
    att::BlockRefW r;
    r.Q = (unsigned)WS_QKV + (unsigned)(((h * 2 + mp) * MTOK + b * SEQ + qb * 256) * 256); r.K = (unsigned)WS_QKV + (unsigned)(((8 + h * 2 + mp) * MTOK + b * SEQ) * 256);
    r.V0 = (unsigned)WS_QKV + (unsigned)(((16 + h * 2) * MTOK + b * SEQ) * 256); r.V1 = (unsigned)WS_QKV + (unsigned)(((17 + h * 2) * MTOK + b * SEQ) * 256);
    r.O0 = (unsigned)WS_O + (unsigned)(((8 + h * 4 + mp * 2) * MTOK + b * SEQ + qb * 256) * 256); r.O1 = (unsigned)WS_O + (unsigned)(((9 + h * 4 + mp * 2) * MTOK + b * SEQ + qb * 256) * 256);
    r.P0 = qb * 256;
    return r;
}
__device__ __forceinline__ void attn_runW(const Frame& F, char* lds) {
    constexpr int total = 256;
    int L = blockIdx.x; if (L >= total) return;
    int pass = 0; const int stride = F.G;
    att::BlockRefW cur = attn_refW(L, 0);
    att::SeamW S;
    att::attn_primeW(F.ws, cur, lds, S);
    for (;;) {
        const bool more_pass = pass == 0, more_item = L + stride < total, last = !more_pass && !more_item;
        int passn = pass + 1, Ln = L;
        if (!more_pass) { passn = 0; Ln = more_item ? L + stride : L; }
        const int Lr = last ? L : Ln, pr = last ? pass : passn;
        auto nref = [Lr, pr]() { return attn_refW(Lr, pr); };
        att::attn_blockW(F.ws, cur, nref, lds, S);
        if (last) break;
        pass = passn; L = Ln; cur = attn_refW(L, pass);
    }
}

constexpr int NPHASE = 10;
#ifndef MK_BAL
#define MK_BAL 1
#endif
constexpr int MOE_RB = MK_FP8 ? DM : DM * 2;
#ifndef MK_ATT_MASK
#define MK_ATT_MASK 3
#endif
#ifndef MK_DIFFW
#define MK_DIFFW 1
#endif
#ifndef MK_KREP_LOG
#define MK_KREP_LOG 0
#endif
#ifndef MK_KROT
#define MK_KROT 0
#endif
#define MOE_ROT(c, nt) (MK_KROT ? (int)((((((c) >> 3) >> 2) * ((nt) / 8)) + ((((c) >> 3) & 3) * ((nt) / 4))) & ((nt) - 1)) : 0)
#ifndef MK_OVERLAP
#define MK_OVERLAP 1
#endif
#ifndef MK_P1_S1
#define MK_P1_S1 0.50
#define MK_P1_S2 1.0
#define MK_P3_S0 0.33
#define MK_P3_S1 0.66
#define MK_P3_S2 1.0
#endif
constexpr int CW_DYN = 48;
__device__ __forceinline__ void ph1(Frame& F, KArgs ka) {
#if MK_FP8 && MK_OVERLAP
    const int bx = (int)blockIdx.x, grp = (bx >> 3) & 1;
    const int rw = (((bx & 7) * 16 + (bx >> 4)) * NWAVES) + F.wave, nw = (F.G / 2) * NWAVES;
    constexpr int X1 = (int)(P0B_IGU * MK_P1_S1), X2 = (int)(P0B_IGU * MK_P1_S2);
    if (grp == 1) p0b_experts(F, ka, 0, X1, rw, nw, nullptr);
#endif
    p1_scan(F);
    pg8::DenseOrder S; S.init((const bf16_t*)(F.ws + WS_XN), (const bf16_t*)(F.ws + WS_WIN), MTOK, NQKV, DM * 2, F.G, (int)blockIdx.x);
    pg8::EpiQKV E{(bf16_t*)(F.ws + WS_QKV), (const float*)(F.ws + WS_ROPE), (unsigned*)F.ctl, (LAS float*)(F.lds + RING_BYTES + 2048)};
    pg8::gemm_phase<pg8::EpiQKV, pg8::DenseOrder, false>(F.lds, F.lds + LDS_IDX, DM * 2, S, E);
#if MK_FP8 && MK_OVERLAP
    if (grp == 0) p0b_experts(F, ka, X1, X2, rw, nw, nullptr);
    if constexpr (X2 < P0B_IGU) p0b_experts(F, ka, X2, P0B_IGU, 0, 1, (unsigned*)F.ctl + CW_DYN);
#endif
}
__device__ __forceinline__ void ph2(Frame& F, KArgs ka, char* lds) {
#if MK_FP8 && MK_OVERLAP
    const int bx = (int)blockIdx.x, j = bx >> 3, cshift = j % 3, ng = cshift < 2 ? 11 : 10;
    const int rw = (((bx & 7) * ng + j / 3) * NWAVES) + F.wave, nw = 8 * ng * NWAVES;
    constexpr int L = P0B_NI - P0B_IGU, Y0 = P0B_IGU + (int)(L * MK_P3_S0), Y1 = P0B_IGU + (int)(L * MK_P3_S1), Y2 = P0B_IGU + (int)(L * MK_P3_S2);
    if (cshift == 0) p0b_experts(F, ka, P0B_IGU, Y0, rw, nw, nullptr);
#endif
    if (MK_ATT_MASK & 1) attn_run<true>(F, lds);
    __syncthreads();
#if MK_FP8 && MK_OVERLAP
    if (cshift == 1) p0b_experts(F, ka, Y0, Y1, rw, nw, nullptr);
#endif
#if MK_DIFFW
    if (MK_ATT_MASK & 2) attn_runW(F, lds);
#else
    if (MK_ATT_MASK & 2) attn_run<false>(F, lds);
#endif
#if MK_FP8 && MK_OVERLAP
    if (cshift == 2) p0b_experts(F, ka, Y1, Y2, rw, nw, nullptr);
    if constexpr (Y2 < P0B_NI) p0b_experts(F, ka, Y2, P0B_NI, 0, 1, (unsigned*)F.ctl + CW_DYN + 1);
#endif
}
__device__ __forceinline__ void ph4(Frame& F, KArgs ka, float* hbuf) {
    pg8::DenseOrder S; S.init((const bf16_t*)(F.ws + WS_MIX), (const bf16_t*)(F.ws + WS_WOUT), MTOK, DM, DM * 2, F.G, (int)blockIdx.x);
    pg8::EpiOut E{(const float*)KIN(0), hbuf, (bf16_t*)(F.ws + WS_HG), (const float*)KIN(12)};
    pg8::gemm_phase<pg8::EpiOut, pg8::DenseOrder, false, false, 127, 127, 1, false, false, (MK_XINIT != 0)>(F.lds, F.lds + LDS_IDX, DM * 2, S, E);
}
__device__ __forceinline__ void ph6(Frame& F, KArgs ka, LAS int* tab) {
    build_tab(F, tab, true);
    pg8::MoeOrder S; S.A = (const void*)(F.ws + WS_HG); S.Bt = (const void*)(F.ws + WS_WGU); S.RB = MOE_RB; S.nN = 16; S.NperE = 4096; S.G = F.G; S.c = (int)blockIdx.x; S.rot = MOE_ROT(blockIdx.x, MOE_RB / 128); S.tab = tab; S.tok = (const int*)(F.ws + WS_TOK);
    pg8::EpiGU E{(bf16_t*)(F.ws + WS_HDN), (const float*)KIN(16), (const float*)KIN(18), (const float*)(F.ws + WS_RSTD), tab, (const LAS float*)(F.lds + LDS_IDX + 2048)}; S.rowsc = (const float*)(F.ws + WS_RSTD); S.bA = (const float*)KIN(16); S.bB = (const float*)KIN(18); S.bcols = 128;
    pg8::gemm_phase<pg8::EpiGU, pg8::MoeOrder, true, MK_FP8 != 0, 127 - FP8_WSHIFT - MK_KREP_LOG, 127 - FP8_HGSHIFT, (1 << MK_KREP_LOG), (MK_FP8 != 0 && MK_FP6 != 0), (MK_BAL != 0)>(F.lds, F.lds + LDS_IDX, MOE_RB, S, E);
}
__device__ __forceinline__ void ph7(Frame& F, KArgs ka, LAS int* tab) {
    build_tab(F, tab, false);
    pg8::MoeOrderDense S; S.A = (const void*)(F.ws + WS_HDN); S.Bt = (const void*)(F.ws + WS_WD); S.RB = MOE_RB; S.nN = 8; S.NperE = 2048; S.G = F.G; S.c = (int)blockIdx.x; S.rot = MOE_ROT(blockIdx.x, MOE_RB / 128); S.tab = tab; S.tok = nullptr;
    pg8::EpiDown E{(bf16_t*)(F.ws + WS_YS), (const float*)KIN(20), (const float*)(F.ws + WS_GATE), tab, (const LAS float*)(F.lds + LDS_IDX + 2048)}; S.rowsc = (const float*)(F.ws + WS_GATE); S.bA = (const float*)KIN(20); S.bB = (const float*)KIN(20) + 128; S.bcols = 256;
    pg8::gemm_phase<pg8::EpiDown, pg8::MoeOrderDense, false, MK_FP8 != 0, 127 - FP8_WSHIFT - MK_KREP_LOG, 127 - FP8_HDSHIFT, (1 << MK_KREP_LOG), (MK_FP8 != 0 && MK_FP6 != 0), (MK_BAL != 0)>(F.lds, F.lds + LDS_IDX, MOE_RB, S, E);
}
__device__ __forceinline__ Frame make_frame(KArgs ka, LAS unsigned char* lds) {
    Frame F; F.lds = lds; F.wave = __builtin_amdgcn_readfirstlane(((int)threadIdx.x) >> 6);
    F.G = gridDim.x; { const int bx = blockIdx.x; F.vcu = (F.G % 8 == 0) ? (bx % 8) * (F.G / 8) + bx / 8 : bx; }
    unsigned char* ws = ka->ws; F.ws = ws; F.ctl = (gu32*)(ws + WS_CTL);
    return F;
}
__global__ void __launch_bounds__(NTHREADS, 2) mk_fwd(Args args) {
    extern __shared__ __attribute__((aligned(16))) unsigned char lds[];
    const KArgs ka = (KArgs)__builtin_amdgcn_kernarg_segment_ptr();
    { volatile LAS unsigned* MISC = (volatile LAS unsigned*)((LAS unsigned char*)lds + LDS_MISC);
      if (((int)threadIdx.x) < 32) MISC[((int)threadIdx.x)] = 0u;
      __syncthreads();
      if (ka->ph_hi - ka->ph_lo > 1) (void)xcd_barrier_post((unsigned*)((gu32*)(ka->ws + WS_CTL) + CW_BAR), MISC + 8); }
#ifndef MK_PHASE_MASK
#define MK_PHASE_MASK 0x3FF
#endif
#ifndef MK_REP_PHASE
#define MK_REP_PHASE -1
#endif
#define IN(k) ((((MK_PHASE_MASK) >> (k)) & 1) && ka->ph_lo <= (k) && (k) < ka->ph_hi)
#define GRIDBAR() do { XcdBarrier b_; b_.bar = (unsigned*)((gu32*)(ka->ws + WS_CTL) + CW_BAR); b_.x = xb_xcc_id(); b_.st = (volatile LAS unsigned*)((LAS unsigned char*)lds + LDS_MISC) + 8; xcd_barrier(b_); } while (0)
#ifdef MK_STAMP
#define SEAM(k) do { if (IN(k) && IN((k) + 1)) { unsigned long long ta_ = 0; if (threadIdx.x == 0) ta_ = wall_clock64(); GRIDBAR(); \
        if (threadIdx.x == 0) { const unsigned d_ = (unsigned)(wall_clock64() - ta_); atomicMax((unsigned*)((gu32*)(ka->ws + WS_CTL)) + 192 + (k), 0xffffffffu - d_); } } } while (0)
#else
#define SEAM(k) do { if (IN(k) && IN((k) + 1)) GRIDBAR(); } while (0)
#endif
#ifdef MK_STAMP
#ifndef MK_STAMP_GRP
#define MK_STAMP_GRP 0
#endif
#if MK_STAMP_GRP == 1
#define ST_GRP(k) ((int)(blockIdx.x & 7))
#elif MK_STAMP_GRP == 2
#define ST_GRP(k) ((int)(blockIdx.x < 32))
#else
#define ST_GRP(k) ((k) == 1 ? (int)((blockIdx.x >> 3) & 1) : (k) == 3 ? (int)((blockIdx.x >> 3) % 3) : 0)
#endif
#define RUN(k, CALL) do { if (IN(k)) { if (threadIdx.x == 0) { const unsigned long long t_ = wall_clock64(); volatile LAS unsigned* M_ = (volatile LAS unsigned*)((LAS unsigned char*)lds + LDS_MISC); M_[24] = (unsigned)t_; M_[25] = (unsigned)(t_ >> 32); } \
        { Frame F = make_frame(ka, (LAS unsigned char*)lds); LAS int* tab = (LAS int*)(F.lds + LDS_TAB); float* hbuf = ka->out; (void)tab; (void)hbuf; CALL; } \
        __syncthreads(); \
        if (threadIdx.x == 0) { volatile LAS unsigned* M_ = (volatile LAS unsigned*)((LAS unsigned char*)lds + LDS_MISC); const unsigned long long t0_ = (unsigned long long)M_[24] | ((unsigned long long)M_[25] << 32); \
            const unsigned d_ = (unsigned)(wall_clock64() - t0_); unsigned* c_ = (unsigned*)((gu32*)(ka->ws + WS_CTL)); atomicMax(c_ + 64 + (k), d_); atomicAdd(c_ + 80 + (k), d_); atomicAdd(c_ + 96 + 8 * (k) + ST_GRP(k), d_); } } } while (0)
#else
#define RUN(k, CALL) do { if (IN(k)) { Frame F = make_frame(ka, (LAS unsigned char*)lds); LAS int* tab = (LAS int*)(F.lds + LDS_TAB); float* hbuf = ka->out; (void)tab; (void)hbuf; CALL; \
        if (MK_REP_PHASE == (k)) { GRIDBAR(); CALL; } } } while (0)
#endif
#if MK_FP8 && !MK_OVERLAP
    RUN(0, (p0_prologue(F, ka), p0b_experts(F, ka, 0, P0B_NI, F.vcu * NWAVES + F.wave, F.G * NWAVES, nullptr)));
#else
    RUN(0, p0_prologue(F, ka));
#endif
#ifdef MK_PROBE_STREAM
    if (IN(0)) { GRIDBAR(); Frame F = make_frame(ka, (LAS unsigned char*)lds); probe_stream(F, ka); }
#endif
    SEAM(0);
    RUN(1, ph1(F, ka)); SEAM(1);
#if MK_FUSE_NORMS
#else
    RUN(2, p_norms(F)); SEAM(2);
#endif
    RUN(3, ph2(F, ka, (char*)lds)); SEAM(3);
    RUN(4, p3_mix(F, ka)); SEAM(4);
    RUN(5, ph4(F, ka, hbuf)); SEAM(5);
    RUN(6, p5_router(F, ka, hbuf)); SEAM(6);
    RUN(7, ph6(F, ka, tab)); SEAM(7);
    RUN(8, ph7(F, ka, tab)); SEAM(8);
    RUN(9, p8_final(F, ka, hbuf));
#ifdef MK_STAMP
    GRIDBAR();
    if (blockIdx.x == 0 && threadIdx.x == 0) { unsigned* c_ = (unsigned*)((gu32*)(ka->ws + WS_CTL)); constexpr int K_ = (MK_STAMP_SEL) / 100, J_ = (MK_STAMP_SEL) % 100;
        const float mx = 0.01f * (float)__hip_atomic_load(c_ + 64 + K_, __ATOMIC_RELAXED, __HIP_MEMORY_SCOPE_AGENT), mean = 0.01f * (float)__hip_atomic_load(c_ + 80 + K_, __ATOMIC_RELAXED, __HIP_MEMORY_SCOPE_AGENT) / (float)gridDim.x;
        float v;
        if (J_ == 0) v = mx; else if (J_ == 1) v = mx - mean; else if (J_ == 2) v = mean;
        else if (J_ == 70) v = 0.01f * (float)(0xffffffffu - __hip_atomic_load(c_ + 192 + K_, __ATOMIC_RELAXED, __HIP_MEMORY_SCOPE_AGENT));
        else if (J_ == 60 || J_ == 61) { float hi = 0.f, lo = 1e9f; for (int g = 0; g < 8; ++g) { const float m = 0.01f * (float)__hip_atomic_load(c_ + 96 + 8 * K_ + g, __ATOMIC_RELAXED, __HIP_MEMORY_SCOPE_AGENT) / 32.f; hi = m > hi ? m : hi; lo = m < lo ? m : lo; }
            v = J_ == 60 ? hi - mean : mean - lo; }
        else if (J_ == 62 || J_ == 63) { const float ms = 0.01f * (float)__hip_atomic_load(c_ + 96 + 8 * K_ + 1, __ATOMIC_RELAXED, __HIP_MEMORY_SCOPE_AGENT) / 32.f, mr = 0.01f * (float)__hip_atomic_load(c_ + 96 + 8 * K_ + 0, __ATOMIC_RELAXED, __HIP_MEMORY_SCOPE_AGENT) / 224.f;
            v = J_ == 62 ? ms - mr : mr - ms; v = v > 0.f ? v : 0.f; }
        else { constexpr int A_ = (J_ - 3) / 10, B_ = (J_ - 3) % 10; const float na = (K_ == 1) ? 128.f : (K_ == 3 ? (A_ == 2 ? 80.f : 88.f) : 256.f), nb = (K_ == 1) ? 128.f : (K_ == 3 ? (B_ == 2 ? 80.f : 88.f) : 256.f);
            const float ga = 0.01f * (float)__hip_atomic_load(c_ + 96 + 8 * K_ + A_, __ATOMIC_RELAXED, __HIP_MEMORY_SCOPE_AGENT) / na, gb = 0.01f * (float)__hip_atomic_load(c_ + 96 + 8 * K_ + B_, __ATOMIC_RELAXED, __HIP_MEMORY_SCOPE_AGENT) / nb;
            v = ga - gb; v = v > 0.f ? v : 0.f; }
#ifndef MK_STAMP_Q
#define MK_STAMP_Q 8.0f
#endif
        if (J_ == 0 || J_ == 2) v = MK_STAMP_Q * floorf(v / MK_STAMP_Q + 0.5f);
        ka->out[0] = v + 10.0f; }
#endif
#undef IN
#undef SEAM
#undef RUN
#undef GRIDBAR
}

#ifndef MK_N_LAUNCHES
#define MK_N_LAUNCHES 1
#endif
extern "C" void kernel_launch(void* const* d_in, const int* in_sizes, int n_in, void* d_out, int out_size, void* d_ws, size_t ws_size, hipStream_t stream) {
    static int grid = 0;
    if (grid == 0) {
        if (n_in != 22 || in_sizes[0] != MTOK * DM || out_size != MTOK * DM || ws_size < WS_END) {
            fprintf(stderr, "kernel_launch: unexpected shapes (n_in %d, in0 %d, out %d, ws %zu; need ws >= %zu); nothing launched\n", n_in, n_in > 0 ? in_sizes[0] : -1, out_size, ws_size, (size_t)WS_END); grid = -1; return; }
        int dev = 0, cus = 0, per_cu = 0;
        if (hipGetDevice(&dev) != hipSuccess || hipDeviceGetAttribute(&cus, hipDeviceAttributeMultiprocessorCount, dev) != hipSuccess) { fprintf(stderr, "kernel_launch: device query failed\n"); grid = -1; return; }
        if (hipFuncSetAttribute((const void*)mk_fwd, hipFuncAttributeMaxDynamicSharedMemorySize, LDS_BYTES) != hipSuccess) { fprintf(stderr, "kernel_launch: hipFuncSetAttribute failed\n"); grid = -1; return; }
        if (hipOccupancyMaxActiveBlocksPerMultiprocessor(&per_cu, (const void*)mk_fwd, NTHREADS, LDS_BYTES) != hipSuccess || per_cu < 1)
            fprintf(stderr, "kernel_launch: note: occupancy query reports %d workgroups per CU\n", per_cu);
        (void)hipGetLastError();
        grid = 1; while (grid * 2 <= cus && grid < 256) grid *= 2;
    }
    if (grid < 0) return;
    if (hipMemsetAsync((char*)d_ws + WS_CTL, 0, CTL_ZERO_BYTES, stream) != hipSuccess) { fprintf(stderr, "kernel_launch: memset failed\n"); return; }
    Args a{};
    for (int i = 0; i < 22; ++i) a.in[i] = d_in[i];
    a.out = (float*)d_out; a.ws = (unsigned char*)d_ws;
    if (MK_N_LAUNCHES == 1) { a.ph_lo = 0; a.ph_hi = NPHASE; hipLaunchKernelGGL(mk_fwd, dim3(grid), dim3(NTHREADS), LDS_BYTES, stream, a); }
    else for (int p = 0; p < NPHASE; ++p) { a.ph_lo = p; a.ph_hi = p + 1; hipLaunchKernelGGL(mk_fwd, dim3(grid), dim3(NTHREADS), LDS_BYTES, stream, a); }
#ifdef MK_EXTRA_PHASE
    a.ph_lo = MK_EXTRA_PHASE; a.ph_hi = MK_EXTRA_PHASE + 1; hipLaunchKernelGGL(mk_fwd, dim3(grid), dim3(NTHREADS), LDS_BYTES, stream, a);
#endif
    const hipError_t le = hipPeekAtLastError();
    if (le != hipSuccess) fprintf(stderr, "kernel_launch: launch failed: %s\n", hipGetErrorName(le));
}
```

```cpp
#include <hip/hip_runtime.h>
#include <cstdio>
#include <cstdint>

#define LAS __attribute__((address_space(3)))
#define GAS __attribute__((address_space(1)))
typedef unsigned short bf16_t;
typedef short bf16x8 __attribute__((ext_vector_type(8)));
typedef short s16x4 __attribute__((ext_vector_type(4)));
typedef float f32x4 __attribute__((ext_vector_type(4)));
typedef float f32x2 __attribute__((ext_vector_type(2)));
typedef float f32x16 __attribute__((ext_vector_type(16)));
typedef unsigned u32x4 __attribute__((ext_vector_type(4)));
typedef unsigned u32x2 __attribute__((ext_vector_type(2)));
typedef int v4i_t __attribute__((ext_vector_type(4)));
typedef int v8i_t __attribute__((ext_vector_type(8)));

constexpr int DM = 2048, BATCH = 4, SEQ = 4096, MTOK = BATCH * SEQ, INC = 6152, NQKV = 6144, NE = 32, TOPK = 4, ECAP = 16384;
constexpr float EPS = 1e-5f, L2E = 1.4426950408889634f, QSCALE = 0.08838834764831845f * 1.4426950408889634f;
constexpr int NWAVES = 8, NTHREADS = 512;
constexpr size_t MiB = 1u << 20;
constexpr size_t WS_CTL = 0, CTL_ZERO_BYTES = 1 * MiB;
constexpr size_t WS_GWF = 2 * MiB;
constexpr size_t WS_CLOG = 3 * MiB;
constexpr size_t WS_FLOG = 4 * MiB;
constexpr size_t WS_TKE = 5 * MiB;
constexpr size_t WS_TOK = 6 * MiB;
constexpr size_t WS_RSTD = 8 * MiB;
constexpr size_t WS_GATE = 10 * MiB;
constexpr size_t WS_ROPE = 12 * MiB;
constexpr size_t WS_WIN = 20 * MiB;
constexpr size_t WS_WOUT = 44 * MiB;
constexpr size_t WS_TSTART = 52 * MiB;
constexpr size_t WS_WGU = 64 * MiB;
constexpr size_t WS_WD = 576 * MiB;
constexpr size_t WS_XN = 832 * MiB;
constexpr size_t WS_QKV = 896 * MiB;
constexpr size_t WS_O = 1088 * MiB;
constexpr size_t WS_MIX = 1184 * MiB;
constexpr size_t WS_HG = 1248 * MiB;
constexpr size_t WS_HDN = 1312 * MiB;
constexpr size_t WS_YS = 1600 * MiB;
constexpr size_t WS_END = 1888 * MiB;
constexpr int CW_TMO = 0, CW_BAR = 4096, CW_CNT = 8192;
constexpr int CW_QMAX = 12288, CW_KMAX = 12800;
constexpr float FOX_SKIP_T = 30.0f;
constexpr int RING_BYTES = 131072;
constexpr int LDS_IDX = RING_BYTES;
constexpr int LDS_TAB = RING_BYTES + 1024;
constexpr int LDS_MISC = RING_BYTES + 1024 + 512;
constexpr int LDS_BYTES = 147456;

__device__ __forceinline__ unsigned f2bf(float f) { unsigned u = __builtin_bit_cast(unsigned, f); return (u + 0x7fffu + ((u >> 16) & 1u)) >> 16; }
__device__ __forceinline__ unsigned pk2(float lo, float hi) { return f2bf(lo) | (f2bf(hi) << 16); }
__device__ __forceinline__ float bf2f(unsigned short b) { return __builtin_bit_cast(float, (unsigned)b << 16); }
__device__ __forceinline__ unsigned cvt_pk_bf16(float lo, float hi) { unsigned r; asm volatile("v_cvt_pk_bf16_f32 %0, %1, %2" : "=v"(r) : "v"(lo), "v"(hi)); return r; }
__device__ __forceinline__ float wave_sum(float v) {
#pragma unroll
    for (int o = 1; o < 64; o <<= 1) v += __shfl_xor(v, o);
    return v;
}

__device__ __forceinline__ void glds16s(const char* sbase, unsigned voff, unsigned lds_dst) { unsigned keep;
    asm volatile("s_mov_b32 %0, m0\n\ts_mov_b32 m0, %3\n\ts_nop 0\n\tglobal_load_lds_dwordx4 %1, %2\n\ts_mov_b32 m0, %0" : "=&s"(keep) : "v"(voff), "s"(sbase), "s"(lds_dst) : "memory"); }
__device__ __forceinline__ void glds4s(const char* sbase, unsigned voff, unsigned lds_dst) { unsigned keep;
    asm volatile("s_mov_b32 %0, m0\n\ts_mov_b32 m0, %3\n\ts_nop 0\n\tglobal_load_lds_dword %1, %2\n\ts_mov_b32 m0, %0" : "=&s"(keep) : "v"(voff), "s"(sbase), "s"(lds_dst) : "memory"); }
__device__ __forceinline__ const char* uni_ptr(const char* p) { const unsigned long long v = (unsigned long long)p;
    const unsigned lo = (unsigned)__builtin_amdgcn_readfirstlane((int)(unsigned)v), hi = (unsigned)__builtin_amdgcn_readfirstlane((int)(unsigned)(v >> 32)); return (const char*)(((unsigned long long)hi << 32) | lo); }

#ifndef MK_EPI_LDS
#define MK_EPI_LDS 1
#endif
namespace pg8 {
constexpr int BM = 256, BK = 64, HALF = 128, HTB = HALF * BK * 2, STAGE_BYTES = 8 * HTB, NXCD = 8, WGM = 8;
__host__ __device__ __forceinline__ int lds_byte(int r, int c) { const int st = (r >> 4) * 2 + (c >> 5), rr = r & 15, cc = c & 31, ob = rr * 64 + cc * 2; return st * 1024 + (ob ^ (((ob >> 9) & 1) << 5)); }
__host__ __device__ __forceinline__ void stage_rc(int b, int& R, int& C) { const int st = b / 1024, sb = b % 1024, swz = sb ^ (((sb >> 9) & 1) << 5); R = (st >> 1) * 16 + swz / 64; C = (st & 1) * 32 + (swz % 64) / 2; }
__host__ __device__ __forceinline__ int perm32(int rho) { const int n = rho >> 4, i = rho & 15; return 8 * (i >> 2) + 4 * n + (i & 3); }

struct Unit { int pm, pn, e, rows0; };

struct DenseOrder {
    const bf16_t* A; const bf16_t* Bt; int RB; int nM, nN, nwg, G, c; int rot = 0;
    __device__ void init(const bf16_t* A_, const bf16_t* Bt_, int M, int N, int RB_, int G_, int c_) { A = A_; Bt = Bt_; RB = RB_; nM = M / BM; nN = N / BM; nwg = nM * nN; G = G_; c = c_; }
    __device__ __forceinline__ bool next(int i, Unit& u) const {
        const long L = (long)i * G + c; if (L >= nwg) return false;
        int wgid = (int)L; { const int q = nwg / NXCD, r = nwg % NXCD, xcd = wgid % NXCD, off = wgid / NXCD; wgid = (xcd < r ? xcd * (q + 1) : r * (q + 1) + (xcd - r) * q) + off; }
        const int nig = WGM * nN, gid = wgid / nig, fm = gid * WGM, gsz = (nM - fm) < WGM ? (nM - fm) : WGM;
        u.pm = fm + ((wgid % nig) % gsz); u.pn = (wgid % nig) / gsz; u.e = 0; u.rows0 = 0; return true;
    }
    __device__ __forceinline__ const char* a_base(const Unit& u) const { return (const char*)A + (size_t)u.pm * BM * RB; }
    __device__ __forceinline__ const char* b_base(const Unit& u) const { return (const char*)Bt + (size_t)u.pn * BM * RB; }
};
struct MoeOrder {
    const float* bA = nullptr; const float* bB = nullptr; int bcols = 0;
    const float* rowsc = nullptr;
    const void* A; const void* Bt; int RB; int nN; int NperE; int G, c; int rot; const LAS int* tab; const int* tok;
    __device__ __forceinline__ bool next(int i, Unit& u) const {
        const int T = __builtin_amdgcn_readfirstlane(tab[NE]);
        int t;
        if (G == 256) {
            const int x = c & 7, j = c >> 3, XP = nN >> 3, tpr = 256 / nN;
            t = i * tpr + (x / XP) * 4 + (j & 3); u.pn = (x % XP) * 8 + (j >> 2);
            if (t >= T) return false;
        } else {
            const int L = i * G + c; if (L >= T * nN) return false;
            t = L / nN; u.pn = L - t * nN;
        }
        u.pm = t;
        int e; { const int ln = (int)(threadIdx.x & 63); const int tv = tab[ln & 31];
                 e = (int)__popcll(__ballot(ln < NE && tv <= t)) - 1; }
        u.e = e; u.rows0 = __builtin_amdgcn_readfirstlane((t - tab[e]) * BM); return true;
    }
    __device__ __forceinline__ int cnt_of(const Unit& u) const { return __builtin_amdgcn_readfirstlane(tab[NE + 1 + u.e]); }
    __device__ __forceinline__ const char* a_base(const Unit& u) const { return (const char*)A; }
    __device__ __forceinline__ const char* a_base_dense(const Unit& u) const { return (const char*)A + (size_t)u.pm * BM * RB; }
    __device__ __forceinline__ const char* b_base(const Unit& u) const { return (const char*)Bt + ((size_t)u.e * NperE + (size_t)u.pn * BM) * RB; }
};
struct MoeOrderDense : MoeOrder {
    __device__ __forceinline__ const char* a_base(const Unit& u) const { return a_base_dense(u); }
};

template <class Epi, class Sched, bool GATHER, bool FP8 = false, int SCW = 127, int SCA = 127, int KREP = 1, bool FP6 = false, bool BAL = false, bool XINIT = false, int NST = 0>
__device__ __forceinline__ void gemm_phase(LAS unsigned char* lds, LAS unsigned char* lds_idx, const int RB, const Sched& S, const Epi& E) {
    const int tid = threadIdx.x, wid = __builtin_amdgcn_readfirstlane(tid >> 6), lane = tid & 63, wr = wid >> 2, wc = wid & 3, fr = lane & 15, fq = lane >> 4;
    const int nt = (RB / 128) * KREP;
    unsigned voffA[2], voffB[2]; int RA[2], CA2[2];
#pragma unroll
    for (int i = 0; i < 2; ++i) { int R, C; stage_rc(tid * 16 + i * 8192, R, C); const int Rb = (R & ~31) + perm32(R & 31);
        voffA[i] = (unsigned)(R * RB + C * 2); voffB[i] = (unsigned)(Rb * RB + C * 2); RA[i] = R; CA2[i] = C * 2; }
    const int rot = S.rot, ntm = RB / 128 - 1;
#define PG8_KOFF(t) ((size_t)((((t) + rot) & ntm) * 128))
    const size_t hstep = (size_t)HALF * RB;
    const unsigned ldsw = (unsigned)wid * 1024u;
    const unsigned ldsb = (unsigned)__builtin_amdgcn_readfirstlane((int)(unsigned)(uintptr_t)lds);
    const int aoff = lds_byte(wr * 64 + fr, fq * 8), boff = lds_byte(wc * 32 + fr, fq * 8);
#define PG8_SA(b, h) (((b) * 2 + (h)) * HTB)
#define PG8_SB(b, h) ((4 + (b) * 2 + (h)) * HTB)
#define PG8_GL(bufoff, gptr, v0, v1) do { const char* gp_ = uni_ptr((const char*)(gptr)); \
        glds16s(gp_, (v0), ldsb + (unsigned)(bufoff) + ldsw); glds16s(gp_, (v1), ldsb + (unsigned)(bufoff) + ldsw + 8192u); } while (0)
#define PG8_STAGE_B(bufoff, gbase) PG8_GL(bufoff, gbase, voffB[0], voffB[1])
#define PG8_STAGE_A(bufoff, gbase, h, V) do { if constexpr (GATHER) { PG8_GL(bufoff, gbase, V[h][0], V[h][1]); } else { PG8_GL(bufoff, (gbase) + (h) * hstep, voffA[0], voffA[1]); } } while (0)
#define PG8_LDA(dst, b, h) do { _Pragma("unroll") for (int m = 0; m < 4; ++m) _Pragma("unroll") for (int k = 0; k < 2; ++k) dst[m][k] = *(const LAS bf16x8*)(lds + PG8_SA(b, h) + aoff + m * 2048 + k * 1024); } while (0)
#define PG8_LDB(dst, b, h) do { _Pragma("unroll") for (int n = 0; n < 2; ++n) _Pragma("unroll") for (int k = 0; k < 2; ++k) dst[n][k] = *(const LAS bf16x8*)(lds + PG8_SB(b, h) + boff + n * 2048 + k * 1024); } while (0)
#define PG8_CAT(x, y) __builtin_shufflevector(__builtin_bit_cast(v4i_t, x), __builtin_bit_cast(v4i_t, y), 0, 1, 2, 3, 4, 5, 6, 7)
#define PG8_MMA(ai, bj, At, Bt) do { __builtin_amdgcn_s_setprio(1); _Pragma("unroll") for (int m = 0; m < 4; ++m) _Pragma("unroll") for (int n = 0; n < 2; ++n) { \
        if constexpr (FP6) { acc[ai][bj][m][n] = __builtin_amdgcn_mfma_scale_f32_16x16x128_f8f6f4(PG8_CAT(Bt[n][0], Bt[n][1]), PG8_CAT(At[m][0], At[m][1]), acc[ai][bj][m][n], 2, 2, 0, __builtin_bit_cast(v4i_t, Bt[n][1])[2], 0, __builtin_bit_cast(v4i_t, At[m][1])[2]); } \
        else if constexpr (FP8) { acc[ai][bj][m][n] = __builtin_amdgcn_mfma_scale_f32_16x16x128_f8f6f4(PG8_CAT(Bt[n][0], Bt[n][1]), PG8_CAT(At[m][0], At[m][1]), acc[ai][bj][m][n], 0, 0, 0, (SCW | (SCA << 8)), 1, (SCW | (SCA << 8))); }     \
        else { _Pragma("unroll") for (int k = 0; k < 2; ++k) acc[ai][bj][m][n] = __builtin_amdgcn_mfma_f32_16x16x32_bf16(Bt[n][k], At[m][k], acc[ai][bj][m][n], 0, 0, 0); } } \
        __builtin_amdgcn_s_setprio(0); } while (0)
#define PG8_WAIT_V(n) asm volatile("s_waitcnt vmcnt(" #n ")" ::: "memory")
#define PG8_WAIT_L(n) asm volatile("s_waitcnt lgkmcnt(" #n ")" ::: "memory")
#define PG8_WAIT_V8S() do { if constexpr (NST == 16) { if (stf) PG8_WAIT_V(24); else PG8_WAIT_V(8); } else PG8_WAIT_V(8); } while (0)
#define PG8_BAR __builtin_amdgcn_s_barrier()
#define PG8_SCHED __builtin_amdgcn_sched_barrier(0)
    Unit cur, nxt; int ui = 0;
    if (!S.next(0, cur)) return;
    f32x4 acc[2][2][4][2];
    if constexpr (XINIT) E.load_init(acc, cur, wr, wc, fr, fq);
    else {
#pragma unroll
    for (int a = 0; a < 2; ++a)
#pragma unroll
        for (int b = 0; b < 2; ++b)
#pragma unroll
            for (int m = 0; m < 4; ++m)
#pragma unroll
                for (int n = 0; n < 2; ++n) acc[a][b][m][n] = (f32x4){0.f, 0.f, 0.f, 0.f};
    }
    bf16x8 At[4][2], B0[2][2], B1[2][2];
    unsigned VC[2][2];
    if constexpr (GATHER) {
        const int cnt = S.cnt_of(cur);
#pragma unroll
        for (int h = 0; h < 2; ++h)
#pragma unroll
            for (int i = 0; i < 2; ++i) { const int pos = cur.rows0 + h * HALF + RA[i]; int tk = S.tok[(size_t)cur.e * ECAP + pos]; tk = pos < cnt ? tk : 0; VC[h][i] = (unsigned)tk * (unsigned)RB + (unsigned)CA2[i]; }
    } else {
#pragma unroll
        for (int h = 0; h < 2; ++h)
#pragma unroll
            for (int i = 0; i < 2; ++i) VC[h][i] = 0u;
    }
    const char* cA = S.a_base(cur); const char* cB = S.b_base(cur);
    PG8_STAGE_B(PG8_SB(0, 0), cB + PG8_KOFF(0)); PG8_STAGE_B(PG8_SB(0, 1), cB + hstep + PG8_KOFF(0)); PG8_STAGE_A(PG8_SA(0, 0), cA + PG8_KOFF(0), 0, VC); PG8_STAGE_A(PG8_SA(0, 1), cA + PG8_KOFF(0), 1, VC);
    if (wr == 1) PG8_BAR;
    PG8_WAIT_V(2); PG8_BAR;
    if constexpr (BAL) { PG8_STAGE_B(PG8_SB(1, 0), cB + PG8_KOFF(1)); PG8_STAGE_B(PG8_SB(1, 1), cB + hstep + PG8_KOFF(1)); PG8_WAIT_V(4); PG8_BAR; }
    else { PG8_STAGE_B(PG8_SB(1, 0), cB + PG8_KOFF(1)); PG8_STAGE_A(PG8_SA(1, 0), cA + PG8_KOFF(1), 0, VC); PG8_STAGE_B(PG8_SB(1, 1), cB + hstep + PG8_KOFF(1));
    PG8_WAIT_V(6); PG8_BAR; }
    for (;;) {
        const bool has_next = S.next(ui + 1, nxt);
        const char* nA = has_next ? S.a_base(nxt) : cA; const char* nB = has_next ? S.b_base(nxt) : cB;
        for (int t = 0; t < nt; t += 2) {
            const bool last = (t == nt - 2); const bool stf = NST > 0 && ui > 0 && t == 0; (void)stf;
            if constexpr (FP8 && MK_EPI_LDS) {
                if (t == nt - 6 && wid < 4)
                    glds4s(uni_ptr((const char*)((wid < 2 ? S.bA : S.bB) + (size_t)cur.e * DM + cur.pn * S.bcols + (wid & 1) * 64)), (unsigned)lane * 4u, (unsigned)__builtin_amdgcn_readfirstlane((int)(unsigned)(uintptr_t)lds_idx) + 3072u + (unsigned)wid * 256u);
                if (t == nt - 4 && wid >= 4)
                    glds4s(uni_ptr((const char*)(S.rowsc + (size_t)cur.e * ECAP + cur.rows0 + (wid - 4) * 64)), (unsigned)lane * 4u, (unsigned)__builtin_amdgcn_readfirstlane((int)(unsigned)(uintptr_t)lds_idx) + 2048u + (unsigned)(wid - 4) * 256u);
            }
            if constexpr (GATHER) {
                if (has_next && t == nt - 4 && wid < 4)
                    glds4s(uni_ptr((const char*)(S.tok + (size_t)nxt.e * ECAP + nxt.rows0 + wid * 64)), (unsigned)lane * 4u, (unsigned)__builtin_amdgcn_readfirstlane((int)(unsigned)(uintptr_t)lds_idx) + (unsigned)wid * 256u);
            }
            const char* a1 = cA + PG8_KOFF(t + 1);
            const char* a2 = (last ? nA : cA) + PG8_KOFF(t + 2); const char* b2 = (last ? nB : cB) + PG8_KOFF(t + 2);
            const char* a3 = (last ? nA : cA) + PG8_KOFF(t + 3); const char* b3 = (last ? nB : cB) + PG8_KOFF(t + 3);
            PG8_LDB(B0, 0, 0); PG8_LDB(B1, 0, 1); PG8_SCHED; PG8_LDA(At, 0, 0); if constexpr (BAL) PG8_STAGE_A(PG8_SA(1, 0), a1, 0, VC); PG8_STAGE_A(PG8_SA(1, 1), a1, 1, VC);
            if constexpr (GATHER) {
                if (last && has_next) { const int cntn = S.cnt_of(nxt);
#pragma unroll
                    for (int h = 0; h < 2; ++h)
#pragma unroll
                        for (int i = 0; i < 2; ++i) { const int r = h * HALF + RA[i]; int tk = *(const LAS int*)(lds_idx + r * 4); tk = (nxt.rows0 + r) < cntn ? tk : 0; VC[h][i] = (unsigned)tk * (unsigned)RB + (unsigned)CA2[i]; } }
            }
            PG8_WAIT_V8S(); PG8_WAIT_L(0); PG8_BAR; PG8_MMA(0, 0, At, B0); PG8_MMA(0, 1, At, B1); PG8_BAR; PG8_SCHED;
            PG8_LDA(At, 0, 1); PG8_STAGE_B(PG8_SB(0, 0), b2); PG8_STAGE_B(PG8_SB(0, 1), b2 + hstep); if constexpr (!BAL) PG8_STAGE_A(PG8_SA(0, 0), a2, 0, VC);
            if constexpr (BAL) PG8_WAIT_V(6); else PG8_WAIT_V8S(); PG8_WAIT_L(0); PG8_BAR; PG8_MMA(1, 0, At, B0); PG8_MMA(1, 1, At, B1); PG8_BAR; PG8_SCHED;
            PG8_LDB(B0, 1, 0); PG8_LDB(B1, 1, 1); PG8_SCHED; PG8_LDA(At, 1, 0); if constexpr (BAL) PG8_STAGE_A(PG8_SA(0, 0), a2, 0, VC); PG8_STAGE_A(PG8_SA(0, 1), a2, 1, VC);
            PG8_WAIT_V8S(); PG8_WAIT_L(0); PG8_BAR; PG8_MMA(0, 0, At, B0); PG8_MMA(0, 1, At, B1); PG8_BAR; PG8_SCHED;
            PG8_LDA(At, 1, 1); PG8_STAGE_B(PG8_SB(1, 0), b3); PG8_STAGE_B(PG8_SB(1, 1), b3 + hstep); if constexpr (!BAL) PG8_STAGE_A(PG8_SA(1, 0), a3, 0, VC);
            if constexpr (BAL) PG8_WAIT_V(6); else PG8_WAIT_V8S(); PG8_WAIT_L(0); PG8_BAR; PG8_MMA(1, 0, At, B0); PG8_MMA(1, 1, At, B1); PG8_BAR; PG8_SCHED;
        }
        if (wr == 0) PG8_BAR;
        if constexpr (FP6 && KREP > 1) {
#pragma unroll
            for (int a = 0; a < 2; ++a)
#pragma unroll
                for (int b = 0; b < 2; ++b)
#pragma unroll
                    for (int m = 0; m < 4; ++m)
#pragma unroll
                        for (int n = 0; n < 2; ++n) acc[a][b][m][n] = acc[a][b][m][n] * (1.0f / KREP);
        }
        { int ln_; asm volatile("v_mbcnt_lo_u32_b32 %0, -1, 0\n\tv_mbcnt_hi_u32_b32 %0, -1, %0" : "=v"(ln_));
          E(acc, cur, wr, wc, ln_ & 15, ln_ >> 4);
#ifdef MK_PROBE_EPI2
          if constexpr (FP8) { asm volatile("" ::: "memory"); E(acc, cur, wr, wc, ln_ & 15, ln_ >> 4); }
#endif
        }
        if (!has_next) break;
        if constexpr (XINIT) { int ln_; asm volatile("v_mbcnt_lo_u32_b32 %0, -1, 0\n\tv_mbcnt_hi_u32_b32 %0, -1, %0" : "=v"(ln_)); E.load_init(acc, nxt, wr, wc, ln_ & 15, ln_ >> 4); }
        else {
#pragma unroll
        for (int a = 0; a < 2; ++a)
#pragma unroll
            for (int b = 0; b < 2; ++b)
#pragma unroll
                for (int m = 0; m < 4; ++m)
#pragma unroll
                    for (int n = 0; n < 2; ++n) acc[a][b][m][n] = (f32x4){0.f, 0.f, 0.f, 0.f};
        }
        cur = nxt; cA = nA; cB = nB; ++ui;
        if (wr == 1) PG8_BAR;
    }
    PG8_WAIT_V(0);
    PG8_BAR;
#undef PG8_SA
#undef PG8_SB
#undef PG8_GL
#undef PG8_STAGE_A
#undef PG8_STAGE_B
#undef PG8_LDA
#undef PG8_LDB
#undef PG8_MMA
#undef PG8_CAT
#undef PG8_KOFF
#undef PG8_WAIT_V
#undef PG8_WAIT_V8S
#undef PG8_WAIT_L
#undef PG8_BAR
#undef PG8_SCHED
}

}
namespace att {
constexpr int D = 128, NW = 8, QBLK = 32, KVBLK = 64, QB = NW * QBLK;
constexpr int SHM_V = KVBLK * D * 2, SHM_K = KVBLK * D * 2;
constexpr int OFF_WS = 2 * SHM_V + 2 * SHM_K, OFF_CLOG = OFF_WS + NW * 64 * 4, LDS_BYTES = OFF_CLOG + SEQ * 4;
constexpr float THR2 = 8.f * 1.4426950408889634f;
#define KSWZ(row, colB) ((row) * 256 + ((colB) ^ (((row) & 7) << 4)))
#define SBAR() __builtin_amdgcn_sched_barrier(0)
__device__ __forceinline__ int v_st(int k, int c) { const int kk = (k & ~0xC) | ((k & 4) << 1) | ((k & 8) >> 1); return ((kk >> 3) * 4 + (c >> 5)) * 512 + ((kk & 7) * 32 + (c & 31)) * 2; }
__device__ __forceinline__ int v_rd_base(int lane) { return ((lane & 3) << 3) | (((lane >> 2) & 3) << 6) | (((lane >> 4) & 1) << 5) | (((lane >> 5) & 1) << 8); }
constexpr int v_rd_off(int d0, int ks, int half) { return d0 * 512 + ks * 4096 + half * 2048; }
__device__ __forceinline__ int crow(int r, int hi) { return (r & 3) + 8 * (r >> 2) + 4 * hi; }
__device__ __forceinline__ unsigned cvtpk(float lo, float hi) { unsigned r; asm volatile("v_cvt_pk_bf16_f32 %0, %1, %2" : "=v"(r) : "v"(lo), "v"(hi)); return r; }
__device__ __forceinline__ void mask_tile(f32x16& p0, f32x16& p1, int dq) {
    const float NEG = -__builtin_inff();
#pragma unroll
    for (int r = 0; r < 16; ++r) {
        const int c = (r & 3) + 8 * (r >> 2);
        if (dq - c < 0) p0[r] = NEG;
        if (dq - c - 32 < 0) p1[r] = NEG;
    }
}
__device__ __forceinline__ void partialSM(f32x16& p0, f32x16& p1, float& m_reg, float& mn, float& alpha) {
    float pmax = p0[0];
#pragma unroll
    for (int r = 1; r < 16; ++r) pmax = fmaxf(pmax, p0[r]);
#pragma unroll
    for (int r = 0; r < 16; ++r) pmax = fmaxf(pmax, p1[r]);
    { auto rr = __builtin_amdgcn_permlane32_swap(__float_as_uint(pmax), __float_as_uint(pmax), false, false);
      pmax = fmaxf(__uint_as_float(rr[0]), __uint_as_float(rr[1])); }
    if (__builtin_expect(__all((pmax - m_reg) <= THR2), 1)) { mn = m_reg; alpha = 1.f; }
    else { mn = fmaxf(m_reg, pmax); alpha = __builtin_amdgcn_exp2f(m_reg - mn); m_reg = mn; }
#pragma unroll
    for (int r = 0; r < 16; ++r) p0[r] = p0[r] - mn;
#pragma unroll
    for (int r = 0; r < 16; ++r) p1[r] = p1[r] - mn;
#pragma unroll
    for (int r = 0; r < 16; ++r) p0[r] = __builtin_amdgcn_exp2f(p0[r]);
}
__device__ __forceinline__ void finishSM(f32x16& p0, f32x16& p1, float alpha, float& l_reg, bf16x8& pa0, bf16x8& pa1, bf16x8& pa2, bf16x8& pa3) {
#pragma unroll
    for (int r = 0; r < 16; ++r) p1[r] = __builtin_amdgcn_exp2f(p1[r]);
    float ps = 0;
#pragma unroll
    for (int r = 0; r < 16; ++r) ps += p0[r];
#pragma unroll
    for (int r = 0; r < 16; ++r) ps += p1[r];
    { auto rr = __builtin_amdgcn_permlane32_swap(__float_as_uint(ps), __float_as_uint(ps), false, false);
      ps = __uint_as_float(rr[0]) + __uint_as_float(rr[1]); }
    l_reg = l_reg * alpha + ps;
#define PK4(P, B_, OUT) do { unsigned a0 = cvtpk(P[B_+0], P[B_+1]), a1 = cvtpk(P[B_+2], P[B_+3]);                          \
        unsigned b0 = cvtpk(P[B_+4], P[B_+5]), b1 = cvtpk(P[B_+6], P[B_+7]);                                             \
        auto r0 = __builtin_amdgcn_permlane32_swap(a0, b0, false, false); auto r1 = __builtin_amdgcn_permlane32_swap(a1, b1, false, false); \
        u32x4 w = {r0[0], r1[0], r0[1], r1[1]}; OUT = *reinterpret_cast<bf16x8*>(&w); } while (0)
    PK4(p0, 0, pa0); PK4(p0, 8, pa1); PK4(p1, 0, pa2); PK4(p1, 8, pa3);
#undef PK4
}
template <int KB, bool FOX>
__device__ __forceinline__ void qkt(f32x16& p0, f32x16& p1, const char* K_lds, int r32, int hi, const bf16x8* qr, const float* cl  , float cq) {
    if constexpr (FOX) {
#pragma unroll
        for (int g = 0; g < 4; ++g) { const f32x4 c0 = *(const f32x4*)(cl + 8 * g + 4 * hi); const f32x4 c1 = *(const f32x4*)(cl + 32 + 8 * g + 4 * hi);
#pragma unroll
            for (int j = 0; j < 4; ++j) { p0[4 * g + j] = cq - c0[j]; p1[4 * g + j] = cq - c1[j]; } }
    } else { p0 = f32x16{}; p1 = f32x16{}; }
    const char* kb[4];
#pragma unroll
    for (int dd = 0; dd < 4; ++dd) kb[dd] = K_lds + KB * SHM_K + KSWZ(r32, (dd * 16 + hi * 8) * 2);
#pragma unroll
    for (int d0 = 0; d0 < 8; ++d0) { const char* a = kb[d0 & 3] + (d0 >> 2) * 128;
        bf16x8 b0 = *reinterpret_cast<const bf16x8*>(a);
        bf16x8 b1 = *reinterpret_cast<const bf16x8*>(a + 32 * 256);
        p0 = __builtin_amdgcn_mfma_f32_32x32x16_bf16(b0, qr[d0], p0, 0, 0, 0);
        p1 = __builtin_amdgcn_mfma_f32_32x32x16_bf16(b1, qr[d0], p1, 0, 0, 0); }
}
template <int KB>
__device__ __forceinline__ void qkt_lean(f32x16& p0, f32x16& p1, const char* K_lds, int r32, int hi, const bf16x8* qr) {
    p0 = f32x16{}; p1 = f32x16{};
    int kb[4];
#pragma unroll
    for (int dd = 0; dd < 4; ++dd) kb[dd] = (int)(uintptr_t)K_lds + KB * SHM_K + KSWZ(r32, (dd * 16 + hi * 8) * 2);
#define KRD(dst, d0, half) asm volatile("ds_read_b128 %0, %1 offset:%2" : "=&v"(dst) : "v"(kb[(d0) & 3]), "i"(((d0) >> 2) * 128 + (half) * 32 * 256) : "memory")
#define KRD4(P, d0) do { KRD(P##00, d0, 0); KRD(P##01, d0, 1); KRD(P##10, (d0) + 1, 0); KRD(P##11, (d0) + 1, 1); } while (0)
#define KMM(P, d0) do { p0 = __builtin_amdgcn_mfma_f32_32x32x16_bf16(P##00, qr[d0], p0, 0, 0, 0); p1 = __builtin_amdgcn_mfma_f32_32x32x16_bf16(P##01, qr[d0], p1, 0, 0, 0); \
        p0 = __builtin_amdgcn_mfma_f32_32x32x16_bf16(P##10, qr[(d0) + 1], p0, 0, 0, 0); p1 = __builtin_amdgcn_mfma_f32_32x32x16_bf16(P##11, qr[(d0) + 1], p1, 0, 0, 0); } while (0)
#define KW4() do { asm volatile("s_waitcnt lgkmcnt(4)" ::: "memory"); SBAR(); } while (0)
    bf16x8 A00, A01, A10, A11, B00, B01, B10, B11;
    KRD4(A, 0);
    KRD4(B, 2); KW4(); KMM(A, 0); SBAR();
    KRD4(A, 4); KW4(); KMM(B, 2); SBAR();
    KRD4(B, 6); KW4(); KMM(A, 4); SBAR();
    asm volatile("s_waitcnt lgkmcnt(0)" ::: "memory"); SBAR(); KMM(B, 6); SBAR();
#undef KRD
#undef KRD4
#undef KMM
#undef KW4
}
template <int VB>
__device__ __forceinline__ void pv_tile(f32x16* o, int vb0, bf16x8 pa0, bf16x8 pa1, bf16x8 pa2, bf16x8 pa3) {
#define TRRD(dst, off) asm volatile("ds_read_b64_tr_b16 %0, %1 offset:%2" : "=&v"(dst) : "v"(vb0), "i"(off) : "memory")
#define PV_D0(d0) do { s16x4 l0, l1, l2, l3, h0, h1, h2, h3; constexpr int b_ = VB * SHM_V + v_rd_off(d0, 0, 0); \
        TRRD(l0, b_); TRRD(h0, b_ + 2048); TRRD(l1, b_ + 4096); TRRD(h1, b_ + 6144); TRRD(l2, b_ + 8192); TRRD(h2, b_ + 10240); TRRD(l3, b_ + 12288); TRRD(h3, b_ + 14336); \
        asm volatile("s_waitcnt lgkmcnt(0)" ::: "memory"); SBAR();   \
        o[d0] = __builtin_amdgcn_mfma_f32_32x32x16_bf16(pa0, (bf16x8){l0[0], l0[1], l0[2], l0[3], h0[0], h0[1], h0[2], h0[3]}, o[d0], 0, 0, 0);   \
        o[d0] = __builtin_amdgcn_mfma_f32_32x32x16_bf16(pa1, (bf16x8){l1[0], l1[1], l1[2], l1[3], h1[0], h1[1], h1[2], h1[3]}, o[d0], 0, 0, 0);   \
        o[d0] = __builtin_amdgcn_mfma_f32_32x32x16_bf16(pa2, (bf16x8){l2[0], l2[1], l2[2], l2[3], h2[0], h2[1], h2[2], h2[3]}, o[d0], 0, 0, 0);   \
        o[d0] = __builtin_amdgcn_mfma_f32_32x32x16_bf16(pa3, (bf16x8){l3[0], l3[1], l3[2], l3[3], h3[0], h3[1], h3[2], h3[3]}, o[d0], 0, 0, 0); } while (0)
    PV_D0(0); PV_D0(1); PV_D0(2); PV_D0(3);
#undef PV_D0
#undef TRRD
}
constexpr int PV8_V1 = 3 * SHM_V;
__device__ __forceinline__ void pv_pipe8(f32x16* o, int vbA, bf16x8 pa0, bf16x8 pa1, bf16x8 pa2, bf16x8 pa3) {
#define TRR(dst, vb, off) asm volatile("ds_read_b64_tr_b16 %0, %1 offset:%2" : "=&v"(dst) : "v"(vb), "i"(off) : "memory")
#define RD8(P, vb, d0) do { constexpr int b_ = v_rd_off((d0) & 3, 0, 0) + ((d0) >> 2) * PV8_V1; TRR(P##l0, vb, b_); TRR(P##h0, vb, b_ + 2048); TRR(P##l1, vb, b_ + 4096); TRR(P##h1, vb, b_ + 6144); \
        TRR(P##l2, vb, b_ + 8192); TRR(P##h2, vb, b_ + 10240); TRR(P##l3, vb, b_ + 12288); TRR(P##h3, vb, b_ + 14336); } while (0)
#define FR(P, k) (bf16x8){P##l##k[0], P##l##k[1], P##l##k[2], P##l##k[3], P##h##k[0], P##h##k[1], P##h##k[2], P##h##k[3]}
#define MM4(P, oi) do { o[oi] = __builtin_amdgcn_mfma_f32_32x32x16_bf16(pa0, FR(P, 0), o[oi], 0, 0, 0); o[oi] = __builtin_amdgcn_mfma_f32_32x32x16_bf16(pa1, FR(P, 1), o[oi], 0, 0, 0); \
        o[oi] = __builtin_amdgcn_mfma_f32_32x32x16_bf16(pa2, FR(P, 2), o[oi], 0, 0, 0); o[oi] = __builtin_amdgcn_mfma_f32_32x32x16_bf16(pa3, FR(P, 3), o[oi], 0, 0, 0); } while (0)
#define W8() do { asm volatile("s_waitcnt lgkmcnt(8)" ::: "memory"); SBAR(); } while (0)
    s16x4 Al0, Al1, Al2, Al3, Ah0, Ah1, Ah2, Ah3, Bl0, Bl1, Bl2, Bl3, Bh0, Bh1, Bh2, Bh3;
    RD8(A, vbA, 0);
    RD8(B, vbA, 1); W8(); MM4(A, 0); SBAR();
    RD8(A, vbA, 2); W8(); MM4(B, 1); SBAR();
    RD8(B, vbA, 3); W8(); MM4(A, 2); SBAR();
    RD8(A, vbA, 4); W8(); MM4(B, 3); SBAR();
    RD8(B, vbA, 5); W8(); MM4(A, 4); SBAR();
    RD8(A, vbA, 6); W8(); MM4(B, 5); SBAR();
    RD8(B, vbA, 7); W8(); MM4(A, 6); SBAR();
    asm volatile("s_waitcnt lgkmcnt(0)" ::: "memory"); SBAR(); MM4(B, 7);
#undef TRR
#undef RD8
#undef FR
#undef MM4
#undef W8
}
struct BlockRef { unsigned Q, K, V, O; int P0; unsigned clog; int jlo; };
struct Seam { bf16x8 qr[8]; bf16x8 st_v0, st_v1, st_k0, st_k1; };
#define ROWB(p, k0, rr) ((const char*)wsb + (size_t)((p) + (unsigned)((k0) + (rr)) * (unsigned)(D * 2)) + lnoff)
#define VMW() asm volatile("s_waitcnt vmcnt(0)" ::: "memory")
#define VMWN(n) asm volatile("s_waitcnt vmcnt(%0)" :: "i"(n) : "memory")
#define LD8(p) (*reinterpret_cast<const bf16x8*>(p))
#define SLOAD_H(Kp, Vp, k0) do { S.st_v0 = LD8(ROWB(Vp, k0, 0)); S.st_v1 = LD8(ROWB(Vp, k0, 32)); S.st_k0 = LD8(ROWB(Kp, k0, 0)); S.st_k1 = LD8(ROWB(Kp, k0, 32)); } while (0)
#define SWRITE_HK(bf) do { *(bf16x8*)(K_lds + (bf) * SHM_K + kws) = S.st_k0; *(bf16x8*)(K_lds + (bf) * SHM_K + kws + 32 * 256) = S.st_k1; } while (0)
#define SWRITE_HV(bf) do { *(bf16x8*)(V_lds + (bf) * SHM_V + vst0) = S.st_v0; *(bf16x8*)(V_lds + (bf) * SHM_V + vst1) = S.st_v1; } while (0)
#define SWRITE_H(bf) do { SWRITE_HV(bf); SWRITE_HK(bf); } while (0)
__device__ __forceinline__ void attn_prime(const unsigned char* wsb, const BlockRef& cur, char* lds, Seam& S) {
    const int tid = threadIdx.x, wid = __builtin_amdgcn_readfirstlane(tid >> 6), lane = tid & 63, r32 = lane & 31, hi = lane >> 5;
    const int sr = tid >> 4, sc = (tid & 15) * 8, kws = KSWZ(sr, sc * 2); char* K_lds = lds + 2 * SHM_V;
    const unsigned lnoff = (unsigned)(sr * D + sc) * 2u;
#pragma unroll
    for (int d0 = 0; d0 < 8; ++d0) S.qr[d0] = LD8(wsb + (size_t)cur.Q + (unsigned)((wid * QBLK + r32) * D + d0 * 16 + hi * 8) * 2u);
    SLOAD_H(cur.K, cur.V, cur.jlo * KVBLK); VMW(); SWRITE_HK(0);
    __syncthreads();
}
template <bool FOX, class NR>
__device__ __forceinline__ void attn_block(const unsigned char* wsb, const BlockRef& cur, const NR& nref, char* lds, Seam& S) {
    const int tid = threadIdx.x, wid = __builtin_amdgcn_readfirstlane(tid >> 6), lane = tid & 63, r32 = lane & 31, hi = lane >> 5;
    const int j_lo = cur.jlo;
    const int NT = (cur.P0 + QB) / KVBLK - j_lo;
    const int qlo = cur.P0 + wid * QBLK;
    const int qe = FOX ? qlo : (qlo | 63);
    const int qm = (FOX ? (qlo + r32) : (qlo | 63)) - 4 * hi;
    char* V_lds = lds; char* K_lds = lds + 2 * SHM_V;
    float* ws = (float*)(lds + OFF_WS) + wid * 64; float* li_l = ws, * al_l = ws + 32;
    float* cl_lds = (float*)(lds + OFF_CLOG);
    float cq = 0.f;
    if constexpr (FOX) {
        const int nkeys = NT * KVBLK;
        const float* clg = (const float*)(wsb + (size_t)cur.clog);
        for (int i = tid * 4; i < nkeys; i += NTHREADS * 4) *(f32x4*)(cl_lds + i) = *(const f32x4*)(clg + j_lo * KVBLK + i);
        cq = clg[qlo + r32];
        __syncthreads();
    }
    float m_reg = -1e30f, l_reg = 0; f32x16 o[4] = {};
    const int sr = tid >> 4, sc = (tid & 15) * 8, vst0 = v_st(sr, sc), vst1 = v_st(32 + sr, sc), kws = KSWZ(sr, sc * 2);
    const unsigned lnoff = (unsigned)(sr * D + sc) * 2u;
    const int vb0 = (int)(uintptr_t)V_lds + v_rd_base(lane);
    const unsigned Kh = cur.K, Vh = cur.V;
#define RESC(a) do { if (__any((a) < 1.f)) { if (hi == 0) al_l[r32] = (a); asm volatile("s_waitcnt lgkmcnt(0)" ::: "memory");              \
                     for (int d_ = 0; d_ < 4; ++d_) for (int r = 0; r < 16; ++r) o[d_][r] *= al_l[crow(r, hi)]; } } while (0)
#define KBASE(t) ((j_lo + (t)) * KVBLK)
#define CLT(t) (cl_lds + (t) * KVBLK)
#define MASKT(P0_, P1_, t) do { const int kb_ = KBASE(t); if (kb_ + KVBLK - 1 > qe) mask_tile(P0_, P1_, qm - kb_); } while (0)
    f32x16 pA0, pA1, pB0, pB1; float mnA, mnB, alA, alB; bf16x8 pa0, pa1, pa2, pa3;
    SWRITE_HV(0); SBAR();
    if (NT > 1) { SLOAD_H(Kh, Vh, KBASE(1)); }
    SBAR(); qkt<0, FOX>(pA0, pA1, K_lds, r32, hi, S.qr, CLT(0), cq);
    MASKT(pA0, pA1, 0); partialSM(pA0, pA1, m_reg, mnA, alA);
    if (NT > 1) { VMW(); SWRITE_H(1); }
    __syncthreads();
#define HALF_STEP(PX0, PX1, mnX, alX, PY0, PY1, alY, t, KB, VB, SB) do {                                                      \
        SBAR(); qkt<KB, FOX>(PX0, PX1, K_lds, r32, hi, S.qr, CLT(t), cq);                                          \
        finishSM(PY0, PY1, alY, l_reg, pa0, pa1, pa2, pa3); SBAR();                                                           \
        if ((t) + 1 < NT) { SLOAD_H(Kh, Vh, KBASE((t) + 1)); SBAR(); }                                                        \
        pv_tile<VB>(o, vb0, pa0, pa1, pa2, pa3); MASKT(PX0, PX1, (t)); partialSM(PX0, PX1, m_reg, mnX, alX);                  \
        __syncthreads();                                                                                                      \
        if ((t) + 1 < NT) { VMW(); SWRITE_H(SB); }                                                                            \
        RESC(alX); __syncthreads(); } while (0)
    for (int t = 1; t + 1 < NT; t += 2) {
        HALF_STEP(pB0, pB1, mnB, alB, pA0, pA1, alA, t, 1, 0, 0);
        HALF_STEP(pA0, pA1, mnA, alA, pB0, pB1, alB, t + 1, 0, 1, 1);
    }
    constexpr bool even = true;
    if (even) { SBAR(); qkt<1, FOX>(pB0, pB1, K_lds, r32, hi, S.qr, CLT(NT - 1), cq); SBAR(); }
    const BlockRef nxt = nref();
    SLOAD_H(nxt.K, nxt.V, nxt.jlo * KVBLK); SBAR();
#pragma unroll
    for (int d0 = 0; d0 < 8; ++d0) S.qr[d0] = LD8(wsb + (size_t)nxt.Q + (unsigned)((wid * QBLK + r32) * D + d0 * 16 + hi * 8) * 2u);
    SBAR();
    finishSM(pA0, pA1, alA, l_reg, pa0, pa1, pa2, pa3); SBAR();
    pv_tile<0>(o, vb0, pa0, pa1, pa2, pa3);
    if (even) { MASKT(pB0, pB1, NT - 1); partialSM(pB0, pB1, m_reg, mnB, alB); __syncthreads(); RESC(alB);
        finishSM(pB0, pB1, alB, l_reg, pa0, pa1, pa2, pa3); SBAR(); pv_tile<1>(o, vb0, pa0, pa1, pa2, pa3); }
    SBAR(); VMWN(8); SWRITE_HK(0); SBAR();
    if (hi == 0) li_l[r32] = l_reg; asm volatile("s_waitcnt lgkmcnt(0)" ::: "memory");
    float rli[16];
#pragma unroll
    for (int r = 0; r < 16; ++r) rli[r] = __builtin_amdgcn_rcpf(li_l[crow(r, hi)]);
    bf16_t* Ow = (bf16_t*)(const_cast<unsigned char*>(wsb) + (size_t)cur.O) + (size_t)(wid * QBLK) * D;
#pragma unroll
    for (int r = 0; r < 16; ++r) { const int orow = crow(r, hi);
#pragma unroll
        for (int d0 = 0; d0 < 4; ++d0) { const float v = o[d0][r] * rli[r];
            const float vn = __uint_as_float((unsigned)__builtin_amdgcn_update_dpp(0, (int)__float_as_uint(v), 0xB1, 0xF, 0xF, false));
            if ((r32 & 1) == 0) *(unsigned*)(Ow + (size_t)orow * D + d0 * 32 + r32) = cvtpk(v, vn); } }
    __syncthreads();
#undef RESC
#undef KBASE
#undef CLT
#undef MASKT
#undef HALF_STEP
}
constexpr int W_OFF_V1 = 3 * SHM_V, W_OFF_K = 6 * SHM_V, W_OFF_WS = 133120, W_LDS_BYTES = W_OFF_WS + NW * 64 * 4;
struct BlockRefW { unsigned Q, K, V0, V1, O0, O1; int P0; };
struct SeamW { bf16x8 qr[8]; int vs; };
#define DMA_W(R, k0, bf, vsl) do { const unsigned kb_ = (unsigned)(k0) * 256u; \
        const char* gk_ = (const char*)wsb + (size_t)((R).K + kb_); const char* g0_ = (const char*)wsb + (size_t)((R).V0 + kb_); const char* g1_ = (const char*)wsb + (size_t)((R).V1 + kb_); \
        const unsigned lk_ = ldsb + W_OFF_K + (bf) * SHM_K + wid * 2048, lv_ = ldsb + (unsigned)(vsl) * SHM_V + wid * 2048; \
        glds16s(uni_ptr(gk_), vofK0, lk_); glds16s(uni_ptr(gk_), (vofK0 + 1024u) ^ 64u, lk_ + 1024u); \
        glds16s(uni_ptr(g0_), vofV0, lv_); glds16s(uni_ptr(g0_), vofV1, lv_ + 1024u); \
        glds16s(uni_ptr(g1_), vofV0, lv_ + W_OFF_V1); glds16s(uni_ptr(g1_), vofV1, lv_ + W_OFF_V1 + 1024u); } while (0)
#define DMA_OFFS() \
    const unsigned ldsb = (unsigned)__builtin_amdgcn_readfirstlane((int)(unsigned)(uintptr_t)lds); \
    unsigned vofK0, vofV0, vofV1; \
    { int lane; asm volatile("v_mbcnt_lo_u32_b32 %0, -1, 0\n\tv_mbcnt_hi_u32_b32 %0, -1, %0" : "=v"(lane));     \
      const int rk0 = 4 * (2 * wid) + (lane >> 4), rk1 = rk0 + 4; vofK0 = (unsigned)(rk0 * 256 + (((lane & 15) ^ (rk0 & 7)) << 4)); (void)rk1;     \
      const int p0_ = (2 * wid) * 64 + lane, p1_ = p0_ + 64; \
      { const int sub = p0_ >> 5, kk = (sub >> 2) * 8 + ((p0_ >> 2) & 7), k = (kk & ~0xC) | ((kk & 4) << 1) | ((kk & 8) >> 1), c = (sub & 3) * 32 + (p0_ & 3) * 8; vofV0 = (unsigned)(k * 256 + c * 2); } \
      { const int sub = p1_ >> 5, kk = (sub >> 2) * 8 + ((p1_ >> 2) & 7), k = (kk & ~0xC) | ((kk & 4) << 1) | ((kk & 8) >> 1), c = (sub & 3) * 32 + (p1_ & 3) * 8; vofV1 = (unsigned)(k * 256 + c * 2); } }
__device__ __forceinline__ void attn_primeW(const unsigned char* wsb, const BlockRefW& cur, char* lds, SeamW& S) {
    const int tid = threadIdx.x, wid = __builtin_amdgcn_readfirstlane(tid >> 6), lane = tid & 63, r32 = lane & 31, hi = lane >> 5;
    DMA_OFFS();
    S.vs = 0;
    DMA_W(cur, 0, 0, 0);
#pragma unroll
    for (int d0 = 0; d0 < 8; ++d0) S.qr[d0] = LD8(wsb + (size_t)cur.Q + (unsigned)((wid * QBLK + r32) * D + d0 * 16 + hi * 8) * 2u);
    VMW();
    __syncthreads();
}
template <class NR>
__device__ __forceinline__ void attn_blockW(const unsigned char* wsb, const BlockRefW& cur, const NR& nref, char* lds, SeamW& S) {
    const int tid = threadIdx.x, wid = __builtin_amdgcn_readfirstlane(tid >> 6), lane = tid & 63, r32 = lane & 31, hi = lane >> 5;
    const int NT = (cur.P0 + QB) / KVBLK;
    const int qlo = cur.P0 + wid * QBLK, qe = qlo | 63, qm = (qlo | 63) - 4 * hi;
    char* V_lds = lds; char* K_lds = lds + W_OFF_K;
    float* ws = (float*)(lds + W_OFF_WS) + wid * 64; float* li_l = ws, * al_l = ws + 32;
    float m_reg = -1e30f, l_reg = 0; f32x16 o[8] = {};
    DMA_OFFS();
    const int vb0 = (int)(uintptr_t)V_lds + v_rd_base(lane);
    static_assert(PV8_V1 == W_OFF_V1 && v_rd_off(3, 3, 1) + PV8_V1 < 65536, "V1 ring reachable by the 16-bit ds offset");
#define RESCW(a) do { if (__any((a) < 1.f)) { if (hi == 0) al_l[r32] = (a); asm volatile("s_waitcnt lgkmcnt(0)" ::: "memory");              \
                      for (int d_ = 0; d_ < 8; ++d_) for (int r = 0; r < 16; ++r) o[d_][r] *= al_l[crow(r, hi)]; } } while (0)
#define MASKW(P0_, P1_, t) do { const int kb_ = (t) * KVBLK; if (kb_ + KVBLK - 1 > qe) mask_tile(P0_, P1_, qm - kb_); } while (0)
    f32x16 p0, p1; float mn, al; bf16x8 pa0, pa1, pa2, pa3;
    const bool lag = wid >= 4;
    int vs = S.vs;
#define PVW(slot) do { pv_pipe8(o, vb0 + (slot) * SHM_V, pa0, pa1, pa2, pa3); } while (0)
#define STEPW(t, BF) do { const int nvs_ = vs == 2 ? 0 : vs + 1;                                                                \
        DMA_W(cur, ((t) + 1) * KVBLK, 1 - (BF), nvs_);                                                                          \
        if (lag && (t) > 0) { SBAR(); PVW(vs == 0 ? 2 : vs - 1); }                                                               \
        SBAR(); qkt_lean<BF>(p0, p1, K_lds, r32, hi, S.qr); SBAR();                                                            \
        MASKW(p0, p1, (t)); partialSM(p0, p1, m_reg, mn, al); RESCW(al); finishSM(p0, p1, al, l_reg, pa0, pa1, pa2, pa3); SBAR(); \
        if (!lag) { PVW(vs); }                                                                                                   \
        VMW(); __syncthreads(); vs = nvs_; } while (0)
    for (int t = 0; t + 2 < NT; t += 2) { STEPW(t, 0); STEPW(t + 1, 1); }
    STEPW(NT - 2, 0);
    const BlockRefW nxt = nref();
    const int nvs = vs == 2 ? 0 : vs + 1;
    DMA_W(nxt, 0, 0, nvs);
    if (lag) { SBAR(); PVW(vs == 0 ? 2 : vs - 1); }
    SBAR(); qkt_lean<1>(p0, p1, K_lds, r32, hi, S.qr); SBAR();
#pragma unroll
    for (int d0 = 0; d0 < 8; ++d0) S.qr[d0] = LD8(wsb + (size_t)nxt.Q + (unsigned)((wid * QBLK + r32) * D + d0 * 16 + hi * 8) * 2u);
    SBAR();
    MASKW(p0, p1, NT - 1); partialSM(p0, p1, m_reg, mn, al); RESCW(al); finishSM(p0, p1, al, l_reg, pa0, pa1, pa2, pa3); SBAR();
    PVW(vs);
    S.vs = nvs;
    if (hi == 0) li_l[r32] = l_reg; asm volatile("s_waitcnt lgkmcnt(0)" ::: "memory");
    float rli[16];
#pragma unroll
    for (int r = 0; r < 16; ++r) rli[r] = __builtin_amdgcn_rcpf(li_l[crow(r, hi)]);
    { int ln_; asm volatile("v_mbcnt_lo_u32_b32 %0, -1, 0\n\tv_mbcnt_hi_u32_b32 %0, -1, %0" : "=v"(ln_));
      const int r32b = ln_ & 31, hib = ln_ >> 5; const unsigned lo_ = (unsigned)((wid * QBLK + 4 * hib) * D + r32b) * 2u;
#pragma unroll
      for (int hv = 0; hv < 2; ++hv) {
        unsigned char* Ob = const_cast<unsigned char*>(wsb) + (size_t)(hv ? cur.O1 : cur.O0);
#pragma unroll
        for (int r = 0; r < 16; ++r) { const unsigned ro_ = lo_ + (unsigned)(((r & 3) + 8 * (r >> 2)) * D) * 2u;
#pragma unroll
            for (int d0 = 0; d0 < 4; ++d0) { const float v = o[hv * 4 + d0][r] * rli[r];
                const float vn = __uint_as_float((unsigned)__builtin_amdgcn_update_dpp(0, (int)__float_as_uint(v), 0xB1, 0xF, 0xF, false));
                if ((r32b & 1) == 0) *(unsigned*)(Ob + (ro_ + (unsigned)(d0 * 64))) = cvtpk(v, vn); } }
      } }
    VMW(); __syncthreads();
#undef RESCW
#undef MASKW
#undef STEPW
#undef PVW
}
#undef DMA_W
#undef DMA_OFFS
#undef ROWB
#undef VMW
#undef VMWN
#undef LD8
#undef SLOAD_H
#undef SWRITE_HK
#undef SWRITE_HV
#undef SWRITE_H
#undef KSWZ
#undef SBAR
}
#ifndef MK_FP8
#define MK_FP8 1
#endif
constexpr int FP8_WSHIFT = 8, FP8_HGSHIFT = 3, FP8_HDSHIFT = 2, FP8_YSHIFT = 6;
#ifndef MK_YS8
#define MK_YS8 1
#endif
__device__ __forceinline__ float clamp448(float v) { return __builtin_amdgcn_fmed3f(v, -448.0f, 448.0f); }
__device__ __forceinline__ unsigned pk_fp8x4(float a, float b, float c, float d) {
    int w = 0; w = __builtin_amdgcn_cvt_pk_fp8_f32(clamp448(a), clamp448(b), w, false); w = __builtin_amdgcn_cvt_pk_fp8_f32(clamp448(c), clamp448(d), w, true); return (unsigned)w; }
#ifndef MK_FP6
#define MK_FP6 1
#endif
typedef float v16f_t __attribute__((ext_vector_type(16)));
typedef int v6i_t __attribute__((ext_vector_type(6)));
__device__ __forceinline__ void fp6_record(const v16f_t a, const v16f_t b, u32x4& lo, u32x4& hi) {
    float mx = 0.f;
#pragma unroll
    for (int i = 0; i < 16; ++i) asm("v_max3_f32 %0, |%1|, |%2|, %0" : "+v"(mx) : "v"(a[i]), "v"(b[i]));
    int sb = (int)((__float_as_uint(mx) >> 23) & 0xffu) - 2; sb = sb < 1 ? 1 : sb;
    const float scale = __uint_as_float((unsigned)sb << 23);
    const v6i_t r = __builtin_amdgcn_cvt_scalef32_2xpk16_fp6_f32(a, b, scale);
    lo = (u32x4){(unsigned)r[0], (unsigned)r[1], (unsigned)r[2], (unsigned)r[3]}; hi = (u32x4){(unsigned)r[4], (unsigned)r[5], (unsigned)sb, 0u};
}
__device__ __forceinline__ void xpose4(float (&X)[4][8]) {
#pragma unroll
    for (int m = 0; m < 2; ++m)
#pragma unroll
        for (int j = 0; j < 8; ++j) { auto r = __builtin_amdgcn_permlane32_swap(__float_as_uint(X[m][j]), __float_as_uint(X[m + 2][j]), false, false); X[m][j] = __uint_as_float(r[0]); X[m + 2][j] = __uint_as_float(r[1]); }
#pragma unroll
    for (int m = 0; m < 4; m += 2)
#pragma unroll
        for (int j = 0; j < 8; ++j) { auto r = __builtin_amdgcn_permlane16_swap(__float_as_uint(X[m][j]), __float_as_uint(X[m + 1][j]), false, false); X[m][j] = __uint_as_float(r[0]); X[m + 1][j] = __uint_as_float(r[1]); }
}
#define XROW16(X, q) X[q][0], X[q][1], X[q][2], X[q][3], X[q][4], X[q][5], X[q][6], X[q][7]
#ifndef MK_XINIT
#define MK_XINIT 1
#endif
#ifndef MK_FUSE_NORMS
#define MK_FUSE_NORMS 1
#endif
namespace pg8 {
struct EpiQKV {
    bf16_t* QKV; const float* rope; unsigned* ctl; LAS float* nsc;
    __device__ __forceinline__ void operator()(const f32x4 (&acc)[2][2][4][2], const Unit& u, int wr, int wc, int fr, int fq) const {
        const int pn = u.pn; const bool isrope = pn < 8; const float sc = (pn < 4 || (pn >= 12 && pn < 16)) ? QSCALE : 1.0f;
        const bool isnorm = MK_FUSE_NORMS && pn >= 12 && pn < 20;
        const int cw = wc * 32 + 8 * fq;
#pragma unroll
        for (int ai = 0; ai < 2; ++ai)
#pragma unroll
            for (int m = 0; m < 4; ++m) {
                const int row = u.pm * BM + ai * HALF + wr * 64 + m * 16 + fr;
                f32x4 cs0 = {1.f, 0.f, 1.f, 0.f}, cs1 = {1.f, 0.f, 1.f, 0.f};
                if (isrope) { const float* rp = rope + (size_t)row * 128 + (16 * wc + 4 * fq) * 2; cs0 = *(const f32x4*)rp; cs1 = *(const f32x4*)(rp + 4); }
#pragma unroll
                for (int bj = 0; bj < 2; ++bj) {
                    f32x4 v0 = acc[ai][bj][m][0], v1 = acc[ai][bj][m][1];
                    if (isrope) {
                        const f32x4 a = v0, b = v1;
                        v0[0] = a[0] * cs0[0] - a[1] * cs0[1]; v0[1] = a[1] * cs0[0] + a[0] * cs0[1]; v0[2] = a[2] * cs0[2] - a[3] * cs0[3]; v0[3] = a[3] * cs0[2] + a[2] * cs0[3];
                        v1[0] = b[0] * cs1[0] - b[1] * cs1[1]; v1[1] = b[1] * cs1[0] + b[0] * cs1[1]; v1[2] = b[2] * cs1[2] - b[3] * cs1[3]; v1[3] = b[3] * cs1[2] + b[2] * cs1[3];
                    }
                    v0 = v0 * sc; v1 = v1 * sc;
                    if (isnorm) { float ss = (v0[0] * v0[0] + v0[1] * v0[1]) + (v0[2] * v0[2] + v0[3] * v0[3]) + (v1[0] * v1[0] + v1[1] * v1[1]) + (v1[2] * v1[2] + v1[3] * v1[3]);
                        ss += __shfl_xor(ss, 16); ss += __shfl_xor(ss, 32);
                        if (fq == 0) nsc[((ai * HALF + wr * 64 + m * 16 + fr) * 2 + bj) * 4 + wc] = ss; }
                    u32x4 w; w.x = cvt_pk_bf16(v0[0], v0[1]); w.y = cvt_pk_bf16(v0[2], v0[3]); w.z = cvt_pk_bf16(v1[0], v1[1]); w.w = cvt_pk_bf16(v1[2], v1[3]);
                    *(u32x4*)(QKV + ((size_t)(pn * 2 + bj) * MTOK + row) * 128 + cw) = w;
                }
            }
        if (isnorm) {
            __syncthreads();
            const int t = (int)threadIdx.x; const f32x4 pq = *(const LAS f32x4*)(nsc + t * 4);
            float s = (pq.x + pq.y) + (pq.z + pq.w);
            s = fmaxf(s, __shfl_xor(s, 2)); s = fmaxf(s, __shfl_xor(s, 4)); s = fmaxf(s, __shfl_xor(s, 8)); s = fmaxf(s, __shfl_xor(s, 16)); s = fmaxf(s, __shfl_xor(s, 32));
            if ((t & 63) < 2) { const int isk = pn >= 16, hd = ((pn - (isk ? 16 : 12)) * 2) + (t & 1), bh = (u.pm >> 4) * 8 + hd;
                atomicMax(ctl + (isk ? CW_KMAX + bh : CW_QMAX + bh * 16 + (u.pm & 15)), __float_as_uint(s)); }
        }
    }
};
struct EpiOut {
    const float* x; float* h; bf16_t* hg; const float* gffn;
    __device__ __forceinline__ void load_init(f32x4 (&acc)[2][2][4][2], const Unit& u, int wr, int wc, int fr, int fq) const {
#pragma unroll
        for (int bj = 0; bj < 2; ++bj)
#pragma unroll
            for (int ai = 0; ai < 2; ++ai)
#pragma unroll
                for (int m = 0; m < 4; ++m) { const size_t off = (size_t)(u.pm * BM + ai * HALF + wr * 64 + m * 16 + fr) * DM + u.pn * BM + bj * HALF + wc * 32 + 8 * fq;
                    acc[ai][bj][m][0] = *(const f32x4*)(x + off); acc[ai][bj][m][1] = *(const f32x4*)(x + off + 4); }
    }
    __device__ __forceinline__ void operator()(const f32x4 (&acc)[2][2][4][2], const Unit& u, int wr, int wc, int fr, int fq) const {
#pragma unroll
        for (int bj = 0; bj < 2; ++bj) {
            const int col0 = u.pn * BM + bj * HALF + wc * 32 + 8 * fq;
            const f32x4 g0 = *(const f32x4*)(gffn + col0), g1 = *(const f32x4*)(gffn + col0 + 4);
#pragma unroll
            for (int ai = 0; ai < 2; ++ai) {
#if MK_FP8 && MK_FP6
                float X[4][8];
#endif
#pragma unroll
                for (int m = 0; m < 4; ++m) {
                    const size_t off = (size_t)(u.pm * BM + ai * HALF + wr * 64 + m * 16 + fr) * DM + col0;
                    const f32x4 h0 = MK_XINIT ? acc[ai][bj][m][0] : *(const f32x4*)(x + off) + acc[ai][bj][m][0], h1 = MK_XINIT ? acc[ai][bj][m][1] : *(const f32x4*)(x + off + 4) + acc[ai][bj][m][1];
                    *(f32x4*)(h + off) = h0; *(f32x4*)(h + off + 4) = h1;
                    const f32x4 a = h0 * g0, b = h1 * g1;
#if MK_FP8 && MK_FP6
                    X[m][0] = a[0]; X[m][1] = a[1]; X[m][2] = a[2]; X[m][3] = a[3]; X[m][4] = b[0]; X[m][5] = b[1]; X[m][6] = b[2]; X[m][7] = b[3];
#elif MK_FP8
                    constexpr float sc8 = (float)(1 << FP8_HGSHIFT);
                    u32x2 w8; w8.x = pk_fp8x4(a[0] * sc8, a[1] * sc8, a[2] * sc8, a[3] * sc8); w8.y = pk_fp8x4(b[0] * sc8, b[1] * sc8, b[2] * sc8, b[3] * sc8);
                    *(u32x2*)((unsigned char*)hg + off) = w8;
#else
                    u32x4 w; w.x = cvt_pk_bf16(a[0], a[1]); w.y = cvt_pk_bf16(a[2], a[3]); w.z = cvt_pk_bf16(b[0], b[1]); w.w = cvt_pk_bf16(b[2], b[3]);
                    *(u32x4*)(hg + off) = w;
#endif
                }
#if MK_FP8 && MK_FP6
                xpose4(X);
                u32x4 lo, hi; fp6_record((v16f_t){XROW16(X, 0), XROW16(X, 1)}, (v16f_t){XROW16(X, 2), XROW16(X, 3)}, lo, hi);
                unsigned char* rp = (unsigned char*)hg + (size_t)(u.pm * BM + ai * HALF + wr * 64 + fq * 16 + fr) * DM + (2 * u.pn + bj) * 128 + 16 * wc;
                *(u32x4*)rp = lo; *(u32x4*)(rp + 64) = hi;
#endif
            }
        }
    }
};
template <int SC> __device__ __forceinline__ f32x2 swiglu_pk(f32x2 g, f32x2 u) {
    g.x = fminf(g.x, 7.0f); g.y = fminf(g.y, 7.0f);
    u.x = __builtin_amdgcn_fmed3f(u.x, -7.0f, 7.0f); u.y = __builtin_amdgcn_fmed3f(u.y, -7.0f, 7.0f);
    const f32x2 t = g * (-1.702f * 1.4426950408889634f);
    f32x2 e; e.x = __builtin_amdgcn_exp2f(t.x); e.y = __builtin_amdgcn_exp2f(t.y);
    const f32x2 d = e + 1.0f;
    f32x2 r; r.x = __builtin_amdgcn_rcpf(d.x); r.y = __builtin_amdgcn_rcpf(d.y);
    const f32x2 us = u * (float)SC + (float)SC;
    return (g * r) * us;
}
__device__ __forceinline__ unsigned pk_fp8x4_nc(f32x2 a, f32x2 b) {
    int w = 0; w = __builtin_amdgcn_cvt_pk_fp8_f32(a.x, a.y, w, false); w = __builtin_amdgcn_cvt_pk_fp8_f32(b.x, b.y, w, true); return (unsigned)w; }
__device__ __forceinline__ float swiglu1(float g, float uu) {
    g = fminf(g, 7.0f); uu = fminf(fmaxf(uu, -7.0f), 7.0f);
    const float e = __builtin_amdgcn_exp2f(g * (-1.702f * 1.4426950408889634f));
    return g * __builtin_amdgcn_rcpf(1.0f + e) * (uu + 1.0f);
}
struct EpiGU {
    bf16_t* hdn; const float* bgate; const float* bup; const float* rstd; const LAS int* tab; const LAS float* rl;
    __device__ __forceinline__ void operator()(const f32x4 (&acc)[2][2][4][2], const Unit& u, int wr, int wc, int fr, int fq) const {
        const int j0 = u.pn * HALF + wc * 32 + 8 * fq; const int cnt = tab[NE + 1 + u.e];
#if MK_EPI_LDS
        const LAS float* bl = rl + 256 + wc * 32 + 8 * fq;
        const f32x4 bg0 = *(const LAS f32x4*)(bl), bg1 = *(const LAS f32x4*)(bl + 4), bu0 = *(const LAS f32x4*)(bl + 128), bu1 = *(const LAS f32x4*)(bl + 132);
#else
        const f32x4 bg0 = *(const f32x4*)(bgate + (size_t)u.e * DM + j0), bg1 = *(const f32x4*)(bgate + (size_t)u.e * DM + j0 + 4);
        const f32x4 bu0 = *(const f32x4*)(bup + (size_t)u.e * DM + j0), bu1 = *(const f32x4*)(bup + (size_t)u.e * DM + j0 + 4);
#endif
#pragma unroll
        for (int ai = 0; ai < 2; ++ai) {
#if MK_FP8 && MK_FP6
            float X[4][8];
#endif
#pragma unroll
            for (int m = 0; m < 4; ++m) {
                const int r = ai * HALF + wr * 64 + m * 16 + fr, pos = u.rows0 + r;
                float rs = MK_EPI_LDS ? rl[r] : rstd[(size_t)u.e * ECAP + pos]; rs = pos < cnt ? rs : 0.f;
                const f32x4 g0 = acc[ai][0][m][0] * rs + bg0, g1 = acc[ai][0][m][1] * rs + bg1, u0 = acc[ai][1][m][0] * rs + bu0, u1 = acc[ai][1][m][1] * rs + bu1;
#if MK_FP8 && MK_FP6
                { const f32x2 h00 = swiglu_pk<1>((f32x2){g0[0], g0[1]}, (f32x2){u0[0], u0[1]}), h01 = swiglu_pk<1>((f32x2){g0[2], g0[3]}, (f32x2){u0[2], u0[3]});
                  const f32x2 h10 = swiglu_pk<1>((f32x2){g1[0], g1[1]}, (f32x2){u1[0], u1[1]}), h11 = swiglu_pk<1>((f32x2){g1[2], g1[3]}, (f32x2){u1[2], u1[3]});
                  X[m][0] = h00.x; X[m][1] = h00.y; X[m][2] = h01.x; X[m][3] = h01.y; X[m][4] = h10.x; X[m][5] = h10.y; X[m][6] = h11.x; X[m][7] = h11.y; }
#elif MK_FP8
                constexpr int SC8 = 1 << FP8_HDSHIFT;
                const f32x2 h00 = swiglu_pk<SC8>((f32x2){g0[0], g0[1]}, (f32x2){u0[0], u0[1]}), h01 = swiglu_pk<SC8>((f32x2){g0[2], g0[3]}, (f32x2){u0[2], u0[3]});
                const f32x2 h10 = swiglu_pk<SC8>((f32x2){g1[0], g1[1]}, (f32x2){u1[0], u1[1]}), h11 = swiglu_pk<SC8>((f32x2){g1[2], g1[3]}, (f32x2){u1[2], u1[3]});
                u32x2 w8; w8.x = pk_fp8x4_nc(h00, h01); w8.y = pk_fp8x4_nc(h10, h11);
                *(u32x2*)((unsigned char*)hdn + (size_t)(u.pm * BM + r) * DM + j0) = w8;
#else
                u32x4 w; w.x = cvt_pk_bf16(swiglu1(g0[0], u0[0]), swiglu1(g0[1], u0[1])); w.y = cvt_pk_bf16(swiglu1(g0[2], u0[2]), swiglu1(g0[3], u0[3]));
                w.z = cvt_pk_bf16(swiglu1(g1[0], u1[0]), swiglu1(g1[1], u1[1])); w.w = cvt_pk_bf16(swiglu1(g1[2], u1[2]), swiglu1(g1[3], u1[3]));
                *(u32x4*)(hdn + (size_t)(u.pm * BM + r) * DM + j0) = w;
#endif
            }
#if MK_FP8 && MK_FP6
            xpose4(X);
            u32x4 lo, hi; fp6_record((v16f_t){XROW16(X, 0), XROW16(X, 1)}, (v16f_t){XROW16(X, 2), XROW16(X, 3)}, lo, hi);
            unsigned char* rp = (unsigned char*)hdn + (size_t)(u.pm * BM + ai * HALF + wr * 64 + fq * 16 + fr) * DM + u.pn * 128 + 16 * wc;
            *(u32x4*)rp = lo; *(u32x4*)(rp + 64) = hi;
#endif
        }
    }
};
struct EpiDown {
    bf16_t* ys; const float* bdown; const float* gate; const LAS int* tab; const LAS float* rl;
    __device__ __forceinline__ void operator()(const f32x4 (&acc)[2][2][4][2], const Unit& u, int wr, int wc, int fr, int fq) const {
        const int cnt = tab[NE + 1 + u.e]; const int c0 = u.pn * BM + wc * 32 + 8 * fq;
#if MK_EPI_LDS
        const LAS float* bl = rl + 256 + wc * 32 + 8 * fq;
        const f32x4 b00 = *(const LAS f32x4*)(bl), b01 = *(const LAS f32x4*)(bl + 4), b10 = *(const LAS f32x4*)(bl + HALF), b11 = *(const LAS f32x4*)(bl + HALF + 4);
#else
        const float* bp = bdown + (size_t)u.e * DM + c0;
        const f32x4 b00 = *(const f32x4*)(bp), b01 = *(const f32x4*)(bp + 4), b10 = *(const f32x4*)(bp + HALF), b11 = *(const f32x4*)(bp + HALF + 4);
#endif
#pragma unroll
        for (int ai = 0; ai < 2; ++ai)
#pragma unroll
            for (int m = 0; m < 4; ++m) {
                const int r = ai * HALF + wr * 64 + m * 16 + fr, pos = u.rows0 + r;
                float gt = MK_EPI_LDS ? rl[r] : gate[(size_t)u.e * ECAP + pos]; gt = pos < cnt ? gt : 0.f;
#if MK_YS8
                const float gs = gt * (float)(1 << FP8_YSHIFT);
                unsigned char* yp = (unsigned char*)ys + (size_t)(u.pm * BM + r) * DM + c0;
                { const f32x4 a = (acc[ai][0][m][0] + b00) * gs, b = (acc[ai][0][m][1] + b01) * gs; u32x2 w8; w8.x = pk_fp8x4(a[0], a[1], a[2], a[3]); w8.y = pk_fp8x4(b[0], b[1], b[2], b[3]); *(u32x2*)yp = w8; }
                { const f32x4 a = (acc[ai][1][m][0] + b10) * gs, b = (acc[ai][1][m][1] + b11) * gs; u32x2 w8; w8.x = pk_fp8x4(a[0], a[1], a[2], a[3]); w8.y = pk_fp8x4(b[0], b[1], b[2], b[3]); *(u32x2*)(yp + HALF) = w8; }
#else
                bf16_t* yp = ys + (size_t)(u.pm * BM + r) * DM + c0;
                { const f32x4 a = (acc[ai][0][m][0] + b00) * gt, b = (acc[ai][0][m][1] + b01) * gt; u32x4 w; w.x = cvt_pk_bf16(a[0], a[1]); w.y = cvt_pk_bf16(a[2], a[3]); w.z = cvt_pk_bf16(b[0], b[1]); w.w = cvt_pk_bf16(b[2], b[3]); *(u32x4*)yp = w; }
                { const f32x4 a = (acc[ai][1][m][0] + b10) * gt, b = (acc[ai][1][m][1] + b11) * gt; u32x4 w; w.x = cvt_pk_bf16(a[0], a[1]); w.y = cvt_pk_bf16(a[2], a[3]); w.z = cvt_pk_bf16(b[0], b[1]); w.w = cvt_pk_bf16(b[2], b[3]); *(u32x4*)(yp + HALF) = w; }
#endif
            }
    }
};
}

typedef GAS unsigned gu32;
#define RLX_AGENT __ATOMIC_RELAXED, __HIP_MEMORY_SCOPE_AGENT
#define LDS_WAIT() asm volatile("s_waitcnt lgkmcnt(0)" ::: "memory")
#define VM_WAIT() asm volatile("s_waitcnt vmcnt(0)" ::: "memory")
#define XB_TMO      128
#define XB_XCNT(j)  (256  + 64 * (j))
#define XB_XSUB(j)  (1280 + 64 * (j))
#define XB_XGEN(j)  (2304 + 64 * (j))
#define XB_TOP      3328
#define XB_TOPGEN   3392
#define XCD_BAR_WORDS 3456
#define XB_SPIN_CAP (1u << 18)
__device__ __forceinline__ unsigned xb_ld(unsigned* p)              { return __hip_atomic_load(p, __ATOMIC_RELAXED, __HIP_MEMORY_SCOPE_AGENT); }
__device__ __forceinline__ unsigned xb_add(unsigned* p, unsigned v) { return __hip_atomic_fetch_add(p, v, __ATOMIC_RELAXED, __HIP_MEMORY_SCOPE_AGENT); }
__device__ __forceinline__ unsigned xb_xcc_id() { return (unsigned)__builtin_amdgcn_s_getreg((3 << 11) | 20) & 0xFu; }
#define XB_SPIN(cond, bar) do { unsigned _sp = 0; while (cond) { __builtin_amdgcn_s_sleep(1); \
    if ((++_sp & 255u) == 0u) { if (xb_ld(&(bar)[XB_TMO])) break; if (_sp > XB_SPIN_CAP) { atomicAdd(&(bar)[XB_TMO], 1u); break; } } } } while (0)
struct XcdBarrier { unsigned* bar; unsigned x; volatile LAS unsigned* st; };
__device__ __forceinline__ XcdBarrier xcd_barrier_post(unsigned* bar, volatile LAS unsigned* st) {
    XcdBarrier b; b.bar = bar; b.x = xb_xcc_id(); b.st = st;
    if (threadIdx.x == 0) (void)xb_add(&bar[XB_XCNT(b.x)], 1u);
    return b;
}
__device__ __forceinline__ void xcd_barrier_complete(unsigned* bar, unsigned x, unsigned& nloc, unsigned& nx) {
    const unsigned G = gridDim.x * gridDim.y * gridDim.z;
    unsigned sum, cnt, mine, sp = 0u;
    for (;;) {
        sum = 0u; cnt = 0u; mine = 0u;
#pragma unroll
        for (unsigned j = 0; j < 16; ++j) { const unsigned c = xb_ld(&bar[XB_XCNT(j)]); sum += c; cnt += (c > 0u) ? 1u : 0u; mine = (j == x) ? c : mine; }
        if (sum == G) break;
        __builtin_amdgcn_s_sleep(1);
        if ((++sp & 255u) == 0u) { if (xb_ld(&bar[XB_TMO])) break; if (sp > XB_SPIN_CAP) { atomicAdd(&bar[XB_TMO], 1u); break; } }
    }
    nloc = mine > 0u ? mine : 1u; nx = cnt > 0u ? cnt : 1u;
}
__device__ __forceinline__ void xcd_barrier(const XcdBarrier& b) {
    asm volatile("s_waitcnt vmcnt(0)" ::: "memory");
    __syncthreads();
    if (threadIdx.x == 0) {
        unsigned* bar = b.bar;
        __builtin_amdgcn_s_waitcnt(0);
        unsigned nloc = b.st[0], nx = b.st[1];
        if (nloc == 0u) { xcd_barrier_complete(bar, b.x, nloc, nx); b.st[0] = nloc; b.st[1] = nx; }
        const unsigned old = xb_add(&bar[XB_XSUB(b.x)], 1u);
        const unsigned gen = old / nloc;
        if (old + 1u == (gen + 1u) * nloc) {
            __builtin_amdgcn_fence(__ATOMIC_RELEASE, "agent");
            asm volatile("s_waitcnt vmcnt(0)" ::: "memory");
            const unsigned og = xb_add(&bar[XB_TOP], 1u);
            const unsigned tg = og / nx;
            if (og + 1u == (tg + 1u) * nx) xb_add(&bar[XB_TOPGEN], 1u);
            else XB_SPIN(xb_ld(&bar[XB_TOPGEN]) == tg, bar);
            __builtin_amdgcn_fence(__ATOMIC_ACQUIRE, "agent");
            xb_add(&bar[XB_XGEN(b.x)], 1u);
            asm volatile("s_waitcnt vmcnt(0)" ::: "memory");
        } else {
            XB_SPIN(xb_ld(&bar[XB_XGEN(b.x)]) == gen, bar);
            __builtin_amdgcn_fence(__ATOMIC_ACQUIRE, "agent");
            asm volatile("s_waitcnt vmcnt(0)" ::: "memory");
        }
    }
    __syncthreads();
}

struct Args { const void* in[22]; float* out; unsigned char* ws; int ph_lo, ph_hi; };
typedef __attribute__((address_space(4))) const volatile Args* KArgs;
#define KIN(k) ((const void*)ka->in[k])
struct Frame {
    LAS unsigned char* lds; int wave, G, vcu;
    gu32* ctl; unsigned char* ws;
};

__device__ __forceinline__ void tr_item(const float* W, size_t ldw, int k0, int c0a, int c0b, bool perm, bf16_t* dst  , LAS float* scr, int lane) {
    const int kr = lane >> 4, q = lane & 15; const int col = (q < 8) ? c0a + 4 * q : c0b + 4 * (q - 8);
    f32x4 v[16];
#pragma unroll
    for (int it = 0; it < 16; ++it) v[it] = *(const f32x4*)(W + (size_t)(k0 + 4 * it + kr) * ldw + col);
#pragma unroll
    for (int it = 0; it < 16; ++it) { const int k = 4 * it + kr; *(LAS f32x4*)(scr + k * 64 + 4 * (q ^ ((k >> 3) & 7))) = v[it]; }
    LDS_WAIT(); asm volatile("" ::: "memory");
    const int n0l = lane >> 3, c = lane & 7;
#pragma unroll
    for (int j = 0; j < 8; ++j) { const int n = n0l + 8 * j; const int slot = perm ? ((n >> 1) + 32 * (n & 1)) : n;
        const LAS float* s = scr + (8 * c) * 64 + 4 * ((slot >> 2) ^ c) + (slot & 3);
        u32x4 o; o.x = pk2(s[0 * 64], s[1 * 64]); o.y = pk2(s[2 * 64], s[3 * 64]); o.z = pk2(s[4 * 64], s[5 * 64]); o.w = pk2(s[6 * 64], s[7 * 64]);
        *(u32x4*)(dst + (size_t)n * DM + k0 + 8 * c) = o; }
    LDS_WAIT(); asm volatile("" ::: "memory");
}
__device__ __forceinline__ void tr8_load(f32x4 (&v)[16], const float* W, size_t ldw, int k0, int c0, int lane) {
    const int kr = lane >> 3, q = lane & 7; const float* p = W + (size_t)(k0 + kr) * ldw + c0 + 4 * q;
#pragma unroll
    for (int it = 0; it < 16; ++it) v[it] = __builtin_nontemporal_load((const f32x4*)(p + (size_t)(8 * it) * ldw));
}
__device__ __forceinline__ void tr6_put(const f32x4 (&v)[16], LAS float* scr, int lane) {
    const int kr = lane >> 3, q = lane & 7;
#pragma unroll
    for (int it = 0; it < 16; ++it) { const int k = 8 * it + kr; *(LAS f32x4*)(scr + k * 32 + 4 * (q ^ ((k >> 4) & 7))) = v[it]; }
    LDS_WAIT(); asm volatile("" ::: "memory");
}
__device__ __forceinline__ void tr6_emit(int k0, unsigned char* dst, LAS float* scr, int lane) {
#pragma unroll
    for (int jj = 0; jj < 2; ++jj) { const int p = lane + 64 * jj, n = p >> 2, ch = p & 3;
        v16f_t a, b;
#pragma unroll
        for (int i = 0; i < 16; ++i) { const int ka = 32 * ch + i, kb = ka + 16;
            a[i] = scr[ka * 32 + 4 * ((n >> 2) ^ (2 * ch)) + (n & 3)]; b[i] = scr[kb * 32 + 4 * ((n >> 2) ^ (2 * ch + 1)) + (n & 3)]; }
        u32x4 lo, hi; fp6_record(a, b, lo, hi);
        unsigned char* rp = dst + (size_t)n * DM + k0 + 16 * ch;
        __builtin_nontemporal_store(lo, (u32x4*)rp); __builtin_nontemporal_store(hi, (u32x4*)(rp + 64)); }
    LDS_WAIT(); asm volatile("" ::: "memory");
}
__device__ __forceinline__ void tr6_store(const f32x4 (&v)[16], int k0, unsigned char* dst, LAS float* scr, int lane) { tr6_put(v, scr, lane); tr6_emit(k0, dst, scr, lane); }
__device__ __forceinline__ void tr8_store(const f32x4 (&v)[16], int k0, unsigned char* dst  , LAS float* scr, int lane) {
    const int kr = lane >> 3, q = lane & 7;
#pragma unroll
    for (int it = 0; it < 16; ++it) { const int k = 8 * it + kr; *(LAS f32x4*)(scr + k * 32 + 4 * (q ^ ((k >> 4) & 7))) = v[it]; }
    LDS_WAIT(); asm volatile("" ::: "memory");
    const int n0l = lane >> 3, c = lane & 7; constexpr float sc8 = (float)(1 << FP8_WSHIFT);
#pragma unroll
    for (int j = 0; j < 4; ++j) { const int n = n0l + 8 * j;
        const LAS float* s = scr + (16 * c) * 32 + 4 * ((n >> 2) ^ c) + (n & 3);
        u32x4 o; o.x = pk_fp8x4(s[0 * 32] * sc8, s[1 * 32] * sc8, s[2 * 32] * sc8, s[3 * 32] * sc8); o.y = pk_fp8x4(s[4 * 32] * sc8, s[5 * 32] * sc8, s[6 * 32] * sc8, s[7 * 32] * sc8);
        o.z = pk_fp8x4(s[8 * 32] * sc8, s[9 * 32] * sc8, s[10 * 32] * sc8, s[11 * 32] * sc8); o.w = pk_fp8x4(s[12 * 32] * sc8, s[13 * 32] * sc8, s[14 * 32] * sc8, s[15 * 32] * sc8);
        *(u32x4*)(dst + (size_t)n * DM + k0 + 16 * c) = o; }
    LDS_WAIT(); asm volatile("" ::: "memory");
}
__device__ __forceinline__ float log2_sigmoid(float z) {
    const float az = fabsf(z); const float e = __builtin_amdgcn_exp2f(-az * L2E);
    return fminf(z, 0.f) * L2E - __builtin_amdgcn_logf(1.0f + e) ;
}
__device__ __forceinline__ void p0_prologue(Frame& F, KArgs ka) {
    const float* x = (const float*)KIN(0); const int* pos = (const int*)KIN(1); const float* g_attn = (const float*)KIN(2); const float* w_in = (const float*)KIN(3);
    const float* b_forget = (const float*)KIN(4); const float* w_out = (const float*)KIN(11); const float* g_ffn = (const float*)KIN(12); const float* w_router = (const float*)KIN(13);
    const float* w_gate = (const float*)KIN(15); const float* w_up = (const float*)KIN(17); const float* w_down = (const float*)KIN(19);
    const int gw = F.vcu * NWAVES + F.wave, NGW = F.G * NWAVES; const int gt = F.vcu * NTHREADS + ((int)threadIdx.x), NGT = F.G * NTHREADS;
    { float* rope = (float*)(F.ws + WS_ROPE);
#pragma unroll 8
      for (int p = gt; p < MTOK * 64; p += NGT) { const int m = p >> 6, i = p & 63;
          const float invf = exp2f(-(float)i * 0.20762050593046014f); const float ang = (float)pos[m] * invf;
          const double rv = (double)ang * 0.15915494309189533576888; const float rev = (float)(rv - floor(rv));
          *(f32x2*)(rope + (size_t)p * 2) = (f32x2){__builtin_amdgcn_cosf(rev), __builtin_amdgcn_sinf(rev)}; } }
    { bf16_t* gwf = (bf16_t*)(F.ws + WS_GWF);
      for (int f = gt; f < 64 * 2 * 2 * 64; f += NGT) { const int ln = f & 63, p = (f >> 6) & 1, eh = (f >> 7) & 1, s = f >> 8;
          unsigned o[4];
#pragma unroll
          for (int j2 = 0; j2 < 4; ++j2) { unsigned hv[2];
#pragma unroll
              for (int q = 0; q < 2; ++q) { const int k = 32 * s + 8 * (ln >> 4) + 2 * j2 + q, e = 16 * eh + (ln & 15); const float val = g_ffn[k] * w_router[k * NE + e];
                  const unsigned hi = f2bf(val); const float lo = val - bf2f((unsigned short)hi); hv[q] = p ? f2bf(lo) : hi; }
              o[j2] = hv[0] | (hv[1] << 16); }
          *(u32x4*)(gwf + (size_t)f * 8) = (u32x4){o[0], o[1], o[2], o[3]}; } }
    { LAS float* gwfT = (LAS float*)F.lds;
#pragma unroll 4
      for (int k = ((int)threadIdx.x); k < DM; k += NTHREADS) { const f32x4 w0 = *(const f32x4*)(w_in + (size_t)k * INC + NQKV), w1 = *(const f32x4*)(w_in + (size_t)k * INC + NQKV + 4); const float g = g_attn[k];
          gwfT[0 * DM + k] = g * w0.x; gwfT[1 * DM + k] = g * w0.y; gwfT[2 * DM + k] = g * w0.z; gwfT[3 * DM + k] = g * w0.w; gwfT[4 * DM + k] = g * w1.x; gwfT[5 * DM + k] = g * w1.y; gwfT[6 * DM + k] = g * w1.z; gwfT[7 * DM + k] = g * w1.w; }
      __syncthreads();
      bf16_t* XN = (bf16_t*)(F.ws + WS_XN); float* flog = (float*)(F.ws + WS_FLOG);
      f32x4 gv[8];
#pragma unroll
      for (int j = 0; j < 8; ++j) gv[j] = *((const f32x4*)g_attn + ((int)(threadIdx.x & 63)) + 64 * j);
      f32x4 vn[8];
      if (gw < MTOK) { const f32x4* xr = (const f32x4*)(x + (size_t)gw * DM) + ((int)(threadIdx.x & 63));
#pragma unroll
          for (int j = 0; j < 8; ++j) vn[j] = __builtin_nontemporal_load(xr + 64 * j); }
      for (int m = gw; m < MTOK; m += NGW) {
          f32x4 v[8]; float s = 0.f;
#pragma unroll
          for (int j = 0; j < 8; ++j) { v[j] = vn[j]; s += (v[j].x * v[j].x + v[j].y * v[j].y) + (v[j].z * v[j].z + v[j].w * v[j].w); }
          if (m + NGW < MTOK) { const f32x4* xr = (const f32x4*)(x + (size_t)(m + NGW) * DM) + ((int)(threadIdx.x & 63));
#pragma unroll
              for (int j = 0; j < 8; ++j) vn[j] = __builtin_nontemporal_load(xr + 64 * j); }
          const float rstd = 1.0f / sqrtf(wave_sum(s) * (1.0f / DM) + EPS);
          unsigned long long* o8 = (unsigned long long*)(XN + (size_t)m * DM) + ((int)(threadIdx.x & 63));
#pragma unroll
          for (int j = 0; j < 8; ++j) { const f32x4 t = v[j] * gv[j] * rstd; o8[64 * j] = (unsigned long long)pk2(t.x, t.y) | ((unsigned long long)pk2(t.z, t.w) << 32); }
          float myz = 0.f;
#pragma unroll 1
          for (int jh = 0; jh < 8; ++jh) { float acc = 0.f;
#pragma unroll
              for (int j = 0; j < 8; ++j) { const f32x4 w = *(const LAS f32x4*)(gwfT + jh * DM + 256 * j + 4 * ((int)(threadIdx.x & 63))); acc += (v[j].x * w.x + v[j].y * w.y) + (v[j].z * w.z + v[j].w * w.w); }
              acc = wave_sum(acc); if (((int)(threadIdx.x & 63)) == jh) myz = acc; }
          if (((int)(threadIdx.x & 63)) < 8) flog[(size_t)m * 8 + ((int)(threadIdx.x & 63))] = log2_sigmoid(myz * rstd + b_forget[((int)(threadIdx.x & 63))]);
      }
      __syncthreads();
    }
    { LAS float* scr = (LAS float*)(F.lds + F.wave * 16384);
      bf16_t* Win = (bf16_t*)(F.ws + WS_WIN); bf16_t* Wout = (bf16_t*)(F.ws + WS_WOUT); bf16_t* Wgu = (bf16_t*)(F.ws + WS_WGU); bf16_t* Wd = (bf16_t*)(F.ws + WS_WD);
      constexpr int I_IN = 32 * 96, I_OUT = 32 * 32, I_GU = NE * 32 * 64, I_D = NE * 32 * 32, NITEMS = I_IN + I_OUT + I_GU + I_D;
      for (int it = gw; it < NITEMS; it += NGW) {
          int r = it;
          if (r < I_IN) { const int kb = r / 96, nb = r % 96, n0 = nb * 64;
              if (n0 < 2048) { const int base = n0 & ~127, i0 = ((n0 >> 6) & 1) * 32; tr_item(w_in, INC, kb * 64, base + i0, base + 64 + i0, true, Win + (size_t)n0 * DM, scr, ((int)(threadIdx.x & 63))); }
              else tr_item(w_in, INC, kb * 64, n0, n0 + 32, false, Win + (size_t)n0 * DM, scr, ((int)(threadIdx.x & 63)));
              continue; }
          r -= I_IN;
          if (r < I_OUT) { const int kb = r / 32, nb = r % 32; tr_item(w_out, DM, kb * 64, nb * 64, nb * 64 + 32, false, Wout + (size_t)nb * 64 * DM, scr, ((int)(threadIdx.x & 63))); continue; }
          r -= I_OUT;
#if MK_FP8
          break;
#else
          if (r < I_GU) { const int e = r / (32 * 64), rr = r % (32 * 64), kb = rr / 64, nb = rr % 64;
              const int pn = nb >> 2, w = nb & 3; const float* src = (w < 2 ? w_gate : w_up) + (size_t)e * DM * DM; const int c0 = pn * 128 + (w & 1) * 64;
              tr_item(src, DM, kb * 64, c0, c0 + 32, false, Wgu + ((size_t)e * 4096 + (size_t)nb * 64) * DM, scr, ((int)(threadIdx.x & 63))); continue; }
          r -= I_GU;
          { const int e = r / (32 * 32), rr = r % (32 * 32), kb = rr / 32, nb = rr % 32;
            tr_item(w_down + (size_t)e * DM * DM, DM, kb * 64, nb * 64, nb * 64 + 32, false, Wd + ((size_t)e * DM + (size_t)nb * 64) * DM, scr, ((int)(threadIdx.x & 63))); }
#endif
      }
    }
}

__device__ __forceinline__ void probe_stream(Frame& F, KArgs ka) {
    const float* src[3] = {(const float*)KIN(15), (const float*)KIN(17), (const float*)KIN(19)};
    const size_t n4 = (size_t)NE * DM * DM / 4; const size_t gt = (size_t)F.vcu * NTHREADS + threadIdx.x, NGT = (size_t)F.G * NTHREADS;
#pragma unroll
    for (int m = 0; m < 3; ++m) { unsigned* dst = (unsigned*)(F.ws + WS_HDN) + (size_t)m * n4;
#pragma unroll 8
        for (size_t i = gt; i < n4; i += NGT) { const f32x4 v = __builtin_nontemporal_load((const f32x4*)src[m] + i); dst[i] = pk_fp8x4(v.x * 256.f, v.y * 256.f, v.z * 256.f, v.w * 256.f); } }
}
#if MK_FP8
#if MK_FP6
#define P0B_STORE(v, k0, dst, scr, lane) tr6_store(v, k0, dst, scr, lane)
#else
#define P0B_STORE(v, k0, dst, scr, lane) tr8_store(v, k0, dst, scr, lane)
#endif
constexpr int P0B_ROWB = DM;
constexpr int P0B_IGU = NE * 32 * 64, P0B_ID = NE * 32 * 32, P0B_NI = P0B_IGU + P0B_ID;
__device__ __forceinline__ void p0b_experts(Frame& F, KArgs ka, const int it_lo, const int it_hi, const int rankw, const int nw, unsigned* dyn) {
    const float* w_gate = (const float*)KIN(15); const float* w_up = (const float*)KIN(17); const float* w_down = (const float*)KIN(19);
    constexpr int I_GU = P0B_IGU;
    LAS float* scr = (LAS float*)(F.lds + F.wave * 16384);
    bf16_t* Wgu = (bf16_t*)(F.ws + WS_WGU); bf16_t* Wd = (bf16_t*)(F.ws + WS_WD);
    __syncthreads();
      { const int lane = (int)(threadIdx.x & 63);
#define FP8_DESC(r_, SRC, K0, C0, DST) do { int r2 = (r_); \
          if (r2 < I_GU) { const int e = r2 / (16 * 128), rr = r2 % (16 * 128), kb = rr / 128, nb = rr % 128; const int pn = nb >> 3, w = nb & 7; \
              SRC = (w < 4 ? w_gate : w_up) + (size_t)e * DM * DM; C0 = pn * 128 + (w & 3) * 32; K0 = kb * 128; const size_t row = (size_t)e * 4096 + (size_t)nb * 32; \
              DST = (unsigned char*)Wgu + row * P0B_ROWB; } \
          else { r2 -= I_GU; const int e = r2 / (16 * 64), rr = r2 % (16 * 64), kb = rr / 64, nb = rr % 64; \
              SRC = w_down + (size_t)e * DM * DM; C0 = nb * 32; K0 = kb * 128; const size_t row = (size_t)e * DM + (size_t)nb * 32; \
              DST = (unsigned char*)Wd + row * P0B_ROWB; } } while (0)
        f32x4 va[16], vb[16]; const float* src; int k0 = 0, c0 = 0; unsigned char* dst = nullptr; const float* srcn; int k0n = 0, c0n = 0; unsigned char* dstn = nullptr;
#if MK_FP6
#define P0B_NEXT(last) (dyn != nullptr ? it_lo + __builtin_amdgcn_readfirstlane(lane == 0 ? (int)__hip_atomic_fetch_add(dyn, 1u, __ATOMIC_RELAXED, __HIP_MEMORY_SCOPE_AGENT) : 0) : (last) + nw)
        int last = P0B_NEXT(it_lo + rankw - nw), ia = last;
        if (ia < it_hi) { FP8_DESC(ia, src, k0, c0, dst); tr8_load(va, src, DM, k0, c0, lane); }
        last = P0B_NEXT(last); int ib = last;
        if (ib < it_hi) { FP8_DESC(ib, srcn, k0n, c0n, dstn); tr8_load(vb, srcn, DM, k0n, c0n, lane); }
        for (;;) {
            if (ia >= it_hi) break;
            { tr6_put(va, scr, lane); const int ke = k0; unsigned char* de = dst;
              last = P0B_NEXT(last); ia = last;
              if (ia < it_hi) { FP8_DESC(ia, src, k0, c0, dst); tr8_load(va, src, DM, k0, c0, lane); }
              tr6_emit(ke, de, scr, lane); }
            if (ib >= it_hi) break;
            { tr6_put(vb, scr, lane); const int ke = k0n; unsigned char* de = dstn;
              last = P0B_NEXT(last); ib = last;
              if (ib < it_hi) { FP8_DESC(ib, srcn, k0n, c0n, dstn); tr8_load(vb, srcn, DM, k0n, c0n, lane); }
              tr6_emit(ke, de, scr, lane); }
        }
#undef P0B_NEXT
#else
        const int NGW = nw; int it = it_lo + rankw;
        if (it < it_hi) { FP8_DESC(it, src, k0, c0, dst); tr8_load(va, src, DM, k0, c0, lane); }
        while (it < it_hi) {
            int itn = it + NGW;
            if (itn < it_hi) { FP8_DESC(itn, srcn, k0n, c0n, dstn); tr8_load(vb, srcn, DM, k0n, c0n, lane); }
            P0B_STORE(va, k0, dst, scr, lane);
            it = itn; if (it >= it_hi) break;
            itn = it + NGW;
            if (itn < it_hi) { FP8_DESC(itn, src, k0, c0, dst); tr8_load(va, src, DM, k0, c0, lane); }
            P0B_STORE(vb, k0n, dstn, scr, lane);
            it = itn;
        }
#endif
#undef FP8_DESC
      }
    __syncthreads();
}
#endif
__device__ __forceinline__ void p1_scan(Frame& F) {
    if (blockIdx.x >= BATCH * 8) return;
    const int bh = blockIdx.x, b = bh >> 3, h = bh & 7, t = ((int)threadIdx.x);
    const float* flog = (const float*)(F.ws + WS_FLOG); float* clog = (float*)(F.ws + WS_CLOG) + (size_t)bh * SEQ;
    LAS double* sc = (LAS double*)F.lds;
    double loc[8]; double run = 0.0;
#pragma unroll
    for (int i = 0; i < 8; ++i) { run += (double)flog[(size_t)(b * SEQ + t * 8 + i) * 8 + h]; loc[i] = run; }
    double v = run; const int ln = t & 63, wv = t >> 6;
#pragma unroll
    for (int o = 1; o < 64; o <<= 1) { const double n = __shfl_up(v, o); v = ln >= o ? v + n : v; }
    if (ln == 63) sc[wv] = v;
    __syncthreads();
    double base = v - run;
#pragma unroll
    for (int w = 0; w < NWAVES - 1; ++w) { const double wt = sc[w]; base += w < wv ? wt : 0.0; }
#pragma unroll
    for (int i = 0; i < 8; ++i) clog[t * 8 + i] = (float)(base + loc[i]);
    __syncthreads();
}

__device__ __forceinline__ void p_norms(Frame& F) {
    const bf16_t* QKV = (const bf16_t*)(F.ws + WS_QKV);
    const int lane = (int)(threadIdx.x & 63), gw = F.vcu * NWAVES + F.wave, NGW = F.G * NWAVES;
    for (int task = gw; task < 2 * 32 * 16; task += NGW) {
        const int isk = task >> 9, bh = (task >> 4) & 31, ch = task & 15, b = bh >> 3, h = bh & 7;
        const bf16_t* base = QKV + ((size_t)((isk ? 32 : 24) + h) * MTOK + (size_t)b * SEQ + ch * 256) * 128 + (lane >> 4) * 128 + (lane & 15) * 8;
        float mx = 0.f;
#pragma unroll 4
        for (int it = 0; it < 64; ++it) {
            const u32x4 w = *(const u32x4*)(base + (size_t)it * 4 * 128);
            float ss = 0.f;
#pragma unroll
            for (int j = 0; j < 4; ++j) { const float a = bf2f((unsigned short)(w[j] & 0xffff)), c = bf2f((unsigned short)(w[j] >> 16)); ss += a * a + c * c; }
            ss += __shfl_xor(ss, 1); ss += __shfl_xor(ss, 2); ss += __shfl_xor(ss, 4); ss += __shfl_xor(ss, 8);
            mx = fmaxf(mx, ss);
        }
        mx = fmaxf(mx, __shfl_xor(mx, 16)); mx = fmaxf(mx, __shfl_xor(mx, 32));
        if (lane == 0) atomicMax((unsigned*)(F.ctl + (isk ? CW_KMAX + bh : CW_QMAX + bh * 16 + ch)), __float_as_uint(mx));
    }
}

__device__ __forceinline__ void p3_mix(Frame& F, KArgs ka) {
    const float* lq1 = (const float*)KIN(5); const float* lk1 = (const float*)KIN(6); const float* lq2 = (const float*)KIN(7); const float* lk2 = (const float*)KIN(8);
    const float* gd = (const float*)KIN(9); const float* gf = (const float*)KIN(10);
    const int l = ((int)(threadIdx.x & 63));
    const float s1 = wave_sum(lq1[l] * lk1[l] + lq1[l + 64] * lk1[l + 64]), s2 = wave_sum(lq2[l] * lk2[l] + lq2[l + 64] * lk2[l + 64]);
    const float lam = expf(s1) - expf(s2) + 0.2f;
    const bf16_t* O = (const bf16_t*)(F.ws + WS_O); bf16_t* mix = (bf16_t*)(F.ws + WS_MIX);
    const f32x2 gd0 = *(const f32x2*)(gd + 2 * l), gd1 = *(const f32x2*)(gd + 128 + 2 * l), gfv = *(const f32x2*)(gf + 2 * l);
    const int gw = F.vcu * NWAVES + F.wave, NGW = F.G * NWAVES;
    for (int m = gw; m < MTOK; m += NGW) {
        unsigned ov[24];
#pragma unroll
        for (int vh = 0; vh < 24; ++vh) ov[vh] = *(const unsigned*)(O + ((size_t)vh * MTOK + m) * 128 + 2 * l);
        unsigned* mrow = (unsigned*)(mix + (size_t)m * DM);
#pragma unroll
        for (int h = 0; h < 4; ++h) {
            const unsigned a0 = ov[8 + h * 4 + 0], a1 = ov[8 + h * 4 + 1], b0 = ov[8 + h * 4 + 2], b1 = ov[8 + h * 4 + 3];
            const float d00 = bf2f(a0 & 0xffff) - lam * bf2f(b0 & 0xffff), d01 = bf2f(a0 >> 16) - lam * bf2f(b0 >> 16);
            const float d10 = bf2f(a1 & 0xffff) - lam * bf2f(b1 & 0xffff), d11 = bf2f(a1 >> 16) - lam * bf2f(b1 >> 16);
            const float ss = wave_sum((d00 * d00 + d01 * d01) + (d10 * d10 + d11 * d11));
            const float rs = 0.8f / sqrtf(ss * (1.0f / 256.0f) + EPS);
            mrow[(h * 256) / 2 + l] = pk2(d00 * rs * gd0.x, d01 * rs * gd0.y);
            mrow[(h * 256 + 128) / 2 + l] = pk2(d10 * rs * gd1.x, d11 * rs * gd1.y);
        }
#pragma unroll
        for (int h = 0; h < 8; ++h) {
            const float f0 = bf2f(ov[h] & 0xffff), f1 = bf2f(ov[h] >> 16);
            const float ss = wave_sum(f0 * f0 + f1 * f1);
            const float rs = 1.0f / sqrtf(ss * (1.0f / 128.0f) + EPS);
            mrow[(1024 + h * 128) / 2 + l] = pk2(f0 * rs * gfv.x, f1 * rs * gfv.y);
        }
    }
}

__device__ __forceinline__ void p5_router(Frame& F, KArgs ka, const float* hbuf) {
    const float* b_router = (const float*)KIN(14);
    const bf16_t* gwf = (const bf16_t*)(F.ws + WS_GWF);
    int* tke = (int*)(F.ws + WS_TKE); int* tokl = (int*)(F.ws + WS_TOK); float* rstdl = (float*)(F.ws + WS_RSTD); float* gatel = (float*)(F.ws + WS_GATE);
    LAS float* sc = (LAS float*)(F.lds + F.wave * 4096);
    const int l = ((int)(threadIdx.x & 63)), r16 = l & 15, kq = l >> 4;
    const int gw = F.vcu * NWAVES + F.wave, NGW = F.G * NWAVES;
    if (((int)threadIdx.x) < NE) ((LAS int*)(F.lds + 8 * 4096))[((int)threadIdx.x)] = 0;
    __syncthreads();
    for (int item = gw; item < MTOK / 8; item += NGW) {
        const int tile = item >> 1, kh = item & 1;
        const float* hr = hbuf + (size_t)(tile * 16 + r16) * DM + 8 * kq + 1024 * kh;
        f32x4 acc0 = {0.f, 0.f, 0.f, 0.f}, acc1 = {0.f, 0.f, 0.f, 0.f}; float ss = 0.f;
        f32x4 va[2][4], vb[2][4];
#define P5_LOAD(bf_, s4_) do { _Pragma("unroll") for (int u = 0; u < 4; ++u) { va[bf_][u] = __builtin_nontemporal_load((const f32x4*)(hr + 32 * (4 * (s4_) + u))); vb[bf_][u] = __builtin_nontemporal_load((const f32x4*)(hr + 32 * (4 * (s4_) + u) + 4)); } } while (0)
        P5_LOAD(0, 0);
#pragma unroll 1
        for (int s8 = 0; s8 < 8; s8 += 2) {
#pragma unroll
          for (int hb_ = 0; hb_ < 2; ++hb_) { const int s4 = s8 + hb_;
            if (hb_ == 0) P5_LOAD(1, s4 + 1); else if (s4 < 7) P5_LOAD(0, s4 + 1);
#pragma unroll
            for (int u = 0; u < 4; ++u) { const f32x4 v0 = va[hb_][u], v1 = vb[hb_][u];
            ss += (v0.x * v0.x + v0.y * v0.y) + (v0.z * v0.z + v0.w * v0.w) + (v1.x * v1.x + v1.y * v1.y) + (v1.z * v1.z + v1.w * v1.w);
            unsigned hi[4], lo[4];
#define SPL(i, A, B) do { const unsigned ha = f2bf(A), hb = f2bf(B); hi[i] = ha | (hb << 16); lo[i] = pk2(A - bf2f((unsigned short)ha), B - bf2f((unsigned short)hb)); } while (0)
            SPL(0, v0.x, v0.y); SPL(1, v0.z, v0.w); SPL(2, v1.x, v1.y); SPL(3, v1.z, v1.w);
#undef SPL
            const u32x4 hiv = {hi[0], hi[1], hi[2], hi[3]}, lov = {lo[0], lo[1], lo[2], lo[3]};
            const bf16x8 ah = __builtin_bit_cast(bf16x8, hiv), al = __builtin_bit_cast(bf16x8, lov);
            const bf16x8* bf = (const bf16x8*)(gwf + (size_t)(32 * kh + 4 * s4 + u) * 4 * 512) + l;
            const bf16x8 b0h = bf[0], b0l = bf[64], b1h = bf[128], b1l = bf[192];
            acc0 = __builtin_amdgcn_mfma_f32_16x16x32_bf16(ah, b0h, acc0, 0, 0, 0); acc0 = __builtin_amdgcn_mfma_f32_16x16x32_bf16(al, b0h, acc0, 0, 0, 0); acc0 = __builtin_amdgcn_mfma_f32_16x16x32_bf16(ah, b0l, acc0, 0, 0, 0);
            acc1 = __builtin_amdgcn_mfma_f32_16x16x32_bf16(ah, b1h, acc1, 0, 0, 0); acc1 = __builtin_amdgcn_mfma_f32_16x16x32_bf16(al, b1h, acc1, 0, 0, 0); acc1 = __builtin_amdgcn_mfma_f32_16x16x32_bf16(ah, b1l, acc1, 0, 0, 0);
            }
          }
        }
#undef P5_LOAD
        { LAS float* px = (LAS float*)(F.lds + (F.wave | 1) * 4096) + 9 * l;
          if (kh) { px[0] = acc0[0]; px[1] = acc0[1]; px[2] = acc0[2]; px[3] = acc0[3]; px[4] = acc1[0]; px[5] = acc1[1]; px[6] = acc1[2]; px[7] = acc1[3]; px[8] = ss; }
          __syncthreads();
          if (!kh) { acc0[0] += px[0]; acc0[1] += px[1]; acc0[2] += px[2]; acc0[3] += px[3]; acc1[0] += px[4]; acc1[1] += px[5]; acc1[2] += px[6]; acc1[3] += px[7]; ss += px[8]; } }
        if (kh == 0) {
        ss += __shfl_xor(ss, 16); ss += __shfl_xor(ss, 32);
        const float rstd = 1.0f / sqrtf(ss * (1.0f / DM) + EPS);
        if (kq == 0) sc[16 * 33 + r16] = rstd;
        LDS_WAIT(); asm volatile("" ::: "memory");
#pragma unroll
        for (int rg = 0; rg < 4; ++rg) { const int tr = 4 * kq + rg; const float rt = sc[16 * 33 + tr];
            sc[tr * 33 + r16] = acc0[rg] * rt + b_router[r16]; sc[tr * 33 + 16 + r16] = acc1[rg] * rt + b_router[16 + r16]; }
        LDS_WAIT(); asm volatile("" ::: "memory");
        }
        LAS int* cntL = (LAS int*)(F.lds + 8 * 4096); LAS int* baseL = cntL + 32;
        int m = 0, ti[TOPK] = {0, 0, 0, 0}, rk[TOPK] = {0, 0, 0, 0}; float gk[TOPK] = {0.f, 0.f, 0.f, 0.f}, rt = 0.f;
        const bool sel = kh == 0 && l < 16;
        if (sel) {
            m = tile * 16 + l; float lg[NE];
#pragma unroll
            for (int e = 0; e < NE; ++e) lg[e] = sc[l * 33 + e];
            float tv[TOPK];
#pragma unroll
            for (int k = 0; k < TOPK; ++k) { float best = -3.4e38f; int bi = 0;
#pragma unroll
                for (int e = 0; e < NE; ++e) { const bool c = lg[e] > best; best = c ? lg[e] : best; bi = c ? e : bi; }
                tv[k] = best; ti[k] = bi;
#pragma unroll
                for (int e = 0; e < NE; ++e) lg[e] = (e == bi) ? -3.4e38f : lg[e]; }
            const float e1 = __expf(tv[1] - tv[0]), e2 = __expf(tv[2] - tv[0]), e3 = __expf(tv[3] - tv[0]); const float inv = 1.0f / (1.0f + e1 + e2 + e3);
            gk[0] = inv; gk[1] = e1 * inv; gk[2] = e2 * inv; gk[3] = e3 * inv; rt = sc[16 * 33 + l];
#pragma unroll
            for (int k = 0; k < TOPK; ++k) rk[k] = __hip_atomic_fetch_add((int*)(cntL + ti[k]), 1, __ATOMIC_RELAXED, __HIP_MEMORY_SCOPE_WORKGROUP);
        }
        LDS_WAIT(); asm volatile("" ::: "memory");
        __syncthreads();
        if (((int)threadIdx.x) < NE) { const int c = cntL[((int)threadIdx.x)]; int b = 0;
            if (c > 0) b = (int)__hip_atomic_fetch_add((unsigned*)(F.ctl + CW_CNT + 64 * ((int)threadIdx.x)), (unsigned)c, RLX_AGENT);
            baseL[((int)threadIdx.x)] = b; cntL[((int)threadIdx.x)] = 0; }
        LDS_WAIT(); asm volatile("" ::: "memory");
        __syncthreads();
        if (sel) {
#pragma unroll
            for (int k = 0; k < TOPK; ++k) { const int e = ti[k]; const int pos = baseL[e] + rk[k];
                tokl[(size_t)e * ECAP + pos] = m; rstdl[(size_t)e * ECAP + pos] = rt; gatel[(size_t)e * ECAP + pos] = gk[k]; tke[m * TOPK + k] = pos * 32 + e; }
        }
        LDS_WAIT(); asm volatile("" ::: "memory");
        __syncthreads();
    }
}

__device__ __forceinline__ void build_tab(Frame& F, LAS int* tab, bool publish) {
    if (((int)threadIdx.x) < NE) tab[NE + 1 + ((int)threadIdx.x)] = (int)__hip_atomic_load(F.ctl + CW_CNT + 64 * ((int)threadIdx.x), RLX_AGENT);
    __syncthreads();
    if (((int)threadIdx.x) == 0) { int s = 0; for (int e = 0; e < NE; ++e) { tab[e] = s; s += (tab[NE + 1 + e] + 255) >> 8; } tab[NE] = s; }
    __syncthreads();
    if (publish && blockIdx.x == 0 && ((int)threadIdx.x) <= NE) ((int*)(F.ws + WS_TSTART))[((int)threadIdx.x)] = tab[((int)threadIdx.x)];
}

__device__ __forceinline__ void p8_final(Frame& F, KArgs ka, float* hout) {
    const float* gfin = (const float*)KIN(21);
    const bf16_t* ys = (const bf16_t*)(F.ws + WS_YS); const int* tke = (const int*)(F.ws + WS_TKE); const int* tstart = (const int*)(F.ws + WS_TSTART);
    const int gw = F.vcu * NWAVES + F.wave, NGW = F.G * NWAVES;
    f32x4 gv[8];
#pragma unroll
    for (int j = 0; j < 8; ++j) gv[j] = *((const f32x4*)gfin + ((int)(threadIdx.x & 63)) + 64 * j);
    for (int m = gw; m < MTOK; m += NGW) {
        f32x4* hr = (f32x4*)(hout + (size_t)m * DM) + ((int)(threadIdx.x & 63));
        f32x4 v[8];
#pragma unroll
        for (int j = 0; j < 8; ++j) v[j] = hr[64 * j];
#pragma unroll
        for (int k = 0; k < TOPK; ++k) { const int code = tke[m * TOPK + k]; const int e = code & 31, pos = code >> 5; const size_t slot = (size_t)tstart[e] * 256 + pos;
#if MK_YS8
            const unsigned* yr = (const unsigned*)((const unsigned char*)ys + slot * DM) + ((int)(threadIdx.x & 63)); constexpr float ysc = 1.0f / (float)(1 << FP8_YSHIFT);
#pragma unroll
            for (int j = 0; j < 8; ++j) { const unsigned w = yr[64 * j]; const f32x2 lo = __builtin_amdgcn_cvt_pk_f32_fp8((int)w, false), hi = __builtin_amdgcn_cvt_pk_f32_fp8((int)w, true);
                v[j].x += lo.x * ysc; v[j].y += lo.y * ysc; v[j].z += hi.x * ysc; v[j].w += hi.y * ysc; } }
#else
            const u32x2* yr = (const u32x2*)(ys + slot * DM) + ((int)(threadIdx.x & 63));
#pragma unroll
            for (int j = 0; j < 8; ++j) { const u32x2 w = yr[64 * j]; v[j].x += bf2f(w.x & 0xffff); v[j].y += bf2f(w.x >> 16); v[j].z += bf2f(w.y & 0xffff); v[j].w += bf2f(w.y >> 16); } }
#endif
        float s = 0.f;
#pragma unroll
        for (int j = 0; j < 8; ++j) s += (v[j].x * v[j].x + v[j].y * v[j].y) + (v[j].z * v[j].z + v[j].w * v[j].w);
        const float rstd = 1.0f / sqrtf(wave_sum(s) * (1.0f / DM) + EPS);
#pragma unroll
        for (int j = 0; j < 8; ++j) hr[64 * j] = v[j] * gv[j] * rstd;
    }
}
template <bool FOX>
__device__ __forceinline__ att::BlockRef attn_ref(const Frame& F, int L, int pass) {
    const int xcd = L & 7, k = L >> 3, x = k & 7, qb = pass ? 15 - x : x;
    att::BlockRef r;
    if constexpr (FOX) {
        const int bh = xcd * 4 + (k >> 3), b = bh >> 3, h = bh & 7;
        r.Q = (unsigned)WS_QKV + (unsigned)(((24 + h) * MTOK + b * SEQ + qb * 256) * 256); r.K = (unsigned)WS_QKV + (unsigned)(((32 + h) * MTOK + b * SEQ) * 256);
        r.V = (unsigned)WS_QKV + (unsigned)(((40 + h) * MTOK + b * SEQ) * 256); r.O = (unsigned)WS_O + (unsigned)((h * MTOK + b * SEQ + qb * 256) * 256);
        r.clog = (unsigned)WS_CLOG + (unsigned)((b * 8 + h) * SEQ * 4);
        { const float qm2 = __uint_as_float(__hip_atomic_load((unsigned*)(F.ctl + CW_QMAX + bh * 16 + qb), RLX_AGENT)), km2 = __uint_as_float(__hip_atomic_load((unsigned*)(F.ctl + CW_KMAX + bh), RLX_AGENT));
          const float bound = (MK_FUSE_NORMS ? 2.02f : 2.002f) * sqrtf(qm2 * km2) + FOX_SKIP_T;       const float* clg = (const float*)(F.ws + WS_CLOG) + (size_t)(b * 8 + h) * SEQ;
          int lane; asm volatile("v_mbcnt_lo_u32_b32 %0, -1, 0\n\tv_mbcnt_hi_u32_b32 %0, -1, %0" : "=v"(lane));
          const int ntb = qb * 4;
          bool skip = false; if (lane < ntb) skip = (bound + clg[qb * 256] - clg[64 * lane + 63]) <= 0.f;
          r.jlo = (int)__popcll(__ballot(skip)) & ~1; }
    } else {
        const int vhb = xcd * 8 + (k >> 3), b = vhb >> 4, vv = vhb & 15, h = vv >> 2, mp = (vv >> 1) & 1, vhalf = vv & 1;
        r.Q = (unsigned)WS_QKV + (unsigned)(((h * 2 + mp) * MTOK + b * SEQ + qb * 256) * 256); r.K = (unsigned)WS_QKV + (unsigned)(((8 + h * 2 + mp) * MTOK + b * SEQ) * 256);
        r.V = (unsigned)WS_QKV + (unsigned)(((16 + h * 2 + vhalf) * MTOK + b * SEQ) * 256); r.O = (unsigned)WS_O + (unsigned)(((8 + vv) * MTOK + b * SEQ + qb * 256) * 256);
        r.clog = 0u; r.jlo = 0;
    }
    r.P0 = qb * 256;
    return r;
}
template <bool FOX>
__device__ __forceinline__ void attn_run(const Frame& F, char* lds) {
    constexpr int total = FOX ? 256 : 512;
    int L = blockIdx.x; if (L >= total) return;
    int pass = 0; const int stride = F.G;
    att::BlockRef cur = attn_ref<FOX>(F, L, 0);
    att::Seam S;
    att::attn_prime(F.ws, cur, lds, S);
    for (;;) {
        const bool more_pass = pass == 0, more_item = L + stride < total, last = !more_pass && !more_item;
        int passn = pass + 1, Ln = L;
        if (!more_pass) { passn = 0; Ln = more_item ? L + stride : L; }
        const int Lr = last ? L : Ln, pr = last ? pass : passn;
        auto nref = [&F, Lr, pr]() { return attn_ref<FOX>(F, Lr, pr); };
        att::attn_block<FOX>(F.ws, cur, nref, lds, S);
        if (last) break;
        pass = passn; L = Ln; cur = attn_ref<FOX>(F, L, pass);
    }
}

__device__ __forceinline__ att::BlockRefW attn_refW(int L, int pass) {
    const int xcd = L & 7, k = L >> 3, x = k & 7, qb = pass ? 15 - x : x;
    const int bhm = xcd * 4 + (k >> 3), b = bhm >> 3, hm = bhm & 7, h = hm >> 1, mp = hm & 1;
    att::BlockRefW r;
    r.Q = (unsigned)WS_QKV + (unsigned)(((h * 2 + mp) * MTOK + b * SEQ + qb * 256) * 256); r.K = (unsigned)WS_QKV + (unsigned)(((8 + h * 2 + mp) * MTOK + b * SEQ) * 256);
    r.V0 = (unsigned)WS_QKV + (unsigned)(((16 + h * 2) * MTOK + b * SEQ) * 256); r.V1 = (unsigned)WS_QKV + (unsigned)(((17 + h * 2) * MTOK + b * SEQ) * 256);
    r.O0 = (unsigned)WS_O + (unsigned)(((8 + h * 4 + mp * 2) * MTOK + b * SEQ + qb * 256) * 256); r.O1 = (unsigned)WS_O + (unsigned)(((9 + h * 4 + mp * 2) * MTOK + b * SEQ + qb * 256) * 256);
    r.P0 = qb * 256;
    return r;
}
__device__ __forceinline__ void attn_runW(const Frame& F, char* lds) {
    constexpr int total = 256;
    int L = blockIdx.x; if (L >= total) return;
    int pass = 0; const int stride = F.G;
    att::BlockRefW cur = attn_refW(L, 0);
    att::SeamW S;
    att::attn_primeW(F.ws, cur, lds, S);
    for (;;) {
        const bool more_pass = pass == 0, more_item = L + stride < total, last = !more_pass && !more_item;
        int passn = pass + 1, Ln = L;
        if (!more_pass) { passn = 0; Ln = more_item ? L + stride : L; }
        const int Lr = last ? L : Ln, pr = last ? pass : passn;
        auto nref = [Lr, pr]() { return attn_refW(Lr, pr); };
        att::attn_blockW(F.ws, cur, nref, lds, S);
        if (last) break;
        pass = passn; L = Ln; cur = attn_refW(L, pass);
    }
}

constexpr int NPHASE = 10;
#ifndef MK_NST_QKV
#define MK_NST_QKV 16
#endif
#ifndef MK_BAL
#define MK_BAL 1
#endif
constexpr int MOE_RB = MK_FP8 ? DM : DM * 2;
#ifndef MK_ATT_MASK
#define MK_ATT_MASK 3
#endif
#ifndef MK_DIFFW
#define MK_DIFFW 1
#endif
#ifndef MK_KREP_LOG
#define MK_KREP_LOG 0
#endif
#ifndef MK_KROT
#define MK_KROT 0
#endif
#define MOE_ROT(c, nt) (MK_KROT ? (int)((((((c) >> 3) >> 2) * ((nt) / 8)) + ((((c) >> 3) & 3) * ((nt) / 4))) & ((nt) - 1)) : 0)
#ifndef MK_OVERLAP
#define MK_OVERLAP 1
#endif
#ifndef MK_P1_S1
#define MK_P1_S1 0.50
#define MK_P1_S2 1.0
#define MK_P3_S0 0.33
#define MK_P3_S1 0.66
#define MK_P3_S2 1.0
#endif
constexpr int CW_DYN = 48;
__device__ __forceinline__ void ph1(Frame& F, KArgs ka) {
#if MK_FP8 && MK_OVERLAP
    const int bx = (int)blockIdx.x, grp = (bx >> 3) & 1;
    const int rw = (((bx & 7) * 16 + (bx >> 4)) * NWAVES) + F.wave, nw = (F.G / 2) * NWAVES;
    constexpr int X1 = (int)(P0B_IGU * MK_P1_S1), X2 = (int)(P0B_IGU * MK_P1_S2);
    if (grp == 1) p0b_experts(F, ka, 0, X1, rw, nw, nullptr);
#endif
    p1_scan(F);
    pg8::DenseOrder S; S.init((const bf16_t*)(F.ws + WS_XN), (const bf16_t*)(F.ws + WS_WIN), MTOK, NQKV, DM * 2, F.G, (int)blockIdx.x);
    pg8::EpiQKV E{(bf16_t*)(F.ws + WS_QKV), (const float*)(F.ws + WS_ROPE), (unsigned*)F.ctl, (LAS float*)(F.lds + RING_BYTES + 2048)};
    pg8::gemm_phase<pg8::EpiQKV, pg8::DenseOrder, false, false, 127, 127, 1, false, false, false, MK_NST_QKV>(F.lds, F.lds + LDS_IDX, DM * 2, S, E);
#if MK_FP8 && MK_OVERLAP
    if (grp == 0) p0b_experts(F, ka, X1, X2, rw, nw, nullptr);
    if constexpr (X2 < P0B_IGU) p0b_experts(F, ka, X2, P0B_IGU, 0, 1, (unsigned*)F.ctl + CW_DYN);
#endif
}
__device__ __forceinline__ void ph2(Frame& F, KArgs ka, char* lds) {
#if MK_FP8 && MK_OVERLAP
    const int bx = (int)blockIdx.x, j = bx >> 3, cshift = j % 3, ng = cshift < 2 ? 11 : 10;
    const int rw = (((bx & 7) * ng + j / 3) * NWAVES) + F.wave, nw = 8 * ng * NWAVES;
    constexpr int L = P0B_NI - P0B_IGU, Y0 = P0B_IGU + (int)(L * MK_P3_S0), Y1 = P0B_IGU + (int)(L * MK_P3_S1), Y2 = P0B_IGU + (int)(L * MK_P3_S2);
    if (cshift == 0) p0b_experts(F, ka, P0B_IGU, Y0, rw, nw, nullptr);
#endif
    if (MK_ATT_MASK & 1) attn_run<true>(F, lds);
    __syncthreads();
#if MK_FP8 && MK_OVERLAP
    if (cshift == 1) p0b_experts(F, ka, Y0, Y1, rw, nw, nullptr);
#endif
#if MK_DIFFW
    if (MK_ATT_MASK & 2) attn_runW(F, lds);
#else
    if (MK_ATT_MASK & 2) attn_run<false>(F, lds);
#endif
#if MK_FP8 && MK_OVERLAP
    if (cshift == 2) p0b_experts(F, ka, Y1, Y2, rw, nw, nullptr);
    if constexpr (Y2 < P0B_NI) p0b_experts(F, ka, Y2, P0B_NI, 0, 1, (unsigned*)F.ctl + CW_DYN + 1);
#endif
}
__device__ __forceinline__ void ph4(Frame& F, KArgs ka, float* hbuf) {
    pg8::DenseOrder S; S.init((const bf16_t*)(F.ws + WS_MIX), (const bf16_t*)(F.ws + WS_WOUT), MTOK, DM, DM * 2, F.G, (int)blockIdx.x);
    pg8::EpiOut E{(const float*)KIN(0), hbuf, (bf16_t*)(F.ws + WS_HG), (const float*)KIN(12)};
    pg8::gemm_phase<pg8::EpiOut, pg8::DenseOrder, false, false, 127, 127, 1, false, false, (MK_XINIT != 0)>(F.lds, F.lds + LDS_IDX, DM * 2, S, E);
}
__device__ __forceinline__ void ph6(Frame& F, KArgs ka, LAS int* tab) {
    build_tab(F, tab, true);
    pg8::MoeOrder S; S.A = (const void*)(F.ws + WS_HG); S.Bt = (const void*)(F.ws + WS_WGU); S.RB = MOE_RB; S.nN = 16; S.NperE = 4096; S.G = F.G; S.c = (int)blockIdx.x; S.rot = MOE_ROT(blockIdx.x, MOE_RB / 128); S.tab = tab; S.tok = (const int*)(F.ws + WS_TOK);
    pg8::EpiGU E{(bf16_t*)(F.ws + WS_HDN), (const float*)KIN(16), (const float*)KIN(18), (const float*)(F.ws + WS_RSTD), tab, (const LAS float*)(F.lds + LDS_IDX + 2048)}; S.rowsc = (const float*)(F.ws + WS_RSTD); S.bA = (const float*)KIN(16); S.bB = (const float*)KIN(18); S.bcols = 128;
    pg8::gemm_phase<pg8::EpiGU, pg8::MoeOrder, true, MK_FP8 != 0, 127 - FP8_WSHIFT - MK_KREP_LOG, 127 - FP8_HGSHIFT, (1 << MK_KREP_LOG), (MK_FP8 != 0 && MK_FP6 != 0), (MK_BAL != 0)>(F.lds, F.lds + LDS_IDX, MOE_RB, S, E);
}
__device__ __forceinline__ void ph7(Frame& F, KArgs ka, LAS int* tab) {
    build_tab(F, tab, false);
    pg8::MoeOrderDense S; S.A = (const void*)(F.ws + WS_HDN); S.Bt = (const void*)(F.ws + WS_WD); S.RB = MOE_RB; S.nN = 8; S.NperE = 2048; S.G = F.G; S.c = (int)blockIdx.x; S.rot = MOE_ROT(blockIdx.x, MOE_RB / 128); S.tab = tab; S.tok = nullptr;
    pg8::EpiDown E{(bf16_t*)(F.ws + WS_YS), (const float*)KIN(20), (const float*)(F.ws + WS_GATE), tab, (const LAS float*)(F.lds + LDS_IDX + 2048)}; S.rowsc = (const float*)(F.ws + WS_GATE); S.bA = (const float*)KIN(20); S.bB = (const float*)KIN(20) + 128; S.bcols = 256;
    pg8::gemm_phase<pg8::EpiDown, pg8::MoeOrderDense, false, MK_FP8 != 0, 127 - FP8_WSHIFT - MK_KREP_LOG, 127 - FP8_HDSHIFT, (1 << MK_KREP_LOG), (MK_FP8 != 0 && MK_FP6 != 0), (MK_BAL != 0)>(F.lds, F.lds + LDS_IDX, MOE_RB, S, E);
}
__device__ __forceinline__ Frame make_frame(KArgs ka, LAS unsigned char* lds) {
    Frame F; F.lds = lds; F.wave = __builtin_amdgcn_readfirstlane(((int)threadIdx.x) >> 6);
    F.G = gridDim.x; { const int bx = blockIdx.x; F.vcu = (F.G % 8 == 0) ? (bx % 8) * (F.G / 8) + bx / 8 : bx; }
    unsigned char* ws = ka->ws; F.ws = ws; F.ctl = (gu32*)(ws + WS_CTL);
    return F;
}
__global__ void __launch_bounds__(NTHREADS, 2) mk_fwd(Args args) {
    extern __shared__ __attribute__((aligned(16))) unsigned char lds[];
    const KArgs ka = (KArgs)__builtin_amdgcn_kernarg_segment_ptr();
    { volatile LAS unsigned* MISC = (volatile LAS unsigned*)((LAS unsigned char*)lds + LDS_MISC);
      if (((int)threadIdx.x) < 32) MISC[((int)threadIdx.x)] = 0u;
      __syncthreads();
      if (ka->ph_hi - ka->ph_lo > 1) (void)xcd_barrier_post((unsigned*)((gu32*)(ka->ws + WS_CTL) + CW_BAR), MISC + 8); }
#ifndef MK_PHASE_MASK
#define MK_PHASE_MASK 0x3FF
#endif
#ifndef MK_REP_PHASE
#define MK_REP_PHASE -1
#endif
#define IN(k) ((((MK_PHASE_MASK) >> (k)) & 1) && ka->ph_lo <= (k) && (k) < ka->ph_hi)
#define GRIDBAR() do { XcdBarrier b_; b_.bar = (unsigned*)((gu32*)(ka->ws + WS_CTL) + CW_BAR); b_.x = xb_xcc_id(); b_.st = (volatile LAS unsigned*)((LAS unsigned char*)lds + LDS_MISC) + 8; xcd_barrier(b_); } while (0)
#ifdef MK_STAMP
#define SEAM(k) do { if (IN(k) && IN((k) + 1)) { unsigned long long ta_ = 0; if (threadIdx.x == 0) ta_ = wall_clock64(); GRIDBAR(); \
        if (threadIdx.x == 0) { const unsigned d_ = (unsigned)(wall_clock64() - ta_); atomicMax((unsigned*)((gu32*)(ka->ws + WS_CTL)) + 192 + (k), 0xffffffffu - d_); } } } while (0)
#else
#define SEAM(k) do { if (IN(k) && IN((k) + 1)) GRIDBAR(); } while (0)
#endif
#ifdef MK_STAMP
#ifndef MK_STAMP_GRP
#define MK_STAMP_GRP 0
#endif
#if MK_STAMP_GRP == 1
#define ST_GRP(k) ((int)(blockIdx.x & 7))
#elif MK_STAMP_GRP == 2
#define ST_GRP(k) ((int)(blockIdx.x < 32))
#else
#define ST_GRP(k) ((k) == 1 ? (int)((blockIdx.x >> 3) & 1) : (k) == 3 ? (int)((blockIdx.x >> 3) % 3) : 0)
#endif
#define RUN(k, CALL) do { if (IN(k)) { if (threadIdx.x == 0) { const unsigned long long t_ = wall_clock64(); volatile LAS unsigned* M_ = (volatile LAS unsigned*)((LAS unsigned char*)lds + LDS_MISC); M_[24] = (unsigned)t_; M_[25] = (unsigned)(t_ >> 32); } \
        { Frame F = make_frame(ka, (LAS unsigned char*)lds); LAS int* tab = (LAS int*)(F.lds + LDS_TAB); float* hbuf = ka->out; (void)tab; (void)hbuf; CALL; } \
        __syncthreads(); \
        if (threadIdx.x == 0) { volatile LAS unsigned* M_ = (volatile LAS unsigned*)((LAS unsigned char*)lds + LDS_MISC); const unsigned long long t0_ = (unsigned long long)M_[24] | ((unsigned long long)M_[25] << 32); \
            const unsigned d_ = (unsigned)(wall_clock64() - t0_); unsigned* c_ = (unsigned*)((gu32*)(ka->ws + WS_CTL)); atomicMax(c_ + 64 + (k), d_); atomicAdd(c_ + 80 + (k), d_); atomicAdd(c_ + 96 + 8 * (k) + ST_GRP(k), d_); } } } while (0)
#else
#define RUN(k, CALL) do { if (IN(k)) { Frame F = make_frame(ka, (LAS unsigned char*)lds); LAS int* tab = (LAS int*)(F.lds + LDS_TAB); float* hbuf = ka->out; (void)tab; (void)hbuf; CALL; \
        if (MK_REP_PHASE == (k)) { GRIDBAR(); CALL; } } } while (0)
#endif
#if MK_FP8 && !MK_OVERLAP
    RUN(0, (p0_prologue(F, ka), p0b_experts(F, ka, 0, P0B_NI, F.vcu * NWAVES + F.wave, F.G * NWAVES, nullptr)));
#else
    RUN(0, p0_prologue(F, ka));
#endif
#ifdef MK_PROBE_STREAM
    if (IN(0)) { GRIDBAR(); Frame F = make_frame(ka, (LAS unsigned char*)lds); probe_stream(F, ka); }
#endif
    SEAM(0);
    RUN(1, ph1(F, ka)); SEAM(1);
#if MK_FUSE_NORMS
#else
    RUN(2, p_norms(F)); SEAM(2);
#endif
    RUN(3, ph2(F, ka, (char*)lds)); SEAM(3);
    RUN(4, p3_mix(F, ka)); SEAM(4);
    RUN(5, ph4(F, ka, hbuf)); SEAM(5);
    RUN(6, p5_router(F, ka, hbuf)); SEAM(6);
    RUN(7, ph6(F, ka, tab)); SEAM(7);
    RUN(8, ph7(F, ka, tab)); SEAM(8);
    RUN(9, p8_final(F, ka, hbuf));
#ifdef MK_STAMP
    GRIDBAR();
    if (blockIdx.x == 0 && threadIdx.x == 0) { unsigned* c_ = (unsigned*)((gu32*)(ka->ws + WS_CTL)); constexpr int K_ = (MK_STAMP_SEL) / 100, J_ = (MK_STAMP_SEL) % 100;
        const float mx = 0.01f * (float)__hip_atomic_load(c_ + 64 + K_, __ATOMIC_RELAXED, __HIP_MEMORY_SCOPE_AGENT), mean = 0.01f * (float)__hip_atomic_load(c_ + 80 + K_, __ATOMIC_RELAXED, __HIP_MEMORY_SCOPE_AGENT) / (float)gridDim.x;
        float v;
        if (J_ == 0) v = mx; else if (J_ == 1) v = mx - mean; else if (J_ == 2) v = mean;
        else if (J_ == 70) v = 0.01f * (float)(0xffffffffu - __hip_atomic_load(c_ + 192 + K_, __ATOMIC_RELAXED, __HIP_MEMORY_SCOPE_AGENT));
        else if (J_ == 60 || J_ == 61) { float hi = 0.f, lo = 1e9f; for (int g = 0; g < 8; ++g) { const float m = 0.01f * (float)__hip_atomic_load(c_ + 96 + 8 * K_ + g, __ATOMIC_RELAXED, __HIP_MEMORY_SCOPE_AGENT) / 32.f; hi = m > hi ? m : hi; lo = m < lo ? m : lo; }
            v = J_ == 60 ? hi - mean : mean - lo; }
        else if (J_ == 62 || J_ == 63) { const float ms = 0.01f * (float)__hip_atomic_load(c_ + 96 + 8 * K_ + 1, __ATOMIC_RELAXED, __HIP_MEMORY_SCOPE_AGENT) / 32.f, mr = 0.01f * (float)__hip_atomic_load(c_ + 96 + 8 * K_ + 0, __ATOMIC_RELAXED, __HIP_MEMORY_SCOPE_AGENT) / 224.f;
            v = J_ == 62 ? ms - mr : mr - ms; v = v > 0.f ? v : 0.f; }
        else { constexpr int A_ = (J_ - 3) / 10, B_ = (J_ - 3) % 10; const float na = (K_ == 1) ? 128.f : (K_ == 3 ? (A_ == 2 ? 80.f : 88.f) : 256.f), nb = (K_ == 1) ? 128.f : (K_ == 3 ? (B_ == 2 ? 80.f : 88.f) : 256.f);
            const float ga = 0.01f * (float)__hip_atomic_load(c_ + 96 + 8 * K_ + A_, __ATOMIC_RELAXED, __HIP_MEMORY_SCOPE_AGENT) / na, gb = 0.01f * (float)__hip_atomic_load(c_ + 96 + 8 * K_ + B_, __ATOMIC_RELAXED, __HIP_MEMORY_SCOPE_AGENT) / nb;
            v = ga - gb; v = v > 0.f ? v : 0.f; }
#ifndef MK_STAMP_Q
#define MK_STAMP_Q 8.0f
#endif
        if (J_ == 0 || J_ == 2) v = MK_STAMP_Q * floorf(v / MK_STAMP_Q + 0.5f);
        ka->out[0] = v + 10.0f; }
#endif
#undef IN
#undef SEAM
#undef RUN
#undef GRIDBAR
}

#ifndef MK_N_LAUNCHES
#define MK_N_LAUNCHES 1
#endif
extern "C" void kernel_launch(void* const* d_in, const int* in_sizes, int n_in, void* d_out, int out_size, void* d_ws, size_t ws_size, hipStream_t stream) {
    static int grid = 0;
    if (grid == 0) {
        if (n_in != 22 || in_sizes[0] != MTOK * DM || out_size != MTOK * DM || ws_size < WS_END) {
            fprintf(stderr, "kernel_launch: unexpected shapes (n_in %d, in0 %d, out %d, ws %zu; need ws >= %zu); nothing launched\n", n_in, n_in > 0 ? in_sizes[0] : -1, out_size, ws_size, (size_t)WS_END); grid = -1; return; }
        int dev = 0, cus = 0, per_cu = 0;
        if (hipGetDevice(&dev) != hipSuccess || hipDeviceGetAttribute(&cus, hipDeviceAttributeMultiprocessorCount, dev) != hipSuccess) { fprintf(stderr, "kernel_launch: device query failed\n"); grid = -1; return; }
        if (hipFuncSetAttribute((const void*)mk_fwd, hipFuncAttributeMaxDynamicSharedMemorySize, LDS_BYTES) != hipSuccess) { fprintf(stderr, "kernel_launch: hipFuncSetAttribute failed\n"); grid = -1; return; }
        if (hipOccupancyMaxActiveBlocksPerMultiprocessor(&per_cu, (const void*)mk_fwd, NTHREADS, LDS_BYTES) != hipSuccess || per_cu < 1)
            fprintf(stderr, "kernel_launch: note: occupancy query reports %d workgroups per CU\n", per_cu);
        (void)hipGetLastError();
        grid = 1; while (grid * 2 <= cus && grid < 256) grid *= 2;
    }
    if (grid < 0) return;
    if (hipMemsetAsync((char*)d_ws + WS_CTL, 0, CTL_ZERO_BYTES, stream) != hipSuccess) { fprintf(stderr, "kernel_launch: memset failed\n"); return; }
    Args a{};
    for (int i = 0; i < 22; ++i) a.in[i] = d_in[i];
    a.out = (float*)d_out; a.ws = (unsigned char*)d_ws;
    if (MK_N_LAUNCHES == 1) { a.ph_lo = 0; a.ph_hi = NPHASE; hipLaunchKernelGGL(mk_fwd, dim3(grid), dim3(NTHREADS), LDS_BYTES, stream, a); }
    else for (int p = 0; p < NPHASE; ++p) { a.ph_lo = p; a.ph_hi = p + 1; hipLaunchKernelGGL(mk_fwd, dim3(grid), dim3(NTHREADS), LDS_BYTES, stream, a); }
#ifdef MK_EXTRA_PHASE
    a.ph_lo = MK_EXTRA_PHASE; a.ph_hi = MK_EXTRA_PHASE + 1; hipLaunchKernelGGL(mk_fwd, dim3(grid), dim3(NTHREADS), LDS_BYTES, stream, a);
#endif
    const hipError_t le = hipPeekAtLastError();
    if (le != hipSuccess) fprintf(stderr, "kernel_launch: launch failed: %s\n", hipGetErrorName(le));
}
```

```cpp
#include <hip/hip_runtime.h>
#include <cstdio>
#include <cstdint>

#define LAS __attribute__((address_space(3)))
#define GAS __attribute__((address_space(1)))
typedef unsigned short bf16_t;
typedef short bf16x8 __attribute__((ext_vector_type(8)));
typedef short s16x4 __attribute__((ext_vector_type(4)));
typedef float f32x4 __attribute__((ext_vector_type(4)));
typedef float f32x2 __attribute__((ext_vector_type(2)));
typedef float f32x16 __attribute__((ext_vector_type(16)));
typedef unsigned u32x4 __attribute__((ext_vector_type(4)));
typedef unsigned u32x2 __attribute__((ext_vector_type(2)));
typedef int v4i_t __attribute__((ext_vector_type(4)));
typedef int v8i_t __attribute__((ext_vector_type(8)));

constexpr int DM = 2048, BATCH = 4, SEQ = 4096, MTOK = BATCH * SEQ, INC = 6152, NQKV = 6144, NE = 32, TOPK = 4, ECAP = 16384;
constexpr float EPS = 1e-5f, L2E = 1.4426950408889634f, QSCALE = 0.08838834764831845f * 1.4426950408889634f;
constexpr int NWAVES = 8, NTHREADS = 512;
constexpr size_t MiB = 1u << 20;
constexpr size_t WS_CTL = 0, CTL_ZERO_BYTES = 1 * MiB;
constexpr size_t WS_GWF = 2 * MiB;
constexpr size_t WS_CLOG = 3 * MiB;
constexpr size_t WS_FLOG = 4 * MiB;
constexpr size_t WS_TKE = 5 * MiB;
constexpr size_t WS_TOK = 6 * MiB;
constexpr size_t WS_RSTD = 8 * MiB;
constexpr size_t WS_GATE = 10 * MiB;
constexpr size_t WS_ROPE = 12 * MiB;
constexpr size_t WS_WIN = 20 * MiB;
constexpr size_t WS_WOUT = 44 * MiB;
constexpr size_t WS_TSTART = 52 * MiB;
constexpr size_t WS_WGU = 64 * MiB;
constexpr size_t WS_WD = 576 * MiB;
constexpr size_t WS_XN = 832 * MiB;
constexpr size_t WS_QKV = 896 * MiB;
constexpr size_t WS_O = 1088 * MiB;
constexpr size_t WS_MIX = 1184 * MiB;
constexpr size_t WS_HG = 1248 * MiB;
constexpr size_t WS_HDN = 1312 * MiB;
constexpr size_t WS_YS = 1600 * MiB;
constexpr size_t WS_END = 1888 * MiB;
constexpr int CW_TMO = 0, CW_BAR = 4096, CW_CNT = 8192;
constexpr int CW_QMAX = 12288, CW_KMAX = 12800;
constexpr float FOX_SKIP_T = 30.0f;
constexpr int RING_BYTES = 131072;
constexpr int LDS_IDX = RING_BYTES;
constexpr int LDS_TAB = RING_BYTES + 1024;
constexpr int LDS_MISC = RING_BYTES + 1024 + 512;
constexpr int LDS_BYTES = 147456;

__device__ __forceinline__ unsigned f2bf(float f) { unsigned u = __builtin_bit_cast(unsigned, f); return (u + 0x7fffu + ((u >> 16) & 1u)) >> 16; }
__device__ __forceinline__ unsigned pk2(float lo, float hi) { return f2bf(lo) | (f2bf(hi) << 16); }
__device__ __forceinline__ float bf2f(unsigned short b) { return __builtin_bit_cast(float, (unsigned)b << 16); }
__device__ __forceinline__ unsigned cvt_pk_bf16(float lo, float hi) { unsigned r; asm volatile("v_cvt_pk_bf16_f32 %0, %1, %2" : "=v"(r) : "v"(lo), "v"(hi)); return r; }
__device__ __forceinline__ float wave_sum(float v) {
#pragma unroll
    for (int o = 1; o < 64; o <<= 1) v += __shfl_xor(v, o);
    return v;
}

__device__ __forceinline__ void glds16s(const char* sbase, unsigned voff, unsigned lds_dst) { unsigned keep;
    asm volatile("s_mov_b32 %0, m0\n\ts_mov_b32 m0, %3\n\ts_nop 0\n\tglobal_load_lds_dwordx4 %1, %2\n\ts_mov_b32 m0, %0" : "=&s"(keep) : "v"(voff), "s"(sbase), "s"(lds_dst) : "memory"); }
__device__ __forceinline__ void glds4s(const char* sbase, unsigned voff, unsigned lds_dst) { unsigned keep;
    asm volatile("s_mov_b32 %0, m0\n\ts_mov_b32 m0, %3\n\ts_nop 0\n\tglobal_load_lds_dword %1, %2\n\ts_mov_b32 m0, %0" : "=&s"(keep) : "v"(voff), "s"(sbase), "s"(lds_dst) : "memory"); }
__device__ __forceinline__ const char* uni_ptr(const char* p) { const unsigned long long v = (unsigned long long)p;
    const unsigned lo = (unsigned)__builtin_amdgcn_readfirstlane((int)(unsigned)v), hi = (unsigned)__builtin_amdgcn_readfirstlane((int)(unsigned)(v >> 32)); return (const char*)(((unsigned long long)hi << 32) | lo); }

#ifndef MK_EPI_LDS
#define MK_EPI_LDS 1
#endif
namespace pg8 {
constexpr int BM = 256, BK = 64, HALF = 128, HTB = HALF * BK * 2, STAGE_BYTES = 8 * HTB, NXCD = 8, WGM = 8;
__host__ __device__ __forceinline__ int lds_byte(int r, int c) { const int st = (r >> 4) * 2 + (c >> 5), rr = r & 15, cc = c & 31, ob = rr * 64 + cc * 2; return st * 1024 + (ob ^ (((ob >> 9) & 1) << 5)); }
__host__ __device__ __forceinline__ void stage_rc(int b, int& R, int& C) { const int st = b / 1024, sb = b % 1024, swz = sb ^ (((sb >> 9) & 1) << 5); R = (st >> 1) * 16 + swz / 64; C = (st & 1) * 32 + (swz % 64) / 2; }
__host__ __device__ __forceinline__ int perm32(int rho) { const int n = rho >> 4, i = rho & 15; return 8 * (i >> 2) + 4 * n + (i & 3); }

struct Unit { int pm, pn, e, rows0; };

struct DenseOrder {
    const bf16_t* A; const bf16_t* Bt; int RB; int nM, nN, nwg, G, c; int rot = 0;
    __device__ void init(const bf16_t* A_, const bf16_t* Bt_, int M, int N, int RB_, int G_, int c_) { A = A_; Bt = Bt_; RB = RB_; nM = M / BM; nN = N / BM; nwg = nM * nN; G = G_; c = c_; }
    __device__ __forceinline__ bool next(int i, Unit& u) const {
        const long L = (long)i * G + c; if (L >= nwg) return false;
        int wgid = (int)L; { const int q = nwg / NXCD, r = nwg % NXCD, xcd = wgid % NXCD, off = wgid / NXCD; wgid = (xcd < r ? xcd * (q + 1) : r * (q + 1) + (xcd - r) * q) + off; }
        const int nig = WGM * nN, gid = wgid / nig, fm = gid * WGM, gsz = (nM - fm) < WGM ? (nM - fm) : WGM;
        u.pm = fm + ((wgid % nig) % gsz); u.pn = (wgid % nig) / gsz; u.e = 0; u.rows0 = 0; return true;
    }
    __device__ __forceinline__ const char* a_base(const Unit& u) const { return (const char*)A + (size_t)u.pm * BM * RB; }
    __device__ __forceinline__ const char* b_base(const Unit& u) const { return (const char*)Bt + (size_t)u.pn * BM * RB; }
};
struct MoeOrder {
    const float* bA = nullptr; const float* bB = nullptr; int bcols = 0;
    const float* rowsc = nullptr;
    const void* A; const void* Bt; int RB; int nN; int NperE; int G, c; int rot; const LAS int* tab; const int* tok;
    __device__ __forceinline__ bool next(int i, Unit& u) const {
        const int T = __builtin_amdgcn_readfirstlane(tab[NE]);
        int t;
        if (G == 256) {
            const int x = c & 7, j = c >> 3, XP = nN >> 3, tpr = 256 / nN;
            t = i * tpr + (x / XP) * 4 + (j & 3); u.pn = (x % XP) * 8 + (j >> 2);
            if (t >= T) return false;
        } else {
            const int L = i * G + c; if (L >= T * nN) return false;
            t = L / nN; u.pn = L - t * nN;
        }
        u.pm = t;
        int e; { const int ln = (int)(threadIdx.x & 63); const int tv = tab[ln & 31];
                 e = (int)__popcll(__ballot(ln < NE && tv <= t)) - 1; }
        u.e = e; u.rows0 = __builtin_amdgcn_readfirstlane((t - tab[e]) * BM); return true;
    }
    __device__ __forceinline__ int cnt_of(const Unit& u) const { return __builtin_amdgcn_readfirstlane(tab[NE + 1 + u.e]); }
    __device__ __forceinline__ const char* a_base(const Unit& u) const { return (const char*)A; }
    __device__ __forceinline__ const char* a_base_dense(const Unit& u) const { return (const char*)A + (size_t)u.pm * BM * RB; }
    __device__ __forceinline__ const char* b_base(const Unit& u) const { return (const char*)Bt + ((size_t)u.e * NperE + (size_t)u.pn * BM) * RB; }
};
struct MoeOrderDense : MoeOrder {
    __device__ __forceinline__ const char* a_base(const Unit& u) const { return a_base_dense(u); }
};

template <class Epi, class Sched, bool GATHER, bool FP8 = false, int SCW = 127, int SCA = 127, int KREP = 1, bool FP6 = false, bool BAL = false, bool XINIT = false>
__device__ __forceinline__ void gemm_phase(LAS unsigned char* lds, LAS unsigned char* lds_idx, const int RB, const Sched& S, const Epi& E) {
    const int tid = threadIdx.x, wid = __builtin_amdgcn_readfirstlane(tid >> 6), lane = tid & 63, wr = wid >> 2, wc = wid & 3, fr = lane & 15, fq = lane >> 4;
    const int nt = (RB / 128) * KREP;
    unsigned voffA[2], voffB[2]; int RA[2], CA2[2];
#pragma unroll
    for (int i = 0; i < 2; ++i) { int R, C; stage_rc(tid * 16 + i * 8192, R, C); const int Rb = (R & ~31) + perm32(R & 31);
        voffA[i] = (unsigned)(R * RB + C * 2); voffB[i] = (unsigned)(Rb * RB + C * 2); RA[i] = R; CA2[i] = C * 2; }
    const int rot = S.rot, ntm = RB / 128 - 1;
#define PG8_KOFF(t) ((size_t)((((t) + rot) & ntm) * 128))
    const size_t hstep = (size_t)HALF * RB;
    const unsigned ldsw = (unsigned)wid * 1024u;
    const unsigned ldsb = (unsigned)__builtin_amdgcn_readfirstlane((int)(unsigned)(uintptr_t)lds);
    const int aoff = lds_byte(wr * 64 + fr, fq * 8), boff = lds_byte(wc * 32 + fr, fq * 8);
#define PG8_SA(b, h) (((b) * 2 + (h)) * HTB)
#define PG8_SB(b, h) ((4 + (b) * 2 + (h)) * HTB)
#define PG8_GL(bufoff, gptr, v0, v1) do { const char* gp_ = uni_ptr((const char*)(gptr)); \
        glds16s(gp_, (v0), ldsb + (unsigned)(bufoff) + ldsw); glds16s(gp_, (v1), ldsb + (unsigned)(bufoff) + ldsw + 8192u); } while (0)
#define PG8_STAGE_B(bufoff, gbase) PG8_GL(bufoff, gbase, voffB[0], voffB[1])
#define PG8_STAGE_A(bufoff, gbase, h, V) do { if constexpr (GATHER) { PG8_GL(bufoff, gbase, V[h][0], V[h][1]); } else { PG8_GL(bufoff, (gbase) + (h) * hstep, voffA[0], voffA[1]); } } while (0)
#define PG8_LDA(dst, b, h) do { _Pragma("unroll") for (int m = 0; m < 4; ++m) _Pragma("unroll") for (int k = 0; k < 2; ++k) dst[m][k] = *(const LAS bf16x8*)(lds + PG8_SA(b, h) + aoff + m * 2048 + k * 1024); } while (0)
#define PG8_LDB(dst, b, h) do { _Pragma("unroll") for (int n = 0; n < 2; ++n) _Pragma("unroll") for (int k = 0; k < 2; ++k) dst[n][k] = *(const LAS bf16x8*)(lds + PG8_SB(b, h) + boff + n * 2048 + k * 1024); } while (0)
#define PG8_CAT(x, y) __builtin_shufflevector(__builtin_bit_cast(v4i_t, x), __builtin_bit_cast(v4i_t, y), 0, 1, 2, 3, 4, 5, 6, 7)
#define PG8_MMA(ai, bj, At, Bt) do { __builtin_amdgcn_s_setprio(1); _Pragma("unroll") for (int m = 0; m < 4; ++m) _Pragma("unroll") for (int n = 0; n < 2; ++n) { \
        if constexpr (FP6) { acc[ai][bj][m][n] = __builtin_amdgcn_mfma_scale_f32_16x16x128_f8f6f4(PG8_CAT(Bt[n][0], Bt[n][1]), PG8_CAT(At[m][0], At[m][1]), acc[ai][bj][m][n], 2, 2, 0, __builtin_bit_cast(v4i_t, Bt[n][1])[2], 0, __builtin_bit_cast(v4i_t, At[m][1])[2]); } \
        else if constexpr (FP8) { acc[ai][bj][m][n] = __builtin_amdgcn_mfma_scale_f32_16x16x128_f8f6f4(PG8_CAT(Bt[n][0], Bt[n][1]), PG8_CAT(At[m][0], At[m][1]), acc[ai][bj][m][n], 0, 0, 0, (SCW | (SCA << 8)), 1, (SCW | (SCA << 8))); }     \
        else { _Pragma("unroll") for (int k = 0; k < 2; ++k) acc[ai][bj][m][n] = __builtin_amdgcn_mfma_f32_16x16x32_bf16(Bt[n][k], At[m][k], acc[ai][bj][m][n], 0, 0, 0); } } \
        __builtin_amdgcn_s_setprio(0); } while (0)
#define PG8_WAIT_V(n) asm volatile("s_waitcnt vmcnt(" #n ")" ::: "memory")
#define PG8_WAIT_L(n) asm volatile("s_waitcnt lgkmcnt(" #n ")" ::: "memory")
#define PG8_BAR __builtin_amdgcn_s_barrier()
#define PG8_SCHED __builtin_amdgcn_sched_barrier(0)
    Unit cur, nxt; int ui = 0;
    if (!S.next(0, cur)) return;
    f32x4 acc[2][2][4][2];
    if constexpr (XINIT) E.load_init(acc, cur, wr, wc, fr, fq);
    else {
#pragma unroll
    for (int a = 0; a < 2; ++a)
#pragma unroll
        for (int b = 0; b < 2; ++b)
#pragma unroll
            for (int m = 0; m < 4; ++m)
#pragma unroll
                for (int n = 0; n < 2; ++n) acc[a][b][m][n] = (f32x4){0.f, 0.f, 0.f, 0.f};
    }
    bf16x8 At[4][2], B0[2][2], B1[2][2];
    unsigned VC[2][2];
    if constexpr (GATHER) {
        const int cnt = S.cnt_of(cur);
#pragma unroll
        for (int h = 0; h < 2; ++h)
#pragma unroll
            for (int i = 0; i < 2; ++i) { const int pos = cur.rows0 + h * HALF + RA[i]; int tk = S.tok[(size_t)cur.e * ECAP + pos]; tk = pos < cnt ? tk : 0; VC[h][i] = (unsigned)tk * (unsigned)RB + (unsigned)CA2[i]; }
    } else {
#pragma unroll
        for (int h = 0; h < 2; ++h)
#pragma unroll
            for (int i = 0; i < 2; ++i) VC[h][i] = 0u;
    }
    const char* cA = S.a_base(cur); const char* cB = S.b_base(cur);
    PG8_STAGE_B(PG8_SB(0, 0), cB + PG8_KOFF(0)); PG8_STAGE_B(PG8_SB(0, 1), cB + hstep + PG8_KOFF(0)); PG8_STAGE_A(PG8_SA(0, 0), cA + PG8_KOFF(0), 0, VC); PG8_STAGE_A(PG8_SA(0, 1), cA + PG8_KOFF(0), 1, VC);
    if (wr == 1) PG8_BAR;
    PG8_WAIT_V(2); PG8_BAR;
    if constexpr (BAL) { PG8_STAGE_B(PG8_SB(1, 0), cB + PG8_KOFF(1)); PG8_STAGE_B(PG8_SB(1, 1), cB + hstep + PG8_KOFF(1)); PG8_WAIT_V(4); PG8_BAR; }
    else { PG8_STAGE_B(PG8_SB(1, 0), cB + PG8_KOFF(1)); PG8_STAGE_A(PG8_SA(1, 0), cA + PG8_KOFF(1), 0, VC); PG8_STAGE_B(PG8_SB(1, 1), cB + hstep + PG8_KOFF(1));
    PG8_WAIT_V(6); PG8_BAR; }
    for (;;) {
        const bool has_next = S.next(ui + 1, nxt);
        const char* nA = has_next ? S.a_base(nxt) : cA; const char* nB = has_next ? S.b_base(nxt) : cB;
        for (int t = 0; t < nt; t += 2) {
            const bool last = (t == nt - 2);
            if constexpr (FP8 && MK_EPI_LDS) {
                if (t == nt - 6 && wid < 4)
                    glds4s(uni_ptr((const char*)((wid < 2 ? S.bA : S.bB) + (size_t)cur.e * DM + cur.pn * S.bcols + (wid & 1) * 64)), (unsigned)lane * 4u, (unsigned)__builtin_amdgcn_readfirstlane((int)(unsigned)(uintptr_t)lds_idx) + 3072u + (unsigned)wid * 256u);
                if (t == nt - 4 && wid >= 4)
                    glds4s(uni_ptr((const char*)(S.rowsc + (size_t)cur.e * ECAP + cur.rows0 + (wid - 4) * 64)), (unsigned)lane * 4u, (unsigned)__builtin_amdgcn_readfirstlane((int)(unsigned)(uintptr_t)lds_idx) + 2048u + (unsigned)(wid - 4) * 256u);
            }
            if constexpr (GATHER) {
                if (has_next && t == nt - 4 && wid < 4)
                    glds4s(uni_ptr((const char*)(S.tok + (size_t)nxt.e * ECAP + nxt.rows0 + wid * 64)), (unsigned)lane * 4u, (unsigned)__builtin_amdgcn_readfirstlane((int)(unsigned)(uintptr_t)lds_idx) + (unsigned)wid * 256u);
            }
            const char* a1 = cA + PG8_KOFF(t + 1);
            const char* a2 = (last ? nA : cA) + PG8_KOFF(t + 2); const char* b2 = (last ? nB : cB) + PG8_KOFF(t + 2);
            const char* a3 = (last ? nA : cA) + PG8_KOFF(t + 3); const char* b3 = (last ? nB : cB) + PG8_KOFF(t + 3);
            PG8_LDB(B0, 0, 0); PG8_LDB(B1, 0, 1); PG8_SCHED; PG8_LDA(At, 0, 0); if constexpr (BAL) PG8_STAGE_A(PG8_SA(1, 0), a1, 0, VC); PG8_STAGE_A(PG8_SA(1, 1), a1, 1, VC);
            if constexpr (GATHER) {
                if (last && has_next) { const int cntn = S.cnt_of(nxt);
#pragma unroll
                    for (int h = 0; h < 2; ++h)
#pragma unroll
                        for (int i = 0; i < 2; ++i) { const int r = h * HALF + RA[i]; int tk = *(const LAS int*)(lds_idx + r * 4); tk = (nxt.rows0 + r) < cntn ? tk : 0; VC[h][i] = (unsigned)tk * (unsigned)RB + (unsigned)CA2[i]; } }
            }
            PG8_WAIT_V(8); PG8_WAIT_L(0); PG8_BAR; PG8_MMA(0, 0, At, B0); PG8_MMA(0, 1, At, B1); PG8_BAR; PG8_SCHED;
            PG8_LDA(At, 0, 1); PG8_STAGE_B(PG8_SB(0, 0), b2); PG8_STAGE_B(PG8_SB(0, 1), b2 + hstep); if constexpr (!BAL) PG8_STAGE_A(PG8_SA(0, 0), a2, 0, VC);
            if constexpr (BAL) PG8_WAIT_V(6); else PG8_WAIT_V(8); PG8_WAIT_L(0); PG8_BAR; PG8_MMA(1, 0, At, B0); PG8_MMA(1, 1, At, B1); PG8_BAR; PG8_SCHED;
            PG8_LDB(B0, 1, 0); PG8_LDB(B1, 1, 1); PG8_SCHED; PG8_LDA(At, 1, 0); if constexpr (BAL) PG8_STAGE_A(PG8_SA(0, 0), a2, 0, VC); PG8_STAGE_A(PG8_SA(0, 1), a2, 1, VC);
            PG8_WAIT_V(8); PG8_WAIT_L(0); PG8_BAR; PG8_MMA(0, 0, At, B0); PG8_MMA(0, 1, At, B1); PG8_BAR; PG8_SCHED;
            PG8_LDA(At, 1, 1); PG8_STAGE_B(PG8_SB(1, 0), b3); PG8_STAGE_B(PG8_SB(1, 1), b3 + hstep); if constexpr (!BAL) PG8_STAGE_A(PG8_SA(1, 0), a3, 0, VC);
            if constexpr (BAL) PG8_WAIT_V(6); else PG8_WAIT_V(8); PG8_WAIT_L(0); PG8_BAR; PG8_MMA(1, 0, At, B0); PG8_MMA(1, 1, At, B1); PG8_BAR; PG8_SCHED;
        }
        if (wr == 0) PG8_BAR;
        if constexpr (FP6 && KREP > 1) {
#pragma unroll
            for (int a = 0; a < 2; ++a)
#pragma unroll
                for (int b = 0; b < 2; ++b)
#pragma unroll
                    for (int m = 0; m < 4; ++m)
#pragma unroll
                        for (int n = 0; n < 2; ++n) acc[a][b][m][n] = acc[a][b][m][n] * (1.0f / KREP);
        }
        { int ln_; asm volatile("v_mbcnt_lo_u32_b32 %0, -1, 0\n\tv_mbcnt_hi_u32_b32 %0, -1, %0" : "=v"(ln_));
          E(acc, cur, wr, wc, ln_ & 15, ln_ >> 4);
#ifdef MK_PROBE_EPI2
          if constexpr (FP8) { asm volatile("" ::: "memory"); E(acc, cur, wr, wc, ln_ & 15, ln_ >> 4); }
#endif
        }
        if (!has_next) break;
        if constexpr (XINIT) { int ln_; asm volatile("v_mbcnt_lo_u32_b32 %0, -1, 0\n\tv_mbcnt_hi_u32_b32 %0, -1, %0" : "=v"(ln_)); E.load_init(acc, nxt, wr, wc, ln_ & 15, ln_ >> 4); }
        else {
#pragma unroll
        for (int a = 0; a < 2; ++a)
#pragma unroll
            for (int b = 0; b < 2; ++b)
#pragma unroll
                for (int m = 0; m < 4; ++m)
#pragma unroll
                    for (int n = 0; n < 2; ++n) acc[a][b][m][n] = (f32x4){0.f, 0.f, 0.f, 0.f};
        }
        cur = nxt; cA = nA; cB = nB; ++ui;
        if (wr == 1) PG8_BAR;
    }
    PG8_WAIT_V(0);
    PG8_BAR;
#undef PG8_SA
#undef PG8_SB
#undef PG8_GL
#undef PG8_STAGE_A
#undef PG8_STAGE_B
#undef PG8_LDA
#undef PG8_LDB
#undef PG8_MMA
#undef PG8_CAT
#undef PG8_KOFF
#undef PG8_WAIT_V
#undef PG8_WAIT_L
#undef PG8_BAR
#undef PG8_SCHED
}

}
namespace att {
constexpr int D = 128, NW = 8, QBLK = 32, KVBLK = 64, QB = NW * QBLK;
constexpr int SHM_V = KVBLK * D * 2, SHM_K = KVBLK * D * 2;
constexpr int OFF_WS = 2 * SHM_V + 2 * SHM_K, OFF_CLOG = OFF_WS + NW * 64 * 4, LDS_BYTES = OFF_CLOG + SEQ * 4;
constexpr float THR2 = 8.f * 1.4426950408889634f;
#define KSWZ(row, colB) ((row) * 256 + ((colB) ^ (((row) & 7) << 4)))
#define SBAR() __builtin_amdgcn_sched_barrier(0)
__device__ __forceinline__ int v_st(int k, int c) { const int kk = (k & ~0xC) | ((k & 4) << 1) | ((k & 8) >> 1); return ((kk >> 3) * 4 + (c >> 5)) * 512 + ((kk & 7) * 32 + (c & 31)) * 2; }
__device__ __forceinline__ int v_rd_base(int lane) { return ((lane & 3) << 3) | (((lane >> 2) & 3) << 6) | (((lane >> 4) & 1) << 5) | (((lane >> 5) & 1) << 8); }
constexpr int v_rd_off(int d0, int ks, int half) { return d0 * 512 + ks * 4096 + half * 2048; }
__device__ __forceinline__ int crow(int r, int hi) { return (r & 3) + 8 * (r >> 2) + 4 * hi; }
__device__ __forceinline__ unsigned cvtpk(float lo, float hi) { unsigned r; asm volatile("v_cvt_pk_bf16_f32 %0, %1, %2" : "=v"(r) : "v"(lo), "v"(hi)); return r; }
__device__ __forceinline__ void mask_tile(f32x16& p0, f32x16& p1, int dq) {
    const float NEG = -__builtin_inff();
#pragma unroll
    for (int r = 0; r < 16; ++r) {
        const int c = (r & 3) + 8 * (r >> 2);
        if (dq - c < 0) p0[r] = NEG;
        if (dq - c - 32 < 0) p1[r] = NEG;
    }
}
__device__ __forceinline__ void partialSM(f32x16& p0, f32x16& p1, float& m_reg, float& mn, float& alpha) {
    float pmax = p0[0];
#pragma unroll
    for (int r = 1; r < 16; ++r) pmax = fmaxf(pmax, p0[r]);
#pragma unroll
    for (int r = 0; r < 16; ++r) pmax = fmaxf(pmax, p1[r]);
    { auto rr = __builtin_amdgcn_permlane32_swap(__float_as_uint(pmax), __float_as_uint(pmax), false, false);
      pmax = fmaxf(__uint_as_float(rr[0]), __uint_as_float(rr[1])); }
    if (__builtin_expect(__all((pmax - m_reg) <= THR2), 1)) { mn = m_reg; alpha = 1.f; }
    else { mn = fmaxf(m_reg, pmax); alpha = __builtin_amdgcn_exp2f(m_reg - mn); m_reg = mn; }
#pragma unroll
    for (int r = 0; r < 16; ++r) p0[r] = p0[r] - mn;
#pragma unroll
    for (int r = 0; r < 16; ++r) p1[r] = p1[r] - mn;
#pragma unroll
    for (int r = 0; r < 16; ++r) p0[r] = __builtin_amdgcn_exp2f(p0[r]);
}
__device__ __forceinline__ void finishSM(f32x16& p0, f32x16& p1, float alpha, float& l_reg, bf16x8& pa0, bf16x8& pa1, bf16x8& pa2, bf16x8& pa3) {
#pragma unroll
    for (int r = 0; r < 16; ++r) p1[r] = __builtin_amdgcn_exp2f(p1[r]);
    float ps = 0;
#pragma unroll
    for (int r = 0; r < 16; ++r) ps += p0[r];
#pragma unroll
    for (int r = 0; r < 16; ++r) ps += p1[r];
    { auto rr = __builtin_amdgcn_permlane32_swap(__float_as_uint(ps), __float_as_uint(ps), false, false);
      ps = __uint_as_float(rr[0]) + __uint_as_float(rr[1]); }
    l_reg = l_reg * alpha + ps;
#define PK4(P, B_, OUT) do { unsigned a0 = cvtpk(P[B_+0], P[B_+1]), a1 = cvtpk(P[B_+2], P[B_+3]);                          \
        unsigned b0 = cvtpk(P[B_+4], P[B_+5]), b1 = cvtpk(P[B_+6], P[B_+7]);                                             \
        auto r0 = __builtin_amdgcn_permlane32_swap(a0, b0, false, false); auto r1 = __builtin_amdgcn_permlane32_swap(a1, b1, false, false); \
        u32x4 w = {r0[0], r1[0], r0[1], r1[1]}; OUT = *reinterpret_cast<bf16x8*>(&w); } while (0)
    PK4(p0, 0, pa0); PK4(p0, 8, pa1); PK4(p1, 0, pa2); PK4(p1, 8, pa3);
#undef PK4
}
template <int KB, bool FOX>
__device__ __forceinline__ void qkt(f32x16& p0, f32x16& p1, const char* K_lds, int r32, int hi, const bf16x8* qr, const float* cl  , float cq) {
    if constexpr (FOX) {
#pragma unroll
        for (int g = 0; g < 4; ++g) { const f32x4 c0 = *(const f32x4*)(cl + 8 * g + 4 * hi); const f32x4 c1 = *(const f32x4*)(cl + 32 + 8 * g + 4 * hi);
#pragma unroll
            for (int j = 0; j < 4; ++j) { p0[4 * g + j] = cq - c0[j]; p1[4 * g + j] = cq - c1[j]; } }
    } else { p0 = f32x16{}; p1 = f32x16{}; }
    const char* kb[4];
#pragma unroll
    for (int dd = 0; dd < 4; ++dd) kb[dd] = K_lds + KB * SHM_K + KSWZ(r32, (dd * 16 + hi * 8) * 2);
#pragma unroll
    for (int d0 = 0; d0 < 8; ++d0) { const char* a = kb[d0 & 3] + (d0 >> 2) * 128;
        bf16x8 b0 = *reinterpret_cast<const bf16x8*>(a);
        bf16x8 b1 = *reinterpret_cast<const bf16x8*>(a + 32 * 256);
        p0 = __builtin_amdgcn_mfma_f32_32x32x16_bf16(b0, qr[d0], p0, 0, 0, 0);
        p1 = __builtin_amdgcn_mfma_f32_32x32x16_bf16(b1, qr[d0], p1, 0, 0, 0); }
}
template <int KB>
__device__ __forceinline__ void qkt_lean(f32x16& p0, f32x16& p1, const char* K_lds, int r32, int hi, const bf16x8* qr) {
    p0 = f32x16{}; p1 = f32x16{};
    int kb[4];
#pragma unroll
    for (int dd = 0; dd < 4; ++dd) kb[dd] = (int)(uintptr_t)K_lds + KB * SHM_K + KSWZ(r32, (dd * 16 + hi * 8) * 2);
#define KRD(dst, d0, half) asm volatile("ds_read_b128 %0, %1 offset:%2" : "=&v"(dst) : "v"(kb[(d0) & 3]), "i"(((d0) >> 2) * 128 + (half) * 32 * 256) : "memory")
#define KRD4(P, d0) do { KRD(P##00, d0, 0); KRD(P##01, d0, 1); KRD(P##10, (d0) + 1, 0); KRD(P##11, (d0) + 1, 1); } while (0)
#define KMM(P, d0) do { p0 = __builtin_amdgcn_mfma_f32_32x32x16_bf16(P##00, qr[d0], p0, 0, 0, 0); p1 = __builtin_amdgcn_mfma_f32_32x32x16_bf16(P##01, qr[d0], p1, 0, 0, 0); \
        p0 = __builtin_amdgcn_mfma_f32_32x32x16_bf16(P##10, qr[(d0) + 1], p0, 0, 0, 0); p1 = __builtin_amdgcn_mfma_f32_32x32x16_bf16(P##11, qr[(d0) + 1], p1, 0, 0, 0); } while (0)
#define KW4() do { asm volatile("s_waitcnt lgkmcnt(4)" ::: "memory"); SBAR(); } while (0)
    bf16x8 A00, A01, A10, A11, B00, B01, B10, B11;
    KRD4(A, 0);
    KRD4(B, 2); KW4(); KMM(A, 0); SBAR();
    KRD4(A, 4); KW4(); KMM(B, 2); SBAR();
    KRD4(B, 6); KW4(); KMM(A, 4); SBAR();
    asm volatile("s_waitcnt lgkmcnt(0)" ::: "memory"); SBAR(); KMM(B, 6); SBAR();
#undef KRD
#undef KRD4
#undef KMM
#undef KW4
}
template <int VB>
__device__ __forceinline__ void pv_tile(f32x16* o, int vb0, bf16x8 pa0, bf16x8 pa1, bf16x8 pa2, bf16x8 pa3) {
#define TRRD(dst, off) asm volatile("ds_read_b64_tr_b16 %0, %1 offset:%2" : "=&v"(dst) : "v"(vb0), "i"(off) : "memory")
#define PV_D0(d0) do { s16x4 l0, l1, l2, l3, h0, h1, h2, h3; constexpr int b_ = VB * SHM_V + v_rd_off(d0, 0, 0); \
        TRRD(l0, b_); TRRD(h0, b_ + 2048); TRRD(l1, b_ + 4096); TRRD(h1, b_ + 6144); TRRD(l2, b_ + 8192); TRRD(h2, b_ + 10240); TRRD(l3, b_ + 12288); TRRD(h3, b_ + 14336); \
        asm volatile("s_waitcnt lgkmcnt(0)" ::: "memory"); SBAR();   \
        o[d0] = __builtin_amdgcn_mfma_f32_32x32x16_bf16(pa0, (bf16x8){l0[0], l0[1], l0[2], l0[3], h0[0], h0[1], h0[2], h0[3]}, o[d0], 0, 0, 0);   \
        o[d0] = __builtin_amdgcn_mfma_f32_32x32x16_bf16(pa1, (bf16x8){l1[0], l1[1], l1[2], l1[3], h1[0], h1[1], h1[2], h1[3]}, o[d0], 0, 0, 0);   \
        o[d0] = __builtin_amdgcn_mfma_f32_32x32x16_bf16(pa2, (bf16x8){l2[0], l2[1], l2[2], l2[3], h2[0], h2[1], h2[2], h2[3]}, o[d0], 0, 0, 0);   \
        o[d0] = __builtin_amdgcn_mfma_f32_32x32x16_bf16(pa3, (bf16x8){l3[0], l3[1], l3[2], l3[3], h3[0], h3[1], h3[2], h3[3]}, o[d0], 0, 0, 0); } while (0)
    PV_D0(0); PV_D0(1); PV_D0(2); PV_D0(3);
#undef PV_D0
#undef TRRD
}
constexpr int PV8_V1 = 3 * SHM_V;
__device__ __forceinline__ void pv_pipe8(f32x16* o, int vbA, bf16x8 pa0, bf16x8 pa1, bf16x8 pa2, bf16x8 pa3) {
#define TRR(dst, vb, off) asm volatile("ds_read_b64_tr_b16 %0, %1 offset:%2" : "=&v"(dst) : "v"(vb), "i"(off) : "memory")
#define RD8(P, vb, d0) do { constexpr int b_ = v_rd_off((d0) & 3, 0, 0) + ((d0) >> 2) * PV8_V1; TRR(P##l0, vb, b_); TRR(P##h0, vb, b_ + 2048); TRR(P##l1, vb, b_ + 4096); TRR(P##h1, vb, b_ + 6144); \
        TRR(P##l2, vb, b_ + 8192); TRR(P##h2, vb, b_ + 10240); TRR(P##l3, vb, b_ + 12288); TRR(P##h3, vb, b_ + 14336); } while (0)
#define FR(P, k) (bf16x8){P##l##k[0], P##l##k[1], P##l##k[2], P##l##k[3], P##h##k[0], P##h##k[1], P##h##k[2], P##h##k[3]}
#define MM4(P, oi) do { o[oi] = __builtin_amdgcn_mfma_f32_32x32x16_bf16(pa0, FR(P, 0), o[oi], 0, 0, 0); o[oi] = __builtin_amdgcn_mfma_f32_32x32x16_bf16(pa1, FR(P, 1), o[oi], 0, 0, 0); \
        o[oi] = __builtin_amdgcn_mfma_f32_32x32x16_bf16(pa2, FR(P, 2), o[oi], 0, 0, 0); o[oi] = __builtin_amdgcn_mfma_f32_32x32x16_bf16(pa3, FR(P, 3), o[oi], 0, 0, 0); } while (0)
#define W8() do { asm volatile("s_waitcnt lgkmcnt(8)" ::: "memory"); SBAR(); } while (0)
    s16x4 Al0, Al1, Al2, Al3, Ah0, Ah1, Ah2, Ah3, Bl0, Bl1, Bl2, Bl3, Bh0, Bh1, Bh2, Bh3;
    RD8(A, vbA, 0);
    RD8(B, vbA, 1); W8(); MM4(A, 0); SBAR();
    RD8(A, vbA, 2); W8(); MM4(B, 1); SBAR();
    RD8(B, vbA, 3); W8(); MM4(A, 2); SBAR();
    RD8(A, vbA, 4); W8(); MM4(B, 3); SBAR();
    RD8(B, vbA, 5); W8(); MM4(A, 4); SBAR();
    RD8(A, vbA, 6); W8(); MM4(B, 5); SBAR();
    RD8(B, vbA, 7); W8(); MM4(A, 6); SBAR();
    asm volatile("s_waitcnt lgkmcnt(0)" ::: "memory"); SBAR(); MM4(B, 7);
#undef TRR
#undef RD8
#undef FR
#undef MM4
#undef W8
}
struct BlockRef { unsigned Q, K, V, O; int P0; unsigned clog; int jlo; };
struct Seam { bf16x8 qr[8]; bf16x8 st_v0, st_v1, st_k0, st_k1; };
#define ROWB(p, k0, rr) ((const char*)wsb + (size_t)((p) + (unsigned)((k0) + (rr)) * (unsigned)(D * 2)) + lnoff)
#define VMW() asm volatile("s_waitcnt vmcnt(0)" ::: "memory")
#define VMWN(n) asm volatile("s_waitcnt vmcnt(%0)" :: "i"(n) : "memory")
#define LD8(p) (*reinterpret_cast<const bf16x8*>(p))
#define SLOAD_H(Kp, Vp, k0) do { S.st_v0 = LD8(ROWB(Vp, k0, 0)); S.st_v1 = LD8(ROWB(Vp, k0, 32)); S.st_k0 = LD8(ROWB(Kp, k0, 0)); S.st_k1 = LD8(ROWB(Kp, k0, 32)); } while (0)
#define SWRITE_HK(bf) do { *(bf16x8*)(K_lds + (bf) * SHM_K + kws) = S.st_k0; *(bf16x8*)(K_lds + (bf) * SHM_K + kws + 32 * 256) = S.st_k1; } while (0)
#define SWRITE_HV(bf) do { *(bf16x8*)(V_lds + (bf) * SHM_V + vst0) = S.st_v0; *(bf16x8*)(V_lds + (bf) * SHM_V + vst1) = S.st_v1; } while (0)
#define SWRITE_H(bf) do { SWRITE_HV(bf); SWRITE_HK(bf); } while (0)
__device__ __forceinline__ void attn_prime(const unsigned char* wsb, const BlockRef& cur, char* lds, Seam& S) {
    const int tid = threadIdx.x, wid = __builtin_amdgcn_readfirstlane(tid >> 6), lane = tid & 63, r32 = lane & 31, hi = lane >> 5;
    const int sr = tid >> 4, sc = (tid & 15) * 8, kws = KSWZ(sr, sc * 2); char* K_lds = lds + 2 * SHM_V;
    const unsigned lnoff = (unsigned)(sr * D + sc) * 2u;
#pragma unroll
    for (int d0 = 0; d0 < 8; ++d0) S.qr[d0] = LD8(wsb + (size_t)cur.Q + (unsigned)((wid * QBLK + r32) * D + d0 * 16 + hi * 8) * 2u);
    SLOAD_H(cur.K, cur.V, cur.jlo * KVBLK); VMW(); SWRITE_HK(0);
    __syncthreads();
}
template <bool FOX, class NR>
__device__ __forceinline__ void attn_block(const unsigned char* wsb, const BlockRef& cur, const NR& nref, char* lds, Seam& S) {
    const int tid = threadIdx.x, wid = __builtin_amdgcn_readfirstlane(tid >> 6), lane = tid & 63, r32 = lane & 31, hi = lane >> 5;
    const int j_lo = cur.jlo;
    const int NT = (cur.P0 + QB) / KVBLK - j_lo;
    const int qlo = cur.P0 + wid * QBLK;
    const int qe = FOX ? qlo : (qlo | 63);
    const int qm = (FOX ? (qlo + r32) : (qlo | 63)) - 4 * hi;
    char* V_lds = lds; char* K_lds = lds + 2 * SHM_V;
    float* ws = (float*)(lds + OFF_WS) + wid * 64; float* li_l = ws, * al_l = ws + 32;
    float* cl_lds = (float*)(lds + OFF_CLOG);
    float cq = 0.f;
    if constexpr (FOX) {
        const int nkeys = NT * KVBLK;
        const float* clg = (const float*)(wsb + (size_t)cur.clog);
        for (int i = tid * 4; i < nkeys; i += NTHREADS * 4) *(f32x4*)(cl_lds + i) = *(const f32x4*)(clg + j_lo * KVBLK + i);
        cq = clg[qlo + r32];
        __syncthreads();
    }
    float m_reg = -1e30f, l_reg = 0; f32x16 o[4] = {};
    const int sr = tid >> 4, sc = (tid & 15) * 8, vst0 = v_st(sr, sc), vst1 = v_st(32 + sr, sc), kws = KSWZ(sr, sc * 2);
    const unsigned lnoff = (unsigned)(sr * D + sc) * 2u;
    const int vb0 = (int)(uintptr_t)V_lds + v_rd_base(lane);
    const unsigned Kh = cur.K, Vh = cur.V;
#define RESC(a) do { if (__any((a) < 1.f)) { if (hi == 0) al_l[r32] = (a); asm volatile("s_waitcnt lgkmcnt(0)" ::: "memory");              \
                     for (int d_ = 0; d_ < 4; ++d_) for (int r = 0; r < 16; ++r) o[d_][r] *= al_l[crow(r, hi)]; } } while (0)
#define KBASE(t) ((j_lo + (t)) * KVBLK)
#define CLT(t) (cl_lds + (t) * KVBLK)
#define MASKT(P0_, P1_, t) do { const int kb_ = KBASE(t); if (kb_ + KVBLK - 1 > qe) mask_tile(P0_, P1_, qm - kb_); } while (0)
    f32x16 pA0, pA1, pB0, pB1; float mnA, mnB, alA, alB; bf16x8 pa0, pa1, pa2, pa3;
    SWRITE_HV(0); SBAR();
    if (NT > 1) { SLOAD_H(Kh, Vh, KBASE(1)); }
    SBAR(); qkt<0, FOX>(pA0, pA1, K_lds, r32, hi, S.qr, CLT(0), cq);
    MASKT(pA0, pA1, 0); partialSM(pA0, pA1, m_reg, mnA, alA);
    if (NT > 1) { VMW(); SWRITE_H(1); }
    __syncthreads();
#define HALF_STEP(PX0, PX1, mnX, alX, PY0, PY1, alY, t, KB, VB, SB) do {                                                      \
        SBAR(); qkt<KB, FOX>(PX0, PX1, K_lds, r32, hi, S.qr, CLT(t), cq);                                          \
        finishSM(PY0, PY1, alY, l_reg, pa0, pa1, pa2, pa3); SBAR();                                                           \
        if ((t) + 1 < NT) { SLOAD_H(Kh, Vh, KBASE((t) + 1)); SBAR(); }                                                        \
        pv_tile<VB>(o, vb0, pa0, pa1, pa2, pa3); MASKT(PX0, PX1, (t)); partialSM(PX0, PX1, m_reg, mnX, alX);                  \
        __syncthreads();                                                                                                      \
        if ((t) + 1 < NT) { VMW(); SWRITE_H(SB); }                                                                            \
        RESC(alX); __syncthreads(); } while (0)
    for (int t = 1; t + 1 < NT; t += 2) {
        HALF_STEP(pB0, pB1, mnB, alB, pA0, pA1, alA, t, 1, 0, 0);
        HALF_STEP(pA0, pA1, mnA, alA, pB0, pB1, alB, t + 1, 0, 1, 1);
    }
    constexpr bool even = true;
    if (even) { SBAR(); qkt<1, FOX>(pB0, pB1, K_lds, r32, hi, S.qr, CLT(NT - 1), cq); SBAR(); }
    const BlockRef nxt = nref();
    SLOAD_H(nxt.K, nxt.V, nxt.jlo * KVBLK); SBAR();
#pragma unroll
    for (int d0 = 0; d0 < 8; ++d0) S.qr[d0] = LD8(wsb + (size_t)nxt.Q + (unsigned)((wid * QBLK + r32) * D + d0 * 16 + hi * 8) * 2u);
    SBAR();
    finishSM(pA0, pA1, alA, l_reg, pa0, pa1, pa2, pa3); SBAR();
    pv_tile<0>(o, vb0, pa0, pa1, pa2, pa3);
    if (even) { MASKT(pB0, pB1, NT - 1); partialSM(pB0, pB1, m_reg, mnB, alB); __syncthreads(); RESC(alB);
        finishSM(pB0, pB1, alB, l_reg, pa0, pa1, pa2, pa3); SBAR(); pv_tile<1>(o, vb0, pa0, pa1, pa2, pa3); }
    SBAR(); VMWN(8); SWRITE_HK(0); SBAR();
    if (hi == 0) li_l[r32] = l_reg; asm volatile("s_waitcnt lgkmcnt(0)" ::: "memory");
    float rli[16];
#pragma unroll
    for (int r = 0; r < 16; ++r) rli[r] = __builtin_amdgcn_rcpf(li_l[crow(r, hi)]);
    bf16_t* Ow = (bf16_t*)(const_cast<unsigned char*>(wsb) + (size_t)cur.O) + (size_t)(wid * QBLK) * D;
#pragma unroll
    for (int r = 0; r < 16; ++r) { const int orow = crow(r, hi);
#pragma unroll
        for (int d0 = 0; d0 < 4; ++d0) { const float v = o[d0][r] * rli[r];
            const float vn = __uint_as_float((unsigned)__builtin_amdgcn_update_dpp(0, (int)__float_as_uint(v), 0xB1, 0xF, 0xF, false));
            if ((r32 & 1) == 0) __builtin_nontemporal_store(cvtpk(v, vn), (unsigned*)(Ow + (size_t)orow * D + d0 * 32 + r32)); } }
    __syncthreads();
#undef RESC
#undef KBASE
#undef CLT
#undef MASKT
#undef HALF_STEP
}
constexpr int W_OFF_V1 = 3 * SHM_V, W_OFF_K = 6 * SHM_V, W_OFF_WS = 133120, W_LDS_BYTES = W_OFF_WS + NW * 64 * 4;
struct BlockRefW { unsigned Q, K, V0, V1, O0, O1; int P0; };
struct SeamW { bf16x8 qr[8]; int vs; };
#define DMA_W(R, k0, bf, vsl) do { const unsigned kb_ = (unsigned)(k0) * 256u; \
        const char* gk_ = (const char*)wsb + (size_t)((R).K + kb_); const char* g0_ = (const char*)wsb + (size_t)((R).V0 + kb_); const char* g1_ = (const char*)wsb + (size_t)((R).V1 + kb_); \
        const unsigned lk_ = ldsb + W_OFF_K + (bf) * SHM_K + wid * 2048, lv_ = ldsb + (unsigned)(vsl) * SHM_V + wid * 2048; \
        glds16s(uni_ptr(gk_), vofK0, lk_); glds16s(uni_ptr(gk_), (vofK0 + 1024u) ^ 64u, lk_ + 1024u); \
        glds16s(uni_ptr(g0_), vofV0, lv_); glds16s(uni_ptr(g0_), vofV1, lv_ + 1024u); \
        glds16s(uni_ptr(g1_), vofV0, lv_ + W_OFF_V1); glds16s(uni_ptr(g1_), vofV1, lv_ + W_OFF_V1 + 1024u); } while (0)
#define DMA_OFFS() \
    const unsigned ldsb = (unsigned)__builtin_amdgcn_readfirstlane((int)(unsigned)(uintptr_t)lds); \
    unsigned vofK0, vofV0, vofV1; \
    { int lane; asm volatile("v_mbcnt_lo_u32_b32 %0, -1, 0\n\tv_mbcnt_hi_u32_b32 %0, -1, %0" : "=v"(lane));     \
      const int rk0 = 4 * (2 * wid) + (lane >> 4), rk1 = rk0 + 4; vofK0 = (unsigned)(rk0 * 256 + (((lane & 15) ^ (rk0 & 7)) << 4)); (void)rk1;     \
      const int p0_ = (2 * wid) * 64 + lane, p1_ = p0_ + 64; \
      { const int sub = p0_ >> 5, kk = (sub >> 2) * 8 + ((p0_ >> 2) & 7), k = (kk & ~0xC) | ((kk & 4) << 1) | ((kk & 8) >> 1), c = (sub & 3) * 32 + (p0_ & 3) * 8; vofV0 = (unsigned)(k * 256 + c * 2); } \
      { const int sub = p1_ >> 5, kk = (sub >> 2) * 8 + ((p1_ >> 2) & 7), k = (kk & ~0xC) | ((kk & 4) << 1) | ((kk & 8) >> 1), c = (sub & 3) * 32 + (p1_ & 3) * 8; vofV1 = (unsigned)(k * 256 + c * 2); } }
__device__ __forceinline__ void attn_primeW(const unsigned char* wsb, const BlockRefW& cur, char* lds, SeamW& S) {
    const int tid = threadIdx.x, wid = __builtin_amdgcn_readfirstlane(tid >> 6), lane = tid & 63, r32 = lane & 31, hi = lane >> 5;
    DMA_OFFS();
    S.vs = 0;
    DMA_W(cur, 0, 0, 0);
#pragma unroll
    for (int d0 = 0; d0 < 8; ++d0) S.qr[d0] = LD8(wsb + (size_t)cur.Q + (unsigned)((wid * QBLK + r32) * D + d0 * 16 + hi * 8) * 2u);
    VMW();
    __syncthreads();
}
template <class NR>
__device__ __forceinline__ void attn_blockW(const unsigned char* wsb, const BlockRefW& cur, const NR& nref, char* lds, SeamW& S) {
    const int tid = threadIdx.x, wid = __builtin_amdgcn_readfirstlane(tid >> 6), lane = tid & 63, r32 = lane & 31, hi = lane >> 5;
    const int NT = (cur.P0 + QB) / KVBLK;
    const int qlo = cur.P0 + wid * QBLK, qe = qlo | 63, qm = (qlo | 63) - 4 * hi;
    char* V_lds = lds; char* K_lds = lds + W_OFF_K;
    float* ws = (float*)(lds + W_OFF_WS) + wid * 64; float* li_l = ws, * al_l = ws + 32;
    float m_reg = -1e30f, l_reg = 0; f32x16 o[8] = {};
    DMA_OFFS();
    const int vb0 = (int)(uintptr_t)V_lds + v_rd_base(lane);
    static_assert(PV8_V1 == W_OFF_V1 && v_rd_off(3, 3, 1) + PV8_V1 < 65536, "V1 ring reachable by the 16-bit ds offset");
#define RESCW(a) do { if (__any((a) < 1.f)) { if (hi == 0) al_l[r32] = (a); asm volatile("s_waitcnt lgkmcnt(0)" ::: "memory");              \
                      for (int d_ = 0; d_ < 8; ++d_) for (int r = 0; r < 16; ++r) o[d_][r] *= al_l[crow(r, hi)]; } } while (0)
#define MASKW(P0_, P1_, t) do { const int kb_ = (t) * KVBLK; if (kb_ + KVBLK - 1 > qe) mask_tile(P0_, P1_, qm - kb_); } while (0)
    f32x16 p0, p1; float mn, al; bf16x8 pa0, pa1, pa2, pa3;
    const bool lag = wid >= 4;
    int vs = S.vs;
#define PVW(slot) do { pv_pipe8(o, vb0 + (slot) * SHM_V, pa0, pa1, pa2, pa3); } while (0)
#define STEPW(t, BF) do { const int nvs_ = vs == 2 ? 0 : vs + 1;                                                                \
        DMA_W(cur, ((t) + 1) * KVBLK, 1 - (BF), nvs_);                                                                          \
        if (lag && (t) > 0) { SBAR(); PVW(vs == 0 ? 2 : vs - 1); }                                                               \
        SBAR(); qkt_lean<BF>(p0, p1, K_lds, r32, hi, S.qr); SBAR();                                                            \
        MASKW(p0, p1, (t)); partialSM(p0, p1, m_reg, mn, al); RESCW(al); finishSM(p0, p1, al, l_reg, pa0, pa1, pa2, pa3); SBAR(); \
        if (!lag) { PVW(vs); }                                                                                                   \
        VMW(); __syncthreads(); vs = nvs_; } while (0)
    for (int t = 0; t + 2 < NT; t += 2) { STEPW(t, 0); STEPW(t + 1, 1); }
    STEPW(NT - 2, 0);
    const BlockRefW nxt = nref();
    const int nvs = vs == 2 ? 0 : vs + 1;
    DMA_W(nxt, 0, 0, nvs);
    if (lag) { SBAR(); PVW(vs == 0 ? 2 : vs - 1); }
    SBAR(); qkt_lean<1>(p0, p1, K_lds, r32, hi, S.qr); SBAR();
#pragma unroll
    for (int d0 = 0; d0 < 8; ++d0) S.qr[d0] = LD8(wsb + (size_t)nxt.Q + (unsigned)((wid * QBLK + r32) * D + d0 * 16 + hi * 8) * 2u);
    SBAR();
    MASKW(p0, p1, NT - 1); partialSM(p0, p1, m_reg, mn, al); RESCW(al); finishSM(p0, p1, al, l_reg, pa0, pa1, pa2, pa3); SBAR();
    PVW(vs);
    S.vs = nvs;
    if (hi == 0) li_l[r32] = l_reg; asm volatile("s_waitcnt lgkmcnt(0)" ::: "memory");
    float rli[16];
#pragma unroll
    for (int r = 0; r < 16; ++r) rli[r] = __builtin_amdgcn_rcpf(li_l[crow(r, hi)]);
    { int ln_; asm volatile("v_mbcnt_lo_u32_b32 %0, -1, 0\n\tv_mbcnt_hi_u32_b32 %0, -1, %0" : "=v"(ln_));
      const int r32b = ln_ & 31, hib = ln_ >> 5; const unsigned lo_ = (unsigned)((wid * QBLK + 4 * hib) * D + r32b) * 2u;
#pragma unroll
      for (int hv = 0; hv < 2; ++hv) {
        unsigned char* Ob = const_cast<unsigned char*>(wsb) + (size_t)(hv ? cur.O1 : cur.O0);
#pragma unroll
        for (int r = 0; r < 16; ++r) { const unsigned ro_ = lo_ + (unsigned)(((r & 3) + 8 * (r >> 2)) * D) * 2u;
#pragma unroll
            for (int d0 = 0; d0 < 4; ++d0) { const float v = o[hv * 4 + d0][r] * rli[r];
                const float vn = __uint_as_float((unsigned)__builtin_amdgcn_update_dpp(0, (int)__float_as_uint(v), 0xB1, 0xF, 0xF, false));
                if ((r32b & 1) == 0) __builtin_nontemporal_store(cvtpk(v, vn), (unsigned*)(Ob + (ro_ + (unsigned)(d0 * 64)))); } }
      } }
    VMW(); __syncthreads();
#undef RESCW
#undef MASKW
#undef STEPW
#undef PVW
}
#undef DMA_W
#undef DMA_OFFS
#undef ROWB
#undef VMW
#undef VMWN
#undef LD8
#undef SLOAD_H
#undef SWRITE_HK
#undef SWRITE_HV
#undef SWRITE_H
#undef KSWZ
#undef SBAR
}
#ifndef MK_FP8
#define MK_FP8 1
#endif
constexpr int FP8_WSHIFT = 8, FP8_HGSHIFT = 3, FP8_HDSHIFT = 2, FP8_YSHIFT = 6;
#ifndef MK_YS8
#define MK_YS8 1
#endif
__device__ __forceinline__ float clamp448(float v) { return __builtin_amdgcn_fmed3f(v, -448.0f, 448.0f); }
__device__ __forceinline__ unsigned pk_fp8x4(float a, float b, float c, float d) {
    int w = 0; w = __builtin_amdgcn_cvt_pk_fp8_f32(clamp448(a), clamp448(b), w, false); w = __builtin_amdgcn_cvt_pk_fp8_f32(clamp448(c), clamp448(d), w, true); return (unsigned)w; }
#ifndef MK_FP6
#define MK_FP6 1
#endif
typedef float v16f_t __attribute__((ext_vector_type(16)));
typedef int v6i_t __attribute__((ext_vector_type(6)));
__device__ __forceinline__ void fp6_record(const v16f_t a, const v16f_t b, u32x4& lo, u32x4& hi) {
    float mx = 0.f;
#pragma unroll
    for (int i = 0; i < 16; ++i) asm("v_max3_f32 %0, |%1|, |%2|, %0" : "+v"(mx) : "v"(a[i]), "v"(b[i]));
    int sb = (int)((__float_as_uint(mx) >> 23) & 0xffu) - 2; sb = sb < 1 ? 1 : sb;
    const float scale = __uint_as_float((unsigned)sb << 23);
    const v6i_t r = __builtin_amdgcn_cvt_scalef32_2xpk16_fp6_f32(a, b, scale);
    lo = (u32x4){(unsigned)r[0], (unsigned)r[1], (unsigned)r[2], (unsigned)r[3]}; hi = (u32x4){(unsigned)r[4], (unsigned)r[5], (unsigned)sb, 0u};
}
__device__ __forceinline__ void xpose4(float (&X)[4][8]) {
#pragma unroll
    for (int m = 0; m < 2; ++m)
#pragma unroll
        for (int j = 0; j < 8; ++j) { auto r = __builtin_amdgcn_permlane32_swap(__float_as_uint(X[m][j]), __float_as_uint(X[m + 2][j]), false, false); X[m][j] = __uint_as_float(r[0]); X[m + 2][j] = __uint_as_float(r[1]); }
#pragma unroll
    for (int m = 0; m < 4; m += 2)
#pragma unroll
        for (int j = 0; j < 8; ++j) { auto r = __builtin_amdgcn_permlane16_swap(__float_as_uint(X[m][j]), __float_as_uint(X[m + 1][j]), false, false); X[m][j] = __uint_as_float(r[0]); X[m + 1][j] = __uint_as_float(r[1]); }
}
#define XROW16(X, q) X[q][0], X[q][1], X[q][2], X[q][3], X[q][4], X[q][5], X[q][6], X[q][7]
#ifndef MK_H_NT
#define MK_H_NT 1
#endif
#ifndef MK_YS16
#define MK_YS16 1
#endif
#ifndef MK_XINIT
#define MK_XINIT 1
#endif
#ifndef MK_FUSE_NORMS
#define MK_FUSE_NORMS 1
#endif
namespace pg8 {
struct EpiQKV {
    bf16_t* QKV; const float* rope; unsigned* ctl; LAS float* nsc;
    __device__ __forceinline__ void operator()(const f32x4 (&acc)[2][2][4][2], const Unit& u, int wr, int wc, int fr, int fq) const {
        const int pn = u.pn; const bool isrope = pn < 8; const float sc = (pn < 4 || (pn >= 12 && pn < 16)) ? QSCALE : 1.0f;
        const bool isnorm = MK_FUSE_NORMS && pn >= 12 && pn < 20;
        const int cw = wc * 32 + 8 * fq;
#pragma unroll
        for (int ai = 0; ai < 2; ++ai)
#pragma unroll
            for (int m = 0; m < 4; ++m) {
                const int row = u.pm * BM + ai * HALF + wr * 64 + m * 16 + fr;
                f32x4 cs0 = {1.f, 0.f, 1.f, 0.f}, cs1 = {1.f, 0.f, 1.f, 0.f};
                if (isrope) { const float* rp = rope + (size_t)row * 128 + (16 * wc + 4 * fq) * 2; cs0 = *(const f32x4*)rp; cs1 = *(const f32x4*)(rp + 4); }
#pragma unroll
                for (int bj = 0; bj < 2; ++bj) {
                    f32x4 v0 = acc[ai][bj][m][0], v1 = acc[ai][bj][m][1];
                    if (isrope) {
                        const f32x4 a = v0, b = v1;
                        v0[0] = a[0] * cs0[0] - a[1] * cs0[1]; v0[1] = a[1] * cs0[0] + a[0] * cs0[1]; v0[2] = a[2] * cs0[2] - a[3] * cs0[3]; v0[3] = a[3] * cs0[2] + a[2] * cs0[3];
                        v1[0] = b[0] * cs1[0] - b[1] * cs1[1]; v1[1] = b[1] * cs1[0] + b[0] * cs1[1]; v1[2] = b[2] * cs1[2] - b[3] * cs1[3]; v1[3] = b[3] * cs1[2] + b[2] * cs1[3];
                    }
                    v0 = v0 * sc; v1 = v1 * sc;
                    if (isnorm) { float ss = (v0[0] * v0[0] + v0[1] * v0[1]) + (v0[2] * v0[2] + v0[3] * v0[3]) + (v1[0] * v1[0] + v1[1] * v1[1]) + (v1[2] * v1[2] + v1[3] * v1[3]);
                        ss += __shfl_xor(ss, 16); ss += __shfl_xor(ss, 32);
                        if (fq == 0) nsc[((ai * HALF + wr * 64 + m * 16 + fr) * 2 + bj) * 4 + wc] = ss; }
                    u32x4 w; w.x = cvt_pk_bf16(v0[0], v0[1]); w.y = cvt_pk_bf16(v0[2], v0[3]); w.z = cvt_pk_bf16(v1[0], v1[1]); w.w = cvt_pk_bf16(v1[2], v1[3]);
                    *(u32x4*)(QKV + ((size_t)(pn * 2 + bj) * MTOK + row) * 128 + cw) = w;
                }
            }
        if (isnorm) {
            __syncthreads();
            const int t = (int)threadIdx.x; const f32x4 pq = *(const LAS f32x4*)(nsc + t * 4);
            float s = (pq.x + pq.y) + (pq.z + pq.w);
            s = fmaxf(s, __shfl_xor(s, 2)); s = fmaxf(s, __shfl_xor(s, 4)); s = fmaxf(s, __shfl_xor(s, 8)); s = fmaxf(s, __shfl_xor(s, 16)); s = fmaxf(s, __shfl_xor(s, 32));
            if ((t & 63) < 2) { const int isk = pn >= 16, hd = ((pn - (isk ? 16 : 12)) * 2) + (t & 1), bh = (u.pm >> 4) * 8 + hd;
                atomicMax(ctl + (isk ? CW_KMAX + bh : CW_QMAX + bh * 16 + (u.pm & 15)), __float_as_uint(s)); }
        }
    }
};
struct EpiOut {
    const float* x; float* h; bf16_t* hg; const float* gffn;
    __device__ __forceinline__ void load_init(f32x4 (&acc)[2][2][4][2], const Unit& u, int wr, int wc, int fr, int fq) const {
#pragma unroll
        for (int bj = 0; bj < 2; ++bj)
#pragma unroll
            for (int ai = 0; ai < 2; ++ai)
#pragma unroll
                for (int m = 0; m < 4; ++m) { const size_t off = (size_t)(u.pm * BM + ai * HALF + wr * 64 + m * 16 + fr) * DM + u.pn * BM + bj * HALF + wc * 32 + 8 * fq;
                    acc[ai][bj][m][0] = *(const f32x4*)(x + off); acc[ai][bj][m][1] = *(const f32x4*)(x + off + 4); }
    }
    __device__ __forceinline__ void operator()(const f32x4 (&acc)[2][2][4][2], const Unit& u, int wr, int wc, int fr, int fq) const {
#pragma unroll
        for (int bj = 0; bj < 2; ++bj) {
            const int col0 = u.pn * BM + bj * HALF + wc * 32 + 8 * fq;
            const f32x4 g0 = *(const f32x4*)(gffn + col0), g1 = *(const f32x4*)(gffn + col0 + 4);
#pragma unroll
            for (int ai = 0; ai < 2; ++ai) {
#if MK_FP8 && MK_FP6
                float X[4][8];
#endif
#pragma unroll
                for (int m = 0; m < 4; ++m) {
                    const size_t off = (size_t)(u.pm * BM + ai * HALF + wr * 64 + m * 16 + fr) * DM + col0;
                    const f32x4 h0 = MK_XINIT ? acc[ai][bj][m][0] : *(const f32x4*)(x + off) + acc[ai][bj][m][0], h1 = MK_XINIT ? acc[ai][bj][m][1] : *(const f32x4*)(x + off + 4) + acc[ai][bj][m][1];
#if MK_H_NT
                    __builtin_nontemporal_store(h0, (f32x4*)(h + off)); __builtin_nontemporal_store(h1, (f32x4*)(h + off + 4));
#else
                    *(f32x4*)(h + off) = h0; *(f32x4*)(h + off + 4) = h1;
#endif
                    const f32x4 a = h0 * g0, b = h1 * g1;
#if MK_FP8 && MK_FP6
                    X[m][0] = a[0]; X[m][1] = a[1]; X[m][2] = a[2]; X[m][3] = a[3]; X[m][4] = b[0]; X[m][5] = b[1]; X[m][6] = b[2]; X[m][7] = b[3];
#elif MK_FP8
                    constexpr float sc8 = (float)(1 << FP8_HGSHIFT);
                    u32x2 w8; w8.x = pk_fp8x4(a[0] * sc8, a[1] * sc8, a[2] * sc8, a[3] * sc8); w8.y = pk_fp8x4(b[0] * sc8, b[1] * sc8, b[2] * sc8, b[3] * sc8);
                    *(u32x2*)((unsigned char*)hg + off) = w8;
#else
                    u32x4 w; w.x = cvt_pk_bf16(a[0], a[1]); w.y = cvt_pk_bf16(a[2], a[3]); w.z = cvt_pk_bf16(b[0], b[1]); w.w = cvt_pk_bf16(b[2], b[3]);
                    *(u32x4*)(hg + off) = w;
#endif
                }
#if MK_FP8 && MK_FP6
                xpose4(X);
                u32x4 lo, hi; fp6_record((v16f_t){XROW16(X, 0), XROW16(X, 1)}, (v16f_t){XROW16(X, 2), XROW16(X, 3)}, lo, hi);
                unsigned char* rp = (unsigned char*)hg + (size_t)(u.pm * BM + ai * HALF + wr * 64 + fq * 16 + fr) * DM + (2 * u.pn + bj) * 128 + 16 * wc;
                *(u32x4*)rp = lo; *(u32x4*)(rp + 64) = hi;
#endif
            }
        }
    }
};
template <int SC> __device__ __forceinline__ f32x2 swiglu_pk(f32x2 g, f32x2 u) {
    g.x = fminf(g.x, 7.0f); g.y = fminf(g.y, 7.0f);
    u.x = __builtin_amdgcn_fmed3f(u.x, -7.0f, 7.0f); u.y = __builtin_amdgcn_fmed3f(u.y, -7.0f, 7.0f);
    const f32x2 t = g * (-1.702f * 1.4426950408889634f);
    f32x2 e; e.x = __builtin_amdgcn_exp2f(t.x); e.y = __builtin_amdgcn_exp2f(t.y);
    const f32x2 d = e + 1.0f;
    f32x2 r; r.x = __builtin_amdgcn_rcpf(d.x); r.y = __builtin_amdgcn_rcpf(d.y);
    const f32x2 us = u * (float)SC + (float)SC;
    return (g * r) * us;
}
__device__ __forceinline__ unsigned pk_fp8x4_nc(f32x2 a, f32x2 b) {
    int w = 0; w = __builtin_amdgcn_cvt_pk_fp8_f32(a.x, a.y, w, false); w = __builtin_amdgcn_cvt_pk_fp8_f32(b.x, b.y, w, true); return (unsigned)w; }
__device__ __forceinline__ float swiglu1(float g, float uu) {
    g = fminf(g, 7.0f); uu = fminf(fmaxf(uu, -7.0f), 7.0f);
    const float e = __builtin_amdgcn_exp2f(g * (-1.702f * 1.4426950408889634f));
    return g * __builtin_amdgcn_rcpf(1.0f + e) * (uu + 1.0f);
}
struct EpiGU {
    bf16_t* hdn; const float* bgate; const float* bup; const float* rstd; const LAS int* tab; const LAS float* rl;
    __device__ __forceinline__ void operator()(const f32x4 (&acc)[2][2][4][2], const Unit& u, int wr, int wc, int fr, int fq) const {
        const int j0 = u.pn * HALF + wc * 32 + 8 * fq; const int cnt = tab[NE + 1 + u.e];
#if MK_EPI_LDS
        const LAS float* bl = rl + 256 + wc * 32 + 8 * fq;
        const f32x4 bg0 = *(const LAS f32x4*)(bl), bg1 = *(const LAS f32x4*)(bl + 4), bu0 = *(const LAS f32x4*)(bl + 128), bu1 = *(const LAS f32x4*)(bl + 132);
#else
        const f32x4 bg0 = *(const f32x4*)(bgate + (size_t)u.e * DM + j0), bg1 = *(const f32x4*)(bgate + (size_t)u.e * DM + j0 + 4);
        const f32x4 bu0 = *(const f32x4*)(bup + (size_t)u.e * DM + j0), bu1 = *(const f32x4*)(bup + (size_t)u.e * DM + j0 + 4);
#endif
#pragma unroll
        for (int ai = 0; ai < 2; ++ai) {
#if MK_FP8 && MK_FP6
            float X[4][8];
#endif
#pragma unroll
            for (int m = 0; m < 4; ++m) {
                const int r = ai * HALF + wr * 64 + m * 16 + fr, pos = u.rows0 + r;
                float rs = MK_EPI_LDS ? rl[r] : rstd[(size_t)u.e * ECAP + pos]; rs = pos < cnt ? rs : 0.f;
                const f32x4 g0 = acc[ai][0][m][0] * rs + bg0, g1 = acc[ai][0][m][1] * rs + bg1, u0 = acc[ai][1][m][0] * rs + bu0, u1 = acc[ai][1][m][1] * rs + bu1;
#if MK_FP8 && MK_FP6
                { const f32x2 h00 = swiglu_pk<1>((f32x2){g0[0], g0[1]}, (f32x2){u0[0], u0[1]}), h01 = swiglu_pk<1>((f32x2){g0[2], g0[3]}, (f32x2){u0[2], u0[3]});
                  const f32x2 h10 = swiglu_pk<1>((f32x2){g1[0], g1[1]}, (f32x2){u1[0], u1[1]}), h11 = swiglu_pk<1>((f32x2){g1[2], g1[3]}, (f32x2){u1[2], u1[3]});
                  X[m][0] = h00.x; X[m][1] = h00.y; X[m][2] = h01.x; X[m][3] = h01.y; X[m][4] = h10.x; X[m][5] = h10.y; X[m][6] = h11.x; X[m][7] = h11.y; }
#elif MK_FP8
                constexpr int SC8 = 1 << FP8_HDSHIFT;
                const f32x2 h00 = swiglu_pk<SC8>((f32x2){g0[0], g0[1]}, (f32x2){u0[0], u0[1]}), h01 = swiglu_pk<SC8>((f32x2){g0[2], g0[3]}, (f32x2){u0[2], u0[3]});
                const f32x2 h10 = swiglu_pk<SC8>((f32x2){g1[0], g1[1]}, (f32x2){u1[0], u1[1]}), h11 = swiglu_pk<SC8>((f32x2){g1[2], g1[3]}, (f32x2){u1[2], u1[3]});
                u32x2 w8; w8.x = pk_fp8x4_nc(h00, h01); w8.y = pk_fp8x4_nc(h10, h11);
                *(u32x2*)((unsigned char*)hdn + (size_t)(u.pm * BM + r) * DM + j0) = w8;
#else
                u32x4 w; w.x = cvt_pk_bf16(swiglu1(g0[0], u0[0]), swiglu1(g0[1], u0[1])); w.y = cvt_pk_bf16(swiglu1(g0[2], u0[2]), swiglu1(g0[3], u0[3]));
                w.z = cvt_pk_bf16(swiglu1(g1[0], u1[0]), swiglu1(g1[1], u1[1])); w.w = cvt_pk_bf16(swiglu1(g1[2], u1[2]), swiglu1(g1[3], u1[3]));
                *(u32x4*)(hdn + (size_t)(u.pm * BM + r) * DM + j0) = w;
#endif
            }
#if MK_FP8 && MK_FP6
            xpose4(X);
            u32x4 lo, hi; fp6_record((v16f_t){XROW16(X, 0), XROW16(X, 1)}, (v16f_t){XROW16(X, 2), XROW16(X, 3)}, lo, hi);
            unsigned char* rp = (unsigned char*)hdn + (size_t)(u.pm * BM + ai * HALF + wr * 64 + fq * 16 + fr) * DM + u.pn * 128 + 16 * wc;
            *(u32x4*)rp = lo; *(u32x4*)(rp + 64) = hi;
#endif
        }
    }
};
struct EpiDown {
    bf16_t* ys; const float* bdown; const float* gate; const LAS int* tab; const LAS float* rl;
    __device__ __forceinline__ void operator()(const f32x4 (&acc)[2][2][4][2], const Unit& u, int wr, int wc, int fr, int fq) const {
        const int cnt = tab[NE + 1 + u.e]; const int c0 = u.pn * BM + wc * 32 + 8 * fq;
#if MK_EPI_LDS
        const LAS float* bl = rl + 256 + wc * 32 + 8 * fq;
        const f32x4 b00 = *(const LAS f32x4*)(bl), b01 = *(const LAS f32x4*)(bl + 4), b10 = *(const LAS f32x4*)(bl + HALF), b11 = *(const LAS f32x4*)(bl + HALF + 4);
#else
        const float* bp = bdown + (size_t)u.e * DM + c0;
        const f32x4 b00 = *(const f32x4*)(bp), b01 = *(const f32x4*)(bp + 4), b10 = *(const f32x4*)(bp + HALF), b11 = *(const f32x4*)(bp + HALF + 4);
#endif
#pragma unroll
        for (int ai = 0; ai < 2; ++ai)
#pragma unroll
            for (int m = 0; m < 4; ++m) {
                const int r = ai * HALF + wr * 64 + m * 16 + fr, pos = u.rows0 + r;
                float gt = MK_EPI_LDS ? rl[r] : gate[(size_t)u.e * ECAP + pos]; gt = pos < cnt ? gt : 0.f;
#if MK_YS8
                const float gs = gt * (float)(1 << FP8_YSHIFT);
#if MK_YS16
                unsigned char* yp = (unsigned char*)ys + (size_t)(u.pm * BM + r) * DM + u.pn * BM + wc * 64 + fq * 16;
                { const f32x4 a = (acc[ai][0][m][0] + b00) * gs, b = (acc[ai][0][m][1] + b01) * gs, c = (acc[ai][1][m][0] + b10) * gs, d = (acc[ai][1][m][1] + b11) * gs;
                  u32x4 w16; w16.x = pk_fp8x4(a[0], a[1], a[2], a[3]); w16.y = pk_fp8x4(b[0], b[1], b[2], b[3]); w16.z = pk_fp8x4(c[0], c[1], c[2], c[3]); w16.w = pk_fp8x4(d[0], d[1], d[2], d[3]); *(u32x4*)yp = w16; }
#else
                unsigned char* yp = (unsigned char*)ys + (size_t)(u.pm * BM + r) * DM + c0;
                { const f32x4 a = (acc[ai][0][m][0] + b00) * gs, b = (acc[ai][0][m][1] + b01) * gs; u32x2 w8; w8.x = pk_fp8x4(a[0], a[1], a[2], a[3]); w8.y = pk_fp8x4(b[0], b[1], b[2], b[3]); *(u32x2*)yp = w8; }
                { const f32x4 a = (acc[ai][1][m][0] + b10) * gs, b = (acc[ai][1][m][1] + b11) * gs; u32x2 w8; w8.x = pk_fp8x4(a[0], a[1], a[2], a[3]); w8.y = pk_fp8x4(b[0], b[1], b[2], b[3]); *(u32x2*)(yp + HALF) = w8; }
#endif
#else
                bf16_t* yp = ys + (size_t)(u.pm * BM + r) * DM + c0;
                { const f32x4 a = (acc[ai][0][m][0] + b00) * gt, b = (acc[ai][0][m][1] + b01) * gt; u32x4 w; w.x = cvt_pk_bf16(a[0], a[1]); w.y = cvt_pk_bf16(a[2], a[3]); w.z = cvt_pk_bf16(b[0], b[1]); w.w = cvt_pk_bf16(b[2], b[3]); *(u32x4*)yp = w; }
                { const f32x4 a = (acc[ai][1][m][0] + b10) * gt, b = (acc[ai][1][m][1] + b11) * gt; u32x4 w; w.x = cvt_pk_bf16(a[0], a[1]); w.y = cvt_pk_bf16(a[2], a[3]); w.z = cvt_pk_bf16(b[0], b[1]); w.w = cvt_pk_bf16(b[2], b[3]); *(u32x4*)(yp + HALF) = w; }
#endif
            }
    }
};
}

typedef GAS unsigned gu32;
#define RLX_AGENT __ATOMIC_RELAXED, __HIP_MEMORY_SCOPE_AGENT
#define LDS_WAIT() asm volatile("s_waitcnt lgkmcnt(0)" ::: "memory")
#define VM_WAIT() asm volatile("s_waitcnt vmcnt(0)" ::: "memory")
#define XB_TMO      128
#define XB_XCNT(j)  (256  + 64 * (j))
#define XB_XSUB(j)  (1280 + 64 * (j))
#define XB_XGEN(j)  (2304 + 64 * (j))
#define XB_TOP      3328
#define XB_TOPGEN   3392
#define XCD_BAR_WORDS 3456
#define XB_SPIN_CAP (1u << 18)
__device__ __forceinline__ unsigned xb_ld(unsigned* p)              { return __hip_atomic_load(p, __ATOMIC_RELAXED, __HIP_MEMORY_SCOPE_AGENT); }
__device__ __forceinline__ unsigned xb_add(unsigned* p, unsigned v) { return __hip_atomic_fetch_add(p, v, __ATOMIC_RELAXED, __HIP_MEMORY_SCOPE_AGENT); }
__device__ __forceinline__ unsigned xb_xcc_id() { return (unsigned)__builtin_amdgcn_s_getreg((3 << 11) | 20) & 0xFu; }
#define XB_SPIN(cond, bar) do { unsigned _sp = 0; while (cond) { __builtin_amdgcn_s_sleep(1); \
    if ((++_sp & 255u) == 0u) { if (xb_ld(&(bar)[XB_TMO])) break; if (_sp > XB_SPIN_CAP) { atomicAdd(&(bar)[XB_TMO], 1u); break; } } } } while (0)
struct XcdBarrier { unsigned* bar; unsigned x; volatile LAS unsigned* st; };
__device__ __forceinline__ XcdBarrier xcd_barrier_post(unsigned* bar, volatile LAS unsigned* st) {
    XcdBarrier b; b.bar = bar; b.x = xb_xcc_id(); b.st = st;
    if (threadIdx.x == 0) (void)xb_add(&bar[XB_XCNT(b.x)], 1u);
    return b;
}
__device__ __forceinline__ void xcd_barrier_complete(unsigned* bar, unsigned x, unsigned& nloc, unsigned& nx) {
    const unsigned G = gridDim.x * gridDim.y * gridDim.z;
    unsigned sum, cnt, mine, sp = 0u;
    for (;;) {
        sum = 0u; cnt = 0u; mine = 0u;
#pragma unroll
        for (unsigned j = 0; j < 16; ++j) { const unsigned c = xb_ld(&bar[XB_XCNT(j)]); sum += c; cnt += (c > 0u) ? 1u : 0u; mine = (j == x) ? c : mine; }
        if (sum == G) break;
        __builtin_amdgcn_s_sleep(1);
        if ((++sp & 255u) == 0u) { if (xb_ld(&bar[XB_TMO])) break; if (sp > XB_SPIN_CAP) { atomicAdd(&bar[XB_TMO], 1u); break; } }
    }
    nloc = mine > 0u ? mine : 1u; nx = cnt > 0u ? cnt : 1u;
}
__device__ __forceinline__ void xcd_barrier(const XcdBarrier& b) {
    asm volatile("s_waitcnt vmcnt(0)" ::: "memory");
    __syncthreads();
    if (threadIdx.x == 0) {
        unsigned* bar = b.bar;
        __builtin_amdgcn_s_waitcnt(0);
        unsigned nloc = b.st[0], nx = b.st[1];
        if (nloc == 0u) { xcd_barrier_complete(bar, b.x, nloc, nx); b.st[0] = nloc; b.st[1] = nx; }
        const unsigned old = xb_add(&bar[XB_XSUB(b.x)], 1u);
        const unsigned gen = old / nloc;
        if (old + 1u == (gen + 1u) * nloc) {
            __builtin_amdgcn_fence(__ATOMIC_RELEASE, "agent");
            asm volatile("s_waitcnt vmcnt(0)" ::: "memory");
            const unsigned og = xb_add(&bar[XB_TOP], 1u);
            const unsigned tg = og / nx;
            if (og + 1u == (tg + 1u) * nx) xb_add(&bar[XB_TOPGEN], 1u);
            else XB_SPIN(xb_ld(&bar[XB_TOPGEN]) == tg, bar);
            __builtin_amdgcn_fence(__ATOMIC_ACQUIRE, "agent");
            xb_add(&bar[XB_XGEN(b.x)], 1u);
            asm volatile("s_waitcnt vmcnt(0)" ::: "memory");
        } else {
            XB_SPIN(xb_ld(&bar[XB_XGEN(b.x)]) == gen, bar);
            __builtin_amdgcn_fence(__ATOMIC_ACQUIRE, "agent");
            asm volatile("s_waitcnt vmcnt(0)" ::: "memory");
        }
    }
    __syncthreads();
}

struct Args { const void* in[22]; float* out; unsigned char* ws; int ph_lo, ph_hi; };
typedef __attribute__((address_space(4))) const volatile Args* KArgs;
#define KIN(k) ((const void*)ka->in[k])
struct Frame {
    LAS unsigned char* lds; int wave, G, vcu;
    gu32* ctl; unsigned char* ws;
};

__device__ __forceinline__ void tr_item(const float* W, size_t ldw, int k0, int c0a, int c0b, bool perm, bf16_t* dst  , LAS float* scr, int lane) {
    const int kr = lane >> 4, q = lane & 15; const int col = (q < 8) ? c0a + 4 * q : c0b + 4 * (q - 8);
    f32x4 v[16];
#pragma unroll
    for (int it = 0; it < 16; ++it) v[it] = *(const f32x4*)(W + (size_t)(k0 + 4 * it + kr) * ldw + col);
#pragma unroll
    for (int it = 0; it < 16; ++it) { const int k = 4 * it + kr; *(LAS f32x4*)(scr + k * 64 + 4 * (q ^ ((k >> 3) & 7))) = v[it]; }
    LDS_WAIT(); asm volatile("" ::: "memory");
    const int n0l = lane >> 3, c = lane & 7;
#pragma unroll
    for (int j = 0; j < 8; ++j) { const int n = n0l + 8 * j; const int slot = perm ? ((n >> 1) + 32 * (n & 1)) : n;
        const LAS float* s = scr + (8 * c) * 64 + 4 * ((slot >> 2) ^ c) + (slot & 3);
        u32x4 o; o.x = pk2(s[0 * 64], s[1 * 64]); o.y = pk2(s[2 * 64], s[3 * 64]); o.z = pk2(s[4 * 64], s[5 * 64]); o.w = pk2(s[6 * 64], s[7 * 64]);
        *(u32x4*)(dst + (size_t)n * DM + k0 + 8 * c) = o; }
    LDS_WAIT(); asm volatile("" ::: "memory");
}
__device__ __forceinline__ void tr8_load(f32x4 (&v)[16], const float* W, size_t ldw, int k0, int c0, int lane) {
    const int kr = lane >> 3, q = lane & 7; const float* p = W + (size_t)(k0 + kr) * ldw + c0 + 4 * q;
#pragma unroll
    for (int it = 0; it < 16; ++it) v[it] = __builtin_nontemporal_load((const f32x4*)(p + (size_t)(8 * it) * ldw));
}
__device__ __forceinline__ void tr6_put(const f32x4 (&v)[16], LAS float* scr, int lane) {
    const int kr = lane >> 3, q = lane & 7;
#pragma unroll
    for (int it = 0; it < 16; ++it) { const int k = 8 * it + kr; *(LAS f32x4*)(scr + k * 32 + 4 * (q ^ ((k >> 4) & 7))) = v[it]; }
    LDS_WAIT(); asm volatile("" ::: "memory");
}
__device__ __forceinline__ void tr6_emit(int k0, unsigned char* dst, LAS float* scr, int lane) {
#pragma unroll
    for (int jj = 0; jj < 2; ++jj) { const int p = lane + 64 * jj, n = p >> 2, ch = p & 3;
        v16f_t a, b;
#pragma unroll
        for (int i = 0; i < 16; ++i) { const int ka = 32 * ch + i, kb = ka + 16;
            a[i] = scr[ka * 32 + 4 * ((n >> 2) ^ (2 * ch)) + (n & 3)]; b[i] = scr[kb * 32 + 4 * ((n >> 2) ^ (2 * ch + 1)) + (n & 3)]; }
        u32x4 lo, hi; fp6_record(a, b, lo, hi);
        unsigned char* rp = dst + (size_t)n * DM + k0 + 16 * ch;
        __builtin_nontemporal_store(lo, (u32x4*)rp); __builtin_nontemporal_store(hi, (u32x4*)(rp + 64)); }
    LDS_WAIT(); asm volatile("" ::: "memory");
}
__device__ __forceinline__ void tr6_store(const f32x4 (&v)[16], int k0, unsigned char* dst, LAS float* scr, int lane) { tr6_put(v, scr, lane); tr6_emit(k0, dst, scr, lane); }
__device__ __forceinline__ void tr8_store(const f32x4 (&v)[16], int k0, unsigned char* dst  , LAS float* scr, int lane) {
    const int kr = lane >> 3, q = lane & 7;
#pragma unroll
    for (int it = 0; it < 16; ++it) { const int k = 8 * it + kr; *(LAS f32x4*)(scr + k * 32 + 4 * (q ^ ((k >> 4) & 7))) = v[it]; }
    LDS_WAIT(); asm volatile("" ::: "memory");
    const int n0l = lane >> 3, c = lane & 7; constexpr float sc8 = (float)(1 << FP8_WSHIFT);
#pragma unroll
    for (int j = 0; j < 4; ++j) { const int n = n0l + 8 * j;
        const LAS float* s = scr + (16 * c) * 32 + 4 * ((n >> 2) ^ c) + (n & 3);
        u32x4 o; o.x = pk_fp8x4(s[0 * 32] * sc8, s[1 * 32] * sc8, s[2 * 32] * sc8, s[3 * 32] * sc8); o.y = pk_fp8x4(s[4 * 32] * sc8, s[5 * 32] * sc8, s[6 * 32] * sc8, s[7 * 32] * sc8);
        o.z = pk_fp8x4(s[8 * 32] * sc8, s[9 * 32] * sc8, s[10 * 32] * sc8, s[11 * 32] * sc8); o.w = pk_fp8x4(s[12 * 32] * sc8, s[13 * 32] * sc8, s[14 * 32] * sc8, s[15 * 32] * sc8);
        *(u32x4*)(dst + (size_t)n * DM + k0 + 16 * c) = o; }
    LDS_WAIT(); asm volatile("" ::: "memory");
}
__device__ __forceinline__ float log2_sigmoid(float z) {
    const float az = fabsf(z); const float e = __builtin_amdgcn_exp2f(-az * L2E);
    return fminf(z, 0.f) * L2E - __builtin_amdgcn_logf(1.0f + e) ;
}
__device__ __forceinline__ void p0_prologue(Frame& F, KArgs ka) {
    const float* x = (const float*)KIN(0); const int* pos = (const int*)KIN(1); const float* g_attn = (const float*)KIN(2); const float* w_in = (const float*)KIN(3);
    const float* b_forget = (const float*)KIN(4); const float* w_out = (const float*)KIN(11); const float* g_ffn = (const float*)KIN(12); const float* w_router = (const float*)KIN(13);
    const float* w_gate = (const float*)KIN(15); const float* w_up = (const float*)KIN(17); const float* w_down = (const float*)KIN(19);
    const int gw = F.vcu * NWAVES + F.wave, NGW = F.G * NWAVES; const int gt = F.vcu * NTHREADS + ((int)threadIdx.x), NGT = F.G * NTHREADS;
    { float* rope = (float*)(F.ws + WS_ROPE);
#pragma unroll 8
      for (int p = gt; p < MTOK * 64; p += NGT) { const int m = p >> 6, i = p & 63;
          const float invf = exp2f(-(float)i * 0.20762050593046014f); const float ang = (float)pos[m] * invf;
          const double rv = (double)ang * 0.15915494309189533576888; const float rev = (float)(rv - floor(rv));
          *(f32x2*)(rope + (size_t)p * 2) = (f32x2){__builtin_amdgcn_cosf(rev), __builtin_amdgcn_sinf(rev)}; } }
    { bf16_t* gwf = (bf16_t*)(F.ws + WS_GWF);
      for (int f = gt; f < 64 * 2 * 2 * 64; f += NGT) { const int ln = f & 63, p = (f >> 6) & 1, eh = (f >> 7) & 1, s = f >> 8;
          unsigned o[4];
#pragma unroll
          for (int j2 = 0; j2 < 4; ++j2) { unsigned hv[2];
#pragma unroll
              for (int q = 0; q < 2; ++q) { const int k = 32 * s + 8 * (ln >> 4) + 2 * j2 + q, e = 16 * eh + (ln & 15); const float val = g_ffn[k] * w_router[k * NE + e];
                  const unsigned hi = f2bf(val); const float lo = val - bf2f((unsigned short)hi); hv[q] = p ? f2bf(lo) : hi; }
              o[j2] = hv[0] | (hv[1] << 16); }
          *(u32x4*)(gwf + (size_t)f * 8) = (u32x4){o[0], o[1], o[2], o[3]}; } }
    { LAS float* gwfT = (LAS float*)F.lds;
#pragma unroll 4
      for (int k = ((int)threadIdx.x); k < DM; k += NTHREADS) { const f32x4 w0 = *(const f32x4*)(w_in + (size_t)k * INC + NQKV), w1 = *(const f32x4*)(w_in + (size_t)k * INC + NQKV + 4); const float g = g_attn[k];
          gwfT[0 * DM + k] = g * w0.x; gwfT[1 * DM + k] = g * w0.y; gwfT[2 * DM + k] = g * w0.z; gwfT[3 * DM + k] = g * w0.w; gwfT[4 * DM + k] = g * w1.x; gwfT[5 * DM + k] = g * w1.y; gwfT[6 * DM + k] = g * w1.z; gwfT[7 * DM + k] = g * w1.w; }
      __syncthreads();
      bf16_t* XN = (bf16_t*)(F.ws + WS_XN); float* flog = (float*)(F.ws + WS_FLOG);
      f32x4 gv[8];
#pragma unroll
      for (int j = 0; j < 8; ++j) gv[j] = *((const f32x4*)g_attn + ((int)(threadIdx.x & 63)) + 64 * j);
      f32x4 vn[8];
      if (gw < MTOK) { const f32x4* xr = (const f32x4*)(x + (size_t)gw * DM) + ((int)(threadIdx.x & 63));
#pragma unroll
          for (int j = 0; j < 8; ++j) vn[j] = __builtin_nontemporal_load(xr + 64 * j); }
      for (int m = gw; m < MTOK; m += NGW) {
          f32x4 v[8]; float s = 0.f;
#pragma unroll
          for (int j = 0; j < 8; ++j) { v[j] = vn[j]; s += (v[j].x * v[j].x + v[j].y * v[j].y) + (v[j].z * v[j].z + v[j].w * v[j].w); }
          if (m + NGW < MTOK) { const f32x4* xr = (const f32x4*)(x + (size_t)(m + NGW) * DM) + ((int)(threadIdx.x & 63));
#pragma unroll
              for (int j = 0; j < 8; ++j) vn[j] = __builtin_nontemporal_load(xr + 64 * j); }
          const float rstd = 1.0f / sqrtf(wave_sum(s) * (1.0f / DM) + EPS);
          unsigned long long* o8 = (unsigned long long*)(XN + (size_t)m * DM) + ((int)(threadIdx.x & 63));
#pragma unroll
          for (int j = 0; j < 8; ++j) { const f32x4 t = v[j] * gv[j] * rstd; o8[64 * j] = (unsigned long long)pk2(t.x, t.y) | ((unsigned long long)pk2(t.z, t.w) << 32); }
          float myz = 0.f;
#pragma unroll 1
          for (int jh = 0; jh < 8; ++jh) { float acc = 0.f;
#pragma unroll
              for (int j = 0; j < 8; ++j) { const f32x4 w = *(const LAS f32x4*)(gwfT + jh * DM + 256 * j + 4 * ((int)(threadIdx.x & 63))); acc += (v[j].x * w.x + v[j].y * w.y) + (v[j].z * w.z + v[j].w * w.w); }
              acc = wave_sum(acc); if (((int)(threadIdx.x & 63)) == jh) myz = acc; }
          if (((int)(threadIdx.x & 63)) < 8) flog[(size_t)m * 8 + ((int)(threadIdx.x & 63))] = log2_sigmoid(myz * rstd + b_forget[((int)(threadIdx.x & 63))]);
      }
      __syncthreads();
    }
    { LAS float* scr = (LAS float*)(F.lds + F.wave * 16384);
      bf16_t* Win = (bf16_t*)(F.ws + WS_WIN); bf16_t* Wout = (bf16_t*)(F.ws + WS_WOUT); bf16_t* Wgu = (bf16_t*)(F.ws + WS_WGU); bf16_t* Wd = (bf16_t*)(F.ws + WS_WD);
      constexpr int I_IN = 32 * 96, I_OUT = 32 * 32, I_GU = NE * 32 * 64, I_D = NE * 32 * 32, NITEMS = I_IN + I_OUT + I_GU + I_D;
      for (int it = gw; it < NITEMS; it += NGW) {
          int r = it;
          if (r < I_IN) { const int kb = r / 96, nb = r % 96, n0 = nb * 64;
              if (n0 < 2048) { const int base = n0 & ~127, i0 = ((n0 >> 6) & 1) * 32; tr_item(w_in, INC, kb * 64, base + i0, base + 64 + i0, true, Win + (size_t)n0 * DM, scr, ((int)(threadIdx.x & 63))); }
              else tr_item(w_in, INC, kb * 64, n0, n0 + 32, false, Win + (size_t)n0 * DM, scr, ((int)(threadIdx.x & 63)));
              continue; }
          r -= I_IN;
          if (r < I_OUT) { const int kb = r / 32, nb = r % 32; tr_item(w_out, DM, kb * 64, nb * 64, nb * 64 + 32, false, Wout + (size_t)nb * 64 * DM, scr, ((int)(threadIdx.x & 63))); continue; }
          r -= I_OUT;
#if MK_FP8
          break;
#else
          if (r < I_GU) { const int e = r / (32 * 64), rr = r % (32 * 64), kb = rr / 64, nb = rr % 64;
              const int pn = nb >> 2, w = nb & 3; const float* src = (w < 2 ? w_gate : w_up) + (size_t)e * DM * DM; const int c0 = pn * 128 + (w & 1) * 64;
              tr_item(src, DM, kb * 64, c0, c0 + 32, false, Wgu + ((size_t)e * 4096 + (size_t)nb * 64) * DM, scr, ((int)(threadIdx.x & 63))); continue; }
          r -= I_GU;
          { const int e = r / (32 * 32), rr = r % (32 * 32), kb = rr / 32, nb = rr % 32;
            tr_item(w_down + (size_t)e * DM * DM, DM, kb * 64, nb * 64, nb * 64 + 32, false, Wd + ((size_t)e * DM + (size_t)nb * 64) * DM, scr, ((int)(threadIdx.x & 63))); }
#endif
      }
    }
}

__device__ __forceinline__ void probe_stream(Frame& F, KArgs ka) {
    const float* src[3] = {(const float*)KIN(15), (const float*)KIN(17), (const float*)KIN(19)};
    const size_t n4 = (size_t)NE * DM * DM / 4; const size_t gt = (size_t)F.vcu * NTHREADS + threadIdx.x, NGT = (size_t)F.G * NTHREADS;
#pragma unroll
    for (int m = 0; m < 3; ++m) { unsigned* dst = (unsigned*)(F.ws + WS_HDN) + (size_t)m * n4;
#pragma unroll 8
        for (size_t i = gt; i < n4; i += NGT) { const f32x4 v = __builtin_nontemporal_load((const f32x4*)src[m] + i); dst[i] = pk_fp8x4(v.x * 256.f, v.y * 256.f, v.z * 256.f, v.w * 256.f); } }
}
#if MK_FP8
#if MK_FP6
#define P0B_STORE(v, k0, dst, scr, lane) tr6_store(v, k0, dst, scr, lane)
#else
#define P0B_STORE(v, k0, dst, scr, lane) tr8_store(v, k0, dst, scr, lane)
#endif
constexpr int P0B_ROWB = DM;
constexpr int P0B_IGU = NE * 32 * 64, P0B_ID = NE * 32 * 32, P0B_NI = P0B_IGU + P0B_ID;
__device__ __forceinline__ void p0b_experts(Frame& F, KArgs ka, const int it_lo, const int it_hi, const int rankw, const int nw, unsigned* dyn) {
    const float* w_gate = (const float*)KIN(15); const float* w_up = (const float*)KIN(17); const float* w_down = (const float*)KIN(19);
    constexpr int I_GU = P0B_IGU;
    LAS float* scr = (LAS float*)(F.lds + F.wave * 16384);
    bf16_t* Wgu = (bf16_t*)(F.ws + WS_WGU); bf16_t* Wd = (bf16_t*)(F.ws + WS_WD);
    __syncthreads();
      { const int lane = (int)(threadIdx.x & 63);
#define FP8_DESC(r_, SRC, K0, C0, DST) do { int r2 = (r_); \
          if (r2 < I_GU) { const int e = r2 / (16 * 128), rr = r2 % (16 * 128), kb = rr / 128, nb = rr % 128; const int pn = nb >> 3, w = nb & 7; \
              SRC = (w < 4 ? w_gate : w_up) + (size_t)e * DM * DM; C0 = pn * 128 + (w & 3) * 32; K0 = kb * 128; const size_t row = (size_t)e * 4096 + (size_t)nb * 32; \
              DST = (unsigned char*)Wgu + row * P0B_ROWB; } \
          else { r2 -= I_GU; const int e = r2 / (16 * 64), rr = r2 % (16 * 64), kb = rr / 64, nb = rr % 64; \
              SRC = w_down + (size_t)e * DM * DM; C0 = nb * 32; K0 = kb * 128; const size_t row = (size_t)e * DM + (size_t)nb * 32; \
              DST = (unsigned char*)Wd + row * P0B_ROWB; } } while (0)
        f32x4 va[16], vb[16]; const float* src; int k0 = 0, c0 = 0; unsigned char* dst = nullptr; const float* srcn; int k0n = 0, c0n = 0; unsigned char* dstn = nullptr;
#if MK_FP6
#define P0B_NEXT(last) (dyn != nullptr ? it_lo + __builtin_amdgcn_readfirstlane(lane == 0 ? (int)__hip_atomic_fetch_add(dyn, 1u, __ATOMIC_RELAXED, __HIP_MEMORY_SCOPE_AGENT) : 0) : (last) + nw)
        int last = P0B_NEXT(it_lo + rankw - nw), ia = last;
        if (ia < it_hi) { FP8_DESC(ia, src, k0, c0, dst); tr8_load(va, src, DM, k0, c0, lane); }
        last = P0B_NEXT(last); int ib = last;
        if (ib < it_hi) { FP8_DESC(ib, srcn, k0n, c0n, dstn); tr8_load(vb, srcn, DM, k0n, c0n, lane); }
        for (;;) {
            if (ia >= it_hi) break;
            { tr6_put(va, scr, lane); const int ke = k0; unsigned char* de = dst;
              last = P0B_NEXT(last); ia = last;
              if (ia < it_hi) { FP8_DESC(ia, src, k0, c0, dst); tr8_load(va, src, DM, k0, c0, lane); }
              tr6_emit(ke, de, scr, lane); }
            if (ib >= it_hi) break;
            { tr6_put(vb, scr, lane); const int ke = k0n; unsigned char* de = dstn;
              last = P0B_NEXT(last); ib = last;
              if (ib < it_hi) { FP8_DESC(ib, srcn, k0n, c0n, dstn); tr8_load(vb, srcn, DM, k0n, c0n, lane); }
              tr6_emit(ke, de, scr, lane); }
        }
#undef P0B_NEXT
#else
        const int NGW = nw; int it = it_lo + rankw;
        if (it < it_hi) { FP8_DESC(it, src, k0, c0, dst); tr8_load(va, src, DM, k0, c0, lane); }
        while (it < it_hi) {
            int itn = it + NGW;
            if (itn < it_hi) { FP8_DESC(itn, srcn, k0n, c0n, dstn); tr8_load(vb, srcn, DM, k0n, c0n, lane); }
            P0B_STORE(va, k0, dst, scr, lane);
            it = itn; if (it >= it_hi) break;
            itn = it + NGW;
            if (itn < it_hi) { FP8_DESC(itn, src, k0, c0, dst); tr8_load(va, src, DM, k0, c0, lane); }
            P0B_STORE(vb, k0n, dstn, scr, lane);
            it = itn;
        }
#endif
#undef FP8_DESC
      }
    __syncthreads();
}
#endif
__device__ __forceinline__ void p1_scan(Frame& F) {
    if (blockIdx.x >= BATCH * 8) return;
    const int bh = blockIdx.x, b = bh >> 3, h = bh & 7, t = ((int)threadIdx.x);
    const float* flog = (const float*)(F.ws + WS_FLOG); float* clog = (float*)(F.ws + WS_CLOG) + (size_t)bh * SEQ;
    LAS double* sc = (LAS double*)F.lds;
    double loc[8]; double run = 0.0;
#pragma unroll
    for (int i = 0; i < 8; ++i) { run += (double)flog[(size_t)(b * SEQ + t * 8 + i) * 8 + h]; loc[i] = run; }
    double v = run; const int ln = t & 63, wv = t >> 6;
#pragma unroll
    for (int o = 1; o < 64; o <<= 1) { const double n = __shfl_up(v, o); v = ln >= o ? v + n : v; }
    if (ln == 63) sc[wv] = v;
    __syncthreads();
    double base = v - run;
#pragma unroll
    for (int w = 0; w < NWAVES - 1; ++w) { const double wt = sc[w]; base += w < wv ? wt : 0.0; }
#pragma unroll
    for (int i = 0; i < 8; ++i) clog[t * 8 + i] = (float)(base + loc[i]);
    __syncthreads();
}

__device__ __forceinline__ void p_norms(Frame& F) {
    const bf16_t* QKV = (const bf16_t*)(F.ws + WS_QKV);
    const int lane = (int)(threadIdx.x & 63), gw = F.vcu * NWAVES + F.wave, NGW = F.G * NWAVES;
    for (int task = gw; task < 2 * 32 * 16; task += NGW) {
        const int isk = task >> 9, bh = (task >> 4) & 31, ch = task & 15, b = bh >> 3, h = bh & 7;
        const bf16_t* base = QKV + ((size_t)((isk ? 32 : 24) + h) * MTOK + (size_t)b * SEQ + ch * 256) * 128 + (lane >> 4) * 128 + (lane & 15) * 8;
        float mx = 0.f;
#pragma unroll 4
        for (int it = 0; it < 64; ++it) {
            const u32x4 w = *(const u32x4*)(base + (size_t)it * 4 * 128);
            float ss = 0.f;
#pragma unroll
            for (int j = 0; j < 4; ++j) { const float a = bf2f((unsigned short)(w[j] & 0xffff)), c = bf2f((unsigned short)(w[j] >> 16)); ss += a * a + c * c; }
            ss += __shfl_xor(ss, 1); ss += __shfl_xor(ss, 2); ss += __shfl_xor(ss, 4); ss += __shfl_xor(ss, 8);
            mx = fmaxf(mx, ss);
        }
        mx = fmaxf(mx, __shfl_xor(mx, 16)); mx = fmaxf(mx, __shfl_xor(mx, 32));
        if (lane == 0) atomicMax((unsigned*)(F.ctl + (isk ? CW_KMAX + bh : CW_QMAX + bh * 16 + ch)), __float_as_uint(mx));
    }
}

__device__ __forceinline__ void p3_mix(Frame& F, KArgs ka) {
    const float* lq1 = (const float*)KIN(5); const float* lk1 = (const float*)KIN(6); const float* lq2 = (const float*)KIN(7); const float* lk2 = (const float*)KIN(8);
    const float* gd = (const float*)KIN(9); const float* gf = (const float*)KIN(10);
    const int l = ((int)(threadIdx.x & 63));
    const float s1 = wave_sum(lq1[l] * lk1[l] + lq1[l + 64] * lk1[l + 64]), s2 = wave_sum(lq2[l] * lk2[l] + lq2[l + 64] * lk2[l + 64]);
    const float lam = expf(s1) - expf(s2) + 0.2f;
    const bf16_t* O = (const bf16_t*)(F.ws + WS_O); bf16_t* mix = (bf16_t*)(F.ws + WS_MIX);
    const f32x2 gd0 = *(const f32x2*)(gd + 2 * l), gd1 = *(const f32x2*)(gd + 128 + 2 * l), gfv = *(const f32x2*)(gf + 2 * l);
    const int gw = F.vcu * NWAVES + F.wave, NGW = F.G * NWAVES;
    for (int m = gw; m < MTOK; m += NGW) {
        unsigned ov[24];
#pragma unroll
        for (int vh = 0; vh < 24; ++vh) ov[vh] = *(const unsigned*)(O + ((size_t)vh * MTOK + m) * 128 + 2 * l);
        unsigned* mrow = (unsigned*)(mix + (size_t)m * DM);
#pragma unroll
        for (int h = 0; h < 4; ++h) {
            const unsigned a0 = ov[8 + h * 4 + 0], a1 = ov[8 + h * 4 + 1], b0 = ov[8 + h * 4 + 2], b1 = ov[8 + h * 4 + 3];
            const float d00 = bf2f(a0 & 0xffff) - lam * bf2f(b0 & 0xffff), d01 = bf2f(a0 >> 16) - lam * bf2f(b0 >> 16);
            const float d10 = bf2f(a1 & 0xffff) - lam * bf2f(b1 & 0xffff), d11 = bf2f(a1 >> 16) - lam * bf2f(b1 >> 16);
            const float ss = wave_sum((d00 * d00 + d01 * d01) + (d10 * d10 + d11 * d11));
            const float rs = 0.8f / sqrtf(ss * (1.0f / 256.0f) + EPS);
            mrow[(h * 256) / 2 + l] = pk2(d00 * rs * gd0.x, d01 * rs * gd0.y);
            mrow[(h * 256 + 128) / 2 + l] = pk2(d10 * rs * gd1.x, d11 * rs * gd1.y);
        }
#pragma unroll
        for (int h = 0; h < 8; ++h) {
            const float f0 = bf2f(ov[h] & 0xffff), f1 = bf2f(ov[h] >> 16);
            const float ss = wave_sum(f0 * f0 + f1 * f1);
            const float rs = 1.0f / sqrtf(ss * (1.0f / 128.0f) + EPS);
            mrow[(1024 + h * 128) / 2 + l] = pk2(f0 * rs * gfv.x, f1 * rs * gfv.y);
        }
    }
}

__device__ __forceinline__ void p5_router(Frame& F, KArgs ka, const float* hbuf) {
    const float* b_router = (const float*)KIN(14);
    const bf16_t* gwf = (const bf16_t*)(F.ws + WS_GWF);
    int* tke = (int*)(F.ws + WS_TKE); int* tokl = (int*)(F.ws + WS_TOK); float* rstdl = (float*)(F.ws + WS_RSTD); float* gatel = (float*)(F.ws + WS_GATE);
    LAS float* sc = (LAS float*)(F.lds + F.wave * 4096);
    const int l = ((int)(threadIdx.x & 63)), r16 = l & 15, kq = l >> 4;
    const int gw = F.vcu * NWAVES + F.wave, NGW = F.G * NWAVES;
    if (((int)threadIdx.x) < NE) ((LAS int*)(F.lds + 8 * 4096))[((int)threadIdx.x)] = 0;
    __syncthreads();
    for (int item = gw; item < MTOK / 8; item += NGW) {
        const int tile = item >> 1, kh = item & 1;
        const float* hr = hbuf + (size_t)(tile * 16 + r16) * DM + 8 * kq + 1024 * kh;
        f32x4 acc0 = {0.f, 0.f, 0.f, 0.f}, acc1 = {0.f, 0.f, 0.f, 0.f}; float ss = 0.f;
        f32x4 va[2][4], vb[2][4];
#define P5_LOAD(bf_, s4_) do { _Pragma("unroll") for (int u = 0; u < 4; ++u) { va[bf_][u] = __builtin_nontemporal_load((const f32x4*)(hr + 32 * (4 * (s4_) + u))); vb[bf_][u] = __builtin_nontemporal_load((const f32x4*)(hr + 32 * (4 * (s4_) + u) + 4)); } } while (0)
        P5_LOAD(0, 0);
#pragma unroll 1
        for (int s8 = 0; s8 < 8; s8 += 2) {
#pragma unroll
          for (int hb_ = 0; hb_ < 2; ++hb_) { const int s4 = s8 + hb_;
            if (hb_ == 0) P5_LOAD(1, s4 + 1); else if (s4 < 7) P5_LOAD(0, s4 + 1);
#pragma unroll
            for (int u = 0; u < 4; ++u) { const f32x4 v0 = va[hb_][u], v1 = vb[hb_][u];
            ss += (v0.x * v0.x + v0.y * v0.y) + (v0.z * v0.z + v0.w * v0.w) + (v1.x * v1.x + v1.y * v1.y) + (v1.z * v1.z + v1.w * v1.w);
            unsigned hi[4], lo[4];
#define SPL(i, A, B) do { const unsigned ha = f2bf(A), hb = f2bf(B); hi[i] = ha | (hb << 16); lo[i] = pk2(A - bf2f((unsigned short)ha), B - bf2f((unsigned short)hb)); } while (0)
            SPL(0, v0.x, v0.y); SPL(1, v0.z, v0.w); SPL(2, v1.x, v1.y); SPL(3, v1.z, v1.w);
#undef SPL
            const u32x4 hiv = {hi[0], hi[1], hi[2], hi[3]}, lov = {lo[0], lo[1], lo[2], lo[3]};
            const bf16x8 ah = __builtin_bit_cast(bf16x8, hiv), al = __builtin_bit_cast(bf16x8, lov);
            const bf16x8* bf = (const bf16x8*)(gwf + (size_t)(32 * kh + 4 * s4 + u) * 4 * 512) + l;
            const bf16x8 b0h = bf[0], b0l = bf[64], b1h = bf[128], b1l = bf[192];
            acc0 = __builtin_amdgcn_mfma_f32_16x16x32_bf16(ah, b0h, acc0, 0, 0, 0); acc0 = __builtin_amdgcn_mfma_f32_16x16x32_bf16(al, b0h, acc0, 0, 0, 0); acc0 = __builtin_amdgcn_mfma_f32_16x16x32_bf16(ah, b0l, acc0, 0, 0, 0);
            acc1 = __builtin_amdgcn_mfma_f32_16x16x32_bf16(ah, b1h, acc1, 0, 0, 0); acc1 = __builtin_amdgcn_mfma_f32_16x16x32_bf16(al, b1h, acc1, 0, 0, 0); acc1 = __builtin_amdgcn_mfma_f32_16x16x32_bf16(ah, b1l, acc1, 0, 0, 0);
            }
          }
        }
#undef P5_LOAD
        { LAS float* px = (LAS float*)(F.lds + (F.wave | 1) * 4096) + 9 * l;
          if (kh) { px[0] = acc0[0]; px[1] = acc0[1]; px[2] = acc0[2]; px[3] = acc0[3]; px[4] = acc1[0]; px[5] = acc1[1]; px[6] = acc1[2]; px[7] = acc1[3]; px[8] = ss; }
          __syncthreads();
          if (!kh) { acc0[0] += px[0]; acc0[1] += px[1]; acc0[2] += px[2]; acc0[3] += px[3]; acc1[0] += px[4]; acc1[1] += px[5]; acc1[2] += px[6]; acc1[3] += px[7]; ss += px[8]; } }
        if (kh == 0) {
        ss += __shfl_xor(ss, 16); ss += __shfl_xor(ss, 32);
        const float rstd = 1.0f / sqrtf(ss * (1.0f / DM) + EPS);
        if (kq == 0) sc[16 * 33 + r16] = rstd;
        LDS_WAIT(); asm volatile("" ::: "memory");
#pragma unroll
        for (int rg = 0; rg < 4; ++rg) { const int tr = 4 * kq + rg; const float rt = sc[16 * 33 + tr];
            sc[tr * 33 + r16] = acc0[rg] * rt + b_router[r16]; sc[tr * 33 + 16 + r16] = acc1[rg] * rt + b_router[16 + r16]; }
        LDS_WAIT(); asm volatile("" ::: "memory");
        }
        LAS int* cntL = (LAS int*)(F.lds + 8 * 4096); LAS int* baseL = cntL + 32;
        int m = 0, ti[TOPK] = {0, 0, 0, 0}, rk[TOPK] = {0, 0, 0, 0}; float gk[TOPK] = {0.f, 0.f, 0.f, 0.f}, rt = 0.f;
        const bool sel = kh == 0 && l < 16;
        if (sel) {
            m = tile * 16 + l; float lg[NE];
#pragma unroll
            for (int e = 0; e < NE; ++e) lg[e] = sc[l * 33 + e];
            float tv[TOPK];
#pragma unroll
            for (int k = 0; k < TOPK; ++k) { float best = -3.4e38f; int bi = 0;
#pragma unroll
                for (int e = 0; e < NE; ++e) { const bool c = lg[e] > best; best = c ? lg[e] : best; bi = c ? e : bi; }
                tv[k] = best; ti[k] = bi;
#pragma unroll
                for (int e = 0; e < NE; ++e) lg[e] = (e == bi) ? -3.4e38f : lg[e]; }
            const float e1 = __expf(tv[1] - tv[0]), e2 = __expf(tv[2] - tv[0]), e3 = __expf(tv[3] - tv[0]); const float inv = 1.0f / (1.0f + e1 + e2 + e3);
            gk[0] = inv; gk[1] = e1 * inv; gk[2] = e2 * inv; gk[3] = e3 * inv; rt = sc[16 * 33 + l];
#pragma unroll
            for (int k = 0; k < TOPK; ++k) rk[k] = __hip_atomic_fetch_add((int*)(cntL + ti[k]), 1, __ATOMIC_RELAXED, __HIP_MEMORY_SCOPE_WORKGROUP);
        }
        LDS_WAIT(); asm volatile("" ::: "memory");
        __syncthreads();
        if (((int)threadIdx.x) < NE) { const int c = cntL[((int)threadIdx.x)]; int b = 0;
            if (c > 0) b = (int)__hip_atomic_fetch_add((unsigned*)(F.ctl + CW_CNT + 64 * ((int)threadIdx.x)), (unsigned)c, RLX_AGENT);
            baseL[((int)threadIdx.x)] = b; cntL[((int)threadIdx.x)] = 0; }
        LDS_WAIT(); asm volatile("" ::: "memory");
        __syncthreads();
        if (sel) {
#pragma unroll
            for (int k = 0; k < TOPK; ++k) { const int e = ti[k]; const int pos = baseL[e] + rk[k];
                tokl[(size_t)e * ECAP + pos] = m; rstdl[(size_t)e * ECAP + pos] = rt; gatel[(size_t)e * ECAP + pos] = gk[k]; tke[m * TOPK + k] = pos * 32 + e; }
        }
        LDS_WAIT(); asm volatile("" ::: "memory");
        __syncthreads();
    }
}

__device__ __forceinline__ void build_tab(Frame& F, LAS int* tab, bool publish) {
    if (((int)threadIdx.x) < NE) tab[NE + 1 + ((int)threadIdx.x)] = (int)__hip_atomic_load(F.ctl + CW_CNT + 64 * ((int)threadIdx.x), RLX_AGENT);
    __syncthreads();
    if (((int)threadIdx.x) == 0) { int s = 0; for (int e = 0; e < NE; ++e) { tab[e] = s; s += (tab[NE + 1 + e] + 255) >> 8; } tab[NE] = s; }
    __syncthreads();
    if (publish && blockIdx.x == 0 && ((int)threadIdx.x) <= NE) ((int*)(F.ws + WS_TSTART))[((int)threadIdx.x)] = tab[((int)threadIdx.x)];
}

__device__ __forceinline__ void p8_final(Frame& F, KArgs ka, float* hout) {
    const float* gfin = (const float*)KIN(21);
    const bf16_t* ys = (const bf16_t*)(F.ws + WS_YS); const int* tke = (const int*)(F.ws + WS_TKE); const int* tstart = (const int*)(F.ws + WS_TSTART);
    const int gw = F.vcu * NWAVES + F.wave, NGW = F.G * NWAVES;
    f32x4 gv[8];
#pragma unroll
    for (int j = 0; j < 8; ++j) gv[j] = *((const f32x4*)gfin + ((int)(threadIdx.x & 63)) + 64 * j);
    for (int m = gw; m < MTOK; m += NGW) {
        f32x4* hr = (f32x4*)(hout + (size_t)m * DM) + ((int)(threadIdx.x & 63));
        f32x4 v[8];
#pragma unroll
        for (int j = 0; j < 8; ++j) v[j] = hr[64 * j];
#pragma unroll
        for (int k = 0; k < TOPK; ++k) { const int code = tke[m * TOPK + k]; const int e = code & 31, pos = code >> 5; const size_t slot = (size_t)tstart[e] * 256 + pos;
#if MK_YS8
#if MK_YS16
            const int yl_ = (int)(threadIdx.x & 63), ypl_ = ((yl_ >> 3) & 3) * 16 + ((yl_ >> 1) & 3) * 4 + (yl_ >> 5) * 2 + (yl_ & 1);
            const unsigned* yr = (const unsigned*)((const unsigned char*)ys + slot * DM) + ypl_; constexpr float ysc = 1.0f / (float)(1 << FP8_YSHIFT);
#else
            const unsigned* yr = (const unsigned*)((const unsigned char*)ys + slot * DM) + ((int)(threadIdx.x & 63)); constexpr float ysc = 1.0f / (float)(1 << FP8_YSHIFT);
#endif
#pragma unroll
            for (int j = 0; j < 8; ++j) { const unsigned w = yr[64 * j]; const f32x2 lo = __builtin_amdgcn_cvt_pk_f32_fp8((int)w, false), hi = __builtin_amdgcn_cvt_pk_f32_fp8((int)w, true);
                v[j].x += lo.x * ysc; v[j].y += lo.y * ysc; v[j].z += hi.x * ysc; v[j].w += hi.y * ysc; } }
#else
            const u32x2* yr = (const u32x2*)(ys + slot * DM) + ((int)(threadIdx.x & 63));
#pragma unroll
            for (int j = 0; j < 8; ++j) { const u32x2 w = yr[64 * j]; v[j].x += bf2f(w.x & 0xffff); v[j].y += bf2f(w.x >> 16); v[j].z += bf2f(w.y & 0xffff); v[j].w += bf2f(w.y >> 16); } }
#endif
        float s = 0.f;
#pragma unroll
        for (int j = 0; j < 8; ++j) s += (v[j].x * v[j].x + v[j].y * v[j].y) + (v[j].z * v[j].z + v[j].w * v[j].w);
        const float rstd = 1.0f / sqrtf(wave_sum(s) * (1.0f / DM) + EPS);
#pragma unroll
        for (int j = 0; j < 8; ++j) hr[64 * j] = v[j] * gv[j] * rstd;
    }
}
template <bool FOX>
__device__ __forceinline__ att::BlockRef attn_ref(const Frame& F, int L, int pass) {
    const int xcd = L & 7, k = L >> 3, x = k & 7, qb = pass ? 15 - x : x;
    att::BlockRef r;
    if constexpr (FOX) {
        const int bh = xcd * 4 + (k >> 3), b = bh >> 3, h = bh & 7;
        r.Q = (unsigned)WS_QKV + (unsigned)(((24 + h) * MTOK + b * SEQ + qb * 256) * 256); r.K = (unsigned)WS_QKV + (unsigned)(((32 + h) * MTOK + b * SEQ) * 256);
        r.V = (unsigned)WS_QKV + (unsigned)(((40 + h) * MTOK + b * SEQ) * 256); r.O = (unsigned)WS_O + (unsigned)((h * MTOK + b * SEQ + qb * 256) * 256);
        r.clog = (unsigned)WS_CLOG + (unsigned)((b * 8 + h) * SEQ * 4);
        { const float qm2 = __uint_as_float(__hip_atomic_load((unsigned*)(F.ctl + CW_QMAX + bh * 16 + qb), RLX_AGENT)), km2 = __uint_as_float(__hip_atomic_load((unsigned*)(F.ctl + CW_KMAX + bh), RLX_AGENT));
          const float bound = (MK_FUSE_NORMS ? 2.02f : 2.002f) * sqrtf(qm2 * km2) + FOX_SKIP_T;       const float* clg = (const float*)(F.ws + WS_CLOG) + (size_t)(b * 8 + h) * SEQ;
          int lane; asm volatile("v_mbcnt_lo_u32_b32 %0, -1, 0\n\tv_mbcnt_hi_u32_b32 %0, -1, %0" : "=v"(lane));
          const int ntb = qb * 4;
          bool skip = false; if (lane < ntb) skip = (bound + clg[qb * 256] - clg[64 * lane + 63]) <= 0.f;
          r.jlo = (int)__popcll(__ballot(skip)) & ~1; }
    } else {
        const int vhb = xcd * 8 + (k >> 3), b = vhb >> 4, vv = vhb & 15, h = vv >> 2, mp = (vv >> 1) & 1, vhalf = vv & 1;
        r.Q = (unsigned)WS_QKV + (unsigned)(((h * 2 + mp) * MTOK + b * SEQ + qb * 256) * 256); r.K = (unsigned)WS_QKV + (unsigned)(((8 + h * 2 + mp) * MTOK + b * SEQ) * 256);
        r.V = (unsigned)WS_QKV + (unsigned)(((16 + h * 2 + vhalf) * MTOK + b * SEQ) * 256); r.O = (unsigned)WS_O + (unsigned)(((8 + vv) * MTOK + b * SEQ + qb * 256) * 256);
        r.clog = 0u; r.jlo = 0;
    }
    r.P0 = qb * 256;
    return r;
}
template <bool FOX>
__device__ __forceinline__ void attn_run(const Frame& F, char* lds) {
    constexpr int total = FOX ? 256 : 512;
    int L = blockIdx.x; if (L >= total) return;
    int pass = 0; const int stride = F.G;
    att::BlockRef cur = attn_ref<FOX>(F, L, 0);
    att::Seam S;
    att::attn_prime(F.ws, cur, lds, S);
    for (;;) {
        const bool more_pass = pass == 0, more_item = L + stride < total, last = !more_pass && !more_item;
        int passn = pass + 1, Ln = L;
        if (!more_pass) { passn = 0; Ln = more_item ? L + stride : L; }
        const int Lr = last ? L : Ln, pr = last ? pass : passn;
        auto nref = [&F, Lr, pr]() { return attn_ref<FOX>(F, Lr, pr); };
        att::attn_block<FOX>(F.ws, cur, nref, lds, S);
        if (last) break;
        pass = passn; L = Ln; cur = attn_ref<FOX>(F, L, pass);
    }
}

__device__ __forceinline__ att::BlockRefW attn_refW(int L, int pass) {
    const int xcd = L & 7, k = L >> 3, x = k & 7, qb = pass ? 15 - x : x;
    const int bhm = xcd * 4 + (k >> 3), b = bhm >> 3, hm = bhm & 7, h = hm >> 1, mp = hm & 1;
    att::BlockRefW r;
    r.Q = (unsigned)WS_QKV + (unsigned)(((h * 2 + mp) * MTOK + b * SEQ + qb * 256) * 256); r.K = (unsigned)WS_QKV + (unsigned)(((8 + h * 2 + mp) * MTOK + b * SEQ) * 256);
    r.V0 = (unsigned)WS_QKV + (unsigned)(((16 + h * 2) * MTOK + b * SEQ) * 256); r.V1 = (unsigned)WS_QKV + (unsigned)(((17 + h * 2) * MTOK + b * SEQ) * 256);
    r.O0 = (unsigned)WS_O + (unsigned)(((8 + h * 4 + mp * 2) * MTOK + b * SEQ + qb * 256) * 256); r.O1 = (unsigned)WS_O + (unsigned)(((9 + h * 4 + mp * 2) * MTOK + b * SEQ + qb * 256) * 256);
    r.P0 = qb * 256;
    return r;
}
__device__ __forceinline__ void attn_runW(const Frame& F, char* lds) {
    constexpr int total = 256;
    int L = blockIdx.x; if (L >= total) return;
    int pass = 0; const int stride = F.G;
    att::BlockRefW cur = attn_refW(L, 0);
    att::SeamW S;
    att::attn_primeW(F.ws, cur, lds, S);
    for (;;) {
        const bool more_pass = pass == 0, more_item = L + stride < total, last = !more_pass && !more_item;
        int passn = pass + 1, Ln = L;
        if (!more_pass) { passn = 0; Ln = more_item ? L + stride : L; }
        const int Lr = last ? L : Ln, pr = last ? pass : passn;
        auto nref = [Lr, pr]() { return attn_refW(Lr, pr); };
        att::attn_blockW(F.ws, cur, nref, lds, S);
        if (last) break;
        pass = passn; L = Ln; cur = attn_refW(L, pass);
    }
}

constexpr int NPHASE = 10;
#ifndef MK_BAL
#define MK_BAL 1
#endif
constexpr int MOE_RB = MK_FP8 ? DM : DM * 2;
#ifndef MK_ATT_MASK
#define MK_ATT_MASK 3
#endif
#ifndef MK_DIFFW
#define MK_DIFFW 1
#endif
#ifndef MK_KREP_LOG
#define MK_KREP_LOG 0
#endif
#ifndef MK_KROT
#define MK_KROT 0
#endif
#define MOE_ROT(c, nt) (MK_KROT ? (int)((((((c) >> 3) >> 2) * ((nt) / 8)) + ((((c) >> 3) & 3) * ((nt) / 4))) & ((nt) - 1)) : 0)
#ifndef MK_OVERLAP
#define MK_OVERLAP 1
#endif
#ifndef MK_P1_S1
#define MK_P1_S1 0.46
#define MK_P1_S2 0.86
#define MK_P3_S0 0.30
#define MK_P3_S1 0.60
#define MK_P3_S2 0.85
#endif
constexpr int CW_DYN = 48;
__device__ __forceinline__ void p0b_tail(Frame& F, KArgs ka, const int lo, const int hi, unsigned* ctr) {
    volatile LAS unsigned* M = (volatile LAS unsigned*)(F.lds + LDS_MISC);
    for (;;) {
        __syncthreads();
        if (threadIdx.x == 0) M[26] = __hip_atomic_fetch_add(ctr, 1u, __ATOMIC_RELAXED, __HIP_MEMORY_SCOPE_AGENT);
        __syncthreads();
        const int base = lo + 32 * (int)__builtin_amdgcn_readfirstlane((int)M[26]);
        if (base >= hi) break;
        p0b_experts(F, ka, base, base + 32 < hi ? base + 32 : hi, F.wave, NWAVES, nullptr);
    }
}
__device__ __forceinline__ void ph1(Frame& F, KArgs ka) {
#if MK_FP8 && MK_OVERLAP
    const int bx = (int)blockIdx.x, grp = (bx >> 3) & 1;
    const int rw = (((bx & 7) * 16 + (bx >> 4)) * NWAVES) + F.wave, nw = (F.G / 2) * NWAVES;
    constexpr int X1 = (int)(P0B_IGU * MK_P1_S1), X2 = (int)(P0B_IGU * MK_P1_S2);
    if (grp == 1) p0b_experts(F, ka, 0, X1, rw, nw, nullptr);
#endif
    p1_scan(F);
    pg8::DenseOrder S; S.init((const bf16_t*)(F.ws + WS_XN), (const bf16_t*)(F.ws + WS_WIN), MTOK, NQKV, DM * 2, F.G, (int)blockIdx.x);
    pg8::EpiQKV E{(bf16_t*)(F.ws + WS_QKV), (const float*)(F.ws + WS_ROPE), (unsigned*)F.ctl, (LAS float*)(F.lds + RING_BYTES + 2048)};
    pg8::gemm_phase<pg8::EpiQKV, pg8::DenseOrder, false>(F.lds, F.lds + LDS_IDX, DM * 2, S, E);
#if MK_FP8 && MK_OVERLAP
    if (grp == 0) p0b_experts(F, ka, X1, X2, rw, nw, nullptr);
    if constexpr (X2 < P0B_IGU) p0b_tail(F, ka, X2, P0B_IGU, (unsigned*)F.ctl + CW_DYN);
#endif
}
__device__ __forceinline__ void ph2(Frame& F, KArgs ka, char* lds) {
#if MK_FP8 && MK_OVERLAP
    const int bx = (int)blockIdx.x, j = bx >> 3, cshift = j % 3, ng = cshift < 2 ? 11 : 10;
    const int rw = (((bx & 7) * ng + j / 3) * NWAVES) + F.wave, nw = 8 * ng * NWAVES;
    constexpr int L = P0B_NI - P0B_IGU, Y0 = P0B_IGU + (int)(L * MK_P3_S0), Y1 = P0B_IGU + (int)(L * MK_P3_S1), Y2 = P0B_IGU + (int)(L * MK_P3_S2);
    if (cshift == 0) p0b_experts(F, ka, P0B_IGU, Y0, rw, nw, nullptr);
#endif
    if (MK_ATT_MASK & 1) attn_run<true>(F, lds);
    __syncthreads();
#if MK_FP8 && MK_OVERLAP
    if (cshift == 1) p0b_experts(F, ka, Y0, Y1, rw, nw, nullptr);
#endif
#if MK_DIFFW
    if (MK_ATT_MASK & 2) attn_runW(F, lds);
#else
    if (MK_ATT_MASK & 2) attn_run<false>(F, lds);
#endif
#if MK_FP8 && MK_OVERLAP
    if (cshift == 2) p0b_experts(F, ka, Y1, Y2, rw, nw, nullptr);
    if constexpr (Y2 < P0B_NI) p0b_tail(F, ka, Y2, P0B_NI, (unsigned*)F.ctl + CW_DYN + 1);
#endif
}
__device__ __forceinline__ void ph4(Frame& F, KArgs ka, float* hbuf) {
    pg8::DenseOrder S; S.init((const bf16_t*)(F.ws + WS_MIX), (const bf16_t*)(F.ws + WS_WOUT), MTOK, DM, DM * 2, F.G, (int)blockIdx.x);
    pg8::EpiOut E{(const float*)KIN(0), hbuf, (bf16_t*)(F.ws + WS_HG), (const float*)KIN(12)};
    pg8::gemm_phase<pg8::EpiOut, pg8::DenseOrder, false, false, 127, 127, 1, false, false, (MK_XINIT != 0)>(F.lds, F.lds + LDS_IDX, DM * 2, S, E);
}
__device__ __forceinline__ void ph6(Frame& F, KArgs ka, LAS int* tab) {
    build_tab(F, tab, true);
    pg8::MoeOrder S; S.A = (const void*)(F.ws + WS_HG); S.Bt = (const void*)(F.ws + WS_WGU); S.RB = MOE_RB; S.nN = 16; S.NperE = 4096; S.G = F.G; S.c = (int)blockIdx.x; S.rot = MOE_ROT(blockIdx.x, MOE_RB / 128); S.tab = tab; S.tok = (const int*)(F.ws + WS_TOK);
    pg8::EpiGU E{(bf16_t*)(F.ws + WS_HDN), (const float*)KIN(16), (const float*)KIN(18), (const float*)(F.ws + WS_RSTD), tab, (const LAS float*)(F.lds + LDS_IDX + 2048)}; S.rowsc = (const float*)(F.ws + WS_RSTD); S.bA = (const float*)KIN(16); S.bB = (const float*)KIN(18); S.bcols = 128;
    pg8::gemm_phase<pg8::EpiGU, pg8::MoeOrder, true, MK_FP8 != 0, 127 - FP8_WSHIFT - MK_KREP_LOG, 127 - FP8_HGSHIFT, (1 << MK_KREP_LOG), (MK_FP8 != 0 && MK_FP6 != 0), (MK_BAL != 0)>(F.lds, F.lds + LDS_IDX, MOE_RB, S, E);
}
__device__ __forceinline__ void ph7(Frame& F, KArgs ka, LAS int* tab) {
    build_tab(F, tab, false);
    pg8::MoeOrderDense S; S.A = (const void*)(F.ws + WS_HDN); S.Bt = (const void*)(F.ws + WS_WD); S.RB = MOE_RB; S.nN = 8; S.NperE = 2048; S.G = F.G; S.c = (int)blockIdx.x; S.rot = MOE_ROT(blockIdx.x, MOE_RB / 128); S.tab = tab; S.tok = nullptr;
    pg8::EpiDown E{(bf16_t*)(F.ws + WS_YS), (const float*)KIN(20), (const float*)(F.ws + WS_GATE), tab, (const LAS float*)(F.lds + LDS_IDX + 2048)}; S.rowsc = (const float*)(F.ws + WS_GATE); S.bA = (const float*)KIN(20); S.bB = (const float*)KIN(20) + 128; S.bcols = 256;
    pg8::gemm_phase<pg8::EpiDown, pg8::MoeOrderDense, false, MK_FP8 != 0, 127 - FP8_WSHIFT - MK_KREP_LOG, 127 - FP8_HDSHIFT, (1 << MK_KREP_LOG), (MK_FP8 != 0 && MK_FP6 != 0), (MK_BAL != 0)>(F.lds, F.lds + LDS_IDX, MOE_RB, S, E);
}
__device__ __forceinline__ Frame make_frame(KArgs ka, LAS unsigned char* lds) {
    Frame F; F.lds = lds; F.wave = __builtin_amdgcn_readfirstlane(((int)threadIdx.x) >> 6);
    F.G = gridDim.x; { const int bx = blockIdx.x; F.vcu = (F.G % 8 == 0) ? (bx % 8) * (F.G / 8) + bx / 8 : bx; }
    unsigned char* ws = ka->ws; F.ws = ws; F.ctl = (gu32*)(ws + WS_CTL);
    return F;
}
__global__ void __launch_bounds__(NTHREADS, 2) mk_fwd(Args args) {
    extern __shared__ __attribute__((aligned(16))) unsigned char lds[];
    const KArgs ka = (KArgs)__builtin_amdgcn_kernarg_segment_ptr();
    { volatile LAS unsigned* MISC = (volatile LAS unsigned*)((LAS unsigned char*)lds + LDS_MISC);
      if (((int)threadIdx.x) < 32) MISC[((int)threadIdx.x)] = 0u;
      __syncthreads();
      if (ka->ph_hi - ka->ph_lo > 1) (void)xcd_barrier_post((unsigned*)((gu32*)(ka->ws + WS_CTL) + CW_BAR), MISC + 8); }
#ifndef MK_PHASE_MASK
#define MK_PHASE_MASK 0x3FF
#endif
#ifndef MK_REP_PHASE
#define MK_REP_PHASE -1
#endif
#define IN(k) ((((MK_PHASE_MASK) >> (k)) & 1) && ka->ph_lo <= (k) && (k) < ka->ph_hi)
#define GRIDBAR() do { XcdBarrier b_; b_.bar = (unsigned*)((gu32*)(ka->ws + WS_CTL) + CW_BAR); b_.x = xb_xcc_id(); b_.st = (volatile LAS unsigned*)((LAS unsigned char*)lds + LDS_MISC) + 8; xcd_barrier(b_); } while (0)
#ifdef MK_STAMP
#define SEAM(k) do { if (IN(k) && IN((k) + 1)) { unsigned long long ta_ = 0; if (threadIdx.x == 0) ta_ = wall_clock64(); GRIDBAR(); \
        if (threadIdx.x == 0) { const unsigned d_ = (unsigned)(wall_clock64() - ta_); atomicMax((unsigned*)((gu32*)(ka->ws + WS_CTL)) + 192 + (k), 0xffffffffu - d_); } } } while (0)
#else
#define SEAM(k) do { if (IN(k) && IN((k) + 1)) GRIDBAR(); } while (0)
#endif
#ifdef MK_STAMP
#ifndef MK_STAMP_GRP
#define MK_STAMP_GRP 0
#endif
#if MK_STAMP_GRP == 1
#define ST_GRP(k) ((int)(blockIdx.x & 7))
#elif MK_STAMP_GRP == 2
#define ST_GRP(k) ((int)(blockIdx.x < 32))
#else
#define ST_GRP(k) ((k) == 1 ? (int)((blockIdx.x >> 3) & 1) : (k) == 3 ? (int)((blockIdx.x >> 3) % 3) : 0)
#endif
#define RUN(k, CALL) do { if (IN(k)) { if (threadIdx.x == 0) { const unsigned long long t_ = wall_clock64(); volatile LAS unsigned* M_ = (volatile LAS unsigned*)((LAS unsigned char*)lds + LDS_MISC); M_[24] = (unsigned)t_; M_[25] = (unsigned)(t_ >> 32); } \
        { Frame F = make_frame(ka, (LAS unsigned char*)lds); LAS int* tab = (LAS int*)(F.lds + LDS_TAB); float* hbuf = ka->out; (void)tab; (void)hbuf; CALL; } \
        __syncthreads(); \
        if (threadIdx.x == 0) { volatile LAS unsigned* M_ = (volatile LAS unsigned*)((LAS unsigned char*)lds + LDS_MISC); const unsigned long long t0_ = (unsigned long long)M_[24] | ((unsigned long long)M_[25] << 32); \
            const unsigned d_ = (unsigned)(wall_clock64() - t0_); unsigned* c_ = (unsigned*)((gu32*)(ka->ws + WS_CTL)); atomicMax(c_ + 64 + (k), d_); atomicAdd(c_ + 80 + (k), d_); atomicAdd(c_ + 96 + 8 * (k) + ST_GRP(k), d_); } } } while (0)
#else
#define RUN(k, CALL) do { if (IN(k)) { Frame F = make_frame(ka, (LAS unsigned char*)lds); LAS int* tab = (LAS int*)(F.lds + LDS_TAB); float* hbuf = ka->out; (void)tab; (void)hbuf; CALL; \
        if (MK_REP_PHASE == (k)) { GRIDBAR(); CALL; } } } while (0)
#endif
#if MK_FP8 && !MK_OVERLAP
    RUN(0, (p0_prologue(F, ka), p0b_experts(F, ka, 0, P0B_NI, F.vcu * NWAVES + F.wave, F.G * NWAVES, nullptr)));
#else
    RUN(0, p0_prologue(F, ka));
#endif
#ifdef MK_PROBE_STREAM
    if (IN(0)) { GRIDBAR(); Frame F = make_frame(ka, (LAS unsigned char*)lds); probe_stream(F, ka); }
#endif
    SEAM(0);
    RUN(1, ph1(F, ka)); SEAM(1);
#if MK_FUSE_NORMS
#else
    RUN(2, p_norms(F)); SEAM(2);
#endif
    RUN(3, ph2(F, ka, (char*)lds)); SEAM(3);
    RUN(4, p3_mix(F, ka)); SEAM(4);
    RUN(5, ph4(F, ka, hbuf)); SEAM(5);
    RUN(6, p5_router(F, ka, hbuf)); SEAM(6);
    RUN(7, ph6(F, ka, tab)); SEAM(7);
    RUN(8, ph7(F, ka, tab)); SEAM(8);
    RUN(9, p8_final(F, ka, hbuf));
#ifdef MK_STAMP
    GRIDBAR();
    if (blockIdx.x == 0 && threadIdx.x == 0) { unsigned* c_ = (unsigned*)((gu32*)(ka->ws + WS_CTL)); constexpr int K_ = (MK_STAMP_SEL) / 100, J_ = (MK_STAMP_SEL) % 100;
        const float mx = 0.01f * (float)__hip_atomic_load(c_ + 64 + K_, __ATOMIC_RELAXED, __HIP_MEMORY_SCOPE_AGENT), mean = 0.01f * (float)__hip_atomic_load(c_ + 80 + K_, __ATOMIC_RELAXED, __HIP_MEMORY_SCOPE_AGENT) / (float)gridDim.x;
        float v;
        if (J_ == 0) v = mx; else if (J_ == 1) v = mx - mean; else if (J_ == 2) v = mean;
        else if (J_ == 70) v = 0.01f * (float)(0xffffffffu - __hip_atomic_load(c_ + 192 + K_, __ATOMIC_RELAXED, __HIP_MEMORY_SCOPE_AGENT));
        else if (J_ == 60 || J_ == 61) { float hi = 0.f, lo = 1e9f; for (int g = 0; g < 8; ++g) { const float m = 0.01f * (float)__hip_atomic_load(c_ + 96 + 8 * K_ + g, __ATOMIC_RELAXED, __HIP_MEMORY_SCOPE_AGENT) / 32.f; hi = m > hi ? m : hi; lo = m < lo ? m : lo; }
            v = J_ == 60 ? hi - mean : mean - lo; }
        else if (J_ == 62 || J_ == 63) { const float ms = 0.01f * (float)__hip_atomic_load(c_ + 96 + 8 * K_ + 1, __ATOMIC_RELAXED, __HIP_MEMORY_SCOPE_AGENT) / 32.f, mr = 0.01f * (float)__hip_atomic_load(c_ + 96 + 8 * K_ + 0, __ATOMIC_RELAXED, __HIP_MEMORY_SCOPE_AGENT) / 224.f;
            v = J_ == 62 ? ms - mr : mr - ms; v = v > 0.f ? v : 0.f; }
        else { constexpr int A_ = (J_ - 3) / 10, B_ = (J_ - 3) % 10; const float na = (K_ == 1) ? 128.f : (K_ == 3 ? (A_ == 2 ? 80.f : 88.f) : 256.f), nb = (K_ == 1) ? 128.f : (K_ == 3 ? (B_ == 2 ? 80.f : 88.f) : 256.f);
            const float ga = 0.01f * (float)__hip_atomic_load(c_ + 96 + 8 * K_ + A_, __ATOMIC_RELAXED, __HIP_MEMORY_SCOPE_AGENT) / na, gb = 0.01f * (float)__hip_atomic_load(c_ + 96 + 8 * K_ + B_, __ATOMIC_RELAXED, __HIP_MEMORY_SCOPE_AGENT) / nb;
            v = ga - gb; v = v > 0.f ? v : 0.f; }
#ifndef MK_STAMP_Q
#define MK_STAMP_Q 8.0f
#endif
        if (J_ == 0 || J_ == 2) v = MK_STAMP_Q * floorf(v / MK_STAMP_Q + 0.5f);
        ka->out[0] = v + 10.0f; }
#endif
#undef IN
#undef SEAM
#undef RUN
#undef GRIDBAR
}

#ifndef MK_N_LAUNCHES
#define MK_N_LAUNCHES 1
#endif
extern "C" void kernel_launch(void* const* d_in, const int* in_sizes, int n_in, void* d_out, int out_size, void* d_ws, size_t ws_size, hipStream_t stream) {
    static int grid = 0;
    if (grid == 0) {
        if (n_in != 22 || in_sizes[0] != MTOK * DM || out_size != MTOK * DM || ws_size < WS_END) {
            fprintf(stderr, "kernel_launch: unexpected shapes (n_in %d, in0 %d, out %d, ws %zu; need ws >= %zu); nothing launched\n", n_in, n_in > 0 ? in_sizes[0] : -1, out_size, ws_size, (size_t)WS_END); grid = -1; return; }
        int dev = 0, cus = 0, per_cu = 0;
        if (hipGetDevice(&dev) != hipSuccess || hipDeviceGetAttribute(&cus, hipDeviceAttributeMultiprocessorCount, dev) != hipSuccess) { fprintf(stderr, "kernel_launch: device query failed\n"); grid = -1; return; }
        if (hipFuncSetAttribute((const void*)mk_fwd, hipFuncAttributeMaxDynamicSharedMemorySize, LDS_BYTES) != hipSuccess) { fprintf(stderr, "kernel_launch: hipFuncSetAttribute failed\n"); grid = -1; return; }
        if (hipOccupancyMaxActiveBlocksPerMultiprocessor(&per_cu, (const void*)mk_fwd, NTHREADS, LDS_BYTES) != hipSuccess || per_cu < 1)
            fprintf(stderr, "kernel_launch: note: occupancy query reports %d workgroups per CU\n", per_cu);
        (void)hipGetLastError();
        grid = 1; while (grid * 2 <= cus && grid < 256) grid *= 2;
    }
    if (grid < 0) return;
    if (hipMemsetAsync((char*)d_ws + WS_CTL, 0, CTL_ZERO_BYTES, stream) != hipSuccess) { fprintf(stderr, "kernel_launch: memset failed\n"); return; }
    Args a{};
    for (int i = 0; i < 22; ++i) a.in[i] = d_in[i];
    a.out = (float*)d_out; a.ws = (unsigned char*)d_ws;
    if (MK_N_LAUNCHES == 1) { a.ph_lo = 0; a.ph_hi = NPHASE; hipLaunchKernelGGL(mk_fwd, dim3(grid), dim3(NTHREADS), LDS_BYTES, stream, a); }
    else for (int p = 0; p < NPHASE; ++p) { a.ph_lo = p; a.ph_hi = p + 1; hipLaunchKernelGGL(mk_fwd, dim3(grid), dim3(NTHREADS), LDS_BYTES, stream, a); }
#ifdef MK_EXTRA_PHASE
    a.ph_lo = MK_EXTRA_PHASE; a.ph_hi = MK_EXTRA_PHASE + 1; hipLaunchKernelGGL(mk_fwd, dim3(grid), dim3(NTHREADS), LDS_BYTES, stream, a);
#endif
    const hipError_t le = hipPeekAtLastError();
    if (le != hipSuccess) fprintf(stderr, "kernel_launch: launch failed: %s\n", hipGetErrorName(le));
}
```
